# Optimizing an MI355X kernel written in HIP

```python
import jax
import jax.numpy as jnp
from jax import lax
import numpy as np

D_MODEL = 1024
BATCH = 32
SEQ = 256
DEPTH = 2
DEC_BATCH = 2
DEC_SEQ = 2048
PAST_LEN = 512

GRID_W = 64
N_BRANCH = 4
BRANCH_W = 256
MLA_HEADS = 4
MLA_Q_LORA = 256
MLA_KV_LORA = 128
MLA_NOPE = 64
MLA_ROPE = 32
MLA_V = 64
MLA_SCALE = (MLA_NOPE + MLA_ROPE) ** -0.5
FNET_GROUPS = 4
FNET_CH = BRANCH_W // FNET_GROUPS
GLA_HEADS = 4
GLA_DK = 32
GLA_DV = 64
GLA_GATE_RANK = 16
GLA_TAU = 16.0
GLA_CHUNK = 64
SWA_HEADS = 4
SWA_KV_HEADS = 2
SWA_GROUP = SWA_HEADS // SWA_KV_HEADS
SWA_HEAD_DIM = 64
SWA_WINDOW = 128
SWA_SCALE = SWA_HEAD_DIM ** -0.5
ATTN_BLOCK = 128
PEER_HEADS = 8
PEER_N_KEYS = 128
PEER_N_EXPERTS = PEER_N_KEYS * PEER_N_KEYS
PEER_KEY_DIM = 256
PEER_HALF = PEER_KEY_DIM // 2
PEER_TOPK = 16
PEER_TOKEN_BLOCK = 128

ROPE_THETA = 10000.0
NORM_EPS = 1e-6
DEEPNORM_ALPHA = (2.0 * DEPTH) ** 0.25
DEEPNORM_BETA = (8.0 * DEPTH) ** -0.25

IN_SPLITS = (
    ('mla_q', MLA_Q_LORA),
    ('mla_kv', MLA_KV_LORA + MLA_ROPE),
    ('fnet', BRANCH_W),
    ('gla_q', GLA_HEADS * GLA_DK),
    ('gla_k', GLA_HEADS * GLA_DK),
    ('gla_v', GLA_HEADS * GLA_DV),
    ('gla_g', BRANCH_W),
    ('gla_af', GLA_GATE_RANK),
    ('gla_ab', GLA_GATE_RANK),
    ('swa_q', SWA_HEADS * SWA_HEAD_DIM),
    ('swa_k', SWA_KV_HEADS * SWA_HEAD_DIM),
    ('swa_v', SWA_KV_HEADS * SWA_HEAD_DIM),
    ('gates', N_BRANCH * D_MODEL),
)
IN_NAMES = tuple(n for n, _ in IN_SPLITS)
IN_OFFSETS = tuple(int(o) for o in np.cumsum([w for _, w in IN_SPLITS])[:-1])
IN_WIDTH = int(sum(w for _, w in IN_SPLITS))

kernel_name = 'hybrid_diffusion_mla_fnet_gla_swa_peer_step'


def layer_norm(x, g=None, b=None):
    xf = x.astype(jnp.float32)
    mu = jnp.mean(xf, -1, keepdims=True)
    var = jnp.mean(jnp.square(xf - mu), -1, keepdims=True)
    y = (xf - mu) * lax.rsqrt(var + NORM_EPS)
    if g is not None:
        y = y * g.astype(jnp.float32) + b.astype(jnp.float32)
    return y.astype(x.dtype)


def rms_norm(x, g):
    xf = x.astype(jnp.float32)
    y = xf * lax.rsqrt(jnp.mean(xf * xf, -1, keepdims=True) + NORM_EPS) * g.astype(jnp.float32)
    return y.astype(x.dtype)


def axial_rope(x):
    n = x.shape[-2]
    half = x.shape[-1] // 2
    t = jnp.arange(n)
    rows = (t // GRID_W).astype(jnp.float32)
    cols = (t % GRID_W).astype(jnp.float32)
    freqs = ROPE_THETA ** (-jnp.arange(0, half, 2, dtype=jnp.float32) / half)

    def rot(xa, pos):
        ang = pos[:, None] * freqs[None, :]
        cos, sin = jnp.cos(ang), jnp.sin(ang)
        x1, x2 = xa[..., :half // 2], xa[..., half // 2:]
        return jnp.concatenate([x1 * cos - x2 * sin, x2 * cos + x1 * sin], -1)

    xf = x.astype(jnp.float32)
    return jnp.concatenate([rot(xf[..., :half], rows), rot(xf[..., half:], cols)], -1).astype(x.dtype)


def softmax_with_sink(s, sink):
    if sink is None:
        return jax.nn.softmax(s, -1)
    s_all = jnp.concatenate([s, jnp.broadcast_to(sink, s[..., :1].shape)], -1)
    return jax.nn.softmax(s_all, -1)[..., :-1]


def dense_attention(q, k, v, scale, sink=None):
    b, hk, g, sq, dk = q.shape
    nb = sq // ATTN_BLOCK
    qb = jnp.moveaxis(q.reshape(b, hk, g, nb, ATTN_BLOCK, dk), 3, 0)
    sink_b = None if sink is None else sink.astype(jnp.float32)[None, :, :, None, None]

    def one_block(qi):
        s = jnp.einsum('bhgqd,bhkd->bhgqk', qi, k, preferred_element_type=jnp.float32) * scale
        p = softmax_with_sink(s, sink_b)
        return jnp.einsum('bhgqk,bhkd->bhgqd', p.astype(v.dtype), v)

    o = lax.map(one_block, qb)
    return jnp.moveaxis(o, 0, 3).reshape(b, hk, g, sq, v.shape[-1])


def windowed_attention(q, k, v, k_ctx, v_ctx, sink):
    b, hk, g, s, dh = q.shape
    blk = SWA_WINDOW
    nb = s // blk
    qb = q.reshape(b, hk, g, nb, blk, dh)

    def band(x):
        xp = jnp.pad(x, ((0, 0), (0, 0), (blk, blk), (0, 0))).reshape(b, hk, nb + 2, blk, x.shape[-1])
        return jnp.concatenate([xp[:, :, :-2], xp[:, :, 1:-1], xp[:, :, 2:]], axis=3)

    kb, vb = band(k), band(v)
    qpos = jnp.arange(nb)[:, None] * blk + jnp.arange(blk)[None, :]
    kpos = (jnp.arange(nb)[:, None] - 1) * blk + jnp.arange(3 * blk)[None, :]
    rel = kpos[:, None, :] - qpos[:, :, None]
    valid = (jnp.abs(rel) <= SWA_WINDOW) & (kpos[:, None, :] >= 0) & (kpos[:, None, :] < s)
    s_band = jnp.einsum('bhgnqd,bhnkd->bhgnqk', qb, kb, preferred_element_type=jnp.float32) * SWA_SCALE
    s_band = jnp.where(valid, s_band, -jnp.inf)
    s_ctx = jnp.einsum('bhgnqd,bhld->bhgnql', qb, k_ctx, preferred_element_type=jnp.float32) * SWA_SCALE
    p = softmax_with_sink(jnp.concatenate([s_band, s_ctx], -1),
                          sink.astype(jnp.float32)[None, :, :, None, None, None])
    p_band, p_ctx = p[..., :3 * blk], p[..., 3 * blk:]
    o = (jnp.einsum('bhgnqk,bhnkd->bhgnqd', p_band.astype(v.dtype), vb)
         + jnp.einsum('bhgnql,bhld->bhgnqd', p_ctx.astype(v.dtype), v_ctx))
    return o.reshape(b, hk, g, s, dh)


def gla_scan(q, k, v, log_a, s0):
    b, s, h, dk = q.shape
    dv = v.shape[-1]
    n = s // GLA_CHUNK
    f32 = jnp.float32
    qc, kc, vc, ac = [t.astype(f32).reshape(b, n, GLA_CHUNK, h, t.shape[-1]) for t in (q, k, v, log_a)]
    cum = jnp.cumsum(ac, axis=2)
    causal = jnp.tril(jnp.ones((GLA_CHUNK, GLA_CHUNK), dtype=bool))
    decay = jnp.exp(jnp.minimum(cum[:, :, :, None] - cum[:, :, None, :], 0.0))
    att = jnp.sum(qc[:, :, :, None] * kc[:, :, None, :] * decay, -1)
    att = jnp.where(causal[:, :, None], att, 0.0)
    o_intra = jnp.einsum('bntsh,bnshv->bnthv', att, vc)
    last = cum[:, :, -1:]
    u = jnp.einsum('bnshk,bnshv->bnhkv', kc * jnp.exp(last - cum), vc)
    g = jnp.exp(last[:, :, 0])

    def step(state, xs):
        g_n, u_n = xs
        return g_n[..., None] * state + u_n, state

    s_final, s_in = lax.scan(step, s0.astype(f32), (jnp.moveaxis(g, 1, 0), jnp.moveaxis(u, 1, 0)))
    s_in = jnp.moveaxis(s_in, 0, 1)
    o_inter = jnp.einsum('bnthk,bnhkv->bnthv', qc * jnp.exp(cum), s_in)
    return (o_intra + o_inter).reshape(b, s, h, dv).astype(v.dtype), s_final.astype(v.dtype)


def gla_bidirectional(parts, lp, s0_fwd, s0_bwd):
    b, s, _ = parts['gla_q'].shape
    q = parts['gla_q'].reshape(b, s, GLA_HEADS, GLA_DK) * (GLA_DK ** -0.5)
    k = parts['gla_k'].reshape(b, s, GLA_HEADS, GLA_DK)
    v = parts['gla_v'].reshape(b, s, GLA_HEADS, GLA_DV)

    def log_decay(a_low, w2, b2):
        z = (a_low @ w2 + b2).astype(jnp.float32)
        return (jax.nn.log_sigmoid(z) / GLA_TAU).reshape(b, s, GLA_HEADS, GLA_DK)

    la_f = log_decay(parts['gla_af'], lp['w_gla_a_fwd'], lp['b_gla_a_fwd'])
    la_b = log_decay(parts['gla_ab'], lp['w_gla_a_bwd'], lp['b_gla_a_bwd'])
    o_f, s_f = gla_scan(q, k, v, la_f, s0_fwd)
    flip = lambda t: jnp.flip(t, axis=1)
    o_b, s_b = gla_scan(flip(q), flip(k), flip(v), flip(la_b), s0_bwd)
    o = rms_norm(o_f + flip(o_b), lp['gla_norm']).reshape(b, s, BRANCH_W)
    return o * jax.nn.silu(parts['gla_g']), s_f, s_b


def fourier_mix(f):
    b, s, _ = f.shape
    fg = f.astype(jnp.float32).reshape(b, s, FNET_GROUPS, FNET_CH)
    return jnp.fft.fft2(fg, axes=(1, 3), norm='ortho').real.reshape(b, s, BRANCH_W).astype(f.dtype)


def mla_project(parts, lp, positional):
    b, s, _ = parts['mla_q'].shape
    q = (rms_norm(parts['mla_q'], lp['mla_q_norm']) @ lp['w_uq'])
    q = q.reshape(b, s, MLA_HEADS, MLA_NOPE + MLA_ROPE).transpose(0, 2, 1, 3)
    q_nope, q_rope = q[..., :MLA_NOPE], q[..., MLA_NOPE:]
    ckv = rms_norm(parts['mla_kv'][..., :MLA_KV_LORA], lp['mla_kv_norm'])
    k_rope = parts['mla_kv'][..., MLA_KV_LORA:]
    if positional:
        q_rope = axial_rope(q_rope)
        k_rope = axial_rope(k_rope)
    return jnp.concatenate([q_nope, q_rope], -1), ckv, k_rope


def mla_expand(ckv, k_rope, w_ukv):
    b, s, _ = ckv.shape
    kv = (ckv @ w_ukv).reshape(b, s, MLA_HEADS, MLA_NOPE + MLA_V).transpose(0, 2, 1, 3)
    k_nope, v = kv[..., :MLA_NOPE], kv[..., MLA_NOPE:]
    k = jnp.concatenate([k_nope, jnp.broadcast_to(k_rope[:, None], (b, MLA_HEADS, s, MLA_ROPE))], -1)
    return k, v


def mla_attend(q, k, v):
    o = dense_attention(q[:, :, None], k, v, MLA_SCALE)[:, :, 0]
    b, h, s, dv = o.shape
    return o.transpose(0, 2, 1, 3).reshape(b, s, h * dv)


def swa_project(parts, positional):
    b, s, _ = parts['swa_q'].shape
    q = parts['swa_q'].reshape(b, s, SWA_KV_HEADS, SWA_GROUP, SWA_HEAD_DIM).transpose(0, 2, 3, 1, 4)
    k = parts['swa_k'].reshape(b, s, SWA_KV_HEADS, SWA_HEAD_DIM).transpose(0, 2, 1, 3)
    v = parts['swa_v'].reshape(b, s, SWA_KV_HEADS, SWA_HEAD_DIM).transpose(0, 2, 1, 3)
    if positional:
        q = axial_rope(q)
        k = axial_rope(k)
    return q, k, v


def swa_merge_heads(o):
    b, hk, g, s, dh = o.shape
    return o.transpose(0, 3, 1, 2, 4).reshape(b, s, hk * g * dh)


def merge_branches(branches, gates, lp):
    b, s = branches.shape[:2]
    proj = jnp.einsum('bsnc,ncd->bsnd', branches, lp['w_branch'])
    g = jax.nn.sigmoid(gates.reshape(b, s, N_BRANCH, D_MODEL))
    return jnp.sum(g * proj, axis=2) @ lp['w_out']


def context_mixer(u, lp):
    b, s, _ = u.shape
    parts = dict(zip(IN_NAMES, jnp.split(u @ lp['w_in'], IN_OFFSETS, axis=-1)))
    q_a, ckv, k_rope = mla_project(parts, lp, positional=False)
    k_a, v_a = mla_expand(ckv, k_rope, lp['w_ukv'])
    o_a = mla_attend(q_a, k_a, v_a)
    o_b = fourier_mix(parts['fnet'])
    zero = jnp.zeros((b, GLA_HEADS, GLA_DK, GLA_DV), jnp.float32)
    o_c, s_f, s_b = gla_bidirectional(parts, lp, zero, zero)
    q_d, k_d, v_d = swa_project(parts, positional=False)
    o_d = swa_merge_heads(dense_attention(q_d, k_d, v_d, SWA_SCALE,
                                          lp['swa_sink'].reshape(SWA_KV_HEADS, SWA_GROUP)))
    mix = merge_branches(jnp.stack([o_a, o_b, o_c, o_d], axis=2), parts['gates'], lp)
    return mix, (ckv, k_rope, k_d, v_d, jnp.stack([s_f, s_b], axis=1))


def latent_mixer(u, lp, cache):
    ckv_c, krope_c, k_ctx, v_ctx, gla_state = cache
    parts = dict(zip(IN_NAMES, jnp.split(u @ lp['w_in'], IN_OFFSETS, axis=-1)))
    q_a, ckv, k_rope = mla_project(parts, lp, positional=True)
    k_lat, v_lat = mla_expand(ckv, k_rope, lp['w_ukv'])
    k_c, v_c = mla_expand(ckv_c, krope_c, lp['w_ukv'])
    o_a = mla_attend(q_a, jnp.concatenate([k_c, k_lat], axis=2), jnp.concatenate([v_c, v_lat], axis=2))
    o_b = fourier_mix(parts['fnet'])
    o_c, _, _ = gla_bidirectional(parts, lp, gla_state[:, 0], gla_state[:, 1])
    q_d, k_d, v_d = swa_project(parts, positional=True)
    o_d = swa_merge_heads(windowed_attention(q_d, k_d, v_d, k_ctx, v_ctx,
                                             lp['swa_sink'].reshape(SWA_KV_HEADS, SWA_GROUP)))
    return merge_branches(jnp.stack([o_a, o_b, o_c, o_d], axis=2), parts['gates'], lp)


def peer(u, lp):
    b, s, d = u.shape
    t = b * s
    xt = u.reshape(t, d)
    q = (xt @ lp['w_peer_q']).reshape(t, PEER_HEADS, 2, PEER_HALF)
    sc = jnp.einsum('thpc,hpkc->thpk', q, lp['peer_keys'], preferred_element_type=jnp.float32)
    v1, i1 = lax.top_k(sc[:, :, 0], PEER_TOPK)
    v2, i2 = lax.top_k(sc[:, :, 1], PEER_TOPK)
    cand = (v1[..., :, None] + v2[..., None, :]).reshape(t, PEER_HEADS, PEER_TOPK * PEER_TOPK)
    cidx = (i1[..., :, None] * PEER_N_KEYS + i2[..., None, :]).reshape(t, PEER_HEADS, PEER_TOPK * PEER_TOPK)
    top, pos = lax.top_k(cand, PEER_TOPK)
    idx = jnp.take_along_axis(cidx, pos, axis=-1)
    w = jax.nn.softmax(top, axis=-1)
    nb = t // PEER_TOKEN_BLOCK
    hk = PEER_HEADS * PEER_TOPK
    tab_u, tab_v = lp['peer_u'], lp['peer_v']

    def block(args):
        xb, ib, wb = args
        act = jax.nn.gelu(jnp.einsum('td,tkd->tk', xb, tab_u[ib]), approximate=False)
        return jnp.einsum('tk,tkd->td', (wb * act).astype(xb.dtype), tab_v[ib])

    out = lax.map(block, (xt.reshape(nb, PEER_TOKEN_BLOCK, d),
                          idx.reshape(nb, PEER_TOKEN_BLOCK, hk),
                          w.reshape(nb, PEER_TOKEN_BLOCK, hk)))
    return out.reshape(b, s, d).astype(u.dtype)


def trunk_layer(x, cond, lp, cache):
    m = jax.nn.silu(cond) @ lp['w_ada'] + lp['b_ada']
    sh1, sc1, g1, sh2, sc2, g2 = jnp.split(m[:, None, :], 6, axis=-1)
    u = layer_norm(x) * (1 + sc1) + sh1
    if cache is None:
        mix, new_cache = context_mixer(u, lp)
    else:
        mix, new_cache = latent_mixer(u, lp, cache), None
    x = layer_norm(DEEPNORM_ALPHA * x + g1 * mix, lp['ln1_g'], lp['ln1_b'])
    u = layer_norm(x) * (1 + sc2) + sh2
    x = layer_norm(DEEPNORM_ALPHA * x + g2 * peer(u, lp), lp['ln2_g'], lp['ln2_b'])
    return x, new_cache


def setup_inputs(seed: int = 0) -> dict:
    key = jax.random.key(seed)
    ks = iter(jax.random.split(key, 48))
    nrm = lambda shape, scale: jax.random.normal(next(ks), shape, jnp.float32) * scale
    L, D = DEPTH, D_MODEL
    return {
        'x_prompt': nrm((BATCH, SEQ, D), 1.0),
        'x_sample': nrm((DEC_BATCH, DEC_SEQ, D), 1.0),
        'c': nrm((DEC_BATCH, D), 1.0),
        'cache_mla_ckv': nrm((DEC_BATCH, L, PAST_LEN, MLA_KV_LORA), 1.0),
        'cache_mla_krope': nrm((DEC_BATCH, L, PAST_LEN, MLA_ROPE), 1.0),
        'cache_swa_k': nrm((DEC_BATCH, L, SWA_KV_HEADS, PAST_LEN, SWA_HEAD_DIM), 1.0),
        'cache_swa_v': nrm((DEC_BATCH, L, SWA_KV_HEADS, PAST_LEN, SWA_HEAD_DIM), 1.0),
        'state_gla': nrm((DEC_BATCH, L, 2, GLA_HEADS, GLA_DK, GLA_DV), 1.0),
        'c_ctx': nrm((D,), 1.0),
        'w_ada': nrm((L, D, 6 * D), 0.5 * D ** -0.5),
        'b_ada': nrm((L, 6 * D), 0.01),
        'w_in': nrm((L, D, IN_WIDTH), D ** -0.5),
        'mla_q_norm': 1.0 + nrm((L, MLA_Q_LORA), 0.02),
        'w_uq': nrm((L, MLA_Q_LORA, MLA_HEADS * (MLA_NOPE + MLA_ROPE)), MLA_Q_LORA ** -0.5),
        'mla_kv_norm': 1.0 + nrm((L, MLA_KV_LORA), 0.02),
        'w_ukv': nrm((L, MLA_KV_LORA, MLA_HEADS * (MLA_NOPE + MLA_V)), MLA_KV_LORA ** -0.5),
        'w_gla_a_fwd': nrm((L, GLA_GATE_RANK, GLA_HEADS * GLA_DK), GLA_GATE_RANK ** -0.5),
        'b_gla_a_fwd': nrm((L, GLA_HEADS * GLA_DK), 0.01),
        'w_gla_a_bwd': nrm((L, GLA_GATE_RANK, GLA_HEADS * GLA_DK), GLA_GATE_RANK ** -0.5),
        'b_gla_a_bwd': nrm((L, GLA_HEADS * GLA_DK), 0.01),
        'gla_norm': 1.0 + nrm((L, GLA_DV), 0.02),
        'swa_sink': nrm((L, SWA_HEADS), 0.1),
        'w_branch': nrm((L, N_BRANCH, BRANCH_W, D), BRANCH_W ** -0.5),
        'w_out': nrm((L, D, D), DEEPNORM_BETA * D ** -0.5),
        'ln1_g': 1.0 + nrm((L, D), 0.02),
        'ln1_b': nrm((L, D), 0.02),
        'ln2_g': 1.0 + nrm((L, D), 0.02),
        'ln2_b': nrm((L, D), 0.02),
        'w_peer_q': nrm((L, D, PEER_HEADS * PEER_KEY_DIM), D ** -0.5),
        'peer_keys': nrm((L, PEER_HEADS, 2, PEER_N_KEYS, PEER_HALF), PEER_HALF ** -0.5),
        'peer_u': nrm((L, PEER_N_EXPERTS, D), D ** -0.5),
        'peer_v': nrm((L, PEER_N_EXPERTS, D), DEEPNORM_BETA * PEER_HEADS ** -0.5),
    }


def reference(x_prompt, x_sample, c, cache_mla_ckv, cache_mla_krope, cache_swa_k, cache_swa_v, state_gla,
              c_ctx, w_ada, b_ada, w_in, mla_q_norm, w_uq, mla_kv_norm, w_ukv,
              w_gla_a_fwd, b_gla_a_fwd, w_gla_a_bwd, b_gla_a_bwd, gla_norm, swa_sink,
              w_branch, w_out, ln1_g, ln1_b, ln2_g, ln2_b, w_peer_q, peer_keys, peer_u, peer_v):
    def layer_params(l):
        return {
            'w_ada': w_ada[l], 'b_ada': b_ada[l], 'w_in': w_in[l],
            'mla_q_norm': mla_q_norm[l], 'w_uq': w_uq[l], 'mla_kv_norm': mla_kv_norm[l], 'w_ukv': w_ukv[l],
            'w_gla_a_fwd': w_gla_a_fwd[l], 'b_gla_a_fwd': b_gla_a_fwd[l],
            'w_gla_a_bwd': w_gla_a_bwd[l], 'b_gla_a_bwd': b_gla_a_bwd[l], 'gla_norm': gla_norm[l],
            'swa_sink': swa_sink[l], 'w_branch': w_branch[l], 'w_out': w_out[l],
            'ln1_g': ln1_g[l], 'ln1_b': ln1_b[l], 'ln2_g': ln2_g[l], 'ln2_b': ln2_b[l],
            'w_peer_q': w_peer_q[l], 'peer_keys': peer_keys[l], 'peer_u': peer_u[l], 'peer_v': peer_v[l],
        }

    h = x_prompt
    ctx_states = []
    for l in range(DEPTH):
        h, st = trunk_layer(h, c_ctx[None, :], layer_params(l), None)
        ctx_states.append(st)
    y_prompt = h
    new_mla_ckv = jnp.stack([st[0] for st in ctx_states], axis=1)
    new_mla_krope = jnp.stack([st[1] for st in ctx_states], axis=1)
    new_swa_k = jnp.stack([st[2] for st in ctx_states], axis=1)
    new_swa_v = jnp.stack([st[3] for st in ctx_states], axis=1)
    new_gla_state = jnp.stack([st[4] for st in ctx_states], axis=1)

    z = x_sample
    for l in range(DEPTH):
        cache = (cache_mla_ckv[:, l], cache_mla_krope[:, l], cache_swa_k[:, l], cache_swa_v[:, l], state_gla[:, l])
        z, _ = trunk_layer(z, c, layer_params(l), cache)
    y_sample = z
    return (y_prompt, y_sample, new_mla_ckv, new_mla_krope, new_swa_k, new_swa_v, new_gla_state)
```

```cpp
#include <hip/hip_runtime.h>
#include <hip/hip_cooperative_groups.h>
#include <cstdio>
#include <cstdint>
namespace cg = cooperative_groups;

#ifndef MULTI
#define MULTI 1
#endif

typedef unsigned short bf16_t;
using bf16x8 = __attribute__((ext_vector_type(8))) short;
using f32x4 = __attribute__((ext_vector_type(4))) float;
using u32x4 = __attribute__((ext_vector_type(4))) unsigned int;

#define T_ALL 12288
#define T_CTX 8192
#define NEG_INF (-__builtin_inff())

__device__ __forceinline__ int tidx() {
  int t = threadIdx.x;
  asm volatile("" : "+v"(t));
  return t;
}
__device__ __forceinline__ bf16_t f2bf(float f) {
  unsigned u = __float_as_uint(f);
  u += 0x7fffu + ((u >> 16) & 1u);
  return (bf16_t)(u >> 16);
}
__device__ __forceinline__ float bf2f(bf16_t b) { return __uint_as_float(((unsigned)b) << 16); }
__device__ __forceinline__ float wsum(float v) {
#pragma unroll
  for (int o = 32; o; o >>= 1) v += __shfl_xor(v, o);
  return v;
}
__device__ __forceinline__ float wmax(float v) {
#pragma unroll
  for (int o = 32; o; o >>= 1) v = fmaxf(v, __shfl_xor(v, o));
  return v;
}
__device__ __forceinline__ float siluf(float x) { return x / (1.f + __expf(-x)); }
__device__ __forceinline__ float sigmf(float x) { return 1.f / (1.f + __expf(-x)); }
__device__ __forceinline__ float logsigf(float z) { return fminf(z, 0.f) - log1pf(__expf(-fabsf(z))); }
__device__ __forceinline__ int cond_row(int g) { return g < T_CTX ? 0 : 1 + ((g - T_CTX) >> 11); }

struct P {
  const float *x_prompt, *x_sample, *c, *cache_ckv, *cache_krope, *cache_swa_k, *cache_swa_v, *state_gla, *c_ctx,
      *w_ada, *b_ada, *w_in, *mla_q_norm, *w_uq, *mla_kv_norm, *w_ukv, *w_gla_a_fwd, *b_gla_a_fwd, *w_gla_a_bwd,
      *b_gla_a_bwd, *gla_norm, *swa_sink, *w_branch, *w_out, *ln1_g, *ln1_b, *ln2_g, *ln2_b, *w_peer_q, *peer_keys,
      *peer_u, *peer_v;
  float* out;
  char* ws;
};

constexpr size_t OFF_Wt_in = 0ull;
constexpr size_t OFF_Wt_uq = OFF_Wt_in + (((2ull * 6144 * 1024 * 2) + 255ull) & ~255ull);
constexpr size_t OFF_Wt_ukv = OFF_Wt_uq + (((2ull * 384 * 256 * 2) + 255ull) & ~255ull);
constexpr size_t OFF_Wt_br = OFF_Wt_ukv + (((2ull * 512 * 128 * 2) + 255ull) & ~255ull);
constexpr size_t OFF_Wt_out = OFF_Wt_br + (((8ull * 1024 * 256 * 2) + 255ull) & ~255ull);
constexpr size_t OFF_Wt_pq = OFF_Wt_out + (((2ull * 1024 * 1024 * 2) + 255ull) & ~255ull);
constexpr size_t OFF_keysbf = OFF_Wt_pq + (((2ull * 2048 * 1024 * 2) + 255ull) & ~255ull);
constexpr size_t OFF_Cch = OFF_keysbf + (((2ull * 16 * 128 * 128 * 2) + 255ull) & ~255ull);
constexpr size_t OFF_A256 = OFF_Cch + (((128ull * 64 * 2) + 255ull) & ~255ull);
constexpr size_t OFF_A2048 = OFF_A256 + (((256ull * 512 * 2) + 255ull) & ~255ull);
constexpr size_t OFF_mada = OFF_A2048 + (((2048ull * 4096 * 2) + 255ull) & ~255ull);
constexpr size_t OFF_xbuf = OFF_mada + (((2ull * 3 * 6144 * 4) + 255ull) & ~255ull);
constexpr size_t OFF_u = OFF_xbuf + (((12288ull * 1024 * 4) + 255ull) & ~255ull);
constexpr size_t OFF_hbuf = OFF_u + (((12288ull * 1024 * 2) + 255ull) & ~255ull);
constexpr size_t OFF_gates = OFF_hbuf + (((12288ull * 1984 * 4) + 255ull) & ~255ull);
constexpr size_t OFF_qn = OFF_gates + (((12288ull * 4096 * 2) + 255ull) & ~255ull);
constexpr size_t OFF_ckv_all = OFF_qn + (((12288ull * 256 * 2) + 255ull) & ~255ull);
constexpr size_t OFF_Qa = OFF_ckv_all + (((13312ull * 128 * 2) + 255ull) & ~255ull);
constexpr size_t OFF_Ka_ctx = OFF_Qa + (((12288ull * 384 * 2) + 255ull) & ~255ull);
constexpr size_t OFF_Ka_lat = OFF_Ka_ctx + (((32ull * 4 * 256 * 96 * 2) + 255ull) & ~255ull);
constexpr size_t OFF_Va_ctx = OFF_Ka_lat + (((2ull * 4 * 2560 * 96 * 2) + 255ull) & ~255ull);
constexpr size_t OFF_Va_lat = OFF_Va_ctx + (((32ull * 4 * 256 * 64 * 2) + 255ull) & ~255ull);
constexpr size_t OFF_Qd = OFF_Va_lat + (((2ull * 4 * 2560 * 64 * 2) + 255ull) & ~255ull);
constexpr size_t OFF_Kd_ctx = OFF_Qd + (((12288ull * 256 * 2) + 255ull) & ~255ull);
constexpr size_t OFF_Kd_lat = OFF_Kd_ctx + (((32ull * 2 * 256 * 64 * 2) + 255ull) & ~255ull);
constexpr size_t OFF_Vd_ctx = OFF_Kd_lat + (((2ull * 2 * 2560 * 64 * 2) + 255ull) & ~255ull);
constexpr size_t OFF_Vd_lat = OFF_Vd_ctx + (((32ull * 2 * 256 * 64 * 2) + 255ull) & ~255ull);
constexpr size_t OFF_fnet = OFF_Vd_lat + (((2ull * 2 * 2560 * 64 * 2) + 255ull) & ~255ull);
constexpr size_t OFF_Yt_ctx = OFF_fnet + (((12288ull * 256 * 2) + 255ull) & ~255ull);
constexpr size_t OFF_Yt_lat = OFF_Yt_ctx + (((32ull * 256 * 512 * 2) + 255ull) & ~255ull);
constexpr size_t OFF_br = OFF_Yt_lat + (((2ull * 256 * 4096 * 2) + 255ull) & ~255ull);
constexpr size_t OFF_un = OFF_br + (((12288ull * 1024 * 2) + 255ull) & ~255ull);
constexpr size_t OFF_sin_ = OFF_un + (((1536ull * 2048 * 4) + 255ull) & ~255ull);
constexpr size_t OFF_gn = OFF_sin_ + (((1536ull * 2048 * 4) + 255ull) & ~255ull);
constexpr size_t OFF_pidx = OFF_gn + (((1536ull * 32 * 4) + 255ull) & ~255ull);
constexpr size_t OFF_pw = OFF_pidx + (((12288ull * 128 * 4) + 255ull) & ~255ull);
constexpr size_t WS_TOTAL = OFF_pw + (((12288ull * 128 * 4) + 255ull) & ~255ull);
#define W_Wt_in ((bf16_t*)(p.ws + OFF_Wt_in))
#define W_Wt_uq ((bf16_t*)(p.ws + OFF_Wt_uq))
#define W_Wt_ukv ((bf16_t*)(p.ws + OFF_Wt_ukv))
#define W_Wt_br ((bf16_t*)(p.ws + OFF_Wt_br))
#define W_Wt_out ((bf16_t*)(p.ws + OFF_Wt_out))
#define W_Wt_pq ((bf16_t*)(p.ws + OFF_Wt_pq))
#define W_keysbf ((bf16_t*)(p.ws + OFF_keysbf))
#define W_Cch ((bf16_t*)(p.ws + OFF_Cch))
#define W_A256 ((bf16_t*)(p.ws + OFF_A256))
#define W_A2048 ((bf16_t*)(p.ws + OFF_A2048))
#define W_mada ((float*)(p.ws + OFF_mada))
#define W_xbuf ((float*)(p.ws + OFF_xbuf))
#define W_u ((bf16_t*)(p.ws + OFF_u))
#define W_hbuf ((float*)(p.ws + OFF_hbuf))
#define W_gates ((bf16_t*)(p.ws + OFF_gates))
#define W_qn ((bf16_t*)(p.ws + OFF_qn))
#define W_ckv_all ((bf16_t*)(p.ws + OFF_ckv_all))
#define W_Qa ((bf16_t*)(p.ws + OFF_Qa))
#define W_Ka_ctx ((bf16_t*)(p.ws + OFF_Ka_ctx))
#define W_Ka_lat ((bf16_t*)(p.ws + OFF_Ka_lat))
#define W_Va_ctx ((bf16_t*)(p.ws + OFF_Va_ctx))
#define W_Va_lat ((bf16_t*)(p.ws + OFF_Va_lat))
#define W_Qd ((bf16_t*)(p.ws + OFF_Qd))
#define W_Kd_ctx ((bf16_t*)(p.ws + OFF_Kd_ctx))
#define W_Kd_lat ((bf16_t*)(p.ws + OFF_Kd_lat))
#define W_Vd_ctx ((bf16_t*)(p.ws + OFF_Vd_ctx))
#define W_Vd_lat ((bf16_t*)(p.ws + OFF_Vd_lat))
#define W_fnet ((bf16_t*)(p.ws + OFF_fnet))
#define W_Yt_ctx ((bf16_t*)(p.ws + OFF_Yt_ctx))
#define W_Yt_lat ((bf16_t*)(p.ws + OFF_Yt_lat))
#define W_br ((bf16_t*)(p.ws + OFF_br))
#define W_un ((float*)(p.ws + OFF_un))
#define W_sin_ ((float*)(p.ws + OFF_sin_))
#define W_gn ((float*)(p.ws + OFF_gn))
#define W_pidx ((int*)(p.ws + OFF_pidx))
#define W_pw ((float*)(p.ws + OFF_pw))

#define GB_LD 72
template <int NJ>
__device__ __forceinline__ void gemm_core_t(f32x4 (&acc)[4][NJ], const bf16_t* __restrict__ A, int lda,
                                            const bf16_t* __restrict__ B, int ldb, int K, char* smem) {
  bf16_t* sa = (bf16_t*)smem;
  bf16_t* sb = sa + 128 * GB_LD;
  const int tid = tidx(), lane = tid & 63, w = tid >> 6, wm = w >> 1, wn = w & 1;
  const int l15 = lane & 15, l4 = lane >> 4;
  u32x4 ra[4], rb[NJ];
#pragma unroll
  for (int i = 0; i < 4; i++) {
    int c = tid + i * 256, r = c >> 3, cc = (c & 7) * 8;
    ra[i] = *(const u32x4*)(A + (size_t)r * lda + cc);
    if (i < NJ) rb[i] = *(const u32x4*)(B + (size_t)r * ldb + cc);
  }
  for (int k0 = 0; k0 < K; k0 += 64) {
    __syncthreads();
#pragma unroll
    for (int i = 0; i < 4; i++) {
      int c = tid + i * 256, r = c >> 3, cc = (c & 7) * 8;
      *(u32x4*)(sa + r * GB_LD + cc) = ra[i];
      if (i < NJ) *(u32x4*)(sb + r * GB_LD + cc) = rb[i];
    }
    __syncthreads();
    if (k0 + 64 < K) {
#pragma unroll
      for (int i = 0; i < 4; i++) {
        int c = tid + i * 256, r = c >> 3, cc = (c & 7) * 8;
        ra[i] = *(const u32x4*)(A + (size_t)r * lda + k0 + 64 + cc);
        if (i < NJ) rb[i] = *(const u32x4*)(B + (size_t)r * ldb + k0 + 64 + cc);
      }
    }
#pragma unroll
    for (int ks = 0; ks < 2; ks++) {
      bf16x8 af[4], bfr[NJ];
#pragma unroll
      for (int i = 0; i < 4; i++) af[i] = *(const bf16x8*)(sa + (wm * 64 + i * 16 + l15) * GB_LD + ks * 32 + l4 * 8);
#pragma unroll
      for (int j = 0; j < NJ; j++) bfr[j] = *(const bf16x8*)(sb + (wn * NJ * 16 + j * 16 + l15) * GB_LD + ks * 32 + l4 * 8);
#pragma unroll
      for (int i = 0; i < 4; i++)
#pragma unroll
        for (int j = 0; j < NJ; j++) acc[i][j] = __builtin_amdgcn_mfma_f32_16x16x32_bf16(af[i], bfr[j], acc[i][j], 0, 0, 0);
    }
  }
}
#define gemm_core gemm_core_t<4>
#define ZERO_ACC_N(acc, NJ)                                        \
  _Pragma("unroll") for (int i_ = 0; i_ < 4; i_++)                 \
  _Pragma("unroll") for (int j_ = 0; j_ < NJ; j_++) { acc[i_][j_] = f32x4{0.f, 0.f, 0.f, 0.f}; }
#define ZERO_ACC(acc) ZERO_ACC_N(acc, 4)
#define EPI_LOOP_N(acc, m0, n0, NJ, ...)                                                   \
  {                                                                                        \
    const int lane_ = tidx() & 63, w_ = tidx() >> 6, wm_ = w_ >> 1, wn_ = w_ & 1; \
    _Pragma("unroll") for (int i_ = 0; i_ < 4; i_++)                                       \
    _Pragma("unroll") for (int j_ = 0; j_ < NJ; j_++)                                      \
    _Pragma("unroll") for (int r_ = 0; r_ < 4; r_++) {                                     \
      const int m = (m0) + wm_ * 64 + i_ * 16 + (lane_ >> 4) * 4 + r_;                     \
      const int n = (n0) + wn_ * (NJ * 16) + j_ * 16 + (lane_ & 15);                       \
      float v = acc[i_][j_][r_];                                                           \
      __VA_ARGS__                                                                          \
    }                                                                                      \
  }
#define EPI_LOOP(acc, m0, n0, ...) EPI_LOOP_N(acc, m0, n0, 4, __VA_ARGS__)

__device__ __forceinline__ void transpose_tile(const float* __restrict__ src, int K, int N, bf16_t* __restrict__ dst, int tile, int ntn,
                               float* sm) {
  int kt = tile / ntn, nt = tile % ntn, k0 = kt * 64, n0 = nt * 64;
  int tx = tidx() & 63, ty = tidx() >> 6;
  __syncthreads();
  for (int i = 0; i < 16; i++) {
    int k = i * 4 + ty, n = n0 + tx;
    sm[k * 65 + tx] = (n < N) ? src[(size_t)(k0 + k) * N + n] : 0.f;
  }
  __syncthreads();
  for (int i = 0; i < 16; i++) {
    int n = i * 4 + ty;
    dst[(size_t)(n0 + n) * K + k0 + tx] = f2bf(sm[tx * 65 + n]);
  }
}

__device__ __forceinline__ void ada_item(const P& p, int item, float* sm) {
  int l = item / 24, cgp = item % 24;
  int lane = tidx() & 63, w = tidx() >> 6;
  const float* W = p.w_ada + (size_t)l * 1024 * 6144 + cgp * 256 + lane * 4;
  float4 a0 = {0, 0, 0, 0}, a1 = {0, 0, 0, 0}, a2 = {0, 0, 0, 0};
  for (int k = w * 256; k < (w + 1) * 256; k++) {
    float4 wv = *(const float4*)(W + (size_t)k * 6144);
    float c0 = siluf(p.c_ctx[k]), c1 = siluf(p.c[k]), c2 = siluf(p.c[1024 + k]);
    a0.x += c0 * wv.x; a0.y += c0 * wv.y; a0.z += c0 * wv.z; a0.w += c0 * wv.w;
    a1.x += c1 * wv.x; a1.y += c1 * wv.y; a1.z += c1 * wv.z; a1.w += c1 * wv.w;
    a2.x += c2 * wv.x; a2.y += c2 * wv.y; a2.z += c2 * wv.z; a2.w += c2 * wv.w;
  }
  __syncthreads();
  *(float4*)(sm + (w * 3 + 0) * 256 + lane * 4) = a0;
  *(float4*)(sm + (w * 3 + 1) * 256 + lane * 4) = a1;
  *(float4*)(sm + (w * 3 + 2) * 256 + lane * 4) = a2;
  __syncthreads();
  for (int o = tidx(); o < 768; o += 256) {
    int r = o >> 8, col = o & 255;
    float s = sm[(0 * 3 + r) * 256 + col] + sm[(1 * 3 + r) * 256 + col] + sm[(2 * 3 + r) * 256 + col] +
              sm[(3 * 3 + r) * 256 + col];
    W_mada[(l * 3 + r) * 6144 + cgp * 256 + col] = s + p.b_ada[l * 6144 + cgp * 256 + col];
  }
}

__device__ __forceinline__ void dft_seq_fill(bf16_t* dst, int S, int item) {
  float inv = rsqrtf((float)S);
  size_t base = (size_t)item * 2048;
  for (int e = 0; e < 8; e++) {
    size_t idx = base + e * 256 + tidx();
    int k = (int)(idx / (2 * S)), col = (int)(idx % (2 * S));
    int s = col < S ? col : col - S;
    int mm = (k * s) & (S - 1);
    float rev = (float)mm / (float)S;
    float v = col < S ? __builtin_amdgcn_cosf(rev) : -__builtin_amdgcn_sinf(rev);
    dst[idx] = f2bf(v * inv);
  }
}

__device__ __forceinline__ void phase_prep(const P& p, char* smem) {
  float* sm = (float*)smem;
  const int nb = gridDim.x;
  const int J_ADA = 48;
  const int J_IN = 2 * 16 * 96;
  const int J_UQ = 2 * 4 * 6;
  const int J_UKV = 2 * 2 * 8;
  const int J_BR = 2 * 4 * 4 * 16;
  const int J_OUT = 2 * 16 * 16;
  const int J_PQ = 2 * 16 * 32;
  const int J_KEYS = 256;
  const int J_CCH = 4;
  const int J_A256 = 64;
  const int J_A2048 = 4096;
  const int total = J_ADA + J_IN + J_UQ + J_UKV + J_BR + J_OUT + J_PQ + J_KEYS + J_CCH + J_A256 + J_A2048;
  for (int it0 = blockIdx.x; it0 < total; it0 += nb) {
    int it = it0;
    if (it < J_ADA) { ada_item(p, it, sm); continue; }
    it -= J_ADA;
    if (it < J_IN) { int l = it / 1536, t = it % 1536; transpose_tile(p.w_in + (size_t)l * 1024 * 6080, 1024, 6080, W_Wt_in + (size_t)l * 6144 * 1024, t, 96, sm); continue; }
    it -= J_IN;
    if (it < J_UQ) { int l = it / 24, t = it % 24; transpose_tile(p.w_uq + (size_t)l * 256 * 384, 256, 384, W_Wt_uq + (size_t)l * 384 * 256, t, 6, sm); continue; }
    it -= J_UQ;
    if (it < J_UKV) { int l = it / 16, t = it % 16; transpose_tile(p.w_ukv + (size_t)l * 128 * 512, 128, 512, W_Wt_ukv + (size_t)l * 512 * 128, t, 8, sm); continue; }
    it -= J_UKV;
    if (it < J_BR) { int lb = it / 64, t = it % 64; transpose_tile(p.w_branch + (size_t)lb * 256 * 1024, 256, 1024, W_Wt_br + (size_t)lb * 1024 * 256, t, 16, sm); continue; }
    it -= J_BR;
    if (it < J_OUT) { int l = it / 256, t = it % 256; transpose_tile(p.w_out + (size_t)l * 1024 * 1024, 1024, 1024, W_Wt_out + (size_t)l * 1024 * 1024, t, 16, sm); continue; }
    it -= J_OUT;
    if (it < J_PQ) { int l = it / 512, t = it % 512; transpose_tile(p.w_peer_q + (size_t)l * 1024 * 2048, 1024, 2048, W_Wt_pq + (size_t)l * 2048 * 1024, t, 32, sm); continue; }
    it -= J_PQ;
    if (it < J_KEYS) {
      size_t base = (size_t)it * 2048;
      for (int e = 0; e < 8; e++) { size_t idx = base + e * 256 + tidx(); W_keysbf[idx] = f2bf(p.peer_keys[idx]); }
      continue;
    }
    it -= J_KEYS;
    if (it < J_CCH) {
      for (int e = 0; e < 8; e++) {
        int idx = it * 2048 + e * 256 + tidx();
        int n = idx >> 6, c = idx & 63;
        int j = n & 63;
        float rev = (float)((j * c) & 63) / 64.f;
        float v = n < 64 ? __builtin_amdgcn_cosf(rev) : __builtin_amdgcn_sinf(rev);
        W_Cch[idx] = f2bf(v * 0.125f);
      }
      continue;
    }
    it -= J_CCH;
    if (it < J_A256) { dft_seq_fill(W_A256, 256, it); continue; }
    it -= J_A256;
    dft_seq_fill(W_A2048, 2048, it);
  }
}

__device__ __forceinline__ void load_row16(const float* row, int lane, float (&v)[16]) {
#pragma unroll
  for (int q = 0; q < 4; q++) {
    float4 t = *(const float4*)(row + q * 256 + lane * 4);
    v[q * 4 + 0] = t.x; v[q * 4 + 1] = t.y; v[q * 4 + 2] = t.z; v[q * 4 + 3] = t.w;
  }
}
__device__ __forceinline__ void store_row16(float* row, int lane, const float (&v)[16]) {
#pragma unroll
  for (int q = 0; q < 4; q++) *(float4*)(row + q * 256 + lane * 4) = float4{v[q * 4], v[q * 4 + 1], v[q * 4 + 2], v[q * 4 + 3]};
}
__device__ __forceinline__ void ln16(float (&v)[16]) {
  float s = 0;
#pragma unroll
  for (int i = 0; i < 16; i++) s += v[i];
  s = wsum(s);
  float mu = s * (1.f / 1024.f);
  float q = 0;
#pragma unroll
  for (int i = 0; i < 16; i++) { v[i] -= mu; q += v[i] * v[i]; }
  q = wsum(q);
  float rs = rsqrtf(q * (1.f / 1024.f) + 1e-6f);
#pragma unroll
  for (int i = 0; i < 16; i++) v[i] *= rs;
}
__device__ __forceinline__ void modulate_store(const float (&v)[16], const float* sh, const float* sc, bf16_t* dst, int lane) {
#pragma unroll
  for (int q = 0; q < 4; q++) {
    float4 a = *(const float4*)(sc + q * 256 + lane * 4);
    float4 b = *(const float4*)(sh + q * 256 + lane * 4);
    ushort4 o;
    o.x = f2bf(v[q * 4 + 0] * (1.f + a.x) + b.x);
    o.y = f2bf(v[q * 4 + 1] * (1.f + a.y) + b.y);
    o.z = f2bf(v[q * 4 + 2] * (1.f + a.z) + b.z);
    o.w = f2bf(v[q * 4 + 3] * (1.f + a.w) + b.w);
    *(ushort4*)(dst + q * 256 + lane * 4) = o;
  }
}
__device__ __forceinline__ void affine16(float (&v)[16], const float* g, const float* b, int lane) {
#pragma unroll
  for (int q = 0; q < 4; q++) {
    float4 a = *(const float4*)(g + q * 256 + lane * 4);
    float4 c = *(const float4*)(b + q * 256 + lane * 4);
    v[q * 4 + 0] = v[q * 4 + 0] * a.x + c.x;
    v[q * 4 + 1] = v[q * 4 + 1] * a.y + c.y;
    v[q * 4 + 2] = v[q * 4 + 2] * a.z + c.z;
    v[q * 4 + 3] = v[q * 4 + 3] * a.w + c.w;
  }
}
__device__ __forceinline__ const float* x_in_row(const P& p, int l, int g) {
  if (l == 0) return g < T_CTX ? p.x_prompt + (size_t)g * 1024 : p.x_sample + (size_t)(g - T_CTX) * 1024;
  return W_xbuf + (size_t)g * 1024;
}
__device__ __forceinline__ float* x_out_row(const P& p, int l, int g) {
  return (l == 0 ? W_xbuf : p.out) + (size_t)g * 1024;
}

__device__ __forceinline__ void phase_ln0(const P& p) {
  int lane = tidx() & 63, w = tidx() >> 6;
  for (int it = blockIdx.x; it < T_ALL / 4; it += gridDim.x) {
    int g = it * 4 + w;
    float v[16];
    load_row16(x_in_row(p, 0, g), lane, v);
    ln16(v);
    const float* m = W_mada + (0 * 3 + cond_row(g)) * 6144;
    modulate_store(v, m, m + 1024, W_u + (size_t)g * 1024, lane);
  }
}

__device__ __forceinline__ void phase_win(const P& p, int l, char* smem) {
  const bf16_t* Wt = W_Wt_in + (size_t)l * 6144 * 1024;
  for (int tile = blockIdx.x; tile < 96 * 48; tile += gridDim.x) {
    int mt = tile / 48, nt = tile % 48, m0 = mt * 128, n0 = nt * 128;
    f32x4 acc[4][4];
    ZERO_ACC(acc);
    gemm_core(acc, W_u + (size_t)m0 * 1024, 1024, Wt + (size_t)n0 * 1024, 1024, 1024, smem);
    EPI_LOOP(acc, m0, n0, {
      if (n < 1984) W_hbuf[(size_t)m * 1984 + n] = v;
      else if (n < 6080) W_gates[(size_t)m * 4096 + (n - 1984)] = f2bf(sigmf(v));
    });
  }
}

__device__ __forceinline__ void rope_cs(float pos, int i, float inv_hp, float& cs, float& sn) {
  float freq = exp2f(-(float)i * inv_hp * 13.287712379549449f);
  float a = pos * freq;
  sn = __sinf(a);
  cs = __cosf(a);
}

__device__ __forceinline__ void phase_post(const P& p, int l) {
  int lane = tidx() & 63, w = tidx() >> 6;
  for (int it = blockIdx.x; it < 13312 / 4; it += gridDim.x) {
    int g = it * 4 + w;
    if (g < T_ALL) {
      const bool lat = g >= T_CTX;
      int b, s;
      if (!lat) { b = g >> 8; s = g & 255; } else { b = (g - T_CTX) >> 11; s = (g - T_CTX) & 2047; }
      const float* h = W_hbuf + (size_t)g * 1984;
      const float prow = (float)(s >> 6), pcol = (float)(s & 63);
      {
        float4 t = *(const float4*)(h + lane * 4);
        float ss = wsum(t.x * t.x + t.y * t.y + t.z * t.z + t.w * t.w);
        float rs = rsqrtf(ss * (1.f / 256.f) + 1e-6f);
        float4 gq = *(const float4*)(p.mla_q_norm + l * 256 + lane * 4);
        ushort4 o;
        o.x = f2bf(t.x * rs * gq.x); o.y = f2bf(t.y * rs * gq.y); o.z = f2bf(t.z * rs * gq.z); o.w = f2bf(t.w * rs * gq.w);
        *(ushort4*)(W_qn + (size_t)g * 256 + lane * 4) = o;
      }
      {
        float2 t = *(const float2*)(h + 256 + lane * 2);
        float ss = wsum(t.x * t.x + t.y * t.y);
        float rs = rsqrtf(ss * (1.f / 128.f) + 1e-6f);
        float2 gk = *(const float2*)(p.mla_kv_norm + l * 128 + lane * 2);
        float v0 = t.x * rs * gk.x, v1 = t.y * rs * gk.y;
        ushort2 o; o.x = f2bf(v0); o.y = f2bf(v1);
        *(ushort2*)(W_ckv_all + (size_t)g * 128 + lane * 2) = o;
        if (!lat) *(float2*)(p.out + 12582912 + ((size_t)((b * 2 + l) * 256 + s)) * 128 + lane * 2) = float2{v0, v1};
      }
      if (lane < 16) {
        int pp = lane >> 3, i = lane & 7;
        float x1 = h[384 + pp * 16 + i], x2 = h[384 + pp * 16 + 8 + i];
        float o1 = x1, o2 = x2;
        if (lat) {
          float cs, sn;
          rope_cs(pp ? pcol : prow, i, 0.125f, cs, sn);
          o1 = x1 * cs - x2 * sn; o2 = x2 * cs + x1 * sn;
        } else {
          float* ok = p.out + 14680064 + ((size_t)((b * 2 + l) * 256 + s)) * 32 + pp * 16 + i;
          ok[0] = o1; ok[8] = o2;
        }
        bf16_t b1 = f2bf(o1), b2 = f2bf(o2);
        for (int hh = 0; hh < 4; hh++) {
          bf16_t* kd = lat ? W_Ka_lat + ((size_t)((b * 4 + hh) * 2560 + 512 + s)) * 96 : W_Ka_ctx + ((size_t)((b * 4 + hh) * 256 + s)) * 96;
          kd[64 + pp * 16 + i] = b1; kd[64 + pp * 16 + 8 + i] = b2;
        }
      }
      {
        float4 t = *(const float4*)(h + 416 + lane * 4);
        ushort4 o; o.x = f2bf(t.x); o.y = f2bf(t.y); o.z = f2bf(t.z); o.w = f2bf(t.w);
        *(ushort4*)(W_fnet + (size_t)g * 256 + lane * 4) = o;
      }
#pragma unroll
      for (int jj = 0; jj < 2; jj++) {
        int pi = lane + 64 * jj, hq = pi >> 5, pp = (pi >> 4) & 1, i = pi & 15;
        float x1 = h[1472 + hq * 64 + pp * 32 + i], x2 = h[1472 + hq * 64 + pp * 32 + 16 + i];
        float o1 = x1, o2 = x2;
        if (lat) {
          float cs, sn;
          rope_cs(pp ? pcol : prow, i, 0.0625f, cs, sn);
          o1 = x1 * cs - x2 * sn; o2 = x2 * cs + x1 * sn;
        }
        bf16_t* qd = W_Qd + (size_t)g * 256 + hq * 64 + pp * 32 + i;
        qd[0] = f2bf(o1); qd[16] = f2bf(o2);
      }
      {
        int kv = lane >> 5, pp = (lane >> 4) & 1, i = lane & 15;
        float x1 = h[1728 + kv * 64 + pp * 32 + i], x2 = h[1728 + kv * 64 + pp * 32 + 16 + i];
        float o1 = x1, o2 = x2;
        bf16_t* kd;
        if (lat) {
          float cs, sn;
          rope_cs(pp ? pcol : prow, i, 0.0625f, cs, sn);
          o1 = x1 * cs - x2 * sn; o2 = x2 * cs + x1 * sn;
          kd = W_Kd_lat + ((size_t)((b * 2 + kv) * 2560 + 512 + s)) * 64;
        } else {
          float* ok = p.out + 15204352 + ((size_t)(((b * 2 + l) * 2 + kv) * 256 + s)) * 64 + pp * 32 + i;
          ok[0] = o1; ok[16] = o2;
          kd = W_Kd_ctx + ((size_t)((b * 2 + kv) * 256 + s)) * 64;
        }
        kd[pp * 32 + i] = f2bf(o1); kd[pp * 32 + 16 + i] = f2bf(o2);
      }
      {
        int e = lane * 2, kv = e >> 6, d = e & 63;
        float2 t = *(const float2*)(h + 1856 + e);
        bf16_t* vd;
        if (lat) vd = W_Vd_lat + ((size_t)((b * 2 + kv) * 2560 + 512 + s)) * 64;
        else {
          *(float2*)(p.out + 17301504 + ((size_t)(((b * 2 + l) * 2 + kv) * 256 + s)) * 64 + d) = t;
          vd = W_Vd_ctx + ((size_t)((b * 2 + kv) * 256 + s)) * 64;
        }
        ushort2 o; o.x = f2bf(t.x); o.y = f2bf(t.y);
        *(ushort2*)(vd + d) = o;
      }
    } else {
      int gc = g - T_ALL, b = gc >> 9, pp = gc & 511;
      {
        float2 t = *(const float2*)(p.cache_ckv + ((size_t)((b * 2 + l) * 512 + pp)) * 128 + lane * 2);
        ushort2 o; o.x = f2bf(t.x); o.y = f2bf(t.y);
        *(ushort2*)(W_ckv_all + (size_t)g * 128 + lane * 2) = o;
      }
      if (lane < 32) {
        bf16_t v = f2bf(p.cache_krope[((size_t)((b * 2 + l) * 512 + pp)) * 32 + lane]);
        for (int hh = 0; hh < 4; hh++) W_Ka_lat[((size_t)((b * 4 + hh) * 2560 + pp)) * 96 + 64 + lane] = v;
      }
      {
        int e = lane * 2, kv = e >> 6, d = e & 63;
        size_t src = ((size_t)(((b * 2 + l) * 2 + kv) * 512 + pp)) * 64 + d;
        float2 tk = *(const float2*)(p.cache_swa_k + src);
        float2 tv = *(const float2*)(p.cache_swa_v + src);
        size_t dst = ((size_t)((b * 2 + kv) * 2560 + pp)) * 64 + d;
        ushort2 ok, ov; ok.x = f2bf(tk.x); ok.y = f2bf(tk.y); ov.x = f2bf(tv.x); ov.y = f2bf(tv.y);
        *(ushort2*)(W_Kd_lat + dst) = ok;
        *(ushort2*)(W_Vd_lat + dst) = ov;
      }
    }
  }
}

__device__ __forceinline__ void phase_small_gemms(const P& p, int l, char* smem) {
  const int NA = 96 * 3, NB = 104 * 4, NC = 384;
  for (int it0 = blockIdx.x; it0 < NA + NB + NC; it0 += gridDim.x) {
    int it = it0;
    f32x4 acc[4][4];
    ZERO_ACC(acc);
    if (it < NA) {
      int mt = it / 3, nt = it % 3, m0 = mt * 128, n0 = nt * 128;
      gemm_core(acc, W_qn + (size_t)m0 * 256, 256, W_Wt_uq + (size_t)l * 384 * 256 + (size_t)n0 * 256, 256, 256, smem);
      const bool lat = m0 >= T_CTX;
      EPI_LOOP(acc, m0, n0, {
        float pv = __shfl_xor(v, 8);
        int c96 = n % 96;
        if (lat && c96 >= 64) {
          int cr = c96 - 64, pp = cr >> 4, ii = cr & 15, i = ii & 7;
          int s = (m - T_CTX) & 2047;
          float cs, sn;
          rope_cs(pp ? (float)(s & 63) : (float)(s >> 6), i, 0.125f, cs, sn);
          v = (ii < 8) ? v * cs - pv * sn : v * cs + pv * sn;
        }
        W_Qa[(size_t)m * 384 + n] = f2bf(v);
      });
      continue;
    }
    it -= NA;
    if (it < NB) {
      int mt = it / 4, nt = it % 4, m0 = mt * 128, n0 = nt * 128;
      gemm_core(acc, W_ckv_all + (size_t)m0 * 128, 128, W_Wt_ukv + (size_t)l * 512 * 128 + (size_t)n0 * 128, 128, 128, smem);
      EPI_LOOP(acc, m0, n0, {
        int hh = n >> 7, c = n & 127;
        bf16_t* kd; bf16_t* vd;
        if (m < T_CTX) {
          int b = m >> 8, s = m & 255;
          size_t r = (size_t)((b * 4 + hh) * 256 + s);
          kd = W_Ka_ctx + r * 96; vd = W_Va_ctx + r * 64;
        } else {
          int b, pos;
          if (m < T_ALL) { b = (m - T_CTX) >> 11; pos = 512 + ((m - T_CTX) & 2047); }
          else { b = (m - T_ALL) >> 9; pos = (m - T_ALL) & 511; }
          size_t r = (size_t)((b * 4 + hh) * 2560 + pos);
          kd = W_Ka_lat + r * 96; vd = W_Va_lat + r * 64;
        }
        if (c < 64) kd[c] = f2bf(v); else vd[c - 64] = f2bf(v);
      });
      continue;
    }
    it -= NB;
    {
      int m0 = it * 128;
      gemm_core(acc, W_fnet + (size_t)m0 * 64, 64, W_Cch, 64, 64, smem);
      EPI_LOOP(acc, m0, 0, {
        int g = m >> 2, grp = m & 3, part = n >> 6, j = n & 63;
        if (g < T_CTX) {
          int b = g >> 8, s = g & 255;
          W_Yt_ctx[((size_t)(b * 256 + grp * 64 + j)) * 512 + part * 256 + s] = f2bf(v);
        } else {
          int b = (g - T_CTX) >> 11, s = (g - T_CTX) & 2047;
          W_Yt_lat[((size_t)(b * 256 + grp * 64 + j)) * 4096 + part * 2048 + s] = f2bf(v);
        }
      });
    }
  }
}

template <int DK>
__device__ __forceinline__ void attn_item(const bf16_t* __restrict__ Qp, int qstride, const bf16_t* __restrict__ Kp,
                          const bf16_t* __restrict__ Vp, bf16_t* __restrict__ Op, int q0, int Sk, int n_ctx, int W,
                          float scale, bool has_sink, float sink, char* smem) {
  constexpr int KLD = DK + 8;
  bf16_t* sK = (bf16_t*)smem;
  bf16_t* sVt = sK + 64 * KLD;
  bf16_t* sP = sVt + 64 * 72;
  const int tid = tidx(), lane = tid & 63, w = tid >> 6, l15 = lane & 15, l4 = lane >> 4;
  bf16_t* sPw = sP + w * 16 * 72;
  bf16x8 qf[DK / 32];
  {
    const bf16_t* qrow = Qp + (size_t)(q0 + w * 16 + l15) * qstride;
#pragma unroll
    for (int ks = 0; ks < DK / 32; ks++) qf[ks] = *(const bf16x8*)(qrow + ks * 32 + l4 * 8);
  }
  f32x4 o[4];
#pragma unroll
  for (int j = 0; j < 4; j++) o[j] = f32x4{0.f, 0.f, 0.f, 0.f};
  float mrow[4], lrow[4];
#pragma unroll
  for (int r = 0; r < 4; r++) { mrow[r] = NEG_INF; lrow[r] = 0.f; }
  const int ntile = Sk >> 6;
  for (int kt = 0; kt < ntile; kt++) {
    const int kbase = kt * 64;
    if (W >= 0 && kbase >= n_ctx) {
      int lp = kbase - n_ctx;
      if (lp + 63 < q0 - W || lp > q0 + 63 + W) continue;
    }
    __syncthreads();
    for (int c = tid; c < 64 * DK / 8; c += 256) {
      int r = c / (DK / 8), cc = (c % (DK / 8)) * 8;
      *(uint4*)(sK + r * KLD + cc) = *(const uint4*)(Kp + (size_t)(kbase + r) * DK + cc);
    }
#pragma unroll
    for (int i = 0; i < 2; i++) {
      int c = tid + i * 256, key = c >> 3, d0 = (c & 7) * 8;
      uint4 vv = *(const uint4*)(Vp + (size_t)(kbase + key) * 64 + d0);
      unsigned wv[4] = {vv.x, vv.y, vv.z, vv.w};
#pragma unroll
      for (int e = 0; e < 4; e++) {
        sVt[(d0 + 2 * e) * 72 + key] = (bf16_t)(wv[e] & 0xffffu);
        sVt[(d0 + 2 * e + 1) * 72 + key] = (bf16_t)(wv[e] >> 16);
      }
    }
    __syncthreads();
    f32x4 s[4];
#pragma unroll
    for (int j = 0; j < 4; j++) {
      s[j] = f32x4{0.f, 0.f, 0.f, 0.f};
#pragma unroll
      for (int ks = 0; ks < DK / 32; ks++) {
        bf16x8 kf = *(const bf16x8*)(sK + (j * 16 + l15) * KLD + ks * 32 + l4 * 8);
        s[j] = __builtin_amdgcn_mfma_f32_16x16x32_bf16(qf[ks], kf, s[j], 0, 0, 0);
      }
    }
#pragma unroll
    for (int j = 0; j < 4; j++)
#pragma unroll
      for (int r = 0; r < 4; r++) {
        float v = s[j][r] * scale;
        if (W >= 0) {
          int kk = kbase + j * 16 + l15, t = q0 + w * 16 + l4 * 4 + r;
          int dlt = kk - n_ctx - t;
          bool valid = (kk < n_ctx) || (dlt <= W && dlt >= -W);
          if (!valid) v = NEG_INF;
        }
        s[j][r] = v;
      }
#pragma unroll
    for (int r = 0; r < 4; r++) {
      float mx = fmaxf(fmaxf(s[0][r], s[1][r]), fmaxf(s[2][r], s[3][r]));
#pragma unroll
      for (int off = 1; off < 16; off <<= 1) mx = fmaxf(mx, __shfl_xor(mx, off));
      float mnew = fmaxf(mrow[r], mx);
      float muse = (mnew == NEG_INF) ? 0.f : mnew;
      float alpha = __expf(mrow[r] - muse);
      float rs = 0.f;
#pragma unroll
      for (int j = 0; j < 4; j++) { float pe = __expf(s[j][r] - muse); s[j][r] = pe; rs += pe; }
#pragma unroll
      for (int off = 1; off < 16; off <<= 1) rs += __shfl_xor(rs, off);
      lrow[r] = lrow[r] * alpha + rs;
      mrow[r] = mnew;
#pragma unroll
      for (int j = 0; j < 4; j++) o[j][r] *= alpha;
    }
#pragma unroll
    for (int j = 0; j < 4; j++)
#pragma unroll
      for (int r = 0; r < 4; r++) sPw[(l4 * 4 + r) * 72 + j * 16 + l15] = f2bf(s[j][r]);
    __syncthreads();
#pragma unroll
    for (int ks = 0; ks < 2; ks++) {
      bf16x8 pf = *(const bf16x8*)(sPw + l15 * 72 + ks * 32 + l4 * 8);
#pragma unroll
      for (int jn = 0; jn < 4; jn++) {
        bf16x8 vf = *(const bf16x8*)(sVt + (jn * 16 + l15) * 72 + ks * 32 + l4 * 8);
        o[jn] = __builtin_amdgcn_mfma_f32_16x16x32_bf16(pf, vf, o[jn], 0, 0, 0);
      }
    }
  }
#pragma unroll
  for (int r = 0; r < 4; r++) {
    float lsum = lrow[r];
    if (has_sink) lsum += __expf(sink - mrow[r]);
    float inv = 1.f / lsum;
#pragma unroll
    for (int jn = 0; jn < 4; jn++)
      Op[(size_t)(q0 + w * 16 + l4 * 4 + r) * 1024 + jn * 16 + l15] = f2bf(o[jn][r] * inv);
  }
}

__device__ __forceinline__ int gla_tok(int tb, int c, int dir, int tau) { return tb + c * 64 + (dir ? 63 - tau : tau); }

__device__ __forceinline__ void gla_cum(const P& p, int l, int tb, int c, int h, int dir, float* cum) {
  const int tid = tidx();
  const float* w2 = (dir ? p.w_gla_a_bwd : p.w_gla_a_fwd) + l * 16 * 128 + h * 32;
  const float* b2 = (dir ? p.b_gla_a_bwd : p.b_gla_a_fwd) + l * 128 + h * 32;
  {
    int tau = tid >> 2, kq = (tid & 3) * 8;
    const float* al = W_hbuf + (size_t)gla_tok(tb, c, dir, tau) * 1984 + (dir ? 1456 : 1440);
    float a[16];
#pragma unroll
    for (int q = 0; q < 4; q++) { float4 t = *(const float4*)(al + q * 4); a[q * 4] = t.x; a[q * 4 + 1] = t.y; a[q * 4 + 2] = t.z; a[q * 4 + 3] = t.w; }
#pragma unroll
    for (int j = 0; j < 8; j++) {
      int k = kq + j;
      float z = b2[k];
#pragma unroll
      for (int r = 0; r < 16; r++) z += a[r] * w2[r * 128 + k];
      cum[tau * 33 + k] = logsigf(z) * (1.f / 16.f);
    }
  }
  __syncthreads();
  if (tid < 32) {
    float run = 0.f;
    for (int tau = 0; tau < 64; tau++) { run += cum[tau * 33 + tid]; cum[tau * 33 + tid] = run; }
  }
  __syncthreads();
}

__device__ __forceinline__ void chunk_info(int cidx, int& tb, int& nch, int& n, int& cbase) {
  if (cidx < 128) { int b = cidx >> 2; n = cidx & 3; nch = 4; tb = b * 256; cbase = b * 4; }
  else { int cl = cidx - 128, b = cl >> 5; n = cl & 31; nch = 32; tb = T_CTX + b * 2048; cbase = 128 + b * 32; }
}

__device__ __forceinline__ void gla_g1_item(const P& p, int l, int item, char* smem) {
  float* cum = (float*)smem;
  float* kd = cum + 64 * 33;
  float* vv = kd + 64 * 33;
  const int tid = tidx();
  int dir = item & 1, h = (item >> 1) & 3, cidx = item >> 3;
  int tb, nch, n, cbase;
  chunk_info(cidx, tb, nch, n, cbase);
  int c = dir ? nch - 1 - n : n;
  __syncthreads();
  gla_cum(p, l, tb, c, h, dir, cum);
  {
    int tau = tid >> 2, q = tid & 3;
    const float* hrow = W_hbuf + (size_t)gla_tok(tb, c, dir, tau) * 1984;
#pragma unroll
    for (int j = 0; j < 8; j++) {
      int k = q * 8 + j;
      kd[tau * 33 + k] = hrow[800 + h * 32 + k] * __expf(cum[63 * 33 + k] - cum[tau * 33 + k]);
    }
#pragma unroll
    for (int j = 0; j < 4; j++) *(float4*)(vv + tau * 64 + q * 16 + j * 4) = *(const float4*)(hrow + 928 + h * 64 + q * 16 + j * 4);
  }
  __syncthreads();
  {
    int k = tid >> 3, v0 = (tid & 7) * 8;
    float a[8];
#pragma unroll
    for (int j = 0; j < 8; j++) a[j] = 0.f;
    for (int tau = 0; tau < 64; tau++) {
      float kk = kd[tau * 33 + k];
#pragma unroll
      for (int j = 0; j < 8; j++) a[j] += kk * vv[tau * 64 + v0 + j];
    }
    float* dst = W_un + (size_t)item * 2048 + k * 64 + v0;
#pragma unroll
    for (int j = 0; j < 8; j++) dst[j] = a[j];
    if (tid < 32) W_gn[item * 32 + tid] = __expf(cum[63 * 33 + tid]);
  }
}

__device__ __forceinline__ void phase_gla_scan(const P& p, int l) {
  for (int it = blockIdx.x; it < 2176; it += gridDim.x) {
    int e = it * 256 + tidx();
    int kv = e & 2047, sd = e >> 11, dir = sd & 1, h = (sd >> 1) & 3, seq = sd >> 3;
    int nch, cbase;
    float s;
    if (seq < 32) { nch = 4; cbase = seq * 4; s = 0.f; }
    else { int b = seq - 32; nch = 32; cbase = 128 + b * 32; s = p.state_gla[((size_t)(((b * 2 + l) * 2 + dir) * 4 + h)) * 2048 + kv]; }
    for (int n = 0; n < nch; n++) {
      int item = ((cbase + n) * 4 + h) * 2 + dir;
      W_sin_[(size_t)item * 2048 + kv] = s;
      s = W_gn[item * 32 + (kv >> 6)] * s + W_un[(size_t)item * 2048 + kv];
    }
    if (seq < 32) p.out[19398656 + ((size_t)(((seq * 2 + l) * 2 + dir) * 4 + h)) * 2048 + kv] = s;
  }
}

__device__ __forceinline__ void phase_gla_out(const P& p, int l, char* smem) {
  float* cum = (float*)smem;
  float* qs = cum + 64 * 33;
  float* kk = qs + 64 * 33;
  float* vv = kk + 64 * 33;
  float* att = vv + 64 * 64;
  const int tid = tidx();
  for (int it = blockIdx.x; it < 768; it += gridDim.x) {
    int h = it & 3, cidx = it >> 2;
    int tb, nch, c, cbase;
    chunk_info(cidx, tb, nch, c, cbase);
    const int tloc = tid >> 2, vq = tid & 3;
    float acc[16];
#pragma unroll
    for (int j = 0; j < 16; j++) acc[j] = 0.f;
    for (int dir = 0; dir < 2; dir++) {
      int n = dir ? nch - 1 - c : c;
      int item = ((cbase + n) * 4 + h) * 2 + dir;
      __syncthreads();
      gla_cum(p, l, tb, c, h, dir, cum);
      {
        int tau = tid >> 2, q = tid & 3;
        const float* hrow = W_hbuf + (size_t)gla_tok(tb, c, dir, tau) * 1984;
#pragma unroll
        for (int j = 0; j < 8; j++) {
          int k = q * 8 + j;
          qs[tau * 33 + k] = hrow[672 + h * 32 + k] * 0.17677669529663687f;
          kk[tau * 33 + k] = hrow[800 + h * 32 + k];
        }
#pragma unroll
        for (int j = 0; j < 4; j++) *(float4*)(vv + tau * 64 + q * 16 + j * 4) = *(const float4*)(hrow + 928 + h * 64 + q * 16 + j * 4);
      }
      __syncthreads();
      {
        int tau = tid >> 2, sq = tid & 3;
        float a[16];
#pragma unroll
        for (int j = 0; j < 16; j++) a[j] = 0.f;
        for (int k = 0; k < 32; k++) {
          float qv = qs[tau * 33 + k], ct = cum[tau * 33 + k];
#pragma unroll
          for (int j = 0; j < 16; j++) {
            int sg = sq * 16 + j;
            a[j] += qv * kk[sg * 33 + k] * __expf(fminf(ct - cum[sg * 33 + k], 0.f));
          }
        }
#pragma unroll
        for (int j = 0; j < 16; j++) { int sg = sq * 16 + j; att[tau * 65 + sg] = (sg <= tau) ? a[j] : 0.f; }
      }
      __syncthreads();
      {
        int tau = dir ? 63 - tloc : tloc;
        for (int sg = 0; sg < 64; sg++) {
          float av = att[tau * 65 + sg];
#pragma unroll
          for (int j = 0; j < 16; j++) acc[j] += av * vv[sg * 64 + vq * 16 + j];
        }
        const float* sin = W_sin_ + (size_t)item * 2048;
        for (int k = 0; k < 32; k++) {
          float qe = qs[tau * 33 + k] * __expf(cum[tau * 33 + k]);
#pragma unroll
          for (int j = 0; j < 4; j++) {
            float4 sv = *(const float4*)(sin + k * 64 + vq * 16 + j * 4);
            acc[j * 4 + 0] += qe * sv.x; acc[j * 4 + 1] += qe * sv.y; acc[j * 4 + 2] += qe * sv.z; acc[j * 4 + 3] += qe * sv.w;
          }
        }
      }
    }
    float ss = 0.f;
#pragma unroll
    for (int j = 0; j < 16; j++) ss += acc[j] * acc[j];
    ss += __shfl_xor(ss, 1);
    ss += __shfl_xor(ss, 2);
    float rs = rsqrtf(ss * (1.f / 64.f) + 1e-6f);
    int tok = tb + c * 64 + tloc;
    const float* grow = W_hbuf + (size_t)tok * 1984 + 1184 + h * 64 + vq * 16;
    bf16_t* dst = W_br + (size_t)tok * 1024 + 512 + h * 64 + vq * 16;
#pragma unroll
    for (int j = 0; j < 16; j++) {
      float val = acc[j] * rs * p.gla_norm[l * 64 + vq * 16 + j];
      dst[j] = f2bf(val * siluf(grow[j]));
    }
  }
}

__device__ __forceinline__ void phase_mixers(const P& p, int l, char* smem) {
  const int N_MLAL = 256, N_DFTL = 64, N_SWAL = 256, N_MLAC = 512, N_SWAC = 512, N_DFTC = 128, N_G1 = 1536;
  const int total = N_MLAL + N_DFTL + N_SWAL + N_MLAC + N_SWAC + N_DFTC + N_G1;
  for (int it0 = blockIdx.x; it0 < total; it0 += gridDim.x) {
    int it = it0;
    int type;
    bool lat = false;
    if (it < N_MLAL) { type = 0; lat = true; }
    else if ((it -= N_MLAL) < N_DFTL) { type = 2; lat = true; }
    else if ((it -= N_DFTL) < N_SWAL) { type = 1; lat = true; }
    else if ((it -= N_SWAL) < N_MLAC) { type = 0; }
    else if ((it -= N_MLAC) < N_SWAC) { type = 1; }
    else if ((it -= N_SWAC) < N_DFTC) { type = 2; }
    else { it -= N_DFTC; type = 3; }
    if (type == 0) {
      int qt, h, b, Sk;
      size_t tok0;
      if (lat) { qt = it & 31; h = (it >> 5) & 3; b = it >> 7; tok0 = T_CTX + b * 2048; Sk = 2560; }
      else { qt = it & 3; h = (it >> 2) & 3; b = it >> 4; tok0 = b * 256; Sk = 256; }
      const bf16_t* Kp = (lat ? W_Ka_lat : W_Ka_ctx) + (size_t)(b * 4 + h) * Sk * 96;
      const bf16_t* Vp = (lat ? W_Va_lat : W_Va_ctx) + (size_t)(b * 4 + h) * Sk * 64;
      attn_item<96>(W_Qa + tok0 * 384 + h * 96, 384, Kp, Vp, W_br + tok0 * 1024 + h * 64, qt * 64, Sk, 0, -1,
                    0.10206207261596575f, false, 0.f, smem);
    } else if (type == 1) {
      int qt, hq, b, Sk, nctx, W;
      size_t tok0;
      if (lat) { qt = it & 31; hq = (it >> 5) & 3; b = it >> 7; tok0 = T_CTX + b * 2048; Sk = 2560; nctx = 512; W = 128; }
      else { qt = it & 3; hq = (it >> 2) & 3; b = it >> 4; tok0 = b * 256; Sk = 256; nctx = 0; W = -1; }
      int kv = hq >> 1;
      const bf16_t* Kp = (lat ? W_Kd_lat : W_Kd_ctx) + (size_t)(b * 2 + kv) * Sk * 64;
      const bf16_t* Vp = (lat ? W_Vd_lat : W_Vd_ctx) + (size_t)(b * 2 + kv) * Sk * 64;
      attn_item<64>(W_Qd + tok0 * 256 + hq * 64, 256, Kp, Vp, W_br + tok0 * 1024 + 768 + hq * 64, qt * 64, Sk, nctx, W,
                    0.125f, true, p.swa_sink[l * 4 + hq], smem);
    } else if (type == 2) {
      int nt = it & 1, mt, b, S;
      size_t tok0;
      if (lat) { mt = (it >> 1) & 15; b = it >> 5; S = 2048; tok0 = T_CTX + b * 2048; }
      else { mt = (it >> 1) & 1; b = it >> 2; S = 256; tok0 = b * 256; }
      const bf16_t* Ap = (lat ? W_A2048 : W_A256) + (size_t)mt * 128 * 2 * S;
      const bf16_t* Bp = (lat ? W_Yt_lat : W_Yt_ctx) + (size_t)(b * 256 + nt * 128) * 2 * S;
      f32x4 acc[4][4];
      ZERO_ACC(acc);
      gemm_core(acc, Ap, 2 * S, Bp, 2 * S, 2 * S, smem);
      EPI_LOOP(acc, mt * 128, nt * 128, { W_br[(tok0 + m) * 1024 + 256 + n] = f2bf(v); });
    } else {
      gla_g1_item(p, l, it, smem);
    }
  }
}

__device__ __forceinline__ void phase_merge(const P& p, int l, char* smem) {
  for (int tile = blockIdx.x; tile < 96 * 16; tile += gridDim.x) {
    int mt = tile >> 4, nt = tile & 15, m0 = mt * 128, n0 = nt * 64;
    f32x4 tot[4][2];
    ZERO_ACC_N(tot, 2);
    for (int b = 0; b < 4; b++) {
      f32x4 acc[4][2];
      ZERO_ACC_N(acc, 2);
      gemm_core_t<2>(acc, W_br + (size_t)m0 * 1024 + b * 256, 1024, W_Wt_br + ((size_t)(l * 4 + b) * 1024 + n0) * 256, 256, 256, smem);
      EPI_LOOP_N(acc, m0, n0, 2, { tot[i_][j_][r_] += bf2f(W_gates[(size_t)m * 4096 + b * 1024 + n]) * v; });
    }
    EPI_LOOP_N(tot, m0, n0, 2, { W_u[(size_t)m * 1024 + n] = f2bf(v); });
  }
}

__device__ __forceinline__ void phase_wout(const P& p, int l, char* smem) {
  float* r = W_hbuf;
  const float alpha = 1.4142135623730951f;
  for (int tile = blockIdx.x; tile < 96 * 8; tile += gridDim.x) {
    int mt = tile >> 3, nt = tile & 7, m0 = mt * 128, n0 = nt * 128;
    f32x4 acc[4][4];
    ZERO_ACC(acc);
    gemm_core(acc, W_u + (size_t)m0 * 1024, 1024, W_Wt_out + ((size_t)l * 1024 + n0) * 1024, 1024, 1024, smem);
    const float* g1 = W_mada + (l * 3 + cond_row(m0)) * 6144 + 2048;
    EPI_LOOP(acc, m0, n0, { r[(size_t)m * 1024 + n] = alpha * x_in_row(p, l, m)[n] + g1[n] * v; });
  }
}

__device__ __forceinline__ void phase_ln_mid(const P& p, int l) {
  int lane = tidx() & 63, w = tidx() >> 6;
  const float* r = W_hbuf;
  for (int it = blockIdx.x; it < T_ALL / 4; it += gridDim.x) {
    int g = it * 4 + w;
    float v[16];
    load_row16(r + (size_t)g * 1024, lane, v);
    ln16(v);
    affine16(v, p.ln1_g + l * 1024, p.ln1_b + l * 1024, lane);
    store_row16(x_out_row(p, l, g), lane, v);
    ln16(v);
    const float* m = W_mada + (l * 3 + cond_row(g)) * 6144;
    modulate_store(v, m + 3072, m + 4096, W_u + (size_t)g * 1024, lane);
  }
}

__device__ __forceinline__ void phase_pq(const P& p, int l, char* smem) {
  bf16_t* pq = (bf16_t*)W_hbuf;
  for (int tile = blockIdx.x; tile < 96 * 16; tile += gridDim.x) {
    int mt = tile >> 4, nt = tile & 15, m0 = mt * 128, n0 = nt * 128;
    f32x4 acc[4][4];
    ZERO_ACC(acc);
    gemm_core(acc, W_u + (size_t)m0 * 1024, 1024, W_Wt_pq + ((size_t)l * 2048 + n0) * 1024, 1024, 1024, smem);
    EPI_LOOP(acc, m0, n0, { pq[(size_t)m * 2048 + n] = f2bf(v); });
  }
}

__device__ __forceinline__ void phase_scores(const P& p, int l, char* smem) {
  const bf16_t* pq = (const bf16_t*)W_hbuf;
  float* sc = (float*)W_gates;
  for (int tile = blockIdx.x; tile < 96 * 16; tile += gridDim.x) {
    int mt = tile >> 4, hp = tile & 15, m0 = mt * 128;
    f32x4 acc[4][4];
    ZERO_ACC(acc);
    gemm_core(acc, pq + (size_t)m0 * 2048 + hp * 128, 2048, W_keysbf + ((size_t)(l * 16 + hp)) * 128 * 128, 128, 128, smem);
    EPI_LOOP(acc, m0, 0, { sc[((size_t)m * 16 + hp) * 128 + n] = v; });
  }
}

__device__ __forceinline__ void top16_of_128(float a0, float a1, int lane, float& sv, int& si) {
  sv = NEG_INF; si = 0;
  for (int r = 0; r < 16; r++) {
    float M = wmax(fmaxf(a0, a1));
    unsigned long long m0 = __ballot(a0 == M);
    int idx;
    if (m0) {
      int src = __ffsll((long long)m0) - 1;
      idx = src;
      if (lane == src) a0 = NEG_INF;
    } else {
      unsigned long long m1 = __ballot(a1 == M);
      int src = __ffsll((long long)m1) - 1;
      idx = 64 + src;
      if (lane == src) a1 = NEG_INF;
    }
    if (lane == r) { sv = M; si = idx; }
  }
}

__device__ __forceinline__ void phase_topk(const P& p, int l) {
  const float* sc = (const float*)W_gates;
  int lane = tidx() & 63, w = tidx() >> 6;
  int ci = 0, cstart = 0;
  bool cvalid = lane < 50;
  for (int a = 0; a < 15; a++) {
    int n = 16 / (a + 1);
    if (lane >= cstart + n) { cstart += n; ci = a + 1; }
    else break;
  }
  int cj = lane - cstart;
  if (!cvalid) { ci = 0; cj = 0; }
  for (int it = blockIdx.x; it < T_ALL * 8 / 4; it += gridDim.x) {
    int th = it * 4 + w, t = th >> 3, h = th & 7;
    const float* s1 = sc + ((size_t)t * 16 + h * 2) * 128;
    const float* s2 = s1 + 128;
    float sv1, sv2; int si1, si2;
    top16_of_128(s1[lane], s1[lane + 64], lane, sv1, si1);
    top16_of_128(s2[lane], s2[lane + 64], lane, sv2, si2);
    float cv = __shfl(sv1, ci) + __shfl(sv2, cj);
    int cidx = __shfl(si1, ci) * 128 + __shfl(si2, cj);
    if (!cvalid) cv = NEG_INF;
    float vwork = cv;
    bool sel = false;
    float Mtop = 0.f;
    for (int r = 0; r < 16; r++) {
      float M = wmax(vwork);
      if (r == 0) Mtop = M;
      unsigned long long mm = __ballot(vwork == M);
      int src = __ffsll((long long)mm) - 1;
      if (lane == src) { sel = true; vwork = NEG_INF; }
    }
    float e = sel ? __expf(cv - Mtop) : 0.f;
    float Z = wsum(e);
    unsigned long long smask = __ballot(sel);
    if (sel) {
      int slot = __popcll(smask & ((1ull << lane) - 1ull));
      W_pidx[(size_t)t * 128 + h * 16 + slot] = cidx;
      W_pw[(size_t)t * 128 + h * 16 + slot] = e / Z;
    }
  }
}

__device__ __forceinline__ void phase_peer(const P& p, int l) {
  int lane = tidx() & 63, w = tidx() >> 6;
  const float* tu = p.peer_u + (size_t)l * 16384 * 1024;
  const float* tv = p.peer_v + (size_t)l * 16384 * 1024;
  for (int it = blockIdx.x; it < T_ALL / 4; it += gridDim.x) {
    int g = it * 4 + w;
    float uu[16];
#pragma unroll
    for (int q = 0; q < 4; q++) {
      ushort4 t = *(const ushort4*)(W_u + (size_t)g * 1024 + q * 256 + lane * 4);
      uu[q * 4] = bf2f(t.x); uu[q * 4 + 1] = bf2f(t.y); uu[q * 4 + 2] = bf2f(t.z); uu[q * 4 + 3] = bf2f(t.w);
    }
    int i0 = W_pidx[(size_t)g * 128 + lane], i1 = W_pidx[(size_t)g * 128 + 64 + lane];
    float w0 = W_pw[(size_t)g * 128 + lane], w1 = W_pw[(size_t)g * 128 + 64 + lane];
    float o[16];
#pragma unroll
    for (int j = 0; j < 16; j++) o[j] = 0.f;
#pragma unroll 2
    for (int e = 0; e < 128; e++) {
      int idx = __shfl(e < 64 ? i0 : i1, e & 63);
      float wt = __shfl(e < 64 ? w0 : w1, e & 63);
      const float* ur = tu + (size_t)idx * 1024;
      float d = 0.f;
#pragma unroll
      for (int q = 0; q < 4; q++) {
        float4 t = *(const float4*)(ur + q * 256 + lane * 4);
        d += uu[q * 4] * t.x + uu[q * 4 + 1] * t.y + uu[q * 4 + 2] * t.z + uu[q * 4 + 3] * t.w;
      }
      d = wsum(d);
      float act = 0.5f * d * (1.f + erff(d * 0.7071067811865476f));
      float cf = wt * act;
      const float* vr = tv + (size_t)idx * 1024;
#pragma unroll
      for (int q = 0; q < 4; q++) {
        float4 t = *(const float4*)(vr + q * 256 + lane * 4);
        o[q * 4] += cf * t.x; o[q * 4 + 1] += cf * t.y; o[q * 4 + 2] += cf * t.z; o[q * 4 + 3] += cf * t.w;
      }
    }
    float* xr = x_out_row(p, l, g);
    float x1[16];
    load_row16(xr, lane, x1);
    const float* m = W_mada + (l * 3 + cond_row(g)) * 6144;
#pragma unroll
    for (int q = 0; q < 4; q++) {
      float4 g2 = *(const float4*)(m + 5120 + q * 256 + lane * 4);
      x1[q * 4 + 0] = 1.4142135623730951f * x1[q * 4 + 0] + g2.x * o[q * 4 + 0];
      x1[q * 4 + 1] = 1.4142135623730951f * x1[q * 4 + 1] + g2.y * o[q * 4 + 1];
      x1[q * 4 + 2] = 1.4142135623730951f * x1[q * 4 + 2] + g2.z * o[q * 4 + 2];
      x1[q * 4 + 3] = 1.4142135623730951f * x1[q * 4 + 3] + g2.w * o[q * 4 + 3];
    }
    ln16(x1);
    affine16(x1, p.ln2_g + l * 1024, p.ln2_b + l * 1024, lane);
    store_row16(xr, lane, x1);
    if (l == 0) {
      ln16(x1);
      const float* m1 = W_mada + (1 * 3 + cond_row(g)) * 6144;
      modulate_store(x1, m1, m1 + 1024, W_u + (size_t)g * 1024, lane);
    }
  }
}

#define N_PHASES 28
__device__ __forceinline__ void run_phase(const P& p, int ph, char* smem) {
#ifdef ONLYQ
  { int l = ph & 1; if (ONLYQ == -1) { phase_prep(p, smem); return; } if (ONLYQ == -2) { phase_ln0(p); return; }
    switch (ONLYQ) { case 0: phase_win(p, l, smem); break; case 1: phase_post(p, l); break; case 2: phase_small_gemms(p, l, smem); break; case 3: phase_mixers(p, l, smem); break; case 4: phase_gla_scan(p, l); break; case 5: phase_gla_out(p, l, smem); break; case 6: phase_merge(p, l, smem); break; case 7: phase_wout(p, l, smem); break; case 8: phase_ln_mid(p, l); break; case 9: phase_pq(p, l, smem); break; case 10: phase_scores(p, l, smem); break; case 11: phase_topk(p, l); break; case 12: phase_peer(p, l); break; } return; }
#endif
  if (ph == 0) { phase_prep(p, smem); return; }
  if (ph == 1) { phase_ln0(p); return; }
  int l = (ph - 2) / 13, q = (ph - 2) % 13;
#ifdef EXCL
  if (q == EXCL) return;
#endif
  switch (q) {
    case 0: phase_win(p, l, smem); break;
    case 1: phase_post(p, l); break;
    case 2: phase_small_gemms(p, l, smem); break;
    case 3: phase_mixers(p, l, smem); break;
    case 4: phase_gla_scan(p, l); break;
    case 5: phase_gla_out(p, l, smem); break;
    case 6: phase_merge(p, l, smem); break;
    case 7: phase_wout(p, l, smem); break;
    case 8: phase_ln_mid(p, l); break;
    case 9: phase_pq(p, l, smem); break;
    case 10: phase_scores(p, l, smem); break;
    case 11: phase_topk(p, l); break;
    case 12: phase_peer(p, l); break;
  }
}

#define SMEM_BYTES 61440

#if MULTI
__global__ void __launch_bounds__(256, 2) k_phase(P p, int ph) {
  __shared__ __attribute__((aligned(16))) char smem[SMEM_BYTES];
  run_phase(p, ph, smem);
}
#else
__global__ void __launch_bounds__(256, 2) k_mega(P p) {
  __shared__ __attribute__((aligned(16))) char smem[SMEM_BYTES];
  cg::grid_group grid = cg::this_grid();
#pragma nounroll
  for (int ph = 0; ph < N_PHASES; ph++) {
    run_phase(p, ph, smem);
    if (ph + 1 < N_PHASES) grid.sync();
  }
}
#endif

extern "C" void kernel_launch(void* const* d_in, const int* in_sizes, int n_in, void* d_out, int out_size, void* d_ws,
                              size_t ws_size, hipStream_t stream) {
  P p{};
  const float** fp = (const float**)&p;
  for (int i = 0; i < 32; i++) fp[i] = (const float*)d_in[i];
  p.out = (float*)d_out;
  p.ws = (char*)d_ws;
  size_t off = WS_TOTAL;
  if (off > ws_size) { fprintf(stderr, "ws too small: need %zu have %zu\n", off, ws_size); return; }
#if MULTI
  for (int ph = 0; ph < N_PHASES; ph++) hipLaunchKernelGGL(k_phase, dim3(512), dim3(256), 0, stream, p, ph);
#else
  static int grid_blocks = 0;
  if (!grid_blocks) {
    int dev = 0, cus = 0, per_cu = 0;
    hipGetDevice(&dev);
    hipDeviceGetAttribute(&cus, hipDeviceAttributeMultiprocessorCount, dev);
    hipOccupancyMaxActiveBlocksPerMultiprocessor(&per_cu, k_mega, 256, 0);
    if (per_cu > 2) per_cu = 2;
    grid_blocks = cus * per_cu;
  }
  void* args[] = {&p};
  hipError_t e = hipLaunchCooperativeKernel((void*)k_mega, dim3(grid_blocks), dim3(256), args, 0, stream);
  if (e != hipSuccess) fprintf(stderr, "cooperative launch failed: %s (grid %d)\n", hipGetErrorString(e), grid_blocks);
#endif
}
```

```cpp
#include <hip/hip_runtime.h>
#include <hip/hip_cooperative_groups.h>
#include <cstdio>
#include <cstdint>
namespace cg = cooperative_groups;

#ifndef MULTI
#define MULTI 0
#endif

typedef unsigned short bf16_t;
using bf16x8 = __attribute__((ext_vector_type(8))) short;
using f32x4 = __attribute__((ext_vector_type(4))) float;
using u32x4 = __attribute__((ext_vector_type(4))) unsigned int;

#define T_ALL 12288
#define T_CTX 8192
#define NEG_INF (-__builtin_inff())

__device__ __forceinline__ int tidx() {
  int t = threadIdx.x;
  asm volatile("" : "+v"(t));
  return t;
}
__device__ __forceinline__ bf16_t f2bf(float f) {
  unsigned u = __float_as_uint(f);
  u += 0x7fffu + ((u >> 16) & 1u);
  return (bf16_t)(u >> 16);
}
__device__ __forceinline__ float bf2f(bf16_t b) { return __uint_as_float(((unsigned)b) << 16); }
__device__ __forceinline__ float wsum_shfl(float v) {
#pragma unroll
  for (int o = 32; o; o >>= 1) v += __shfl_xor(v, o);
  return v;
}
#define DPP_F(old, src, ctrl, rm) __int_as_float(__builtin_amdgcn_update_dpp(__float_as_int(old), __float_as_int(src), ctrl, rm, 0xf, false))
__device__ __forceinline__ float wsum(float v) {
  v += DPP_F(v, v, 0xB1, 0xf);
  v += DPP_F(v, v, 0x4E, 0xf);
  v += DPP_F(v, v, 0x141, 0xf);
  v += DPP_F(v, v, 0x140, 0xf);
  v += DPP_F(0.f, v, 0x142, 0xa);
  v += DPP_F(0.f, v, 0x143, 0xc);
  return __int_as_float(__builtin_amdgcn_readlane(__float_as_int(v), 63));
}
__device__ __forceinline__ float wmax(float v) {
  v = fmaxf(v, DPP_F(v, v, 0xB1, 0xf));
  v = fmaxf(v, DPP_F(v, v, 0x4E, 0xf));
  v = fmaxf(v, DPP_F(v, v, 0x141, 0xf));
  v = fmaxf(v, DPP_F(v, v, 0x140, 0xf));
  v = fmaxf(v, DPP_F(v, v, 0x142, 0xa));
  v = fmaxf(v, DPP_F(v, v, 0x143, 0xc));
  return __int_as_float(__builtin_amdgcn_readlane(__float_as_int(v), 63));
}
__device__ __forceinline__ float siluf(float x) { return x / (1.f + __expf(-x)); }
__device__ __forceinline__ float sigmf(float x) { return 1.f / (1.f + __expf(-x)); }
__device__ __forceinline__ float logsigf(float z) { return fminf(z, 0.f) - log1pf(__expf(-fabsf(z))); }
__device__ __forceinline__ int cond_row(int g) { return g < T_CTX ? 0 : 1 + ((g - T_CTX) >> 11); }

struct P {
  const float *x_prompt, *x_sample, *c, *cache_ckv, *cache_krope, *cache_swa_k, *cache_swa_v, *state_gla, *c_ctx,
      *w_ada, *b_ada, *w_in, *mla_q_norm, *w_uq, *mla_kv_norm, *w_ukv, *w_gla_a_fwd, *b_gla_a_fwd, *w_gla_a_bwd,
      *b_gla_a_bwd, *gla_norm, *swa_sink, *w_branch, *w_out, *ln1_g, *ln1_b, *ln2_g, *ln2_b, *w_peer_q, *peer_keys,
      *peer_u, *peer_v;
  float* out;
  char* ws;
};

constexpr size_t OFF_Wt_in = 0ull;
constexpr size_t OFF_Wt_uq = OFF_Wt_in + (((2ull * 6144 * 1024 * 2) + 255ull) & ~255ull);
constexpr size_t OFF_Wt_ukv = OFF_Wt_uq + (((2ull * 384 * 256 * 2) + 255ull) & ~255ull);
constexpr size_t OFF_Wt_br = OFF_Wt_ukv + (((2ull * 512 * 128 * 2) + 255ull) & ~255ull);
constexpr size_t OFF_Wt_out = OFF_Wt_br + (((8ull * 1024 * 256 * 2) + 255ull) & ~255ull);
constexpr size_t OFF_Wt_pq = OFF_Wt_out + (((2ull * 1024 * 1024 * 2) + 255ull) & ~255ull);
constexpr size_t OFF_keysbf = OFF_Wt_pq + (((2ull * 2048 * 1024 * 2) + 255ull) & ~255ull);
constexpr size_t OFF_Cch = OFF_keysbf + (((2ull * 16 * 128 * 128 * 2) + 255ull) & ~255ull);
constexpr size_t OFF_A256 = OFF_Cch + (((128ull * 64 * 2) + 255ull) & ~255ull);
constexpr size_t OFF_A2048 = OFF_A256 + (((256ull * 512 * 2) + 255ull) & ~255ull);
constexpr size_t OFF_mada = OFF_A2048 + (((2048ull * 4096 * 2) + 255ull) & ~255ull);
constexpr size_t OFF_xbuf = OFF_mada + (((2ull * 3 * 6144 * 4) + 255ull) & ~255ull);
constexpr size_t OFF_u = OFF_xbuf + 256ull;
constexpr size_t OFF_hbuf = OFF_u + (((12288ull * 1024 * 2) + 255ull) & ~255ull);
constexpr size_t OFF_gates = OFF_hbuf + (((12288ull * 1984 * 4) + 255ull) & ~255ull);
constexpr size_t OFF_qn = OFF_gates + (((12288ull * 4096 * 2) + 255ull) & ~255ull);
constexpr size_t OFF_ckv_all = OFF_qn + (((12288ull * 256 * 2) + 255ull) & ~255ull);
constexpr size_t OFF_Qa = OFF_ckv_all + (((13312ull * 128 * 2) + 255ull) & ~255ull);
constexpr size_t OFF_Ka_ctx = OFF_Qa + (((12288ull * 384 * 2) + 255ull) & ~255ull);
constexpr size_t OFF_Ka_lat = OFF_Ka_ctx + (((32ull * 4 * 256 * 96 * 2) + 255ull) & ~255ull);
constexpr size_t OFF_Va_ctx = OFF_Ka_lat + (((2ull * 4 * 2560 * 96 * 2) + 255ull) & ~255ull);
constexpr size_t OFF_Va_lat = OFF_Va_ctx + (((32ull * 4 * 256 * 64 * 2) + 255ull) & ~255ull);
constexpr size_t OFF_Qd = OFF_Va_lat + (((2ull * 4 * 2560 * 64 * 2) + 255ull) & ~255ull);
constexpr size_t OFF_Kd_ctx = OFF_Qd + (((12288ull * 256 * 2) + 255ull) & ~255ull);
constexpr size_t OFF_Kd_lat = OFF_Kd_ctx + (((32ull * 2 * 256 * 64 * 2) + 255ull) & ~255ull);
constexpr size_t OFF_Vd_ctx = OFF_Kd_lat + (((2ull * 2 * 2560 * 64 * 2) + 255ull) & ~255ull);
constexpr size_t OFF_Vd_lat = OFF_Vd_ctx + (((32ull * 2 * 256 * 64 * 2) + 255ull) & ~255ull);
constexpr size_t OFF_fnet = OFF_Vd_lat + (((2ull * 2 * 2560 * 64 * 2) + 255ull) & ~255ull);
constexpr size_t OFF_Yt_ctx = OFF_fnet + (((12288ull * 256 * 2) + 255ull) & ~255ull);
constexpr size_t OFF_Yt_lat = OFF_Yt_ctx + (((32ull * 256 * 512 * 2) + 255ull) & ~255ull);
constexpr size_t OFF_br = OFF_Yt_lat + (((2ull * 256 * 4096 * 2) + 255ull) & ~255ull);
constexpr size_t OFF_un = OFF_br + (((12288ull * 1024 * 2) + 255ull) & ~255ull);
constexpr size_t OFF_sin_ = OFF_un + (((1536ull * 2048 * 4) + 255ull) & ~255ull);
constexpr size_t OFF_gn = OFF_sin_ + (((1536ull * 2048 * 4) + 255ull) & ~255ull);
constexpr size_t OFF_pidx = OFF_gn + (((1536ull * 32 * 4) + 255ull) & ~255ull);
constexpr size_t OFF_pw = OFF_pidx + (((12288ull * 128 * 4) + 255ull) & ~255ull);
constexpr size_t OFF_bar = OFF_pw + (((12288ull * 128 * 4) + 255ull) & ~255ull);
constexpr size_t WS_TOTAL_OLD = OFF_pw + (((12288ull * 128 * 4) + 255ull) & ~255ull);
constexpr size_t OFF_tabU = OFF_bar + 16384ull;
constexpr size_t OFF_tabV = OFF_tabU + 2ull * 16384 * 1024;
constexpr size_t WS_TOTAL = OFF_tabV + 2ull * 16384 * 1024;
#define W_tabU ((unsigned char*)(p.ws + OFF_tabU))
#define W_tabV ((unsigned char*)(p.ws + OFF_tabV))
#define W_Wt_in ((bf16_t*)(p.ws + OFF_Wt_in))
#define W_Wt_uq ((bf16_t*)(p.ws + OFF_Wt_uq))
#define W_Wt_ukv ((bf16_t*)(p.ws + OFF_Wt_ukv))
#define W_Wt_br ((bf16_t*)(p.ws + OFF_Wt_br))
#define W_Wt_out ((bf16_t*)(p.ws + OFF_Wt_out))
#define W_Wt_pq ((bf16_t*)(p.ws + OFF_Wt_pq))
#define W_keysbf ((bf16_t*)(p.ws + OFF_keysbf))
#define W_Cch ((bf16_t*)(p.ws + OFF_Cch))
#define W_A256 ((bf16_t*)(p.ws + OFF_A256))
#define W_A2048 ((bf16_t*)(p.ws + OFF_A2048))
#define W_mada ((float*)(p.ws + OFF_mada))
#define W_xbuf ((float*)(p.ws + OFF_xbuf))
#define W_u ((bf16_t*)(p.ws + OFF_u))
#define W_hbuf ((float*)(p.ws + OFF_hbuf))
#define W_gates ((bf16_t*)(p.ws + OFF_gates))
#define W_qn ((bf16_t*)(p.ws + OFF_qn))
#define W_ckv_all ((bf16_t*)(p.ws + OFF_ckv_all))
#define W_Qa ((bf16_t*)(p.ws + OFF_Qa))
#define W_Ka_ctx ((bf16_t*)(p.ws + OFF_Ka_ctx))
#define W_Ka_lat ((bf16_t*)(p.ws + OFF_Ka_lat))
#define W_Va_ctx ((bf16_t*)(p.ws + OFF_Va_ctx))
#define W_Va_lat ((bf16_t*)(p.ws + OFF_Va_lat))
#define W_Qd ((bf16_t*)(p.ws + OFF_Qd))
#define W_Kd_ctx ((bf16_t*)(p.ws + OFF_Kd_ctx))
#define W_Kd_lat ((bf16_t*)(p.ws + OFF_Kd_lat))
#define W_Vd_ctx ((bf16_t*)(p.ws + OFF_Vd_ctx))
#define W_Vd_lat ((bf16_t*)(p.ws + OFF_Vd_lat))
#define W_fnet ((bf16_t*)(p.ws + OFF_fnet))
#define W_Yt_ctx ((bf16_t*)(p.ws + OFF_Yt_ctx))
#define W_Yt_lat ((bf16_t*)(p.ws + OFF_Yt_lat))
#define W_br ((bf16_t*)(p.ws + OFF_br))
#define W_un ((float*)(p.ws + OFF_un))
#define W_sin_ ((float*)(p.ws + OFF_sin_))
#define W_gn ((float*)(p.ws + OFF_gn))
#define W_pidx ((int*)(p.ws + OFF_pidx))
#define W_pw ((float*)(p.ws + OFF_pw))

#define GB_LD 72
#define G_LOAD(RA, RB, KOFF)                                                         \
  _Pragma("unroll") for (int i = 0; i < 4; i++) {                                    \
    int c = tid + i * 256, r = c >> 3, cc = (c & 7) * 8;                             \
    RA[i] = *(const u32x4*)(A + (size_t)r * lda + (KOFF) + cc);                      \
    if (i < NJ) RB[i] = *(const u32x4*)(B + (size_t)r * ldb + (KOFF) + cc);          \
  }
#define G_STORE(RA, RB)                                                              \
  _Pragma("unroll") for (int i = 0; i < 4; i++) {                                    \
    int c = tid + i * 256, r = c >> 3, cc = (c & 7) * 8;                             \
    *(u32x4*)(sa + r * GB_LD + cc) = RA[i];                                          \
    if (i < NJ) *(u32x4*)(sb + r * GB_LD + cc) = RB[i];                              \
  }
#define G_COMPUTE()                                                                  \
  _Pragma("unroll") for (int ks = 0; ks < 2; ks++) {                                 \
    bf16x8 af[4], bfr[NJ];                                                           \
    _Pragma("unroll") for (int i = 0; i < 4; i++)                                    \
      af[i] = *(const bf16x8*)(sa + (wm * 64 + i * 16 + l15) * GB_LD + ks * 32 + l4 * 8); \
    _Pragma("unroll") for (int j = 0; j < NJ; j++)                                   \
      bfr[j] = *(const bf16x8*)(sb + (wn * NJ * 16 + j * 16 + l15) * GB_LD + ks * 32 + l4 * 8); \
    _Pragma("unroll") for (int i = 0; i < 4; i++)                                    \
    _Pragma("unroll") for (int j = 0; j < NJ; j++)                                   \
      acc[i][j] = __builtin_amdgcn_mfma_f32_16x16x32_bf16(af[i], bfr[j], acc[i][j], 0, 0, 0); \
  }
template <int NJ>
__device__ __forceinline__ void gemm_core_t(f32x4 (&acc)[4][NJ], const bf16_t* __restrict__ A, int lda,
                                            const bf16_t* __restrict__ B, int ldb, int K, char* smem) {
  bf16_t* sa = (bf16_t*)smem;
  bf16_t* sb = sa + 128 * GB_LD;
  const int tid = tidx(), lane = tid & 63, w = tid >> 6, wm = w >> 1, wn = w & 1;
  const int l15 = lane & 15, l4 = lane >> 4;
  u32x4 ra0[4], rb0[NJ], ra1[4], rb1[NJ];
  G_LOAD(ra0, rb0, 0);
  if (K > 64) { G_LOAD(ra1, rb1, 64); }
  for (int k0 = 0; k0 < K; k0 += 128) {
    __syncthreads();
    G_STORE(ra0, rb0);
    __syncthreads();
    if (k0 + 128 < K) { G_LOAD(ra0, rb0, k0 + 128); }
    G_COMPUTE();
    if (k0 + 64 < K) {
      __syncthreads();
      G_STORE(ra1, rb1);
      __syncthreads();
      if (k0 + 192 < K) { G_LOAD(ra1, rb1, k0 + 192); }
      G_COMPUTE();
    }
  }
}
#define gemm_core gemm_core_t<4>
#define ZERO_ACC_N(acc, NJ)                                        \
  _Pragma("unroll") for (int i_ = 0; i_ < 4; i_++)                 \
  _Pragma("unroll") for (int j_ = 0; j_ < NJ; j_++) { acc[i_][j_] = f32x4{0.f, 0.f, 0.f, 0.f}; }
#define ZERO_ACC(acc) ZERO_ACC_N(acc, 4)
#define EPI_LOOP_N(acc, m0, n0, NJ, ...)                                                   \
  {                                                                                        \
    const int lane_ = tidx() & 63, w_ = tidx() >> 6, wm_ = w_ >> 1, wn_ = w_ & 1; \
    _Pragma("unroll") for (int i_ = 0; i_ < 4; i_++)                                       \
    _Pragma("unroll") for (int j_ = 0; j_ < NJ; j_++)                                      \
    _Pragma("unroll") for (int r_ = 0; r_ < 4; r_++) {                                     \
      const int m = (m0) + wm_ * 64 + i_ * 16 + (lane_ >> 4) * 4 + r_;                     \
      const int n = (n0) + wn_ * (NJ * 16) + j_ * 16 + (lane_ & 15);                       \
      float v = acc[i_][j_][r_];                                                           \
      __VA_ARGS__                                                                          \
    }                                                                                      \
  }
#define EPI_LOOP(acc, m0, n0, ...) EPI_LOOP_N(acc, m0, n0, 4, __VA_ARGS__)
#define EPI4_LOOP(acc, c0, t0, ...)                                                        \
  {                                                                                        \
    const int lane_ = tidx() & 63, w_ = tidx() >> 6, wm_ = w_ >> 1, wn_ = w_ & 1;           \
    _Pragma("unroll") for (int i_ = 0; i_ < 4; i_++)                                       \
    _Pragma("unroll") for (int j_ = 0; j_ < 4; j_++) {                                     \
      const int col = (c0) + wm_ * 64 + i_ * 16 + (lane_ >> 4) * 4;                        \
      const int tok = (t0) + wn_ * 64 + j_ * 16 + (lane_ & 15);                            \
      const f32x4 v4 = acc[i_][j_];                                                        \
      __VA_ARGS__                                                                          \
    }                                                                                      \
  }

__device__ __forceinline__ void transpose_tile(const float* __restrict__ src, int K, int N, bf16_t* __restrict__ dst, int tile, int ntn,
                               float* sm) {
  int kt = tile / ntn, nt = tile % ntn, k0 = kt * 64, n0 = nt * 64;
  int tx = tidx() & 63, ty = tidx() >> 6;
  __syncthreads();
  for (int i = 0; i < 16; i++) {
    int k = i * 4 + ty, n = n0 + tx;
    sm[k * 65 + tx] = (n < N) ? src[(size_t)(k0 + k) * N + n] : 0.f;
  }
  __syncthreads();
  for (int i = 0; i < 16; i++) {
    int n = i * 4 + ty;
    dst[(size_t)(n0 + n) * K + k0 + tx] = f2bf(sm[tx * 65 + n]);
  }
}

__device__ __forceinline__ void ada_item(const P& p, int item, float* sm) {
  int l = item / 24, cgp = item % 24;
  int lane = tidx() & 63, w = tidx() >> 6;
  const float* W = p.w_ada + (size_t)l * 1024 * 6144 + cgp * 256 + lane * 4;
  float4 a0 = {0, 0, 0, 0}, a1 = {0, 0, 0, 0}, a2 = {0, 0, 0, 0};
#pragma unroll 8
  for (int k = w * 256; k < (w + 1) * 256; k++) {
    float4 wv = *(const float4*)(W + (size_t)k * 6144);
    float c0 = siluf(p.c_ctx[k]), c1 = siluf(p.c[k]), c2 = siluf(p.c[1024 + k]);
    a0.x += c0 * wv.x; a0.y += c0 * wv.y; a0.z += c0 * wv.z; a0.w += c0 * wv.w;
    a1.x += c1 * wv.x; a1.y += c1 * wv.y; a1.z += c1 * wv.z; a1.w += c1 * wv.w;
    a2.x += c2 * wv.x; a2.y += c2 * wv.y; a2.z += c2 * wv.z; a2.w += c2 * wv.w;
  }
  __syncthreads();
  *(float4*)(sm + (w * 3 + 0) * 256 + lane * 4) = a0;
  *(float4*)(sm + (w * 3 + 1) * 256 + lane * 4) = a1;
  *(float4*)(sm + (w * 3 + 2) * 256 + lane * 4) = a2;
  __syncthreads();
  for (int o = tidx(); o < 768; o += 256) {
    int r = o >> 8, col = o & 255;
    float s = sm[(0 * 3 + r) * 256 + col] + sm[(1 * 3 + r) * 256 + col] + sm[(2 * 3 + r) * 256 + col] +
              sm[(3 * 3 + r) * 256 + col];
    W_mada[(l * 3 + r) * 6144 + cgp * 256 + col] = s + p.b_ada[l * 6144 + cgp * 256 + col];
  }
}

__device__ __forceinline__ void dft_seq_fill(bf16_t* dst, int S, int item) {
  float inv = rsqrtf((float)S);
  size_t base = (size_t)item * 2048;
  for (int e = 0; e < 8; e++) {
    size_t idx = base + e * 256 + tidx();
    int k = (int)(idx / (2 * S)), col = (int)(idx % (2 * S));
    int s = col < S ? col : col - S;
    int mm = (k * s) & (S - 1);
    float rev = (float)mm / (float)S;
    float v = col < S ? __builtin_amdgcn_cosf(rev) : -__builtin_amdgcn_sinf(rev);
    dst[idx] = f2bf(v * inv);
  }
}

#define PEER_U_SCALE 64.f
#define PEER_V_SCALE 16.f
__device__ __forceinline__ void tab_convert_item(const P& p, int item) {
  int l = item >> 12, isv = (item >> 11) & 1, sub = item & 2047;
  const float* src = (isv ? p.peer_v : p.peer_u) + (size_t)l * 16384 * 1024 + (size_t)sub * 8192;
  unsigned char* dst = (isv ? W_tabV : W_tabU) + (size_t)l * 16384 * 1024 + (size_t)sub * 8192;
  const float sc = isv ? PEER_V_SCALE : PEER_U_SCALE;
  int tid = tidx();
  float4 tt[8];
#pragma unroll
  for (int e = 0; e < 8; e++) tt[e] = *(const float4*)(src + (e * 256 + tid) * 4);
#pragma unroll
  for (int e = 0; e < 8; e++) {
    float4 t = tt[e];
    int pk = __builtin_amdgcn_cvt_pk_fp8_f32(t.x * sc, t.y * sc, 0, false);
    pk = __builtin_amdgcn_cvt_pk_fp8_f32(t.z * sc, t.w * sc, pk, true);
    *(int*)(dst + (e * 256 + tid) * 4) = pk;
  }
}

__device__ __forceinline__ void phase_prep(const P& p, char* smem) {
  float* sm = (float*)smem;
  const int nb = gridDim.x;
  const int J_ADA = 48;
  const int J_IN = 2 * 16 * 96;
  const int J_UQ = 2 * 4 * 6;
  const int J_UKV = 2 * 2 * 8;
  const int J_BR = 2 * 4 * 4 * 16;
  const int J_OUT = 2 * 16 * 16;
  const int J_PQ = 2 * 16 * 32;
  const int J_KEYS = 256;
  const int J_CCH = 4;
  const int J_A256 = 64;
  const int J_A2048 = 4096;
  const int J_TAB = 8192;
  const int total = J_ADA + J_IN + J_UQ + J_UKV + J_BR + J_OUT + J_PQ + J_KEYS + J_CCH + J_A256 + J_A2048 + J_TAB;
  for (int it0 = blockIdx.x; it0 < total; it0 += nb) {
    int it = it0;
    if (it < J_ADA) { ada_item(p, it, sm); continue; }
    it -= J_ADA;
    if (it < J_IN) { int l = it / 1536, t = it % 1536; transpose_tile(p.w_in + (size_t)l * 1024 * 6080, 1024, 6080, W_Wt_in + (size_t)l * 6144 * 1024, t, 96, sm); continue; }
    it -= J_IN;
    if (it < J_UQ) { int l = it / 24, t = it % 24; transpose_tile(p.w_uq + (size_t)l * 256 * 384, 256, 384, W_Wt_uq + (size_t)l * 384 * 256, t, 6, sm); continue; }
    it -= J_UQ;
    if (it < J_UKV) { int l = it / 16, t = it % 16; transpose_tile(p.w_ukv + (size_t)l * 128 * 512, 128, 512, W_Wt_ukv + (size_t)l * 512 * 128, t, 8, sm); continue; }
    it -= J_UKV;
    if (it < J_BR) { int lb = it / 64, t = it % 64; transpose_tile(p.w_branch + (size_t)lb * 256 * 1024, 256, 1024, W_Wt_br + (size_t)lb * 1024 * 256, t, 16, sm); continue; }
    it -= J_BR;
    if (it < J_OUT) { int l = it / 256, t = it % 256; transpose_tile(p.w_out + (size_t)l * 1024 * 1024, 1024, 1024, W_Wt_out + (size_t)l * 1024 * 1024, t, 16, sm); continue; }
    it -= J_OUT;
    if (it < J_PQ) { int l = it / 512, t = it % 512; transpose_tile(p.w_peer_q + (size_t)l * 1024 * 2048, 1024, 2048, W_Wt_pq + (size_t)l * 2048 * 1024, t, 32, sm); continue; }
    it -= J_PQ;
    if (it < J_KEYS) {
      size_t base = (size_t)it * 2048;
      float kv_[8];
#pragma unroll
      for (int e = 0; e < 8; e++) kv_[e] = p.peer_keys[base + e * 256 + tidx()];
#pragma unroll
      for (int e = 0; e < 8; e++) W_keysbf[base + e * 256 + tidx()] = f2bf(kv_[e]);
      continue;
    }
    it -= J_KEYS;
    if (it < J_CCH) {
      for (int e = 0; e < 8; e++) {
        int idx = it * 2048 + e * 256 + tidx();
        int n = idx >> 6, c = idx & 63;
        int j = n & 63;
        float rev = (float)((j * c) & 63) / 64.f;
        float v = n < 64 ? __builtin_amdgcn_cosf(rev) : __builtin_amdgcn_sinf(rev);
        W_Cch[idx] = f2bf(v * 0.125f);
      }
      continue;
    }
    it -= J_CCH;
    if (it < J_A256) { dft_seq_fill(W_A256, 256, it); continue; }
    it -= J_A256;
    if (it < J_A2048) { dft_seq_fill(W_A2048, 2048, it); continue; }
    it -= J_A2048;
    tab_convert_item(p, it);
  }
}

__device__ __forceinline__ void load_row16(const float* row, int lane, float (&v)[16]) {
#pragma unroll
  for (int q = 0; q < 4; q++) {
    float4 t = *(const float4*)(row + q * 256 + lane * 4);
    v[q * 4 + 0] = t.x; v[q * 4 + 1] = t.y; v[q * 4 + 2] = t.z; v[q * 4 + 3] = t.w;
  }
}
__device__ __forceinline__ void store_row16(float* row, int lane, const float (&v)[16]) {
#pragma unroll
  for (int q = 0; q < 4; q++) *(float4*)(row + q * 256 + lane * 4) = float4{v[q * 4], v[q * 4 + 1], v[q * 4 + 2], v[q * 4 + 3]};
}
__device__ __forceinline__ void ln16(float (&v)[16]) {
  float s = 0;
#pragma unroll
  for (int i = 0; i < 16; i++) s += v[i];
  s = wsum(s);
  float mu = s * (1.f / 1024.f);
  float q = 0;
#pragma unroll
  for (int i = 0; i < 16; i++) { v[i] -= mu; q += v[i] * v[i]; }
  q = wsum(q);
  float rs = rsqrtf(q * (1.f / 1024.f) + 1e-6f);
#pragma unroll
  for (int i = 0; i < 16; i++) v[i] *= rs;
}
__device__ __forceinline__ void modulate_store(const float (&v)[16], const float* sh, const float* sc, bf16_t* dst, int lane) {
#pragma unroll
  for (int q = 0; q < 4; q++) {
    float4 a = *(const float4*)(sc + q * 256 + lane * 4);
    float4 b = *(const float4*)(sh + q * 256 + lane * 4);
    ushort4 o;
    o.x = f2bf(v[q * 4 + 0] * (1.f + a.x) + b.x);
    o.y = f2bf(v[q * 4 + 1] * (1.f + a.y) + b.y);
    o.z = f2bf(v[q * 4 + 2] * (1.f + a.z) + b.z);
    o.w = f2bf(v[q * 4 + 3] * (1.f + a.w) + b.w);
    *(ushort4*)(dst + q * 256 + lane * 4) = o;
  }
}
__device__ __forceinline__ void affine16(float (&v)[16], const float* g, const float* b, int lane) {
#pragma unroll
  for (int q = 0; q < 4; q++) {
    float4 a = *(const float4*)(g + q * 256 + lane * 4);
    float4 c = *(const float4*)(b + q * 256 + lane * 4);
    v[q * 4 + 0] = v[q * 4 + 0] * a.x + c.x;
    v[q * 4 + 1] = v[q * 4 + 1] * a.y + c.y;
    v[q * 4 + 2] = v[q * 4 + 2] * a.z + c.z;
    v[q * 4 + 3] = v[q * 4 + 3] * a.w + c.w;
  }
}
__device__ __forceinline__ const float* x_in_row(const P& p, int l, int g) {
  if (l == 0) return g < T_CTX ? p.x_prompt + (size_t)g * 1024 : p.x_sample + (size_t)(g - T_CTX) * 1024;
  return p.out + (size_t)g * 1024;
}
__device__ __forceinline__ float* x_out_row(const P& p, int l, int g) {
  return p.out + (size_t)g * 1024;
}

__device__ __forceinline__ void phase_ln0(const P& p) {
  int lane = tidx() & 63, w = tidx() >> 6;
  for (int it = blockIdx.x; it < T_ALL / 4; it += gridDim.x) {
    int g = it * 4 + w;
    float v[16];
    load_row16(x_in_row(p, 0, g), lane, v);
    ln16(v);
    const float* m = W_mada + (0 * 3 + cond_row(g)) * 6144;
    modulate_store(v, m, m + 1024, W_u + (size_t)g * 1024, lane);
  }
}

__device__ __forceinline__ void phase_win(const P& p, int l, char* smem) {
  const bf16_t* Wt = W_Wt_in + (size_t)l * 6144 * 1024;
  for (int tile = blockIdx.x; tile < 96 * 48; tile += gridDim.x) {
    int mt = tile / 48, nt = tile % 48, m0 = mt * 128, n0 = nt * 128;
    f32x4 acc[4][4];
    ZERO_ACC(acc);
    gemm_core(acc, Wt + (size_t)n0 * 1024, 1024, W_u + (size_t)m0 * 1024, 1024, 1024, smem);
    EPI4_LOOP(acc, n0, m0, {
      if (col < 1984) *(float4*)(W_hbuf + (size_t)tok * 1984 + col) = float4{v4[0], v4[1], v4[2], v4[3]};
      else if (col < 6080) {
        ushort4 o_; o_.x = f2bf(sigmf(v4[0])); o_.y = f2bf(sigmf(v4[1])); o_.z = f2bf(sigmf(v4[2])); o_.w = f2bf(sigmf(v4[3]));
        *(ushort4*)(W_gates + (size_t)tok * 4096 + (col - 1984)) = o_;
      }
    });
  }
}

__device__ __forceinline__ void rope_cs(float pos, int i, float inv_hp, float& cs, float& sn) {
  float freq = exp2f(-(float)i * inv_hp * 13.287712379549449f);
  float a = pos * freq;
  sn = __sinf(a);
  cs = __cosf(a);
}

__device__ __forceinline__ void phase_post(const P& p, int l) {
  int lane = tidx() & 63, w = tidx() >> 6;
  for (int it = blockIdx.x; it < 13312 / 4; it += gridDim.x) {
    int g = it * 4 + w;
    if (g < T_ALL) {
      const bool lat = g >= T_CTX;
      int b, s;
      if (!lat) { b = g >> 8; s = g & 255; } else { b = (g - T_CTX) >> 11; s = (g - T_CTX) & 2047; }
      const float* h = W_hbuf + (size_t)g * 1984;
      const float prow = (float)(s >> 6), pcol = (float)(s & 63);
      const float4 pl_q = *(const float4*)(h + lane * 4);
      const float2 pl_c = *(const float2*)(h + 256 + lane * 2);
      const float pl_kr1 = h[384 + ((lane >> 3) & 1) * 16 + (lane & 7)], pl_kr2 = h[384 + ((lane >> 3) & 1) * 16 + 8 + (lane & 7)];
      const float4 pl_f = *(const float4*)(h + 416 + lane * 4);
      float pl_sq1[2], pl_sq2[2];
#pragma unroll
      for (int jj = 0; jj < 2; jj++) {
        int pi = lane + 64 * jj, hq = pi >> 5, pp = (pi >> 4) & 1, i = pi & 15;
        pl_sq1[jj] = h[1472 + hq * 64 + pp * 32 + i]; pl_sq2[jj] = h[1472 + hq * 64 + pp * 32 + 16 + i];
      }
      const float pl_sk1 = h[1728 + (lane >> 5) * 64 + ((lane >> 4) & 1) * 32 + (lane & 15)];
      const float pl_sk2 = h[1728 + (lane >> 5) * 64 + ((lane >> 4) & 1) * 32 + 16 + (lane & 15)];
      const float2 pl_v = *(const float2*)(h + 1856 + lane * 2);
      {
        float4 t = pl_q;
        float ss = wsum(t.x * t.x + t.y * t.y + t.z * t.z + t.w * t.w);
        float rs = rsqrtf(ss * (1.f / 256.f) + 1e-6f);
        float4 gq = *(const float4*)(p.mla_q_norm + l * 256 + lane * 4);
        ushort4 o;
        o.x = f2bf(t.x * rs * gq.x); o.y = f2bf(t.y * rs * gq.y); o.z = f2bf(t.z * rs * gq.z); o.w = f2bf(t.w * rs * gq.w);
        *(ushort4*)(W_qn + (size_t)g * 256 + lane * 4) = o;
      }
      {
        float2 t = pl_c;
        float ss = wsum(t.x * t.x + t.y * t.y);
        float rs = rsqrtf(ss * (1.f / 128.f) + 1e-6f);
        float2 gk = *(const float2*)(p.mla_kv_norm + l * 128 + lane * 2);
        float v0 = t.x * rs * gk.x, v1 = t.y * rs * gk.y;
        ushort2 o; o.x = f2bf(v0); o.y = f2bf(v1);
        *(ushort2*)(W_ckv_all + (size_t)g * 128 + lane * 2) = o;
        if (!lat) *(float2*)(p.out + 12582912 + ((size_t)((b * 2 + l) * 256 + s)) * 128 + lane * 2) = float2{v0, v1};
      }
      if (lane < 16) {
        int pp = lane >> 3, i = lane & 7;
        float x1 = pl_kr1, x2 = pl_kr2;
        float o1 = x1, o2 = x2;
        if (lat) {
          float cs, sn;
          rope_cs(pp ? pcol : prow, i, 0.125f, cs, sn);
          o1 = x1 * cs - x2 * sn; o2 = x2 * cs + x1 * sn;
        } else {
          float* ok = p.out + 14680064 + ((size_t)((b * 2 + l) * 256 + s)) * 32 + pp * 16 + i;
          ok[0] = o1; ok[8] = o2;
        }
        bf16_t b1 = f2bf(o1), b2 = f2bf(o2);
        for (int hh = 0; hh < 4; hh++) {
          bf16_t* kd = lat ? W_Ka_lat + ((size_t)((b * 4 + hh) * 2560 + 512 + s)) * 96 : W_Ka_ctx + ((size_t)((b * 4 + hh) * 256 + s)) * 96;
          kd[64 + pp * 16 + i] = b1; kd[64 + pp * 16 + 8 + i] = b2;
        }
      }
      {
        float4 t = pl_f;
        ushort4 o; o.x = f2bf(t.x); o.y = f2bf(t.y); o.z = f2bf(t.z); o.w = f2bf(t.w);
        *(ushort4*)(W_fnet + (size_t)g * 256 + lane * 4) = o;
      }
#pragma unroll
      for (int jj = 0; jj < 2; jj++) {
        int pi = lane + 64 * jj, hq = pi >> 5, pp = (pi >> 4) & 1, i = pi & 15;
        float x1 = pl_sq1[jj], x2 = pl_sq2[jj];
        float o1 = x1, o2 = x2;
        if (lat) {
          float cs, sn;
          rope_cs(pp ? pcol : prow, i, 0.0625f, cs, sn);
          o1 = x1 * cs - x2 * sn; o2 = x2 * cs + x1 * sn;
        }
        bf16_t* qd = W_Qd + (size_t)g * 256 + hq * 64 + pp * 32 + i;
        qd[0] = f2bf(o1); qd[16] = f2bf(o2);
      }
      {
        int kv = lane >> 5, pp = (lane >> 4) & 1, i = lane & 15;
        float x1 = pl_sk1, x2 = pl_sk2;
        float o1 = x1, o2 = x2;
        bf16_t* kd;
        if (lat) {
          float cs, sn;
          rope_cs(pp ? pcol : prow, i, 0.0625f, cs, sn);
          o1 = x1 * cs - x2 * sn; o2 = x2 * cs + x1 * sn;
          kd = W_Kd_lat + ((size_t)((b * 2 + kv) * 2560 + 512 + s)) * 64;
        } else {
          float* ok = p.out + 15204352 + ((size_t)(((b * 2 + l) * 2 + kv) * 256 + s)) * 64 + pp * 32 + i;
          ok[0] = o1; ok[16] = o2;
          kd = W_Kd_ctx + ((size_t)((b * 2 + kv) * 256 + s)) * 64;
        }
        kd[pp * 32 + i] = f2bf(o1); kd[pp * 32 + 16 + i] = f2bf(o2);
      }
      {
        int e = lane * 2, kv = e >> 6, d = e & 63;
        float2 t = pl_v;
        if (lat) {
          bf16_t* vt = W_Vd_lat + (size_t)(b * 2 + kv) * 64 * 2560 + 512 + s;
          vt[(size_t)d * 2560] = f2bf(t.x); vt[(size_t)(d + 1) * 2560] = f2bf(t.y);
        } else {
          *(float2*)(p.out + 17301504 + ((size_t)(((b * 2 + l) * 2 + kv) * 256 + s)) * 64 + d) = t;
          bf16_t* vt = W_Vd_ctx + (size_t)(b * 2 + kv) * 64 * 256 + s;
          vt[d * 256] = f2bf(t.x); vt[(d + 1) * 256] = f2bf(t.y);
        }
      }
    } else {
      int gc = g - T_ALL, b = gc >> 9, pp = gc & 511;
      {
        float2 t = *(const float2*)(p.cache_ckv + ((size_t)((b * 2 + l) * 512 + pp)) * 128 + lane * 2);
        ushort2 o; o.x = f2bf(t.x); o.y = f2bf(t.y);
        *(ushort2*)(W_ckv_all + (size_t)g * 128 + lane * 2) = o;
      }
      if (lane < 32) {
        bf16_t v = f2bf(p.cache_krope[((size_t)((b * 2 + l) * 512 + pp)) * 32 + lane]);
        for (int hh = 0; hh < 4; hh++) W_Ka_lat[((size_t)((b * 4 + hh) * 2560 + pp)) * 96 + 64 + lane] = v;
      }
      {
        int e = lane * 2, kv = e >> 6, d = e & 63;
        size_t src = ((size_t)(((b * 2 + l) * 2 + kv) * 512 + pp)) * 64 + d;
        float2 tk = *(const float2*)(p.cache_swa_k + src);
        float2 tv = *(const float2*)(p.cache_swa_v + src);
        size_t dst = ((size_t)((b * 2 + kv) * 2560 + pp)) * 64 + d;
        ushort2 ok; ok.x = f2bf(tk.x); ok.y = f2bf(tk.y);
        *(ushort2*)(W_Kd_lat + dst) = ok;
        bf16_t* vt = W_Vd_lat + (size_t)(b * 2 + kv) * 64 * 2560 + pp;
        vt[(size_t)d * 2560] = f2bf(tv.x); vt[(size_t)(d + 1) * 2560] = f2bf(tv.y);
      }
    }
  }
}

__device__ __forceinline__ void phase_small_gemms(const P& p, int l, char* smem) {
  const int NA = 96 * 3, NB = 104 * 4, NC = 384;
  for (int it0 = blockIdx.x; it0 < NA + NB + NC; it0 += gridDim.x) {
    int it = it0;
    f32x4 acc[4][4];
    ZERO_ACC(acc);
    if (it < NA) {
      int mt = it / 3, nt = it % 3, m0 = mt * 128, n0 = nt * 128;
      gemm_core(acc, W_qn + (size_t)m0 * 256, 256, W_Wt_uq + (size_t)l * 384 * 256 + (size_t)n0 * 256, 256, 256, smem);
      const bool lat = m0 >= T_CTX;
      EPI_LOOP(acc, m0, n0, {
        int c96 = n % 96;
        if (lat && c96 >= 64) {
          float pv = DPP_F(v, v, 0x128, 0xf);
          int cr = c96 - 64, pp = cr >> 4, ii = cr & 15, i = ii & 7;
          int s = (m - T_CTX) & 2047;
          float cs, sn;
          rope_cs(pp ? (float)(s & 63) : (float)(s >> 6), i, 0.125f, cs, sn);
          v = (ii < 8) ? v * cs - pv * sn : v * cs + pv * sn;
        }
        W_Qa[(size_t)m * 384 + n] = f2bf(v);
      });
      continue;
    }
    it -= NA;
    if (it < NB) {
      int mt = it / 4, nt = it % 4, m0 = mt * 128, n0 = nt * 128;
      gemm_core(acc, W_ckv_all + (size_t)m0 * 128, 128, W_Wt_ukv + (size_t)l * 512 * 128 + (size_t)n0 * 128, 128, 128, smem);
      EPI_LOOP(acc, m0, n0, {
        int hh = n >> 7, c = n & 127;
        bf16_t* kd; bf16_t* vd; int vstride;
        if (m < T_CTX) {
          int b = m >> 8, s = m & 255;
          size_t r = (size_t)((b * 4 + hh) * 256 + s);
          kd = W_Ka_ctx + r * 96; vd = W_Va_ctx + (size_t)(b * 4 + hh) * 64 * 256 + s; vstride = 256;
        } else {
          int b, pos;
          if (m < T_ALL) { b = (m - T_CTX) >> 11; pos = 512 + ((m - T_CTX) & 2047); }
          else { b = (m - T_ALL) >> 9; pos = (m - T_ALL) & 511; }
          size_t r = (size_t)((b * 4 + hh) * 2560 + pos);
          kd = W_Ka_lat + r * 96; vd = W_Va_lat + (size_t)(b * 4 + hh) * 64 * 2560 + pos; vstride = 2560;
        }
        if (c < 64) kd[c] = f2bf(v); else vd[(size_t)(c - 64) * vstride] = f2bf(v);
      });
      continue;
    }
    it -= NB;
    {
      int m0 = it * 128;
      gemm_core(acc, W_fnet + (size_t)m0 * 64, 64, W_Cch, 64, 64, smem);
      EPI_LOOP(acc, m0, 0, {
        int g = m >> 2, grp = m & 3, part = n >> 6, j = n & 63;
        if (g < T_CTX) {
          int b = g >> 8, s = g & 255;
          W_Yt_ctx[((size_t)(b * 256 + grp * 64 + j)) * 512 + part * 256 + s] = f2bf(v);
        } else {
          int b = (g - T_CTX) >> 11, s = (g - T_CTX) & 2047;
          W_Yt_lat[((size_t)(b * 256 + grp * 64 + j)) * 4096 + part * 2048 + s] = f2bf(v);
        }
      });
    }
  }
}

template <int DK>
__device__ __forceinline__ void attn_item(const bf16_t* __restrict__ Qp, int qstride, const bf16_t* __restrict__ Kp,
                          const bf16_t* __restrict__ Vp, bf16_t* __restrict__ Op, int q0, int Sk, int n_ctx, int W,
                          float scale, bool has_sink, float sink, char* smem) {
  constexpr int KLD = DK + 8;
  bf16_t* sK = (bf16_t*)smem;
  bf16_t* sVt = sK + 64 * KLD;
  bf16_t* sP = sVt + 64 * 72;
  const int tid = tidx(), lane = tid & 63, w = tid >> 6, l15 = lane & 15, l4 = lane >> 4;
  bf16_t* sPw = sP + w * 16 * 72;
  bf16x8 qf[DK / 32];
  {
    const bf16_t* qrow = Qp + (size_t)(q0 + w * 16 + l15) * qstride;
#pragma unroll
    for (int ks = 0; ks < DK / 32; ks++) qf[ks] = *(const bf16x8*)(qrow + ks * 32 + l4 * 8);
  }
  f32x4 o[4];
#pragma unroll
  for (int j = 0; j < 4; j++) o[j] = f32x4{0.f, 0.f, 0.f, 0.f};
  float mrow[4], lrow[4];
#pragma unroll
  for (int r = 0; r < 4; r++) { mrow[r] = NEG_INF; lrow[r] = 0.f; }
  const int ntile = Sk >> 6;
  auto tile_ok = [&](int kt) -> bool {
    int kb = kt * 64;
    if (W >= 0 && kb >= n_ctx) { int lp = kb - n_ctx; if (lp + 63 < q0 - W || lp > q0 + 63 + W) return false; }
    return true;
  };
  u32x4 rk[DK / 32], rv[2];
  int kt = 0;
  while (kt < ntile && !tile_ok(kt)) kt++;
  if (kt < ntile) {
#pragma unroll
    for (int i = 0; i < DK / 32; i++) { int c = tid + i * 256, r = c / (DK / 8), cc = (c % (DK / 8)) * 8; rk[i] = *(const u32x4*)(Kp + (size_t)(kt * 64 + r) * DK + cc); }
#pragma unroll
    for (int i = 0; i < 2; i++) { int c = tid + i * 256, dv = c >> 3, k0 = (c & 7) * 8; rv[i] = *(const u32x4*)(Vp + (size_t)dv * Sk + kt * 64 + k0); }
  }
  while (kt < ntile) {
    const int kbase = kt * 64;
    __syncthreads();
#pragma unroll
    for (int i = 0; i < DK / 32; i++) { int c = tid + i * 256, r = c / (DK / 8), cc = (c % (DK / 8)) * 8; *(u32x4*)(sK + r * KLD + cc) = rk[i]; }
#pragma unroll
    for (int i = 0; i < 2; i++) {
      int c = tid + i * 256, dv = c >> 3, k0 = (c & 7) * 8;
      *(u32x4*)(sVt + dv * 72 + k0) = rv[i];
    }
    __syncthreads();
    int ktn = kt + 1;
    while (ktn < ntile && !tile_ok(ktn)) ktn++;
    if (ktn < ntile) {
#pragma unroll
      for (int i = 0; i < DK / 32; i++) { int c = tid + i * 256, r = c / (DK / 8), cc = (c % (DK / 8)) * 8; rk[i] = *(const u32x4*)(Kp + (size_t)(ktn * 64 + r) * DK + cc); }
#pragma unroll
      for (int i = 0; i < 2; i++) { int c = tid + i * 256, dv = c >> 3, k0 = (c & 7) * 8; rv[i] = *(const u32x4*)(Vp + (size_t)dv * Sk + ktn * 64 + k0); }
    }
    kt = ktn;
    f32x4 s[4];
#pragma unroll
    for (int j = 0; j < 4; j++) {
      s[j] = f32x4{0.f, 0.f, 0.f, 0.f};
#pragma unroll
      for (int ks = 0; ks < DK / 32; ks++) {
        bf16x8 kf = *(const bf16x8*)(sK + (j * 16 + l15) * KLD + ks * 32 + l4 * 8);
        s[j] = __builtin_amdgcn_mfma_f32_16x16x32_bf16(qf[ks], kf, s[j], 0, 0, 0);
      }
    }
#pragma unroll
    for (int j = 0; j < 4; j++)
#pragma unroll
      for (int r = 0; r < 4; r++) {
        float v = s[j][r] * scale;
        if (W >= 0) {
          int kk = kbase + j * 16 + l15, t = q0 + w * 16 + l4 * 4 + r;
          int dlt = kk - n_ctx - t;
          bool valid = (kk < n_ctx) || (dlt <= W && dlt >= -W);
          if (!valid) v = NEG_INF;
        }
        s[j][r] = v;
      }
#pragma unroll
    for (int r = 0; r < 4; r++) {
      float mx = fmaxf(fmaxf(s[0][r], s[1][r]), fmaxf(s[2][r], s[3][r]));
      mx = fmaxf(mx, DPP_F(mx, mx, 0xB1, 0xf));
      mx = fmaxf(mx, DPP_F(mx, mx, 0x4E, 0xf));
      mx = fmaxf(mx, DPP_F(mx, mx, 0x141, 0xf));
      mx = fmaxf(mx, DPP_F(mx, mx, 0x140, 0xf));
      float mnew = fmaxf(mrow[r], mx);
      float muse = (mnew == NEG_INF) ? 0.f : mnew;
      float alpha = __expf(mrow[r] - muse);
      float rs = 0.f;
#pragma unroll
      for (int j = 0; j < 4; j++) { float pe = __expf(s[j][r] - muse); s[j][r] = pe; rs += pe; }
      rs += DPP_F(rs, rs, 0xB1, 0xf);
      rs += DPP_F(rs, rs, 0x4E, 0xf);
      rs += DPP_F(rs, rs, 0x141, 0xf);
      rs += DPP_F(rs, rs, 0x140, 0xf);
      lrow[r] = lrow[r] * alpha + rs;
      mrow[r] = mnew;
#pragma unroll
      for (int j = 0; j < 4; j++) o[j][r] *= alpha;
    }
#pragma unroll
    for (int j = 0; j < 4; j++)
#pragma unroll
      for (int r = 0; r < 4; r++) sPw[(l4 * 4 + r) * 72 + j * 16 + l15] = f2bf(s[j][r]);
    __builtin_amdgcn_s_waitcnt(0xc07f);
    __builtin_amdgcn_wave_barrier();
#pragma unroll
    for (int ks = 0; ks < 2; ks++) {
      bf16x8 pf = *(const bf16x8*)(sPw + l15 * 72 + ks * 32 + l4 * 8);
#pragma unroll
      for (int jn = 0; jn < 4; jn++) {
        bf16x8 vf = *(const bf16x8*)(sVt + (jn * 16 + l15) * 72 + ks * 32 + l4 * 8);
        o[jn] = __builtin_amdgcn_mfma_f32_16x16x32_bf16(pf, vf, o[jn], 0, 0, 0);
      }
    }
  }
#pragma unroll
  for (int r = 0; r < 4; r++) {
    float lsum = lrow[r];
    if (has_sink) lsum += __expf(sink - mrow[r]);
    float inv = 1.f / lsum;
#pragma unroll
    for (int jn = 0; jn < 4; jn++)
      Op[(size_t)(q0 + w * 16 + l4 * 4 + r) * 1024 + jn * 16 + l15] = f2bf(o[jn][r] * inv);
  }
}

__device__ __forceinline__ int gla_tok(int tb, int c, int dir, int tau) { return tb + c * 64 + (dir ? 63 - tau : tau); }

__device__ __forceinline__ void gla_cum_regs(const P& p, int l, int tok, int h, int dir, int w, int lane, float (&c)[8], float (&tot)[8]) {
  const float* w2 = (dir ? p.w_gla_a_bwd : p.w_gla_a_fwd) + l * 16 * 128 + h * 32 + w * 8;
  const float* b2 = (dir ? p.b_gla_a_bwd : p.b_gla_a_fwd) + l * 128 + h * 32 + w * 8;
  const float* al = W_hbuf + (size_t)tok * 1984 + (dir ? 1456 : 1440);
  float a[16];
#pragma unroll
  for (int q = 0; q < 4; q++) { float4 t4 = *(const float4*)(al + q * 4); a[q * 4] = t4.x; a[q * 4 + 1] = t4.y; a[q * 4 + 2] = t4.z; a[q * 4 + 3] = t4.w; }
#pragma unroll
  for (int j = 0; j < 8; j++) {
    float z = b2[j];
#pragma unroll
    for (int r = 0; r < 16; r++) z += a[r] * w2[r * 128 + j];
    float la = logsigf(z) * (1.f / 16.f);
    float v = la;
#pragma unroll
    for (int d = 1; d < 64; d <<= 1) { float t_ = __shfl_up(v, d); if (lane >= d) v += t_; }
    float total = __shfl(v, 63);
    c[j] = dir ? (total - v + la) : v;
    tot[j] = total;
  }
}
__device__ __forceinline__ void gla_load_vt(const P& p, int tok, int h, int w, int lane, bf16_t* sVt) {
  const float* vr = W_hbuf + (size_t)tok * 1984 + 928 + h * 64 + w * 16;
#pragma unroll
  for (int q = 0; q < 4; q++) {
    float4 t4 = *(const float4*)(vr + q * 4);
    sVt[(w * 16 + q * 4 + 0) * 72 + lane] = f2bf(t4.x);
    sVt[(w * 16 + q * 4 + 1) * 72 + lane] = f2bf(t4.y);
    sVt[(w * 16 + q * 4 + 2) * 72 + lane] = f2bf(t4.z);
    sVt[(w * 16 + q * 4 + 3) * 72 + lane] = f2bf(t4.w);
  }
}

__device__ __forceinline__ void chunk_info(int cidx, int& tb, int& nch, int& n, int& cbase) {
  if (cidx < 128) { int b = cidx >> 2; n = cidx & 3; nch = 4; tb = b * 256; cbase = b * 4; }
  else { int cl = cidx - 128, b = cl >> 5; n = cl & 31; nch = 32; tb = T_CTX + b * 2048; cbase = 128 + b * 32; }
}

__device__ __forceinline__ void gla_g1_item(const P& p, int l, int item, char* smem) {
  bf16_t* sKeT = (bf16_t*)smem;
  bf16_t* sVt = sKeT + 32 * 72;
  const int tid = tidx(), lane = tid & 63, w = __builtin_amdgcn_readfirstlane(tid >> 6), l15 = lane & 15, l4 = lane >> 4;
  int dir = item & 1, h = (item >> 1) & 3, cidx = item >> 3;
  int tb, nch, n, cbase;
  chunk_info(cidx, tb, nch, n, cbase);
  int c = dir ? nch - 1 - n : n;
  int tok = tb + c * 64 + lane;
  float cs[8], tot[8];
  gla_cum_regs(p, l, tok, h, dir, w, lane, cs, tot);
  __syncthreads();
  {
    const float* kr = W_hbuf + (size_t)tok * 1984 + 800 + h * 32 + w * 8;
    float4 k0 = *(const float4*)kr, k1 = *(const float4*)(kr + 4);
    float kk[8] = {k0.x, k0.y, k0.z, k0.w, k1.x, k1.y, k1.z, k1.w};
#pragma unroll
    for (int j = 0; j < 8; j++) sKeT[(w * 8 + j) * 72 + lane] = f2bf(kk[j] * __expf(tot[j] - cs[j]));
  }
  gla_load_vt(p, tok, h, w, lane, sVt);
  __syncthreads();
  f32x4 acc[2] = {f32x4{0.f, 0.f, 0.f, 0.f}, f32x4{0.f, 0.f, 0.f, 0.f}};
#pragma unroll
  for (int ks = 0; ks < 2; ks++) {
    bf16x8 bv = *(const bf16x8*)(sVt + (w * 16 + l15) * 72 + ks * 32 + l4 * 8);
#pragma unroll
    for (int mt = 0; mt < 2; mt++) {
      bf16x8 av = *(const bf16x8*)(sKeT + (mt * 16 + l15) * 72 + ks * 32 + l4 * 8);
      acc[mt] = __builtin_amdgcn_mfma_f32_16x16x32_bf16(av, bv, acc[mt], 0, 0, 0);
    }
  }
  float* dst = W_un + (size_t)item * 2048;
#pragma unroll
  for (int mt = 0; mt < 2; mt++)
#pragma unroll
    for (int r = 0; r < 4; r++) dst[(mt * 16 + l4 * 4 + r) * 64 + w * 16 + l15] = acc[mt][r];
  if (lane == 0) {
#pragma unroll
    for (int j = 0; j < 8; j++) W_gn[item * 32 + w * 8 + j] = __expf(tot[j]);
  }
}

__device__ __forceinline__ void phase_gla_scan(const P& p, int l) {
  for (int it = blockIdx.x; it < 2176; it += gridDim.x) {
    int e = it * 256 + tidx();
    int kv = e & 2047, sd = e >> 11, dir = sd & 1, h = (sd >> 1) & 3, seq = ((sd >> 3) + 32) % 34;
    int nch, cbase;
    float s;
    if (seq < 32) { nch = 4; cbase = seq * 4; s = 0.f; }
    else { int b = seq - 32; nch = 32; cbase = 128 + b * 32; s = p.state_gla[((size_t)(((b * 2 + l) * 2 + dir) * 4 + h)) * 2048 + kv]; }
    for (int n0 = 0; n0 < nch; n0 += 4) {
      float gv[4], uv[4];
#pragma unroll
      for (int k = 0; k < 4; k++) {
        int item = ((cbase + n0 + k) * 4 + h) * 2 + dir;
        gv[k] = W_gn[item * 32 + (kv >> 6)];
        uv[k] = W_un[(size_t)item * 2048 + kv];
      }
#pragma unroll
      for (int k = 0; k < 4; k++) {
        int item = ((cbase + n0 + k) * 4 + h) * 2 + dir;
        W_sin_[(size_t)item * 2048 + kv] = s;
        s = gv[k] * s + uv[k];
      }
    }
    if (seq < 32) p.out[19398656 + ((size_t)(((seq * 2 + l) * 2 + dir) * 4 + h)) * 2048 + kv] = s;
  }
}

__device__ __forceinline__ void phase_gla_out(const P& p, int l, char* smem) {
  bf16_t* sQe = (bf16_t*)smem;
  bf16_t* sKe = sQe + 64 * 40;
  bf16_t* sSt = sKe + 64 * 40;
  bf16_t* sVt = sSt + 64 * 40;
  bf16_t* sAtt = sVt + 64 * 72;
  const int tid = tidx(), lane = tid & 63, w = __builtin_amdgcn_readfirstlane(tid >> 6), l15 = lane & 15, l4 = lane >> 4;
  for (int it = blockIdx.x; it < 768; it += gridDim.x) {
    int h = it & 3, cidx = it >> 2;
    int tb, nch, c, cbase;
    chunk_info(cidx, tb, nch, c, cbase);
    const int tok = tb + c * 64 + lane;
    f32x4 o[4];
#pragma unroll
    for (int j = 0; j < 4; j++) o[j] = f32x4{0.f, 0.f, 0.f, 0.f};
    __syncthreads();
    gla_load_vt(p, tok, h, w, lane, sVt);
    for (int dir = 0; dir < 2; dir++) {
      int n = dir ? nch - 1 - c : c;
      int item = ((cbase + n) * 4 + h) * 2 + dir;
      float cs[8], tot[8];
      gla_cum_regs(p, l, tok, h, dir, w, lane, cs, tot);
      if (dir) __syncthreads();
      {
        const float* qr = W_hbuf + (size_t)tok * 1984 + 672 + h * 32 + w * 8;
        const float* kr = qr + 128;
        float4 q0 = *(const float4*)qr, q1 = *(const float4*)(qr + 4), k0 = *(const float4*)kr, k1 = *(const float4*)(kr + 4);
        float qq[8] = {q0.x, q0.y, q0.z, q0.w, q1.x, q1.y, q1.z, q1.w};
        float kk[8] = {k0.x, k0.y, k0.z, k0.w, k1.x, k1.y, k1.z, k1.w};
        const float* sin = W_sin_ + (size_t)item * 2048 + (w * 8) * 64 + lane;
        bf16x8 qv, kv, sv;
#pragma unroll
        for (int j = 0; j < 8; j++) {
          float cm = __shfl(cs[j], 32);
          qv[j] = (short)f2bf(qq[j] * 0.17677669529663687f * __expf(cs[j] - cm));
          kv[j] = (short)f2bf(kk[j] * __expf(cm - cs[j]));
          sv[j] = (short)f2bf(sin[j * 64] * __expf(cm));
        }
        *(bf16x8*)(sQe + lane * 40 + w * 8) = qv;
        *(bf16x8*)(sKe + lane * 40 + w * 8) = kv;
        *(bf16x8*)(sSt + lane * 40 + w * 8) = sv;
      }
      __syncthreads();
      bf16x8 qa = *(const bf16x8*)(sQe + (w * 16 + l15) * 40 + l4 * 8);
#pragma unroll
      for (int jc = 0; jc < 4; jc++) {
        bf16x8 kb = *(const bf16x8*)(sKe + (jc * 16 + l15) * 40 + l4 * 8);
        f32x4 sacc = __builtin_amdgcn_mfma_f32_16x16x32_bf16(qa, kb, f32x4{0.f, 0.f, 0.f, 0.f}, 0, 0, 0);
#pragma unroll
        for (int r = 0; r < 4; r++) {
          int trow = w * 16 + l4 * 4 + r, scol = jc * 16 + l15;
          bool keep = dir ? (scol >= trow) : (scol <= trow);
          sAtt[trow * 72 + scol] = f2bf(keep ? sacc[r] : 0.f);
        }
      }
      __syncthreads();
#pragma unroll
      for (int ks = 0; ks < 2; ks++) {
        bf16x8 aa = *(const bf16x8*)(sAtt + (w * 16 + l15) * 72 + ks * 32 + l4 * 8);
#pragma unroll
        for (int jn = 0; jn < 4; jn++) {
          bf16x8 vb = *(const bf16x8*)(sVt + (jn * 16 + l15) * 72 + ks * 32 + l4 * 8);
          o[jn] = __builtin_amdgcn_mfma_f32_16x16x32_bf16(aa, vb, o[jn], 0, 0, 0);
        }
      }
#pragma unroll
      for (int jn = 0; jn < 4; jn++) {
        bf16x8 sb = *(const bf16x8*)(sSt + (jn * 16 + l15) * 40 + l4 * 8);
        o[jn] = __builtin_amdgcn_mfma_f32_16x16x32_bf16(qa, sb, o[jn], 0, 0, 0);
      }
    }
    float gpre[4][4];
#pragma unroll
    for (int r = 0; r < 4; r++)
#pragma unroll
      for (int jn = 0; jn < 4; jn++) gpre[r][jn] = W_hbuf[(size_t)(tb + c * 64 + w * 16 + l4 * 4 + r) * 1984 + 1184 + h * 64 + jn * 16 + l15];
#pragma unroll
    for (int r = 0; r < 4; r++) {
      float ss = o[0][r] * o[0][r] + o[1][r] * o[1][r] + o[2][r] * o[2][r] + o[3][r] * o[3][r];
      ss += DPP_F(ss, ss, 0xB1, 0xf);
      ss += DPP_F(ss, ss, 0x4E, 0xf);
      ss += DPP_F(ss, ss, 0x141, 0xf);
      ss += DPP_F(ss, ss, 0x140, 0xf);
      float rs = rsqrtf(ss * (1.f / 64.f) + 1e-6f);
      int tk = tb + c * 64 + w * 16 + l4 * 4 + r;
      const float* grow = W_hbuf + (size_t)tk * 1984 + 1184 + h * 64;
      bf16_t* dst = W_br + (size_t)tk * 1024 + 512 + h * 64;
#pragma unroll
      for (int jn = 0; jn < 4; jn++) {
        int vcol = jn * 16 + l15;
        float val = o[jn][r] * rs * p.gla_norm[l * 64 + vcol];
        dst[vcol] = f2bf(val * siluf(gpre[r][jn]));
      }
    }
  }
}

__device__ __forceinline__ void phase_mixers(const P& p, int l, char* smem) {
  const int N_MLAL = 256, N_DFTL = 64, N_SWAL = 256, N_MLAC = 512, N_SWAC = 512, N_DFTC = 128, N_G1 = 1536;
  const int total = N_MLAL + N_DFTL + N_SWAL + N_MLAC + N_SWAC + N_DFTC + N_G1;
  for (int r_ = 0; r_ * (int)gridDim.x < total; r_++) {
    int it0 = r_ * gridDim.x + ((r_ & 1) ? (gridDim.x - 1 - blockIdx.x) : blockIdx.x);
    if (it0 >= total) continue;
    int it = it0;
    int type;
    bool lat = false;
    if (it < N_MLAL) { type = 0; lat = true; }
    else if ((it -= N_MLAL) < N_DFTL) { type = 2; lat = true; }
    else if ((it -= N_DFTL) < N_SWAL) { type = 1; lat = true; }
    else if ((it -= N_SWAL) < N_MLAC) { type = 0; }
    else if ((it -= N_MLAC) < N_SWAC) { type = 1; }
    else if ((it -= N_SWAC) < N_DFTC) { type = 2; }
    else { it -= N_DFTC; type = 3; }
    if (type == 0) {
      int qt, h, b, Sk;
      size_t tok0;
      if (lat) { qt = it & 31; h = (it >> 5) & 3; b = it >> 7; tok0 = T_CTX + b * 2048; Sk = 2560; }
      else { qt = it & 3; h = (it >> 2) & 3; b = it >> 4; tok0 = b * 256; Sk = 256; }
      const bf16_t* Kp = (lat ? W_Ka_lat : W_Ka_ctx) + (size_t)(b * 4 + h) * Sk * 96;
      const bf16_t* Vp = (lat ? W_Va_lat : W_Va_ctx) + (size_t)(b * 4 + h) * Sk * 64;
      attn_item<96>(W_Qa + tok0 * 384 + h * 96, 384, Kp, Vp, W_br + tok0 * 1024 + h * 64, qt * 64, Sk, 0, -1,
                    0.10206207261596575f, false, 0.f, smem);
    } else if (type == 1) {
      int qt, hq, b, Sk, nctx, W;
      size_t tok0;
      if (lat) { qt = it & 31; hq = (it >> 5) & 3; b = it >> 7; tok0 = T_CTX + b * 2048; Sk = 2560; nctx = 512; W = 128; }
      else { qt = it & 3; hq = (it >> 2) & 3; b = it >> 4; tok0 = b * 256; Sk = 256; nctx = 0; W = -1; }
      int kv = hq >> 1;
      const bf16_t* Kp = (lat ? W_Kd_lat : W_Kd_ctx) + (size_t)(b * 2 + kv) * Sk * 64;
      const bf16_t* Vp = (lat ? W_Vd_lat : W_Vd_ctx) + (size_t)(b * 2 + kv) * Sk * 64;
      attn_item<64>(W_Qd + tok0 * 256 + hq * 64, 256, Kp, Vp, W_br + tok0 * 1024 + 768 + hq * 64, qt * 64, Sk, nctx, W,
                    0.125f, true, p.swa_sink[l * 4 + hq], smem);
    } else if (type == 2) {
      int nt = it & 1, mt, b, S;
      size_t tok0;
      if (lat) { mt = (it >> 1) & 15; b = it >> 5; S = 2048; tok0 = T_CTX + b * 2048; }
      else { mt = (it >> 1) & 1; b = it >> 2; S = 256; tok0 = b * 256; }
      const bf16_t* Ap = (lat ? W_A2048 : W_A256) + (size_t)mt * 128 * 2 * S;
      const bf16_t* Bp = (lat ? W_Yt_lat : W_Yt_ctx) + (size_t)(b * 256 + nt * 128) * 2 * S;
      f32x4 acc[4][4];
      ZERO_ACC(acc);
      gemm_core(acc, Ap, 2 * S, Bp, 2 * S, 2 * S, smem);
      EPI_LOOP(acc, mt * 128, nt * 128, { W_br[(tok0 + m) * 1024 + 256 + n] = f2bf(v); });
    } else {
      gla_g1_item(p, l, it, smem);
    }
  }
}

#define EPI4_LOOP_N(acc, c0, t0, NJ, ...)                                                  \
  {                                                                                        \
    const int lane_ = tidx() & 63, w_ = tidx() >> 6, wm_ = w_ >> 1, wn_ = w_ & 1;           \
    _Pragma("unroll") for (int i_ = 0; i_ < 4; i_++)                                       \
    _Pragma("unroll") for (int j_ = 0; j_ < NJ; j_++) {                                    \
      const int col = (c0) + wm_ * 64 + i_ * 16 + (lane_ >> 4) * 4;                        \
      const int tok = (t0) + wn_ * (NJ * 16) + j_ * 16 + (lane_ & 15);                     \
      const f32x4 v4 = acc[i_][j_];                                                        \
      __VA_ARGS__                                                                          \
    }                                                                                      \
  }
__device__ __forceinline__ void phase_merge(const P& p, int l, char* smem) {
  for (int tile = blockIdx.x; tile < 192 * 8; tile += gridDim.x) {
    int tt = tile >> 3, nt = tile & 7, t0 = tt * 64, n0 = nt * 128;
    f32x4 tot[4][2];
    ZERO_ACC_N(tot, 2);
    for (int b = 0; b < 4; b++) {
      f32x4 acc[4][2];
      ZERO_ACC_N(acc, 2);
      gemm_core_t<2>(acc, W_Wt_br + ((size_t)(l * 4 + b) * 1024 + n0) * 256, 256, W_br + (size_t)t0 * 1024 + b * 256, 1024, 256, smem);
      EPI4_LOOP_N(acc, n0, t0, 2, {
        ushort4 g_ = *(const ushort4*)(W_gates + (size_t)tok * 4096 + b * 1024 + col);
        tot[i_][j_][0] += bf2f(g_.x) * v4[0]; tot[i_][j_][1] += bf2f(g_.y) * v4[1];
        tot[i_][j_][2] += bf2f(g_.z) * v4[2]; tot[i_][j_][3] += bf2f(g_.w) * v4[3];
      });
    }
    EPI4_LOOP_N(tot, n0, t0, 2, {
      ushort4 o_; o_.x = f2bf(v4[0]); o_.y = f2bf(v4[1]); o_.z = f2bf(v4[2]); o_.w = f2bf(v4[3]);
      *(ushort4*)(W_u + (size_t)tok * 1024 + col) = o_;
    });
  }
}

__device__ __forceinline__ void phase_wout(const P& p, int l, char* smem) {
  float* r = W_hbuf;
  const float alpha = 1.4142135623730951f;
  for (int tile = blockIdx.x; tile < 96 * 8; tile += gridDim.x) {
    int mt = tile >> 3, nt = tile & 7, m0 = mt * 128, n0 = nt * 128;
    f32x4 acc[4][4];
    ZERO_ACC(acc);
    gemm_core(acc, W_Wt_out + ((size_t)l * 1024 + n0) * 1024, 1024, W_u + (size_t)m0 * 1024, 1024, 1024, smem);
    const float* g1 = W_mada + (l * 3 + cond_row(m0)) * 6144 + 2048;
    {
      const int lane_ = tidx() & 63, w_ = tidx() >> 6, wm_ = w_ >> 1, wn_ = w_ & 1;
#pragma unroll
      for (int ih = 0; ih < 2; ih++) {
        float4 xv[8];
#pragma unroll
        for (int q = 0; q < 8; q++) {
          int i_ = ih * 2 + (q >> 2), j_ = q & 3;
          int col = n0 + wm_ * 64 + i_ * 16 + (lane_ >> 4) * 4, tok = m0 + wn_ * 64 + j_ * 16 + (lane_ & 15);
          xv[q] = *(const float4*)(x_in_row(p, l, tok) + col);
        }
#pragma unroll
        for (int q = 0; q < 8; q++) {
          int i_ = ih * 2 + (q >> 2), j_ = q & 3;
          int col = n0 + wm_ * 64 + i_ * 16 + (lane_ >> 4) * 4, tok = m0 + wn_ * 64 + j_ * 16 + (lane_ & 15);
          float4 gv = *(const float4*)(g1 + col);
          f32x4 v4 = acc[i_][j_];
          *(float4*)(r + (size_t)tok * 1024 + col) = float4{alpha * xv[q].x + gv.x * v4[0], alpha * xv[q].y + gv.y * v4[1], alpha * xv[q].z + gv.z * v4[2], alpha * xv[q].w + gv.w * v4[3]};
        }
      }
    }
  }
}

__device__ __forceinline__ void phase_ln_mid(const P& p, int l) {
  int lane = tidx() & 63, w = tidx() >> 6;
  const float* r = W_hbuf;
  for (int it = blockIdx.x; it < T_ALL / 4; it += gridDim.x) {
    int g = it * 4 + w;
    float v[16];
    load_row16(r + (size_t)g * 1024, lane, v);
    ln16(v);
    affine16(v, p.ln1_g + l * 1024, p.ln1_b + l * 1024, lane);
    store_row16(x_out_row(p, l, g), lane, v);
    ln16(v);
    const float* m = W_mada + (l * 3 + cond_row(g)) * 6144;
    modulate_store(v, m + 3072, m + 4096, W_u + (size_t)g * 1024, lane);
  }
}

__device__ __forceinline__ void phase_pq(const P& p, int l, char* smem) {
  float* sc = (float*)W_gates;
  bf16_t* sa = (bf16_t*)smem;
  const int tid = tidx(), lane = tid & 63, w = tid >> 6, wm = w >> 1, wn = w & 1, l15 = lane & 15, l4 = lane >> 4;
  for (int tile = blockIdx.x; tile < 96 * 16; tile += gridDim.x) {
    int mt = tile >> 4, hp = tile & 15, m0 = mt * 128, n0 = hp * 128;
    f32x4 acc[4][4];
    ZERO_ACC(acc);
    gemm_core(acc, W_Wt_pq + ((size_t)l * 2048 + n0) * 1024, 1024, W_u + (size_t)m0 * 1024, 1024, 1024, smem);
    __syncthreads();
    {
      bf16_t* sB = sa + 128 * GB_LD * (1 + wm);
#pragma unroll
      for (int i = 0; i < 4; i++)
#pragma unroll
        for (int j = 0; j < 4; j++) {
          ushort4 o_;
          o_.x = f2bf(acc[i][j][0]); o_.y = f2bf(acc[i][j][1]); o_.z = f2bf(acc[i][j][2]); o_.w = f2bf(acc[i][j][3]);
          *(ushort4*)(sB + (wn * 64 + j * 16 + l15) * GB_LD + i * 16 + l4 * 4) = o_;
        }
    }
    f32x4 acc2[4][4];
    ZERO_ACC(acc2);
    const bf16_t* keys = W_keysbf + (size_t)(l * 16 + hp) * 128 * 128;
#pragma unroll
    for (int kh = 0; kh < 2; kh++) {
      u32x4 rk[4];
#pragma unroll
      for (int i = 0; i < 4; i++) { int c = tid + i * 256, r = c >> 3, cc = (c & 7) * 8; rk[i] = *(const u32x4*)(keys + r * 128 + kh * 64 + cc); }
      if (kh) __syncthreads();
#pragma unroll
      for (int i = 0; i < 4; i++) { int c = tid + i * 256, r = c >> 3, cc = (c & 7) * 8; *(u32x4*)(sa + r * GB_LD + cc) = rk[i]; }
      __syncthreads();
      const bf16_t* sBk = sa + 128 * GB_LD * (1 + kh);
#pragma unroll
      for (int ks = 0; ks < 2; ks++) {
        bf16x8 af[4], bfr[4];
#pragma unroll
        for (int i = 0; i < 4; i++) af[i] = *(const bf16x8*)(sa + (wm * 64 + i * 16 + l15) * GB_LD + ks * 32 + l4 * 8);
#pragma unroll
        for (int j = 0; j < 4; j++) bfr[j] = *(const bf16x8*)(sBk + (wn * 64 + j * 16 + l15) * GB_LD + ks * 32 + l4 * 8);
#pragma unroll
        for (int i = 0; i < 4; i++)
#pragma unroll
          for (int j = 0; j < 4; j++) acc2[i][j] = __builtin_amdgcn_mfma_f32_16x16x32_bf16(af[i], bfr[j], acc2[i][j], 0, 0, 0);
      }
    }
    EPI_LOOP(acc2, 0, m0, { sc[((size_t)(hp * 128 + m)) * T_ALL + n] = v; });
  }
}

__device__ __forceinline__ void phase_scores(const P& p, int l, char* smem) {}

__device__ __forceinline__ int f2sort(float x) { int b = __float_as_int(x); return b ^ ((b >> 31) & 0x7fffffff); }
__device__ __forceinline__ float sort2f(int s) { return __int_as_float(s ^ ((s >> 31) & 0x7fffffff)); }
#define INS16(L, key) _Pragma("unroll") for (int i_ = 0; i_ < 16; i_++) { int hi_ = max(L[i_], key); key = min(L[i_], key); L[i_] = hi_; }
__device__ __forceinline__ void phase_topk(const P& p, int l) {
  const float* sc = (const float*)W_gates;
  int lane = tidx() & 63, w = tidx() >> 6;
  for (int it = blockIdx.x * 4 + w; it < 192 * 8; it += gridDim.x * 4) {
    int h = it & 7, t = (it >> 3) * 64 + lane;
    int L1[16], L2[16];
#pragma unroll
    for (int i = 0; i < 16; i++) { L1[i] = (int)0x80000000; L2[i] = (int)0x80000000; }
    const float* s1 = sc + (size_t)(h * 2) * 128 * T_ALL + t;
    const float* s2 = s1 + (size_t)128 * T_ALL;
    for (int k0 = 0; k0 < 128; k0 += 16) {
      float xv[16];
#pragma unroll
      for (int k = 0; k < 16; k++) xv[k] = s1[(size_t)(k0 + k) * T_ALL];
#pragma unroll
      for (int k = 0; k < 16; k++) { int key = (f2sort(xv[k]) & ~127) | (127 - (k0 + k)); INS16(L1, key); }
    }
    for (int k0 = 0; k0 < 128; k0 += 16) {
      float xv[16];
#pragma unroll
      for (int k = 0; k < 16; k++) xv[k] = s2[(size_t)(k0 + k) * T_ALL];
#pragma unroll
      for (int k = 0; k < 16; k++) { int key = (f2sort(xv[k]) & ~127) | (127 - (k0 + k)); INS16(L2, key); }
    }
    float v1[16], v2[16];
    unsigned P1[4] = {0u, 0u, 0u, 0u}, P2[4] = {0u, 0u, 0u, 0u};
#pragma unroll
    for (int i = 0; i < 16; i++) {
      v1[i] = sort2f(L1[i] & ~127);
      v2[i] = sort2f(L2[i] & ~127);
      P1[i >> 2] |= (unsigned)(127 - (L1[i] & 127)) << ((i & 3) * 8);
      P2[i >> 2] |= (unsigned)(127 - (L2[i] & 127)) << ((i & 3) * 8);
    }
    int Tk[16];
#pragma unroll
    for (int i = 0; i < 16; i++) Tk[i] = (int)0x80000000;
#pragma unroll
    for (int i = 0; i < 16; i++) {
#pragma unroll
      for (int j = 0; j < 16 / (i + 1); j++) {
        int key = (f2sort(v1[i] + v2[j]) & ~255) | (255 - (i * 16 + j));
        INS16(Tk, key);
      }
    }
    float v0 = sort2f(Tk[0] & ~255);
    float e[16], Z = 0.f;
    int oi[16];
#pragma unroll
    for (int s_ = 0; s_ < 16; s_++) {
      e[s_] = __expf(sort2f(Tk[s_] & ~255) - v0);
      Z += e[s_];
      int code = 255 - (Tk[s_] & 255), i = code >> 4, j = code & 15;
      unsigned r1 = (i >> 2) == 0 ? P1[0] : (i >> 2) == 1 ? P1[1] : (i >> 2) == 2 ? P1[2] : P1[3];
      unsigned r2 = (j >> 2) == 0 ? P2[0] : (j >> 2) == 1 ? P2[1] : (j >> 2) == 2 ? P2[2] : P2[3];
      int i1 = (r1 >> ((i & 3) * 8)) & 255, i2 = (r2 >> ((j & 3) * 8)) & 255;
      oi[s_] = i1 * 128 + i2;
    }
    float inv = 1.f / Z;
    int* po = W_pidx + (size_t)t * 128 + h * 16;
    float* pwo = W_pw + (size_t)t * 128 + h * 16;
#pragma unroll
    for (int q = 0; q < 4; q++) {
      *(int4*)(po + q * 4) = int4{oi[q * 4], oi[q * 4 + 1], oi[q * 4 + 2], oi[q * 4 + 3]};
      *(float4*)(pwo + q * 4) = float4{e[q * 4] * inv, e[q * 4 + 1] * inv, e[q * 4 + 2] * inv, e[q * 4 + 3] * inv};
    }
  }
}

__device__ __forceinline__ void unpack16(u32x4 r, float (&f)[16]) {
#pragma unroll
  for (int q = 0; q < 4; q++) {
    auto lo = __builtin_amdgcn_cvt_pk_f32_fp8((int)r[q], false);
    auto hi = __builtin_amdgcn_cvt_pk_f32_fp8((int)r[q], true);
    f[q * 4 + 0] = lo[0]; f[q * 4 + 1] = lo[1]; f[q * 4 + 2] = hi[0]; f[q * 4 + 3] = hi[1];
  }
}
#define PEER_PF 8
__device__ __forceinline__ void phase_peer(const P& p, int l, char* smem) {
  int lane = tidx() & 63, w = tidx() >> 6;
  float* scoef = (float*)smem + w * 128;
  const unsigned char* tu = W_tabU + (size_t)l * 16384 * 1024 + lane * 16;
  const unsigned char* tv = W_tabV + (size_t)l * 16384 * 1024 + lane * 16;
  for (int it = blockIdx.x; it < T_ALL / 4; it += gridDim.x) {
    int g = it * 4 + w;
    float uu[16];
    {
      u32x4 r0 = *(const u32x4*)(W_u + (size_t)g * 1024 + lane * 16);
      u32x4 r1 = *(const u32x4*)(W_u + (size_t)g * 1024 + lane * 16 + 8);
      uu[0] = __uint_as_float(r0.x << 16); uu[1] = __uint_as_float(r0.x & 0xffff0000u);
      uu[2] = __uint_as_float(r0.y << 16); uu[3] = __uint_as_float(r0.y & 0xffff0000u);
      uu[4] = __uint_as_float(r0.z << 16); uu[5] = __uint_as_float(r0.z & 0xffff0000u);
      uu[6] = __uint_as_float(r0.w << 16); uu[7] = __uint_as_float(r0.w & 0xffff0000u);
      uu[8] = __uint_as_float(r1.x << 16); uu[9] = __uint_as_float(r1.x & 0xffff0000u);
      uu[10] = __uint_as_float(r1.y << 16); uu[11] = __uint_as_float(r1.y & 0xffff0000u);
      uu[12] = __uint_as_float(r1.z << 16); uu[13] = __uint_as_float(r1.z & 0xffff0000u);
      uu[14] = __uint_as_float(r1.w << 16); uu[15] = __uint_as_float(r1.w & 0xffff0000u);
    }
    const int* pi = W_pidx + (size_t)g * 128;
    const float* pwt = W_pw + (size_t)g * 128;
#ifndef PEER_REP
#define PEER_REP 1
#endif
    float o[16];
    for (int rep_ = 0; rep_ < PEER_REP; rep_++) {
    float dv0 = 0.f, dv1 = 0.f;
    for (int e0 = 0; e0 < 128; e0 += PEER_PF) {
      u32x4 ra[PEER_PF];
#pragma unroll
      for (int k = 0; k < PEER_PF; k++) ra[k] = *(const u32x4*)(tu + (size_t)pi[e0 + k] * 1024);
#pragma unroll
      for (int k = 0; k < PEER_PF; k++) {
        float f[16];
        unpack16(ra[k], f);
        float a = 0.f;
#pragma unroll
        for (int j = 0; j < 16; j++) a += uu[j] * f[j];
        float dd = wsum(a);
        if (e0 < 64) dv0 = (lane == e0 + k) ? dd : dv0;
        else dv1 = (lane == e0 + k - 64) ? dd : dv1;
      }
    }
    {
      float d0 = dv0 * (1.f / PEER_U_SCALE), d1 = dv1 * (1.f / PEER_U_SCALE);
      float a0 = 0.5f * d0 * (1.f + erff(d0 * 0.7071067811865476f));
      float a1 = 0.5f * d1 * (1.f + erff(d1 * 0.7071067811865476f));
      scoef[lane] = pwt[lane] * a0 * (1.f / PEER_V_SCALE);
      scoef[64 + lane] = pwt[64 + lane] * a1 * (1.f / PEER_V_SCALE);
    }
    __builtin_amdgcn_s_waitcnt(0xc07f);
    __builtin_amdgcn_wave_barrier();
#pragma unroll
    for (int j = 0; j < 16; j++) o[j] = 0.f;
    for (int e0 = 0; e0 < 128; e0 += PEER_PF) {
      u32x4 ra[PEER_PF];
#pragma unroll
      for (int k = 0; k < PEER_PF; k++) ra[k] = *(const u32x4*)(tv + (size_t)pi[e0 + k] * 1024);
#pragma unroll
      for (int k = 0; k < PEER_PF; k++) {
        float cf = scoef[e0 + k];
        float f[16];
        unpack16(ra[k], f);
#pragma unroll
        for (int j = 0; j < 16; j++) o[j] += cf * f[j];
      }
    }
    __builtin_amdgcn_wave_barrier();
    }
    float* xr = x_out_row(p, l, g) + lane * 16;
    const float* m = W_mada + (l * 3 + cond_row(g)) * 6144 + lane * 16;
    float x1[16];
#pragma unroll
    for (int q = 0; q < 4; q++) {
      float4 xv = *(const float4*)(xr + q * 4);
      float4 g2 = *(const float4*)(m + 5120 + q * 4);
      x1[q * 4 + 0] = 1.4142135623730951f * xv.x + g2.x * o[q * 4 + 0];
      x1[q * 4 + 1] = 1.4142135623730951f * xv.y + g2.y * o[q * 4 + 1];
      x1[q * 4 + 2] = 1.4142135623730951f * xv.z + g2.z * o[q * 4 + 2];
      x1[q * 4 + 3] = 1.4142135623730951f * xv.w + g2.w * o[q * 4 + 3];
    }
    ln16(x1);
#pragma unroll
    for (int q = 0; q < 4; q++) {
      float4 a = *(const float4*)(p.ln2_g + l * 1024 + lane * 16 + q * 4);
      float4 c = *(const float4*)(p.ln2_b + l * 1024 + lane * 16 + q * 4);
      x1[q * 4 + 0] = x1[q * 4 + 0] * a.x + c.x; x1[q * 4 + 1] = x1[q * 4 + 1] * a.y + c.y;
      x1[q * 4 + 2] = x1[q * 4 + 2] * a.z + c.z; x1[q * 4 + 3] = x1[q * 4 + 3] * a.w + c.w;
      *(float4*)(xr + q * 4) = float4{x1[q * 4], x1[q * 4 + 1], x1[q * 4 + 2], x1[q * 4 + 3]};
    }
    if (l == 0) {
      ln16(x1);
      const float* m1 = W_mada + (1 * 3 + cond_row(g)) * 6144 + lane * 16;
#pragma unroll
      for (int q = 0; q < 4; q++) {
        float4 a = *(const float4*)(m1 + 1024 + q * 4);
        float4 b = *(const float4*)(m1 + q * 4);
        ushort4 ov;
        ov.x = f2bf(x1[q * 4 + 0] * (1.f + a.x) + b.x);
        ov.y = f2bf(x1[q * 4 + 1] * (1.f + a.y) + b.y);
        ov.z = f2bf(x1[q * 4 + 2] * (1.f + a.z) + b.z);
        ov.w = f2bf(x1[q * 4 + 3] * (1.f + a.w) + b.w);
        *(ushort4*)(W_u + (size_t)g * 1024 + lane * 16 + q * 4) = ov;
      }
    }
  }
}

#define N_PHASES 28
__device__ __forceinline__ void run_phase(const P& p, int ph, char* smem) {
#ifdef ONLYQ
  { int l = ph & 1; if (ONLYQ == -1) { phase_prep(p, smem); return; } if (ONLYQ == -2) { phase_ln0(p); return; }
    switch (ONLYQ) { case 0: phase_win(p, l, smem); break; case 1: phase_post(p, l); break; case 2: phase_small_gemms(p, l, smem); break; case 3: phase_mixers(p, l, smem); break; case 4: phase_gla_scan(p, l); break; case 5: phase_gla_out(p, l, smem); break; case 6: phase_merge(p, l, smem); break; case 7: phase_wout(p, l, smem); break; case 8: phase_ln_mid(p, l); break; case 9: phase_pq(p, l, smem); break; case 10: phase_scores(p, l, smem); break; case 11: phase_topk(p, l); break; case 12: phase_peer(p, l, smem); break; } return; }
#endif
  if (ph == 0) { phase_prep(p, smem); return; }
  if (ph == 1) { phase_ln0(p); return; }
  int l = (ph - 2) / 13, q = (ph - 2) % 13;
#ifdef EXCL
  if (q == EXCL) return;
#endif
  switch (q) {
    case 0: phase_win(p, l, smem); break;
    case 1: phase_post(p, l); break;
    case 2: phase_small_gemms(p, l, smem); break;
    case 3: phase_mixers(p, l, smem); break;
    case 4: phase_gla_scan(p, l); break;
    case 5: phase_gla_out(p, l, smem); break;
    case 6: phase_merge(p, l, smem); break;
    case 7: phase_wout(p, l, smem); break;
    case 8: phase_ln_mid(p, l); break;
    case 9: phase_pq(p, l, smem); break;
    case 10: phase_scores(p, l, smem); break;
    case 11: phase_topk(p, l); break;
    case 12: phase_peer(p, l, smem); break;
  }
}

#define XB_TMO      128
#define XB_XCNT(j)  (256  + 64 * (j))
#define XB_XSUB(j)  (1280 + 64 * (j))
#define XB_XGEN(j)  (2304 + 64 * (j))
#define XB_TOP      3328
#define XB_TOPGEN   3392
#define XCD_BAR_WORDS 3456
#define XB_SPIN_CAP (1u << 18)
#define LAS __attribute__((address_space(3)))

__device__ __forceinline__ unsigned xb_ld(unsigned* p)              { return __hip_atomic_load(p, __ATOMIC_RELAXED, __HIP_MEMORY_SCOPE_AGENT); }
__device__ __forceinline__ unsigned xb_add(unsigned* p, unsigned v) { return __hip_atomic_fetch_add(p, v, __ATOMIC_RELAXED, __HIP_MEMORY_SCOPE_AGENT); }
__device__ __forceinline__ unsigned xb_xcc_id() { return (unsigned)__builtin_amdgcn_s_getreg((3 << 11) | 20) & 0xFu; }
#define XB_SPIN(cond, bar) do { unsigned _sp = 0; while (cond) { __builtin_amdgcn_s_sleep(1); \
    if ((++_sp & 255u) == 0u) { if (xb_ld(&(bar)[XB_TMO])) break; if (_sp > XB_SPIN_CAP) { atomicAdd(&(bar)[XB_TMO], 1u); break; } } } } while (0)

struct XcdBarrier {
    unsigned* bar; unsigned x;
    volatile LAS unsigned* st;
};

__device__ __forceinline__ XcdBarrier xcd_barrier_post(unsigned* bar, volatile LAS unsigned* st) {
    XcdBarrier b; b.bar = bar; b.x = xb_xcc_id(); b.st = st;
    if (threadIdx.x == 0) (void)xb_add(&bar[XB_XCNT(b.x)], 1u);
    return b;
}
__device__ __forceinline__ void xcd_barrier_complete(unsigned* bar, unsigned x, unsigned& nloc, unsigned& nx) {
    const unsigned G = gridDim.x * gridDim.y * gridDim.z;
    unsigned sum, cnt, mine, sp = 0u;
    for (;;) {
        sum = 0u; cnt = 0u; mine = 0u;
#pragma unroll
        for (unsigned j = 0; j < 16; ++j) { const unsigned c = xb_ld(&bar[XB_XCNT(j)]); sum += c; cnt += (c > 0u) ? 1u : 0u; mine = (j == x) ? c : mine; }
        if (sum == G) break;
        __builtin_amdgcn_s_sleep(1);
        if ((++sp & 255u) == 0u) { if (xb_ld(&bar[XB_TMO])) break; if (sp > XB_SPIN_CAP) { atomicAdd(&bar[XB_TMO], 1u); break; } }
    }
    nloc = mine > 0u ? mine : 1u; nx = cnt > 0u ? cnt : 1u;
}

__device__ __forceinline__ void xcd_barrier(const XcdBarrier& b) {
    asm volatile("s_waitcnt vmcnt(0)" ::: "memory");
    __syncthreads();
    if (threadIdx.x == 0) {
        unsigned* bar = b.bar;
        __builtin_amdgcn_s_waitcnt(0);
        unsigned nloc = b.st[0], nx = b.st[1];
        if (nloc == 0u) { xcd_barrier_complete(bar, b.x, nloc, nx); b.st[0] = nloc; b.st[1] = nx; }
        const unsigned old = xb_add(&bar[XB_XSUB(b.x)], 1u);
        const unsigned gen = old / nloc;
        if (old + 1u == (gen + 1u) * nloc) {
            __builtin_amdgcn_fence(__ATOMIC_RELEASE, "agent");
            asm volatile("s_waitcnt vmcnt(0)" ::: "memory");
            const unsigned og = xb_add(&bar[XB_TOP], 1u);
            const unsigned tg = og / nx;
            if (og + 1u == (tg + 1u) * nx) xb_add(&bar[XB_TOPGEN], 1u);
            else XB_SPIN(xb_ld(&bar[XB_TOPGEN]) == tg, bar);
            __builtin_amdgcn_fence(__ATOMIC_ACQUIRE, "agent");
            xb_add(&bar[XB_XGEN(b.x)], 1u);
            asm volatile("s_waitcnt vmcnt(0)" ::: "memory");
        } else {
            XB_SPIN(xb_ld(&bar[XB_XGEN(b.x)]) == gen, bar);
            __builtin_amdgcn_fence(__ATOMIC_ACQUIRE, "agent");
            asm volatile("s_waitcnt vmcnt(0)" ::: "memory");
        }
    }
    __syncthreads();
}


#define SMEM_BYTES 61440

#if MULTI
__global__ void __launch_bounds__(256, 2) k_phase(P p, int ph) {
  __shared__ __attribute__((aligned(16))) char smem[SMEM_BYTES];
  run_phase(p, ph, smem);
}
#else
__global__ void __launch_bounds__(256, 2) k_mega(P p) {
  __shared__ __attribute__((aligned(16))) char smem[SMEM_BYTES];
  __shared__ uint4 xb_words;
  cg::grid_group grid = cg::this_grid();
  if (threadIdx.x == 0) xb_words = make_uint4(0u, 0u, 0u, 0u);
  __syncthreads();
  XcdBarrier xb = xcd_barrier_post((unsigned*)(p.ws + OFF_bar), (volatile LAS unsigned*)&xb_words);
#pragma nounroll
  for (int ph = 0; ph < N_PHASES; ph++) {
    if (ph >= 2 && (ph - 2) % 13 == 10) continue;
    run_phase(p, ph, smem);
#ifdef DUPMASK
    if (ph >= 2 && ((DUPMASK >> ((ph - 2) % 13)) & 1)) run_phase(p, ph, smem);
#endif
    if (ph + 1 < N_PHASES) {
      if (gridDim.y > 1) grid.sync();
      xcd_barrier(xb);
    }
  }
}
#endif

extern "C" void kernel_launch(void* const* d_in, const int* in_sizes, int n_in, void* d_out, int out_size, void* d_ws,
                              size_t ws_size, hipStream_t stream) {
  P p{};
  const float** fp = (const float**)&p;
  for (int i = 0; i < 32; i++) fp[i] = (const float*)d_in[i];
  p.out = (float*)d_out;
  p.ws = (char*)d_ws;
  size_t off = WS_TOTAL;
  if (off > ws_size) { fprintf(stderr, "ws too small: need %zu have %zu\n", off, ws_size); return; }
#if MULTI
  for (int ph = 0; ph < N_PHASES; ph++) hipLaunchKernelGGL(k_phase, dim3(512), dim3(256), 0, stream, p, ph);
#else
  static int grid_blocks = 0;
  if (!grid_blocks) {
    int dev = 0, cus = 0, per_cu = 0;
    hipGetDevice(&dev);
    hipDeviceGetAttribute(&cus, hipDeviceAttributeMultiprocessorCount, dev);
    hipOccupancyMaxActiveBlocksPerMultiprocessor(&per_cu, k_mega, 256, 0);
    if (per_cu > 2) per_cu = 2;
    grid_blocks = cus * per_cu;
  }
  hipMemsetAsync(p.ws + OFF_bar, 0, 16384, stream);
  void* args[] = {&p};
  hipError_t e = hipLaunchCooperativeKernel((void*)k_mega, dim3(grid_blocks), dim3(256), args, 0, stream);
  if (e != hipSuccess) fprintf(stderr, "cooperative launch failed: %s (grid %d)\n", hipGetErrorString(e), grid_blocks);
#endif
}
```

```cpp
#include <hip/hip_runtime.h>
#include <hip/hip_cooperative_groups.h>
#include <cstdio>
#include <cstdint>
namespace cg = cooperative_groups;

#ifndef MULTI
#define MULTI 0
#endif

typedef unsigned short bf16_t;
using bf16x8 = __attribute__((ext_vector_type(8))) short;
using f32x4 = __attribute__((ext_vector_type(4))) float;
using u32x4 = __attribute__((ext_vector_type(4))) unsigned int;

#define T_ALL 12288
#define T_CTX 8192
#define NEG_INF (-__builtin_inff())

__device__ __forceinline__ int tidx() {
  int t = threadIdx.x;
  asm volatile("" : "+v"(t));
  return t;
}
__device__ __forceinline__ bf16_t f2bf(float f) {
  unsigned u = __float_as_uint(f);
  u += 0x7fffu + ((u >> 16) & 1u);
  return (bf16_t)(u >> 16);
}
__device__ __forceinline__ float bf2f(bf16_t b) { return __uint_as_float(((unsigned)b) << 16); }
__device__ __forceinline__ float wsum_shfl(float v) {
#pragma unroll
  for (int o = 32; o; o >>= 1) v += __shfl_xor(v, o);
  return v;
}
#define DPP_F(old, src, ctrl, rm) __int_as_float(__builtin_amdgcn_update_dpp(__float_as_int(old), __float_as_int(src), ctrl, rm, 0xf, false))
__device__ __forceinline__ float wsum(float v) {
  v += DPP_F(v, v, 0xB1, 0xf);
  v += DPP_F(v, v, 0x4E, 0xf);
  v += DPP_F(v, v, 0x141, 0xf);
  v += DPP_F(v, v, 0x140, 0xf);
  v += DPP_F(0.f, v, 0x142, 0xa);
  v += DPP_F(0.f, v, 0x143, 0xc);
  return __int_as_float(__builtin_amdgcn_readlane(__float_as_int(v), 63));
}
__device__ __forceinline__ float wmax(float v) {
  v = fmaxf(v, DPP_F(v, v, 0xB1, 0xf));
  v = fmaxf(v, DPP_F(v, v, 0x4E, 0xf));
  v = fmaxf(v, DPP_F(v, v, 0x141, 0xf));
  v = fmaxf(v, DPP_F(v, v, 0x140, 0xf));
  v = fmaxf(v, DPP_F(v, v, 0x142, 0xa));
  v = fmaxf(v, DPP_F(v, v, 0x143, 0xc));
  return __int_as_float(__builtin_amdgcn_readlane(__float_as_int(v), 63));
}
__device__ __forceinline__ float siluf(float x) { return x * __builtin_amdgcn_rcpf(1.f + __expf(-x)); }
__device__ __forceinline__ float sigmf(float x) { return __builtin_amdgcn_rcpf(1.f + __expf(-x)); }
__device__ __forceinline__ float logsigf(float z) { return fminf(z, 0.f) - log1pf(__expf(-fabsf(z))); }
__device__ __forceinline__ int cond_row(int g) { return g < T_CTX ? 0 : 1 + ((g - T_CTX) >> 11); }

struct P {
  const float *x_prompt, *x_sample, *c, *cache_ckv, *cache_krope, *cache_swa_k, *cache_swa_v, *state_gla, *c_ctx,
      *w_ada, *b_ada, *w_in, *mla_q_norm, *w_uq, *mla_kv_norm, *w_ukv, *w_gla_a_fwd, *b_gla_a_fwd, *w_gla_a_bwd,
      *b_gla_a_bwd, *gla_norm, *swa_sink, *w_branch, *w_out, *ln1_g, *ln1_b, *ln2_g, *ln2_b, *w_peer_q, *peer_keys,
      *peer_u, *peer_v;
  float* out;
  char* ws;
};

constexpr size_t OFF_Wt_in = 0ull;
constexpr size_t OFF_Wt_uq = OFF_Wt_in + (((2ull * 6144 * 1024 * 2) + 255ull) & ~255ull);
constexpr size_t OFF_Wt_ukv = OFF_Wt_uq + (((2ull * 384 * 256 * 2) + 255ull) & ~255ull);
constexpr size_t OFF_Wt_br = OFF_Wt_ukv + (((2ull * 512 * 128 * 2) + 255ull) & ~255ull);
constexpr size_t OFF_Wt_out = OFF_Wt_br + (((8ull * 1024 * 256 * 2) + 255ull) & ~255ull);
constexpr size_t OFF_Wt_pq = OFF_Wt_out + (((2ull * 1024 * 1024 * 2) + 255ull) & ~255ull);
constexpr size_t OFF_keysbf = OFF_Wt_pq + (((2ull * 2048 * 1024 * 2) + 255ull) & ~255ull);
constexpr size_t OFF_Cch = OFF_keysbf + (((2ull * 16 * 128 * 128 * 2) + 255ull) & ~255ull);
constexpr size_t OFF_A256 = OFF_Cch + (((128ull * 64 * 2) + 255ull) & ~255ull);
constexpr size_t OFF_A2048 = OFF_A256 + (((256ull * 512 * 2) + 255ull) & ~255ull);
constexpr size_t OFF_mada = OFF_A2048 + (((2048ull * 4096 * 2) + 255ull) & ~255ull);
constexpr size_t OFF_xbuf = OFF_mada + (((2ull * 3 * 6144 * 4) + 255ull) & ~255ull);
constexpr size_t OFF_u = OFF_xbuf + 256ull;
constexpr size_t OFF_hbuf = OFF_u + (((12288ull * 1024 * 2) + 255ull) & ~255ull);
constexpr size_t OFF_gates = OFF_hbuf + (((12288ull * 1984 * 4) + 255ull) & ~255ull);
constexpr size_t OFF_qn = OFF_gates + (((12288ull * 4096 * 2) + 255ull) & ~255ull);
constexpr size_t OFF_ckv_all = OFF_qn + (((12288ull * 256 * 2) + 255ull) & ~255ull);
constexpr size_t OFF_Qa = OFF_ckv_all + (((13312ull * 128 * 2) + 255ull) & ~255ull);
constexpr size_t OFF_Ka_ctx = OFF_Qa + (((12288ull * 384 * 2) + 255ull) & ~255ull);
constexpr size_t OFF_Ka_lat = OFF_Ka_ctx + (((32ull * 4 * 256 * 96 * 2) + 255ull) & ~255ull);
constexpr size_t OFF_Va_ctx = OFF_Ka_lat + (((2ull * 4 * 2560 * 96 * 2) + 255ull) & ~255ull);
constexpr size_t OFF_Va_lat = OFF_Va_ctx + (((32ull * 4 * 256 * 64 * 2) + 255ull) & ~255ull);
constexpr size_t OFF_Qd = OFF_Va_lat + (((2ull * 4 * 2560 * 64 * 2) + 255ull) & ~255ull);
constexpr size_t OFF_Kd_ctx = OFF_Qd + (((12288ull * 256 * 2) + 255ull) & ~255ull);
constexpr size_t OFF_Kd_lat = OFF_Kd_ctx + (((32ull * 2 * 256 * 64 * 2) + 255ull) & ~255ull);
constexpr size_t OFF_Vd_ctx = OFF_Kd_lat + (((2ull * 2 * 2560 * 64 * 2) + 255ull) & ~255ull);
constexpr size_t OFF_Vd_lat = OFF_Vd_ctx + (((32ull * 2 * 256 * 64 * 2) + 255ull) & ~255ull);
constexpr size_t OFF_fnet = OFF_Vd_lat + (((2ull * 2 * 2560 * 64 * 2) + 255ull) & ~255ull);
constexpr size_t OFF_Yt_ctx = OFF_fnet + (((12288ull * 256 * 2) + 255ull) & ~255ull);
constexpr size_t OFF_Yt_lat = OFF_Yt_ctx + (((32ull * 256 * 512 * 2) + 255ull) & ~255ull);
constexpr size_t OFF_br = OFF_Yt_lat + (((2ull * 256 * 4096 * 2) + 255ull) & ~255ull);
constexpr size_t OFF_un = OFF_br + (((12288ull * 1024 * 2) + 255ull) & ~255ull);
constexpr size_t OFF_sin_ = OFF_un + (((1536ull * 2048 * 4) + 255ull) & ~255ull);
constexpr size_t OFF_gn = OFF_sin_ + (((1536ull * 2048 * 4) + 255ull) & ~255ull);
constexpr size_t OFF_pidx = OFF_gn + (((1536ull * 32 * 4) + 255ull) & ~255ull);
constexpr size_t OFF_pw = OFF_pidx + (((12288ull * 128 * 4) + 255ull) & ~255ull);
constexpr size_t OFF_bar = OFF_pw + (((12288ull * 128 * 4) + 255ull) & ~255ull);
constexpr size_t WS_TOTAL_OLD = OFF_pw + (((12288ull * 128 * 4) + 255ull) & ~255ull);
constexpr size_t OFF_tabU = OFF_bar + 16384ull;
constexpr size_t OFF_tabV = OFF_tabU + 2ull * 16384 * 1024;
constexpr size_t WS_TOTAL = OFF_tabV + 2ull * 16384 * 1024;
#define W_tabU ((unsigned char*)(p.ws + OFF_tabU))
#define W_tabV ((unsigned char*)(p.ws + OFF_tabV))
#define W_Wt_in ((bf16_t*)(p.ws + OFF_Wt_in))
#define W_Wt_uq ((bf16_t*)(p.ws + OFF_Wt_uq))
#define W_Wt_ukv ((bf16_t*)(p.ws + OFF_Wt_ukv))
#define W_Wt_br ((bf16_t*)(p.ws + OFF_Wt_br))
#define W_Wt_out ((bf16_t*)(p.ws + OFF_Wt_out))
#define W_Wt_pq ((bf16_t*)(p.ws + OFF_Wt_pq))
#define W_keysbf ((bf16_t*)(p.ws + OFF_keysbf))
#define W_Cch ((bf16_t*)(p.ws + OFF_Cch))
#define W_A256 ((bf16_t*)(p.ws + OFF_A256))
#define W_A2048 ((bf16_t*)(p.ws + OFF_A2048))
#define W_mada ((float*)(p.ws + OFF_mada))
#define W_xbuf ((float*)(p.ws + OFF_xbuf))
#define W_u ((bf16_t*)(p.ws + OFF_u))
#define W_hbuf ((float*)(p.ws + OFF_hbuf))
#define W_gates ((bf16_t*)(p.ws + OFF_gates))
#define W_qn ((bf16_t*)(p.ws + OFF_qn))
#define W_ckv_all ((bf16_t*)(p.ws + OFF_ckv_all))
#define W_Qa ((bf16_t*)(p.ws + OFF_Qa))
#define W_Ka_ctx ((bf16_t*)(p.ws + OFF_Ka_ctx))
#define W_Ka_lat ((bf16_t*)(p.ws + OFF_Ka_lat))
#define W_Va_ctx ((bf16_t*)(p.ws + OFF_Va_ctx))
#define W_Va_lat ((bf16_t*)(p.ws + OFF_Va_lat))
#define W_Qd ((bf16_t*)(p.ws + OFF_Qd))
#define W_Kd_ctx ((bf16_t*)(p.ws + OFF_Kd_ctx))
#define W_Kd_lat ((bf16_t*)(p.ws + OFF_Kd_lat))
#define W_Vd_ctx ((bf16_t*)(p.ws + OFF_Vd_ctx))
#define W_Vd_lat ((bf16_t*)(p.ws + OFF_Vd_lat))
#define W_fnet ((bf16_t*)(p.ws + OFF_fnet))
#define W_Yt_ctx ((bf16_t*)(p.ws + OFF_Yt_ctx))
#define W_Yt_lat ((bf16_t*)(p.ws + OFF_Yt_lat))
#define W_br ((bf16_t*)(p.ws + OFF_br))
#define W_un ((float*)(p.ws + OFF_un))
#define W_sin_ ((float*)(p.ws + OFF_sin_))
#define W_gn ((float*)(p.ws + OFF_gn))
#define W_pidx ((int*)(p.ws + OFF_pidx))
#define W_pw ((float*)(p.ws + OFF_pw))

#define GB_LD 72
#define G_LOAD(RA, RB, KOFF)                                                         \
  _Pragma("unroll") for (int i = 0; i < 4; i++) {                                    \
    int c = tid + i * 256, r = c >> 3, cc = (c & 7) * 8;                             \
    RA[i] = *(const u32x4*)(A + (size_t)r * lda + (KOFF) + cc);                      \
    if (i < NJ) RB[i] = *(const u32x4*)(B + (size_t)r * ldb + (KOFF) + cc);          \
  }
#define G_STORE(RA, RB)                                                              \
  _Pragma("unroll") for (int i = 0; i < 4; i++) {                                    \
    int c = tid + i * 256, r = c >> 3, cc = (c & 7) * 8;                             \
    *(u32x4*)(sa + r * GB_LD + cc) = RA[i];                                          \
    if (i < NJ) *(u32x4*)(sb + r * GB_LD + cc) = RB[i];                              \
  }
#define G_COMPUTE()                                                                  \
  _Pragma("unroll") for (int ks = 0; ks < 2; ks++) {                                 \
    bf16x8 af[4], bfr[NJ];                                                           \
    _Pragma("unroll") for (int i = 0; i < 4; i++)                                    \
      af[i] = *(const bf16x8*)(sa + (wm * 64 + i * 16 + l15) * GB_LD + ks * 32 + l4 * 8); \
    _Pragma("unroll") for (int j = 0; j < NJ; j++)                                   \
      bfr[j] = *(const bf16x8*)(sb + (wn * NJ * 16 + j * 16 + l15) * GB_LD + ks * 32 + l4 * 8); \
    _Pragma("unroll") for (int i = 0; i < 4; i++)                                    \
    _Pragma("unroll") for (int j = 0; j < NJ; j++)                                   \
      acc[i][j] = __builtin_amdgcn_mfma_f32_16x16x32_bf16(af[i], bfr[j], acc[i][j], 0, 0, 0); \
  }
template <int NJ>
__device__ __forceinline__ void gemm_core_t(f32x4 (&acc)[4][NJ], const bf16_t* __restrict__ A, int lda,
                                            const bf16_t* __restrict__ B, int ldb, int K, char* smem) {
  bf16_t* sa = (bf16_t*)smem;
  bf16_t* sb = sa + 128 * GB_LD;
  const int tid = tidx(), lane = tid & 63, w = tid >> 6, wm = w >> 1, wn = w & 1;
  const int l15 = lane & 15, l4 = lane >> 4;
  u32x4 ra0[4], rb0[NJ], ra1[4], rb1[NJ];
  G_LOAD(ra0, rb0, 0);
  if (K > 64) { G_LOAD(ra1, rb1, 64); }
  for (int k0 = 0; k0 < K; k0 += 128) {
    __syncthreads();
    G_STORE(ra0, rb0);
    __syncthreads();
    if (k0 + 128 < K) { G_LOAD(ra0, rb0, k0 + 128); }
    G_COMPUTE();
    if (k0 + 64 < K) {
      __syncthreads();
      G_STORE(ra1, rb1);
      __syncthreads();
      if (k0 + 192 < K) { G_LOAD(ra1, rb1, k0 + 192); }
      G_COMPUTE();
    }
  }
}
#define gemm_core gemm_core_t<4>
#define ZERO_ACC_N(acc, NJ)                                        \
  _Pragma("unroll") for (int i_ = 0; i_ < 4; i_++)                 \
  _Pragma("unroll") for (int j_ = 0; j_ < NJ; j_++) { acc[i_][j_] = f32x4{0.f, 0.f, 0.f, 0.f}; }
#define ZERO_ACC(acc) ZERO_ACC_N(acc, 4)
#define EPI_LOOP_N(acc, m0, n0, NJ, ...)                                                   \
  {                                                                                        \
    const int lane_ = tidx() & 63, w_ = tidx() >> 6, wm_ = w_ >> 1, wn_ = w_ & 1; \
    _Pragma("unroll") for (int i_ = 0; i_ < 4; i_++)                                       \
    _Pragma("unroll") for (int j_ = 0; j_ < NJ; j_++)                                      \
    _Pragma("unroll") for (int r_ = 0; r_ < 4; r_++) {                                     \
      const int m = (m0) + wm_ * 64 + i_ * 16 + (lane_ >> 4) * 4 + r_;                     \
      const int n = (n0) + wn_ * (NJ * 16) + j_ * 16 + (lane_ & 15);                       \
      float v = acc[i_][j_][r_];                                                           \
      __VA_ARGS__                                                                          \
    }                                                                                      \
  }
#define EPI_LOOP(acc, m0, n0, ...) EPI_LOOP_N(acc, m0, n0, 4, __VA_ARGS__)
#define EPI4_LOOP(acc, c0, t0, ...)                                                        \
  {                                                                                        \
    const int lane_ = tidx() & 63, w_ = tidx() >> 6, wm_ = w_ >> 1, wn_ = w_ & 1;           \
    _Pragma("unroll") for (int i_ = 0; i_ < 4; i_++)                                       \
    _Pragma("unroll") for (int j_ = 0; j_ < 4; j_++) {                                     \
      const int col = (c0) + wm_ * 64 + i_ * 16 + (lane_ >> 4) * 4;                        \
      const int tok = (t0) + wn_ * 64 + j_ * 16 + (lane_ & 15);                            \
      const f32x4 v4 = acc[i_][j_];                                                        \
      __VA_ARGS__                                                                          \
    }                                                                                      \
  }

__device__ __forceinline__ void transpose_tile(const float* __restrict__ src, int K, int N, bf16_t* __restrict__ dst, int tile, int ntn,
                               float* sm) {
  int kt = tile / ntn, nt = tile % ntn, k0 = kt * 64, n0 = nt * 64;
  int tx = tidx() & 63, ty = tidx() >> 6;
  __syncthreads();
  for (int i = 0; i < 16; i++) {
    int k = i * 4 + ty, n = n0 + tx;
    sm[k * 65 + tx] = (n < N) ? src[(size_t)(k0 + k) * N + n] : 0.f;
  }
  __syncthreads();
  for (int i = 0; i < 16; i++) {
    int n = i * 4 + ty;
    dst[(size_t)(n0 + n) * K + k0 + tx] = f2bf(sm[tx * 65 + n]);
  }
}

__device__ __forceinline__ void ada_item(const P& p, int item, float* sm) {
  int l = item / 24, cgp = item % 24;
  int lane = tidx() & 63, w = tidx() >> 6;
  const float* W = p.w_ada + (size_t)l * 1024 * 6144 + cgp * 256 + lane * 4;
  float4 a0 = {0, 0, 0, 0}, a1 = {0, 0, 0, 0}, a2 = {0, 0, 0, 0};
#pragma unroll 8
  for (int k = w * 256; k < (w + 1) * 256; k++) {
    float4 wv = *(const float4*)(W + (size_t)k * 6144);
    float c0 = siluf(p.c_ctx[k]), c1 = siluf(p.c[k]), c2 = siluf(p.c[1024 + k]);
    a0.x += c0 * wv.x; a0.y += c0 * wv.y; a0.z += c0 * wv.z; a0.w += c0 * wv.w;
    a1.x += c1 * wv.x; a1.y += c1 * wv.y; a1.z += c1 * wv.z; a1.w += c1 * wv.w;
    a2.x += c2 * wv.x; a2.y += c2 * wv.y; a2.z += c2 * wv.z; a2.w += c2 * wv.w;
  }
  __syncthreads();
  *(float4*)(sm + (w * 3 + 0) * 256 + lane * 4) = a0;
  *(float4*)(sm + (w * 3 + 1) * 256 + lane * 4) = a1;
  *(float4*)(sm + (w * 3 + 2) * 256 + lane * 4) = a2;
  __syncthreads();
  for (int o = tidx(); o < 768; o += 256) {
    int r = o >> 8, col = o & 255;
    float s = sm[(0 * 3 + r) * 256 + col] + sm[(1 * 3 + r) * 256 + col] + sm[(2 * 3 + r) * 256 + col] +
              sm[(3 * 3 + r) * 256 + col];
    W_mada[(l * 3 + r) * 6144 + cgp * 256 + col] = s + p.b_ada[l * 6144 + cgp * 256 + col];
  }
}

__device__ __forceinline__ void dft_seq_fill(bf16_t* dst, int S, int item) {
  float inv = rsqrtf((float)S);
  size_t base = (size_t)item * 2048;
  for (int e = 0; e < 8; e++) {
    size_t idx = base + e * 256 + tidx();
    int k = (int)(idx / (2 * S)), col = (int)(idx % (2 * S));
    int s = col < S ? col : col - S;
    int mm = (k * s) & (S - 1);
    float rev = (float)mm / (float)S;
    float v = col < S ? __builtin_amdgcn_cosf(rev) : -__builtin_amdgcn_sinf(rev);
    dst[idx] = f2bf(v * inv);
  }
}

#define PEER_U_SCALE 64.f
#define PEER_V_SCALE 16.f
__device__ __forceinline__ void tab_convert_item(const P& p, int item) {
  int l = item >> 12, isv = (item >> 11) & 1, sub = item & 2047;
  const float* src = (isv ? p.peer_v : p.peer_u) + (size_t)l * 16384 * 1024 + (size_t)sub * 8192;
  unsigned char* dst = (isv ? W_tabV : W_tabU) + (size_t)l * 16384 * 1024 + (size_t)sub * 8192;
  const float sc = isv ? PEER_V_SCALE : PEER_U_SCALE;
  int tid = tidx();
  float4 tt[8];
#pragma unroll
  for (int e = 0; e < 8; e++) tt[e] = *(const float4*)(src + (e * 256 + tid) * 4);
#pragma unroll
  for (int e = 0; e < 8; e++) {
    float4 t = tt[e];
    int pk = __builtin_amdgcn_cvt_pk_fp8_f32(t.x * sc, t.y * sc, 0, false);
    pk = __builtin_amdgcn_cvt_pk_fp8_f32(t.z * sc, t.w * sc, pk, true);
    *(int*)(dst + (e * 256 + tid) * 4) = pk;
  }
}

__device__ __forceinline__ void phase_prep(const P& p, char* smem) {
  float* sm = (float*)smem;
  const int nb = gridDim.x;
  const int J_ADA = 48;
  const int J_IN = 2 * 16 * 96;
  const int J_UQ = 2 * 4 * 6;
  const int J_UKV = 2 * 2 * 8;
  const int J_BR = 2 * 4 * 4 * 16;
  const int J_OUT = 2 * 16 * 16;
  const int J_PQ = 2 * 16 * 32;
  const int J_KEYS = 256;
  const int J_CCH = 4;
  const int J_A256 = 64;
  const int J_A2048 = 4096;
  const int J_TAB = 8192;
  const int total = J_ADA + J_IN + J_UQ + J_UKV + J_BR + J_OUT + J_PQ + J_KEYS + J_CCH + J_A256 + J_A2048 + J_TAB;
  for (int it0 = blockIdx.x; it0 < total; it0 += nb) {
    int it = it0;
    if (it < J_ADA) { ada_item(p, it, sm); continue; }
    it -= J_ADA;
    if (it < J_IN) { int l = it / 1536, t = it % 1536; transpose_tile(p.w_in + (size_t)l * 1024 * 6080, 1024, 6080, W_Wt_in + (size_t)l * 6144 * 1024, t, 96, sm); continue; }
    it -= J_IN;
    if (it < J_UQ) { int l = it / 24, t = it % 24; transpose_tile(p.w_uq + (size_t)l * 256 * 384, 256, 384, W_Wt_uq + (size_t)l * 384 * 256, t, 6, sm); continue; }
    it -= J_UQ;
    if (it < J_UKV) { int l = it / 16, t = it % 16; transpose_tile(p.w_ukv + (size_t)l * 128 * 512, 128, 512, W_Wt_ukv + (size_t)l * 512 * 128, t, 8, sm); continue; }
    it -= J_UKV;
    if (it < J_BR) { int lb = it / 64, t = it % 64; transpose_tile(p.w_branch + (size_t)lb * 256 * 1024, 256, 1024, W_Wt_br + (size_t)lb * 1024 * 256, t, 16, sm); continue; }
    it -= J_BR;
    if (it < J_OUT) { int l = it / 256, t = it % 256; transpose_tile(p.w_out + (size_t)l * 1024 * 1024, 1024, 1024, W_Wt_out + (size_t)l * 1024 * 1024, t, 16, sm); continue; }
    it -= J_OUT;
    if (it < J_PQ) { int l = it / 512, t = it % 512; transpose_tile(p.w_peer_q + (size_t)l * 1024 * 2048, 1024, 2048, W_Wt_pq + (size_t)l * 2048 * 1024, t, 32, sm); continue; }
    it -= J_PQ;
    if (it < J_KEYS) {
      size_t base = (size_t)it * 2048;
      float kv_[8];
#pragma unroll
      for (int e = 0; e < 8; e++) kv_[e] = p.peer_keys[base + e * 256 + tidx()];
#pragma unroll
      for (int e = 0; e < 8; e++) W_keysbf[base + e * 256 + tidx()] = f2bf(kv_[e]);
      continue;
    }
    it -= J_KEYS;
    if (it < J_CCH) {
      for (int e = 0; e < 8; e++) {
        int idx = it * 2048 + e * 256 + tidx();
        int n = idx >> 6, c = idx & 63;
        int j = n & 63;
        float rev = (float)((j * c) & 63) / 64.f;
        float v = n < 64 ? __builtin_amdgcn_cosf(rev) : __builtin_amdgcn_sinf(rev);
        W_Cch[idx] = f2bf(v * 0.125f);
      }
      continue;
    }
    it -= J_CCH;
    if (it < J_A256) { dft_seq_fill(W_A256, 256, it); continue; }
    it -= J_A256;
    if (it < J_A2048) { dft_seq_fill(W_A2048, 2048, it); continue; }
    it -= J_A2048;
    tab_convert_item(p, it);
  }
}

__device__ __forceinline__ void load_row16(const float* row, int lane, float (&v)[16]) {
#pragma unroll
  for (int q = 0; q < 4; q++) {
    float4 t = *(const float4*)(row + q * 256 + lane * 4);
    v[q * 4 + 0] = t.x; v[q * 4 + 1] = t.y; v[q * 4 + 2] = t.z; v[q * 4 + 3] = t.w;
  }
}
__device__ __forceinline__ void store_row16(float* row, int lane, const float (&v)[16]) {
#pragma unroll
  for (int q = 0; q < 4; q++) *(float4*)(row + q * 256 + lane * 4) = float4{v[q * 4], v[q * 4 + 1], v[q * 4 + 2], v[q * 4 + 3]};
}
__device__ __forceinline__ void ln16(float (&v)[16]) {
  float s = 0;
#pragma unroll
  for (int i = 0; i < 16; i++) s += v[i];
  s = wsum(s);
  float mu = s * (1.f / 1024.f);
  float q = 0;
#pragma unroll
  for (int i = 0; i < 16; i++) { v[i] -= mu; q += v[i] * v[i]; }
  q = wsum(q);
  float rs = rsqrtf(q * (1.f / 1024.f) + 1e-6f);
#pragma unroll
  for (int i = 0; i < 16; i++) v[i] *= rs;
}
__device__ __forceinline__ void modulate_store(const float (&v)[16], const float* sh, const float* sc, bf16_t* dst, int lane) {
#pragma unroll
  for (int q = 0; q < 4; q++) {
    float4 a = *(const float4*)(sc + q * 256 + lane * 4);
    float4 b = *(const float4*)(sh + q * 256 + lane * 4);
    ushort4 o;
    o.x = f2bf(v[q * 4 + 0] * (1.f + a.x) + b.x);
    o.y = f2bf(v[q * 4 + 1] * (1.f + a.y) + b.y);
    o.z = f2bf(v[q * 4 + 2] * (1.f + a.z) + b.z);
    o.w = f2bf(v[q * 4 + 3] * (1.f + a.w) + b.w);
    *(ushort4*)(dst + q * 256 + lane * 4) = o;
  }
}
__device__ __forceinline__ void affine16(float (&v)[16], const float* g, const float* b, int lane) {
#pragma unroll
  for (int q = 0; q < 4; q++) {
    float4 a = *(const float4*)(g + q * 256 + lane * 4);
    float4 c = *(const float4*)(b + q * 256 + lane * 4);
    v[q * 4 + 0] = v[q * 4 + 0] * a.x + c.x;
    v[q * 4 + 1] = v[q * 4 + 1] * a.y + c.y;
    v[q * 4 + 2] = v[q * 4 + 2] * a.z + c.z;
    v[q * 4 + 3] = v[q * 4 + 3] * a.w + c.w;
  }
}
__device__ __forceinline__ const float* x_in_row(const P& p, int l, int g) {
  if (l == 0) return g < T_CTX ? p.x_prompt + (size_t)g * 1024 : p.x_sample + (size_t)(g - T_CTX) * 1024;
  return p.out + (size_t)g * 1024;
}
__device__ __forceinline__ float* x_out_row(const P& p, int l, int g) {
  return p.out + (size_t)g * 1024;
}

__device__ __forceinline__ void phase_ln0(const P& p) {
  int lane = tidx() & 63, w = tidx() >> 6;
  for (int it = blockIdx.x; it < T_ALL / 4; it += gridDim.x) {
    int g = it * 4 + w;
    float v[16];
    load_row16(x_in_row(p, 0, g), lane, v);
    ln16(v);
    const float* m = W_mada + (0 * 3 + cond_row(g)) * 6144;
    modulate_store(v, m, m + 1024, W_u + (size_t)g * 1024, lane);
  }
}

__device__ __forceinline__ void phase_win(const P& p, int l, char* smem) {
  const bf16_t* Wt = W_Wt_in + (size_t)l * 6144 * 1024;
  for (int tile = blockIdx.x; tile < 96 * 48; tile += gridDim.x) {
    int mt = tile / 48, nt = tile % 48, m0 = mt * 128, n0 = nt * 128;
    f32x4 acc[4][4];
    ZERO_ACC(acc);
    gemm_core(acc, Wt + (size_t)n0 * 1024, 1024, W_u + (size_t)m0 * 1024, 1024, 1024, smem);
    EPI4_LOOP(acc, n0, m0, {
      if (col < 1984) *(float4*)(W_hbuf + (size_t)tok * 1984 + col) = float4{v4[0], v4[1], v4[2], v4[3]};
      else if (col < 6080) {
        ushort4 o_; o_.x = f2bf(sigmf(v4[0])); o_.y = f2bf(sigmf(v4[1])); o_.z = f2bf(sigmf(v4[2])); o_.w = f2bf(sigmf(v4[3]));
        *(ushort4*)(W_gates + (size_t)tok * 4096 + (col - 1984)) = o_;
      }
    });
  }
}

__device__ __forceinline__ void rope_cs(float pos, int i, float inv_hp, float& cs, float& sn) {
  float freq = exp2f(-(float)i * inv_hp * 13.287712379549449f);
  float a = pos * freq;
  sn = __sinf(a);
  cs = __cosf(a);
}

__device__ __forceinline__ void phase_post(const P& p, int l) {
  int lane = tidx() & 63, w = tidx() >> 6;
  for (int it = blockIdx.x; it < 13312 / 4; it += gridDim.x) {
    int g = it * 4 + w;
    if (g < T_ALL) {
      const bool lat = g >= T_CTX;
      int b, s;
      if (!lat) { b = g >> 8; s = g & 255; } else { b = (g - T_CTX) >> 11; s = (g - T_CTX) & 2047; }
      const float* h = W_hbuf + (size_t)g * 1984;
      const float prow = (float)(s >> 6), pcol = (float)(s & 63);
      const float4 pl_q = *(const float4*)(h + lane * 4);
      const float2 pl_c = *(const float2*)(h + 256 + lane * 2);
      const float pl_kr1 = h[384 + ((lane >> 3) & 1) * 16 + (lane & 7)], pl_kr2 = h[384 + ((lane >> 3) & 1) * 16 + 8 + (lane & 7)];
      const float4 pl_f = *(const float4*)(h + 416 + lane * 4);
      float pl_sq1[2], pl_sq2[2];
#pragma unroll
      for (int jj = 0; jj < 2; jj++) {
        int pi = lane + 64 * jj, hq = pi >> 5, pp = (pi >> 4) & 1, i = pi & 15;
        pl_sq1[jj] = h[1472 + hq * 64 + pp * 32 + i]; pl_sq2[jj] = h[1472 + hq * 64 + pp * 32 + 16 + i];
      }
      const float pl_sk1 = h[1728 + (lane >> 5) * 64 + ((lane >> 4) & 1) * 32 + (lane & 15)];
      const float pl_sk2 = h[1728 + (lane >> 5) * 64 + ((lane >> 4) & 1) * 32 + 16 + (lane & 15)];
      const float2 pl_v = *(const float2*)(h + 1856 + lane * 2);
      {
        float4 t = pl_q;
        float ss = wsum(t.x * t.x + t.y * t.y + t.z * t.z + t.w * t.w);
        float rs = rsqrtf(ss * (1.f / 256.f) + 1e-6f);
        float4 gq = *(const float4*)(p.mla_q_norm + l * 256 + lane * 4);
        ushort4 o;
        o.x = f2bf(t.x * rs * gq.x); o.y = f2bf(t.y * rs * gq.y); o.z = f2bf(t.z * rs * gq.z); o.w = f2bf(t.w * rs * gq.w);
        *(ushort4*)(W_qn + (size_t)g * 256 + lane * 4) = o;
      }
      {
        float2 t = pl_c;
        float ss = wsum(t.x * t.x + t.y * t.y);
        float rs = rsqrtf(ss * (1.f / 128.f) + 1e-6f);
        float2 gk = *(const float2*)(p.mla_kv_norm + l * 128 + lane * 2);
        float v0 = t.x * rs * gk.x, v1 = t.y * rs * gk.y;
        ushort2 o; o.x = f2bf(v0); o.y = f2bf(v1);
        *(ushort2*)(W_ckv_all + (size_t)g * 128 + lane * 2) = o;
        if (!lat) *(float2*)(p.out + 12582912 + ((size_t)((b * 2 + l) * 256 + s)) * 128 + lane * 2) = float2{v0, v1};
      }
      if (lane < 16) {
        int pp = lane >> 3, i = lane & 7;
        float x1 = pl_kr1, x2 = pl_kr2;
        float o1 = x1, o2 = x2;
        if (lat) {
          float cs, sn;
          rope_cs(pp ? pcol : prow, i, 0.125f, cs, sn);
          o1 = x1 * cs - x2 * sn; o2 = x2 * cs + x1 * sn;
        } else {
          float* ok = p.out + 14680064 + ((size_t)((b * 2 + l) * 256 + s)) * 32 + pp * 16 + i;
          ok[0] = o1; ok[8] = o2;
        }
        bf16_t b1 = f2bf(o1), b2 = f2bf(o2);
        for (int hh = 0; hh < 4; hh++) {
          bf16_t* kd = lat ? W_Ka_lat + ((size_t)((b * 4 + hh) * 2560 + 512 + s)) * 96 : W_Ka_ctx + ((size_t)((b * 4 + hh) * 256 + s)) * 96;
          kd[64 + pp * 16 + i] = b1; kd[64 + pp * 16 + 8 + i] = b2;
        }
      }
      {
        float4 t = pl_f;
        ushort4 o; o.x = f2bf(t.x); o.y = f2bf(t.y); o.z = f2bf(t.z); o.w = f2bf(t.w);
        *(ushort4*)(W_fnet + (size_t)g * 256 + lane * 4) = o;
      }
#pragma unroll
      for (int jj = 0; jj < 2; jj++) {
        int pi = lane + 64 * jj, hq = pi >> 5, pp = (pi >> 4) & 1, i = pi & 15;
        float x1 = pl_sq1[jj], x2 = pl_sq2[jj];
        float o1 = x1, o2 = x2;
        if (lat) {
          float cs, sn;
          rope_cs(pp ? pcol : prow, i, 0.0625f, cs, sn);
          o1 = x1 * cs - x2 * sn; o2 = x2 * cs + x1 * sn;
        }
        bf16_t* qd = W_Qd + (size_t)g * 256 + hq * 64 + pp * 32 + i;
        qd[0] = f2bf(o1); qd[16] = f2bf(o2);
      }
      {
        int kv = lane >> 5, pp = (lane >> 4) & 1, i = lane & 15;
        float x1 = pl_sk1, x2 = pl_sk2;
        float o1 = x1, o2 = x2;
        bf16_t* kd;
        if (lat) {
          float cs, sn;
          rope_cs(pp ? pcol : prow, i, 0.0625f, cs, sn);
          o1 = x1 * cs - x2 * sn; o2 = x2 * cs + x1 * sn;
          kd = W_Kd_lat + ((size_t)((b * 2 + kv) * 2560 + 512 + s)) * 64;
        } else {
          float* ok = p.out + 15204352 + ((size_t)(((b * 2 + l) * 2 + kv) * 256 + s)) * 64 + pp * 32 + i;
          ok[0] = o1; ok[16] = o2;
          kd = W_Kd_ctx + ((size_t)((b * 2 + kv) * 256 + s)) * 64;
        }
        kd[pp * 32 + i] = f2bf(o1); kd[pp * 32 + 16 + i] = f2bf(o2);
      }
      {
        int e = lane * 2, kv = e >> 6, d = e & 63;
        float2 t = pl_v;
        if (lat) {
          bf16_t* vt = W_Vd_lat + (size_t)(b * 2 + kv) * 64 * 2560 + 512 + s;
          vt[(size_t)d * 2560] = f2bf(t.x); vt[(size_t)(d + 1) * 2560] = f2bf(t.y);
        } else {
          *(float2*)(p.out + 17301504 + ((size_t)(((b * 2 + l) * 2 + kv) * 256 + s)) * 64 + d) = t;
          bf16_t* vt = W_Vd_ctx + (size_t)(b * 2 + kv) * 64 * 256 + s;
          vt[d * 256] = f2bf(t.x); vt[(d + 1) * 256] = f2bf(t.y);
        }
      }
    } else {
      int gc = g - T_ALL, b = gc >> 9, pp = gc & 511;
      {
        float2 t = *(const float2*)(p.cache_ckv + ((size_t)((b * 2 + l) * 512 + pp)) * 128 + lane * 2);
        ushort2 o; o.x = f2bf(t.x); o.y = f2bf(t.y);
        *(ushort2*)(W_ckv_all + (size_t)g * 128 + lane * 2) = o;
      }
      if (lane < 32) {
        bf16_t v = f2bf(p.cache_krope[((size_t)((b * 2 + l) * 512 + pp)) * 32 + lane]);
        for (int hh = 0; hh < 4; hh++) W_Ka_lat[((size_t)((b * 4 + hh) * 2560 + pp)) * 96 + 64 + lane] = v;
      }
      {
        int e = lane * 2, kv = e >> 6, d = e & 63;
        size_t src = ((size_t)(((b * 2 + l) * 2 + kv) * 512 + pp)) * 64 + d;
        float2 tk = *(const float2*)(p.cache_swa_k + src);
        float2 tv = *(const float2*)(p.cache_swa_v + src);
        size_t dst = ((size_t)((b * 2 + kv) * 2560 + pp)) * 64 + d;
        ushort2 ok; ok.x = f2bf(tk.x); ok.y = f2bf(tk.y);
        *(ushort2*)(W_Kd_lat + dst) = ok;
        bf16_t* vt = W_Vd_lat + (size_t)(b * 2 + kv) * 64 * 2560 + pp;
        vt[(size_t)d * 2560] = f2bf(tv.x); vt[(size_t)(d + 1) * 2560] = f2bf(tv.y);
      }
    }
  }
}

__device__ __forceinline__ void phase_small_gemms(const P& p, int l, char* smem) {
  const int NA = 96 * 3, NB = 104 * 4, NC = 384;
  for (int it0 = blockIdx.x; it0 < NA + NB + NC; it0 += gridDim.x) {
    int it = it0;
    f32x4 acc[4][4];
    ZERO_ACC(acc);
    if (it < NA) {
      int mt = it / 3, nt = it % 3, m0 = mt * 128, n0 = nt * 128;
      gemm_core(acc, W_qn + (size_t)m0 * 256, 256, W_Wt_uq + (size_t)l * 384 * 256 + (size_t)n0 * 256, 256, 256, smem);
      const bool lat = m0 >= T_CTX;
      EPI_LOOP(acc, m0, n0, {
        int c96 = n % 96;
        if (lat && c96 >= 64) {
          float pv = DPP_F(v, v, 0x128, 0xf);
          int cr = c96 - 64, pp = cr >> 4, ii = cr & 15, i = ii & 7;
          int s = (m - T_CTX) & 2047;
          float cs, sn;
          rope_cs(pp ? (float)(s & 63) : (float)(s >> 6), i, 0.125f, cs, sn);
          v = (ii < 8) ? v * cs - pv * sn : v * cs + pv * sn;
        }
        W_Qa[(size_t)m * 384 + n] = f2bf(v);
      });
      continue;
    }
    it -= NA;
    if (it < NB) {
      int mt = it / 4, nt = it % 4, m0 = mt * 128, n0 = nt * 128;
      gemm_core(acc, W_ckv_all + (size_t)m0 * 128, 128, W_Wt_ukv + (size_t)l * 512 * 128 + (size_t)n0 * 128, 128, 128, smem);
      EPI_LOOP(acc, m0, n0, {
        int hh = n >> 7, c = n & 127;
        bf16_t* kd; bf16_t* vd; int vstride;
        if (m < T_CTX) {
          int b = m >> 8, s = m & 255;
          size_t r = (size_t)((b * 4 + hh) * 256 + s);
          kd = W_Ka_ctx + r * 96; vd = W_Va_ctx + (size_t)(b * 4 + hh) * 64 * 256 + s; vstride = 256;
        } else {
          int b, pos;
          if (m < T_ALL) { b = (m - T_CTX) >> 11; pos = 512 + ((m - T_CTX) & 2047); }
          else { b = (m - T_ALL) >> 9; pos = (m - T_ALL) & 511; }
          size_t r = (size_t)((b * 4 + hh) * 2560 + pos);
          kd = W_Ka_lat + r * 96; vd = W_Va_lat + (size_t)(b * 4 + hh) * 64 * 2560 + pos; vstride = 2560;
        }
        if (c < 64) kd[c] = f2bf(v); else vd[(size_t)(c - 64) * vstride] = f2bf(v);
      });
      continue;
    }
    it -= NB;
    {
      int m0 = it * 128;
      gemm_core(acc, W_fnet + (size_t)m0 * 64, 64, W_Cch, 64, 64, smem);
      EPI_LOOP(acc, m0, 0, {
        int g = m >> 2, grp = m & 3, part = n >> 6, j = n & 63;
        if (g < T_CTX) {
          int b = g >> 8, s = g & 255;
          W_Yt_ctx[((size_t)(b * 256 + grp * 64 + j)) * 512 + part * 256 + s] = f2bf(v);
        } else {
          int b = (g - T_CTX) >> 11, s = (g - T_CTX) & 2047;
          W_Yt_lat[((size_t)(b * 256 + grp * 64 + j)) * 4096 + part * 2048 + s] = f2bf(v);
        }
      });
    }
  }
}

template <int DK>
__device__ __forceinline__ void attn_item(const bf16_t* __restrict__ Qp, int qstride, const bf16_t* __restrict__ Kp,
                          const bf16_t* __restrict__ Vp, bf16_t* __restrict__ Op, int q0, int Sk, int n_ctx, int W,
                          float scale, bool has_sink, float sink, char* smem) {
  constexpr int KLD = DK + 8;
  bf16_t* sK = (bf16_t*)smem;
  bf16_t* sVt = sK + 64 * KLD;
  bf16_t* sP = sVt + 64 * 72;
  const int tid = tidx(), lane = tid & 63, w = tid >> 6, l15 = lane & 15, l4 = lane >> 4;
  bf16_t* sPw = sP + w * 16 * 72;
  bf16x8 qf[DK / 32];
  {
    const bf16_t* qrow = Qp + (size_t)(q0 + w * 16 + l15) * qstride;
#pragma unroll
    for (int ks = 0; ks < DK / 32; ks++) qf[ks] = *(const bf16x8*)(qrow + ks * 32 + l4 * 8);
  }
  f32x4 o[4];
#pragma unroll
  for (int j = 0; j < 4; j++) o[j] = f32x4{0.f, 0.f, 0.f, 0.f};
  float mrow[4], lrow[4];
#pragma unroll
  for (int r = 0; r < 4; r++) { mrow[r] = NEG_INF; lrow[r] = 0.f; }
  const int ntile = Sk >> 6;
  auto tile_ok = [&](int kt) -> bool {
    int kb = kt * 64;
    if (W >= 0 && kb >= n_ctx) { int lp = kb - n_ctx; if (lp + 63 < q0 - W || lp > q0 + 63 + W) return false; }
    return true;
  };
  u32x4 rk[DK / 32], rv[2];
  int kt = 0;
  while (kt < ntile && !tile_ok(kt)) kt++;
  if (kt < ntile) {
#pragma unroll
    for (int i = 0; i < DK / 32; i++) { int c = tid + i * 256, r = c / (DK / 8), cc = (c % (DK / 8)) * 8; rk[i] = *(const u32x4*)(Kp + (size_t)(kt * 64 + r) * DK + cc); }
#pragma unroll
    for (int i = 0; i < 2; i++) { int c = tid + i * 256, dv = c >> 3, k0 = (c & 7) * 8; rv[i] = *(const u32x4*)(Vp + (size_t)dv * Sk + kt * 64 + k0); }
  }
  while (kt < ntile) {
    const int kbase = kt * 64;
    __syncthreads();
#pragma unroll
    for (int i = 0; i < DK / 32; i++) { int c = tid + i * 256, r = c / (DK / 8), cc = (c % (DK / 8)) * 8; *(u32x4*)(sK + r * KLD + cc) = rk[i]; }
#pragma unroll
    for (int i = 0; i < 2; i++) {
      int c = tid + i * 256, dv = c >> 3, k0 = (c & 7) * 8;
      *(u32x4*)(sVt + dv * 72 + k0) = rv[i];
    }
    __syncthreads();
    int ktn = kt + 1;
    while (ktn < ntile && !tile_ok(ktn)) ktn++;
    if (ktn < ntile) {
#pragma unroll
      for (int i = 0; i < DK / 32; i++) { int c = tid + i * 256, r = c / (DK / 8), cc = (c % (DK / 8)) * 8; rk[i] = *(const u32x4*)(Kp + (size_t)(ktn * 64 + r) * DK + cc); }
#pragma unroll
      for (int i = 0; i < 2; i++) { int c = tid + i * 256, dv = c >> 3, k0 = (c & 7) * 8; rv[i] = *(const u32x4*)(Vp + (size_t)dv * Sk + ktn * 64 + k0); }
    }
    kt = ktn;
    f32x4 s[4];
#pragma unroll
    for (int j = 0; j < 4; j++) {
      s[j] = f32x4{0.f, 0.f, 0.f, 0.f};
#pragma unroll
      for (int ks = 0; ks < DK / 32; ks++) {
        bf16x8 kf = *(const bf16x8*)(sK + (j * 16 + l15) * KLD + ks * 32 + l4 * 8);
        s[j] = __builtin_amdgcn_mfma_f32_16x16x32_bf16(qf[ks], kf, s[j], 0, 0, 0);
      }
    }
#pragma unroll
    for (int j = 0; j < 4; j++)
#pragma unroll
      for (int r = 0; r < 4; r++) {
        float v = s[j][r] * scale;
        if (W >= 0) {
          int kk = kbase + j * 16 + l15, t = q0 + w * 16 + l4 * 4 + r;
          int dlt = kk - n_ctx - t;
          bool valid = (kk < n_ctx) || (dlt <= W && dlt >= -W);
          if (!valid) v = NEG_INF;
        }
        s[j][r] = v;
      }
#pragma unroll
    for (int r = 0; r < 4; r++) {
      float mx = fmaxf(fmaxf(s[0][r], s[1][r]), fmaxf(s[2][r], s[3][r]));
      mx = fmaxf(mx, DPP_F(mx, mx, 0xB1, 0xf));
      mx = fmaxf(mx, DPP_F(mx, mx, 0x4E, 0xf));
      mx = fmaxf(mx, DPP_F(mx, mx, 0x141, 0xf));
      mx = fmaxf(mx, DPP_F(mx, mx, 0x140, 0xf));
      float mnew = fmaxf(mrow[r], mx);
      float muse = (mnew == NEG_INF) ? 0.f : mnew;
      float alpha = __expf(mrow[r] - muse);
      float rs = 0.f;
#pragma unroll
      for (int j = 0; j < 4; j++) { float pe = __expf(s[j][r] - muse); s[j][r] = pe; rs += pe; }
      rs += DPP_F(rs, rs, 0xB1, 0xf);
      rs += DPP_F(rs, rs, 0x4E, 0xf);
      rs += DPP_F(rs, rs, 0x141, 0xf);
      rs += DPP_F(rs, rs, 0x140, 0xf);
      lrow[r] = lrow[r] * alpha + rs;
      mrow[r] = mnew;
#pragma unroll
      for (int j = 0; j < 4; j++) o[j][r] *= alpha;
    }
#pragma unroll
    for (int j = 0; j < 4; j++)
#pragma unroll
      for (int r = 0; r < 4; r++) sPw[(l4 * 4 + r) * 72 + j * 16 + l15] = f2bf(s[j][r]);
    __builtin_amdgcn_s_waitcnt(0xc07f);
    __builtin_amdgcn_wave_barrier();
#pragma unroll
    for (int ks = 0; ks < 2; ks++) {
      bf16x8 pf = *(const bf16x8*)(sPw + l15 * 72 + ks * 32 + l4 * 8);
#pragma unroll
      for (int jn = 0; jn < 4; jn++) {
        bf16x8 vf = *(const bf16x8*)(sVt + (jn * 16 + l15) * 72 + ks * 32 + l4 * 8);
        o[jn] = __builtin_amdgcn_mfma_f32_16x16x32_bf16(pf, vf, o[jn], 0, 0, 0);
      }
    }
  }
#pragma unroll
  for (int r = 0; r < 4; r++) {
    float lsum = lrow[r];
    if (has_sink) lsum += __expf(sink - mrow[r]);
    float inv = 1.f / lsum;
#pragma unroll
    for (int jn = 0; jn < 4; jn++)
      Op[(size_t)(q0 + w * 16 + l4 * 4 + r) * 1024 + jn * 16 + l15] = f2bf(o[jn][r] * inv);
  }
}

__device__ __forceinline__ int gla_tok(int tb, int c, int dir, int tau) { return tb + c * 64 + (dir ? 63 - tau : tau); }

#define GLA_W2_OFF 40960
__device__ __forceinline__ void gla_stage_w2(const P& p, int l, char* smem) {
  float* w2s = (float*)(smem + GLA_W2_OFF);
  const int tid = tidx();
  __syncthreads();
#pragma unroll
  for (int i = 0; i < 2; i++) {
    int e = (tid + i * 256) * 4;
    *(float4*)(w2s + e) = *(const float4*)(p.w_gla_a_fwd + l * 2048 + e);
    *(float4*)(w2s + 2048 + e) = *(const float4*)(p.w_gla_a_bwd + l * 2048 + e);
  }
  if (tid < 128) w2s[4096 + tid] = p.b_gla_a_fwd[l * 128 + tid];
  else w2s[4096 + tid] = p.b_gla_a_bwd[l * 128 + tid - 128];
  __syncthreads();
}
__device__ __forceinline__ void gla_load_alow(const P& p, int tok, int dir, float4 (&al)[4]) {
  const float* src = W_hbuf + (size_t)tok * 1984 + (dir ? 1456 : 1440);
#pragma unroll
  for (int q = 0; q < 4; q++) al[q] = *(const float4*)(src + q * 4);
}
__device__ __forceinline__ void gla_cum_regs(const char* smem, const float4 (&al)[4], int h, int dir, int w, int lane, float (&c)[8], float (&tot)[8]) {
  const float* w2 = (const float*)(smem + GLA_W2_OFF) + dir * 2048 + h * 32 + w * 8;
  const float* b2 = (const float*)(smem + GLA_W2_OFF) + 4096 + dir * 128 + h * 32 + w * 8;
  float a[16];
#pragma unroll
  for (int q = 0; q < 4; q++) { a[q * 4] = al[q].x; a[q * 4 + 1] = al[q].y; a[q * 4 + 2] = al[q].z; a[q * 4 + 3] = al[q].w; }
#pragma unroll
  for (int j = 0; j < 8; j++) {
    float z = b2[j];
#pragma unroll
    for (int r = 0; r < 16; r++) z += a[r] * w2[r * 128 + j];
    float la = logsigf(z) * (1.f / 16.f);
    float v = la;
#pragma unroll
    for (int d = 1; d < 64; d <<= 1) { float t_ = __shfl_up(v, d); if (lane >= d) v += t_; }
    float total = __shfl(v, 63);
    c[j] = dir ? (total - v + la) : v;
    tot[j] = total;
  }
}
__device__ __forceinline__ void gla_load_v(const P& p, int tok, int h, int w, float4 (&vr)[4]) {
  const float* src = W_hbuf + (size_t)tok * 1984 + 928 + h * 64 + w * 16;
#pragma unroll
  for (int q = 0; q < 4; q++) vr[q] = *(const float4*)(src + q * 4);
}
__device__ __forceinline__ void gla_store_vt(const float4 (&vr)[4], int w, int lane, bf16_t* sVt) {
#pragma unroll
  for (int q = 0; q < 4; q++) {
    sVt[(w * 16 + q * 4 + 0) * 72 + lane] = f2bf(vr[q].x);
    sVt[(w * 16 + q * 4 + 1) * 72 + lane] = f2bf(vr[q].y);
    sVt[(w * 16 + q * 4 + 2) * 72 + lane] = f2bf(vr[q].z);
    sVt[(w * 16 + q * 4 + 3) * 72 + lane] = f2bf(vr[q].w);
  }
}

__device__ __forceinline__ void chunk_info(int cidx, int& tb, int& nch, int& n, int& cbase) {
  if (cidx < 128) { int b = cidx >> 2; n = cidx & 3; nch = 4; tb = b * 256; cbase = b * 4; }
  else { int cl = cidx - 128, b = cl >> 5; n = cl & 31; nch = 32; tb = T_CTX + b * 2048; cbase = 128 + b * 32; }
}

__device__ __forceinline__ void gla_g1_item(const P& p, int l, int item, char* smem) {
  bf16_t* sKeT = (bf16_t*)smem;
  bf16_t* sVt = sKeT + 32 * 72;
  const int tid = tidx(), lane = tid & 63, w = __builtin_amdgcn_readfirstlane(tid >> 6), l15 = lane & 15, l4 = lane >> 4;
  int dir = item & 1, h = (item >> 1) & 3, cidx = item >> 3;
  int tb, nch, n, cbase;
  chunk_info(cidx, tb, nch, n, cbase);
  int c = dir ? nch - 1 - n : n;
  int tok = tb + c * 64 + lane;
  float4 al[4], vr[4];
  gla_load_alow(p, tok, dir, al);
  const float* kr = W_hbuf + (size_t)tok * 1984 + 800 + h * 32 + w * 8;
  float4 k0 = *(const float4*)kr, k1 = *(const float4*)(kr + 4);
  gla_load_v(p, tok, h, w, vr);
  float cs[8], tot[8];
  gla_cum_regs(smem, al, h, dir, w, lane, cs, tot);
  __syncthreads();
  {
    float kk[8] = {k0.x, k0.y, k0.z, k0.w, k1.x, k1.y, k1.z, k1.w};
#pragma unroll
    for (int j = 0; j < 8; j++) sKeT[(w * 8 + j) * 72 + lane] = f2bf(kk[j] * __expf(tot[j] - cs[j]));
  }
  gla_store_vt(vr, w, lane, sVt);
  __syncthreads();
  f32x4 acc[2] = {f32x4{0.f, 0.f, 0.f, 0.f}, f32x4{0.f, 0.f, 0.f, 0.f}};
#pragma unroll
  for (int ks = 0; ks < 2; ks++) {
    bf16x8 bv = *(const bf16x8*)(sVt + (w * 16 + l15) * 72 + ks * 32 + l4 * 8);
#pragma unroll
    for (int mt = 0; mt < 2; mt++) {
      bf16x8 av = *(const bf16x8*)(sKeT + (mt * 16 + l15) * 72 + ks * 32 + l4 * 8);
      acc[mt] = __builtin_amdgcn_mfma_f32_16x16x32_bf16(av, bv, acc[mt], 0, 0, 0);
    }
  }
  float* dst = W_un + (size_t)item * 2048;
#pragma unroll
  for (int mt = 0; mt < 2; mt++)
#pragma unroll
    for (int r = 0; r < 4; r++) dst[(mt * 16 + l4 * 4 + r) * 64 + w * 16 + l15] = acc[mt][r];
  if (lane == 0) {
#pragma unroll
    for (int j = 0; j < 8; j++) W_gn[item * 32 + w * 8 + j] = __expf(tot[j]);
  }
}

__device__ __forceinline__ void phase_gla_scan(const P& p, int l) {
  for (int it = blockIdx.x; it < 2176; it += gridDim.x) {
    int e = it * 256 + tidx();
    int kv = e & 2047, sd = e >> 11, dir = sd & 1, h = (sd >> 1) & 3, seq = ((sd >> 3) + 32) % 34;
    int nch, cbase;
    float s;
    if (seq < 32) { nch = 4; cbase = seq * 4; s = 0.f; }
    else { int b = seq - 32; nch = 32; cbase = 128 + b * 32; s = p.state_gla[((size_t)(((b * 2 + l) * 2 + dir) * 4 + h)) * 2048 + kv]; }
    for (int n0 = 0; n0 < nch; n0 += 4) {
      float gv[4], uv[4];
#pragma unroll
      for (int k = 0; k < 4; k++) {
        int item = ((cbase + n0 + k) * 4 + h) * 2 + dir;
        gv[k] = W_gn[item * 32 + (kv >> 6)];
        uv[k] = W_un[(size_t)item * 2048 + kv];
      }
#pragma unroll
      for (int k = 0; k < 4; k++) {
        int item = ((cbase + n0 + k) * 4 + h) * 2 + dir;
        W_sin_[(size_t)item * 2048 + kv] = s;
        s = gv[k] * s + uv[k];
      }
    }
    if (seq < 32) p.out[19398656 + ((size_t)(((seq * 2 + l) * 2 + dir) * 4 + h)) * 2048 + kv] = s;
  }
}

__device__ __forceinline__ void phase_gla_out(const P& p, int l, char* smem) {
  bf16_t* sQe = (bf16_t*)smem;
  bf16_t* sKe = sQe + 64 * 40;
  bf16_t* sSt = sKe + 64 * 40;
  bf16_t* sVt = sSt + 64 * 40;
  bf16_t* sAtt = sVt + 64 * 72;
  const int tid = tidx(), lane = tid & 63, w = __builtin_amdgcn_readfirstlane(tid >> 6), l15 = lane & 15, l4 = lane >> 4;
  gla_stage_w2(p, l, smem);
  for (int it = blockIdx.x; it < 768; it += gridDim.x) {
    int h = it & 3, cidx = it >> 2;
    int tb, nch, c, cbase;
    chunk_info(cidx, tb, nch, c, cbase);
    const int tok = tb + c * 64 + lane;
    f32x4 o[4];
#pragma unroll
    for (int j = 0; j < 4; j++) o[j] = f32x4{0.f, 0.f, 0.f, 0.f};
    float4 vr[4], alf[4], alb[4];
    gla_load_v(p, tok, h, w, vr);
    gla_load_alow(p, tok, 0, alf);
    gla_load_alow(p, tok, 1, alb);
    const float* qr = W_hbuf + (size_t)tok * 1984 + 672 + h * 32 + w * 8;
    const float* kr = qr + 128;
    const float4 q0 = *(const float4*)qr, q1 = *(const float4*)(qr + 4), k0 = *(const float4*)kr, k1 = *(const float4*)(kr + 4);
    float sinv[2][8];
#pragma unroll
    for (int dir = 0; dir < 2; dir++) {
      int n = dir ? nch - 1 - c : c;
      int item = ((cbase + n) * 4 + h) * 2 + dir;
      const float* sin = W_sin_ + (size_t)item * 2048 + (w * 8) * 64 + lane;
#pragma unroll
      for (int j = 0; j < 8; j++) sinv[dir][j] = sin[j * 64];
    }
    float gpre[4][4];
#pragma unroll
    for (int r = 0; r < 4; r++)
#pragma unroll
      for (int jn = 0; jn < 4; jn++) gpre[r][jn] = W_hbuf[(size_t)(tb + c * 64 + w * 16 + l4 * 4 + r) * 1984 + 1184 + h * 64 + jn * 16 + l15];
    __syncthreads();
    gla_store_vt(vr, w, lane, sVt);
#pragma unroll
    for (int dir = 0; dir < 2; dir++) {
      float cs[8], tot[8];
      gla_cum_regs(smem, dir ? alb : alf, h, dir, w, lane, cs, tot);
      if (dir) __syncthreads();
      {
        float qq[8] = {q0.x, q0.y, q0.z, q0.w, q1.x, q1.y, q1.z, q1.w};
        float kk[8] = {k0.x, k0.y, k0.z, k0.w, k1.x, k1.y, k1.z, k1.w};
        bf16x8 qv, kv, sv;
#pragma unroll
        for (int j = 0; j < 8; j++) {
          float cm = __shfl(cs[j], 32);
          qv[j] = (short)f2bf(qq[j] * 0.17677669529663687f * __expf(cs[j] - cm));
          kv[j] = (short)f2bf(kk[j] * __expf(cm - cs[j]));
          sv[j] = (short)f2bf(sinv[dir][j] * __expf(cm));
        }
        *(bf16x8*)(sQe + lane * 40 + w * 8) = qv;
        *(bf16x8*)(sKe + lane * 40 + w * 8) = kv;
        *(bf16x8*)(sSt + lane * 40 + w * 8) = sv;
      }
      __syncthreads();
      bf16x8 qa = *(const bf16x8*)(sQe + (w * 16 + l15) * 40 + l4 * 8);
#pragma unroll
      for (int jc = 0; jc < 4; jc++) {
        bf16x8 kb = *(const bf16x8*)(sKe + (jc * 16 + l15) * 40 + l4 * 8);
        f32x4 sacc = __builtin_amdgcn_mfma_f32_16x16x32_bf16(qa, kb, f32x4{0.f, 0.f, 0.f, 0.f}, 0, 0, 0);
#pragma unroll
        for (int r = 0; r < 4; r++) {
          int trow = w * 16 + l4 * 4 + r, scol = jc * 16 + l15;
          bool keep = dir ? (scol >= trow) : (scol <= trow);
          sAtt[trow * 72 + scol] = f2bf(keep ? sacc[r] : 0.f);
        }
      }
      __syncthreads();
#pragma unroll
      for (int ks = 0; ks < 2; ks++) {
        bf16x8 aa = *(const bf16x8*)(sAtt + (w * 16 + l15) * 72 + ks * 32 + l4 * 8);
#pragma unroll
        for (int jn = 0; jn < 4; jn++) {
          bf16x8 vb = *(const bf16x8*)(sVt + (jn * 16 + l15) * 72 + ks * 32 + l4 * 8);
          o[jn] = __builtin_amdgcn_mfma_f32_16x16x32_bf16(aa, vb, o[jn], 0, 0, 0);
        }
      }
#pragma unroll
      for (int jn = 0; jn < 4; jn++) {
        bf16x8 sb = *(const bf16x8*)(sSt + (jn * 16 + l15) * 40 + l4 * 8);
        o[jn] = __builtin_amdgcn_mfma_f32_16x16x32_bf16(qa, sb, o[jn], 0, 0, 0);
      }
    }
#pragma unroll
    for (int r = 0; r < 4; r++) {
      float ss = o[0][r] * o[0][r] + o[1][r] * o[1][r] + o[2][r] * o[2][r] + o[3][r] * o[3][r];
      ss += DPP_F(ss, ss, 0xB1, 0xf);
      ss += DPP_F(ss, ss, 0x4E, 0xf);
      ss += DPP_F(ss, ss, 0x141, 0xf);
      ss += DPP_F(ss, ss, 0x140, 0xf);
      float rs = rsqrtf(ss * (1.f / 64.f) + 1e-6f);
      int tk = tb + c * 64 + w * 16 + l4 * 4 + r;
      const float* grow = W_hbuf + (size_t)tk * 1984 + 1184 + h * 64;
      bf16_t* dst = W_br + (size_t)tk * 1024 + 512 + h * 64;
#pragma unroll
      for (int jn = 0; jn < 4; jn++) {
        int vcol = jn * 16 + l15;
        float val = o[jn][r] * rs * p.gla_norm[l * 64 + vcol];
        dst[vcol] = f2bf(val * siluf(gpre[r][jn]));
      }
    }
  }
}

__device__ __forceinline__ void phase_mixers(const P& p, int l, char* smem) {
  const int N_MLAL = 256, N_DFTL = 64, N_SWAL = 256, N_MLAC = 512, N_SWAC = 512, N_DFTC = 128, N_G1 = 1536;
  const int total = N_MLAL + N_DFTL + N_SWAL + N_MLAC + N_SWAC + N_DFTC + N_G1;
  gla_stage_w2(p, l, smem);
  for (int r_ = 0; r_ * (int)gridDim.x < total; r_++) {
    int it0 = r_ * gridDim.x + ((r_ & 1) ? (gridDim.x - 1 - blockIdx.x) : blockIdx.x);
    if (it0 >= total) continue;
    int it = it0;
    int type;
    bool lat = false;
    if (it < N_MLAL) { type = 0; lat = true; }
    else if ((it -= N_MLAL) < N_DFTL) { type = 2; lat = true; }
    else if ((it -= N_DFTL) < N_SWAL) { type = 1; lat = true; }
    else if ((it -= N_SWAL) < N_MLAC) { type = 0; }
    else if ((it -= N_MLAC) < N_SWAC) { type = 1; }
    else if ((it -= N_SWAC) < N_DFTC) { type = 2; }
    else { it -= N_DFTC; type = 3; }
#ifdef DUPTYPE
    for (int rep_ = 0; rep_ < ((type == (DUPTYPE & 3) && (int)lat == (DUPTYPE >> 2)) ? 2 : 1); rep_++)
#endif
    if (type == 0) {
      int qt, h, b, Sk;
      size_t tok0;
      if (lat) { qt = it & 31; h = (it >> 5) & 3; b = it >> 7; tok0 = T_CTX + b * 2048; Sk = 2560; }
      else { qt = it & 3; h = (it >> 2) & 3; b = it >> 4; tok0 = b * 256; Sk = 256; }
      const bf16_t* Kp = (lat ? W_Ka_lat : W_Ka_ctx) + (size_t)(b * 4 + h) * Sk * 96;
      const bf16_t* Vp = (lat ? W_Va_lat : W_Va_ctx) + (size_t)(b * 4 + h) * Sk * 64;
      attn_item<96>(W_Qa + tok0 * 384 + h * 96, 384, Kp, Vp, W_br + tok0 * 1024 + h * 64, qt * 64, Sk, 0, -1,
                    0.10206207261596575f, false, 0.f, smem);
    } else if (type == 1) {
      int qt, hq, b, Sk, nctx, W;
      size_t tok0;
      if (lat) { qt = it & 31; hq = (it >> 5) & 3; b = it >> 7; tok0 = T_CTX + b * 2048; Sk = 2560; nctx = 512; W = 128; }
      else { qt = it & 3; hq = (it >> 2) & 3; b = it >> 4; tok0 = b * 256; Sk = 256; nctx = 0; W = -1; }
      int kv = hq >> 1;
      const bf16_t* Kp = (lat ? W_Kd_lat : W_Kd_ctx) + (size_t)(b * 2 + kv) * Sk * 64;
      const bf16_t* Vp = (lat ? W_Vd_lat : W_Vd_ctx) + (size_t)(b * 2 + kv) * Sk * 64;
      attn_item<64>(W_Qd + tok0 * 256 + hq * 64, 256, Kp, Vp, W_br + tok0 * 1024 + 768 + hq * 64, qt * 64, Sk, nctx, W,
                    0.125f, true, p.swa_sink[l * 4 + hq], smem);
    } else if (type == 2) {
      int nt = it & 1, mt, b, S;
      size_t tok0;
      if (lat) { mt = (it >> 1) & 15; b = it >> 5; S = 2048; tok0 = T_CTX + b * 2048; }
      else { mt = (it >> 1) & 1; b = it >> 2; S = 256; tok0 = b * 256; }
      const bf16_t* Ap = (lat ? W_A2048 : W_A256) + (size_t)mt * 128 * 2 * S;
      const bf16_t* Bp = (lat ? W_Yt_lat : W_Yt_ctx) + (size_t)(b * 256 + nt * 128) * 2 * S;
      f32x4 acc[4][4];
      ZERO_ACC(acc);
      gemm_core(acc, Ap, 2 * S, Bp, 2 * S, 2 * S, smem);
      EPI_LOOP(acc, mt * 128, nt * 128, { W_br[(tok0 + m) * 1024 + 256 + n] = f2bf(v); });
    } else {
      gla_g1_item(p, l, it, smem);
    }
  }
}

#define EPI4_LOOP_N(acc, c0, t0, NJ, ...)                                                  \
  {                                                                                        \
    const int lane_ = tidx() & 63, w_ = tidx() >> 6, wm_ = w_ >> 1, wn_ = w_ & 1;           \
    _Pragma("unroll") for (int i_ = 0; i_ < 4; i_++)                                       \
    _Pragma("unroll") for (int j_ = 0; j_ < NJ; j_++) {                                    \
      const int col = (c0) + wm_ * 64 + i_ * 16 + (lane_ >> 4) * 4;                        \
      const int tok = (t0) + wn_ * (NJ * 16) + j_ * 16 + (lane_ & 15);                     \
      const f32x4 v4 = acc[i_][j_];                                                        \
      __VA_ARGS__                                                                          \
    }                                                                                      \
  }
__device__ __forceinline__ void phase_merge(const P& p, int l, char* smem) {
  for (int tile = blockIdx.x; tile < 192 * 8; tile += gridDim.x) {
    int tt = tile >> 3, nt = tile & 7, t0 = tt * 64, n0 = nt * 128;
    f32x4 tot[4][2];
    ZERO_ACC_N(tot, 2);
    for (int b = 0; b < 4; b++) {
      f32x4 acc[4][2];
      ZERO_ACC_N(acc, 2);
      gemm_core_t<2>(acc, W_Wt_br + ((size_t)(l * 4 + b) * 1024 + n0) * 256, 256, W_br + (size_t)t0 * 1024 + b * 256, 1024, 256, smem);
      EPI4_LOOP_N(acc, n0, t0, 2, {
        ushort4 g_ = *(const ushort4*)(W_gates + (size_t)tok * 4096 + b * 1024 + col);
        tot[i_][j_][0] += bf2f(g_.x) * v4[0]; tot[i_][j_][1] += bf2f(g_.y) * v4[1];
        tot[i_][j_][2] += bf2f(g_.z) * v4[2]; tot[i_][j_][3] += bf2f(g_.w) * v4[3];
      });
    }
    EPI4_LOOP_N(tot, n0, t0, 2, {
      ushort4 o_; o_.x = f2bf(v4[0]); o_.y = f2bf(v4[1]); o_.z = f2bf(v4[2]); o_.w = f2bf(v4[3]);
      *(ushort4*)(W_u + (size_t)tok * 1024 + col) = o_;
    });
  }
}

__device__ __forceinline__ void phase_wout(const P& p, int l, char* smem) {
  float* r = W_hbuf;
  const float alpha = 1.4142135623730951f;
  for (int tile = blockIdx.x; tile < 96 * 8; tile += gridDim.x) {
    int mt = tile >> 3, nt = tile & 7, m0 = mt * 128, n0 = nt * 128;
    f32x4 acc[4][4];
    ZERO_ACC(acc);
    gemm_core(acc, W_Wt_out + ((size_t)l * 1024 + n0) * 1024, 1024, W_u + (size_t)m0 * 1024, 1024, 1024, smem);
    const float* g1 = W_mada + (l * 3 + cond_row(m0)) * 6144 + 2048;
    {
      const int lane_ = tidx() & 63, w_ = tidx() >> 6, wm_ = w_ >> 1, wn_ = w_ & 1;
#pragma unroll
      for (int ih = 0; ih < 2; ih++) {
        float4 xv[8];
#pragma unroll
        for (int q = 0; q < 8; q++) {
          int i_ = ih * 2 + (q >> 2), j_ = q & 3;
          int col = n0 + wm_ * 64 + i_ * 16 + (lane_ >> 4) * 4, tok = m0 + wn_ * 64 + j_ * 16 + (lane_ & 15);
          xv[q] = *(const float4*)(x_in_row(p, l, tok) + col);
        }
#pragma unroll
        for (int q = 0; q < 8; q++) {
          int i_ = ih * 2 + (q >> 2), j_ = q & 3;
          int col = n0 + wm_ * 64 + i_ * 16 + (lane_ >> 4) * 4, tok = m0 + wn_ * 64 + j_ * 16 + (lane_ & 15);
          float4 gv = *(const float4*)(g1 + col);
          f32x4 v4 = acc[i_][j_];
          *(float4*)(r + (size_t)tok * 1024 + col) = float4{alpha * xv[q].x + gv.x * v4[0], alpha * xv[q].y + gv.y * v4[1], alpha * xv[q].z + gv.z * v4[2], alpha * xv[q].w + gv.w * v4[3]};
        }
      }
    }
  }
}

__device__ __forceinline__ void phase_ln_mid(const P& p, int l) {
  int lane = tidx() & 63, w = tidx() >> 6;
  const float* r = W_hbuf;
  for (int it = blockIdx.x; it < T_ALL / 4; it += gridDim.x) {
    int g = it * 4 + w;
    float v[16];
    load_row16(r + (size_t)g * 1024, lane, v);
    ln16(v);
    affine16(v, p.ln1_g + l * 1024, p.ln1_b + l * 1024, lane);
    store_row16(x_out_row(p, l, g), lane, v);
    ln16(v);
    const float* m = W_mada + (l * 3 + cond_row(g)) * 6144;
    modulate_store(v, m + 3072, m + 4096, W_u + (size_t)g * 1024, lane);
  }
}

__device__ __forceinline__ void phase_pq(const P& p, int l, char* smem) {
  float* sc = (float*)W_gates;
  bf16_t* sa = (bf16_t*)smem;
  const int tid = tidx(), lane = tid & 63, w = tid >> 6, wm = w >> 1, wn = w & 1, l15 = lane & 15, l4 = lane >> 4;
  for (int tile = blockIdx.x; tile < 96 * 16; tile += gridDim.x) {
    int mt = tile >> 4, hp = tile & 15, m0 = mt * 128, n0 = hp * 128;
    f32x4 acc[4][4];
    ZERO_ACC(acc);
    gemm_core(acc, W_Wt_pq + ((size_t)l * 2048 + n0) * 1024, 1024, W_u + (size_t)m0 * 1024, 1024, 1024, smem);
    __syncthreads();
    {
      bf16_t* sB = sa + 128 * GB_LD * (1 + wm);
#pragma unroll
      for (int i = 0; i < 4; i++)
#pragma unroll
        for (int j = 0; j < 4; j++) {
          ushort4 o_;
          o_.x = f2bf(acc[i][j][0]); o_.y = f2bf(acc[i][j][1]); o_.z = f2bf(acc[i][j][2]); o_.w = f2bf(acc[i][j][3]);
          *(ushort4*)(sB + (wn * 64 + j * 16 + l15) * GB_LD + i * 16 + l4 * 4) = o_;
        }
    }
    f32x4 acc2[4][4];
    ZERO_ACC(acc2);
    const bf16_t* keys = W_keysbf + (size_t)(l * 16 + hp) * 128 * 128;
#pragma unroll
    for (int kh = 0; kh < 2; kh++) {
      u32x4 rk[4];
#pragma unroll
      for (int i = 0; i < 4; i++) { int c = tid + i * 256, r = c >> 3, cc = (c & 7) * 8; rk[i] = *(const u32x4*)(keys + r * 128 + kh * 64 + cc); }
      if (kh) __syncthreads();
#pragma unroll
      for (int i = 0; i < 4; i++) { int c = tid + i * 256, r = c >> 3, cc = (c & 7) * 8; *(u32x4*)(sa + r * GB_LD + cc) = rk[i]; }
      __syncthreads();
      const bf16_t* sBk = sa + 128 * GB_LD * (1 + kh);
#pragma unroll
      for (int ks = 0; ks < 2; ks++) {
        bf16x8 af[4], bfr[4];
#pragma unroll
        for (int i = 0; i < 4; i++) af[i] = *(const bf16x8*)(sa + (wm * 64 + i * 16 + l15) * GB_LD + ks * 32 + l4 * 8);
#pragma unroll
        for (int j = 0; j < 4; j++) bfr[j] = *(const bf16x8*)(sBk + (wn * 64 + j * 16 + l15) * GB_LD + ks * 32 + l4 * 8);
#pragma unroll
        for (int i = 0; i < 4; i++)
#pragma unroll
          for (int j = 0; j < 4; j++) acc2[i][j] = __builtin_amdgcn_mfma_f32_16x16x32_bf16(af[i], bfr[j], acc2[i][j], 0, 0, 0);
      }
    }
    EPI_LOOP(acc2, 0, m0, { sc[((size_t)(hp * 128 + m)) * T_ALL + n] = v; });
  }
}

__device__ __forceinline__ void phase_scores(const P& p, int l, char* smem) {}

__device__ __forceinline__ int f2sort(float x) { int b = __float_as_int(x); return b ^ ((b >> 31) & 0x7fffffff); }
__device__ __forceinline__ float sort2f(int s) { return __int_as_float(s ^ ((s >> 31) & 0x7fffffff)); }
#define INS16(L, key) _Pragma("unroll") for (int i_ = 0; i_ < 16; i_++) { int hi_ = max(L[i_], key); key = min(L[i_], key); L[i_] = hi_; }
__device__ __forceinline__ void phase_topk(const P& p, int l) {
  const float* sc = (const float*)W_gates;
  int lane = tidx() & 63, w = tidx() >> 6;
  for (int it = blockIdx.x * 4 + w; it < 192 * 8; it += gridDim.x * 4) {
    int h = it & 7, t = (it >> 3) * 64 + lane;
    int L1[16], L2[16];
#pragma unroll
    for (int i = 0; i < 16; i++) { L1[i] = (int)0x80000000; L2[i] = (int)0x80000000; }
    const float* s1 = sc + (size_t)(h * 2) * 128 * T_ALL + t;
    const float* s2 = s1 + (size_t)128 * T_ALL;
    for (int k0 = 0; k0 < 128; k0 += 16) {
      float xv[16];
#pragma unroll
      for (int k = 0; k < 16; k++) xv[k] = s1[(size_t)(k0 + k) * T_ALL];
#pragma unroll
      for (int k = 0; k < 16; k++) { int key = (f2sort(xv[k]) & ~127) | (127 - (k0 + k)); INS16(L1, key); }
    }
    for (int k0 = 0; k0 < 128; k0 += 16) {
      float xv[16];
#pragma unroll
      for (int k = 0; k < 16; k++) xv[k] = s2[(size_t)(k0 + k) * T_ALL];
#pragma unroll
      for (int k = 0; k < 16; k++) { int key = (f2sort(xv[k]) & ~127) | (127 - (k0 + k)); INS16(L2, key); }
    }
    float v1[16], v2[16];
    unsigned P1[4] = {0u, 0u, 0u, 0u}, P2[4] = {0u, 0u, 0u, 0u};
#pragma unroll
    for (int i = 0; i < 16; i++) {
      v1[i] = sort2f(L1[i] & ~127);
      v2[i] = sort2f(L2[i] & ~127);
      P1[i >> 2] |= (unsigned)(127 - (L1[i] & 127)) << ((i & 3) * 8);
      P2[i >> 2] |= (unsigned)(127 - (L2[i] & 127)) << ((i & 3) * 8);
    }
    int Tk[16];
#pragma unroll
    for (int i = 0; i < 16; i++) Tk[i] = (int)0x80000000;
#pragma unroll
    for (int i = 0; i < 16; i++) {
#pragma unroll
      for (int j = 0; j < 16 / (i + 1); j++) {
        int key = (f2sort(v1[i] + v2[j]) & ~255) | (255 - (i * 16 + j));
        INS16(Tk, key);
      }
    }
    float v0 = sort2f(Tk[0] & ~255);
    float e[16], Z = 0.f;
    int oi[16];
#pragma unroll
    for (int s_ = 0; s_ < 16; s_++) {
      e[s_] = __expf(sort2f(Tk[s_] & ~255) - v0);
      Z += e[s_];
      int code = 255 - (Tk[s_] & 255), i = code >> 4, j = code & 15;
      unsigned r1 = (i >> 2) == 0 ? P1[0] : (i >> 2) == 1 ? P1[1] : (i >> 2) == 2 ? P1[2] : P1[3];
      unsigned r2 = (j >> 2) == 0 ? P2[0] : (j >> 2) == 1 ? P2[1] : (j >> 2) == 2 ? P2[2] : P2[3];
      int i1 = (r1 >> ((i & 3) * 8)) & 255, i2 = (r2 >> ((j & 3) * 8)) & 255;
      oi[s_] = i1 * 128 + i2;
    }
    float inv = 1.f / Z;
    int* po = W_pidx + (size_t)t * 128 + h * 16;
    float* pwo = W_pw + (size_t)t * 128 + h * 16;
#pragma unroll
    for (int q = 0; q < 4; q++) {
      *(int4*)(po + q * 4) = int4{oi[q * 4], oi[q * 4 + 1], oi[q * 4 + 2], oi[q * 4 + 3]};
      *(float4*)(pwo + q * 4) = float4{e[q * 4] * inv, e[q * 4 + 1] * inv, e[q * 4 + 2] * inv, e[q * 4 + 3] * inv};
    }
  }
}

__device__ __forceinline__ void unpack16(u32x4 r, float (&f)[16]) {
#pragma unroll
  for (int q = 0; q < 4; q++) {
    auto lo = __builtin_amdgcn_cvt_pk_f32_fp8((int)r[q], false);
    auto hi = __builtin_amdgcn_cvt_pk_f32_fp8((int)r[q], true);
    f[q * 4 + 0] = lo[0]; f[q * 4 + 1] = lo[1]; f[q * 4 + 2] = hi[0]; f[q * 4 + 3] = hi[1];
  }
}
#define PEER_PF 8
__device__ __forceinline__ void phase_peer(const P& p, int l, char* smem) {
  int lane = tidx() & 63, w = tidx() >> 6;
  float* scoef = (float*)smem + w * 128;
  const unsigned char* tu = W_tabU + (size_t)l * 16384 * 1024 + lane * 16;
  const unsigned char* tv = W_tabV + (size_t)l * 16384 * 1024 + lane * 16;
  for (int it = blockIdx.x; it < T_ALL / 4; it += gridDim.x) {
    int g = it * 4 + w;
    float uu[16];
    {
      u32x4 r0 = *(const u32x4*)(W_u + (size_t)g * 1024 + lane * 16);
      u32x4 r1 = *(const u32x4*)(W_u + (size_t)g * 1024 + lane * 16 + 8);
      uu[0] = __uint_as_float(r0.x << 16); uu[1] = __uint_as_float(r0.x & 0xffff0000u);
      uu[2] = __uint_as_float(r0.y << 16); uu[3] = __uint_as_float(r0.y & 0xffff0000u);
      uu[4] = __uint_as_float(r0.z << 16); uu[5] = __uint_as_float(r0.z & 0xffff0000u);
      uu[6] = __uint_as_float(r0.w << 16); uu[7] = __uint_as_float(r0.w & 0xffff0000u);
      uu[8] = __uint_as_float(r1.x << 16); uu[9] = __uint_as_float(r1.x & 0xffff0000u);
      uu[10] = __uint_as_float(r1.y << 16); uu[11] = __uint_as_float(r1.y & 0xffff0000u);
      uu[12] = __uint_as_float(r1.z << 16); uu[13] = __uint_as_float(r1.z & 0xffff0000u);
      uu[14] = __uint_as_float(r1.w << 16); uu[15] = __uint_as_float(r1.w & 0xffff0000u);
    }
    const int* pi = W_pidx + (size_t)g * 128;
    const float* pwt = W_pw + (size_t)g * 128;
#ifndef PEER_REP
#define PEER_REP 1
#endif
    float o[16];
    for (int rep_ = 0; rep_ < PEER_REP; rep_++) {
    float dv0 = 0.f, dv1 = 0.f;
    for (int e0 = 0; e0 < 128; e0 += PEER_PF) {
      u32x4 ra[PEER_PF];
#pragma unroll
      for (int k = 0; k < PEER_PF; k++) ra[k] = *(const u32x4*)(tu + (size_t)pi[e0 + k] * 1024);
#pragma unroll
      for (int k = 0; k < PEER_PF; k++) {
        float f[16];
        unpack16(ra[k], f);
        float a = 0.f;
#pragma unroll
        for (int j = 0; j < 16; j++) a += uu[j] * f[j];
        float dd = wsum(a);
        if (e0 < 64) dv0 = (lane == e0 + k) ? dd : dv0;
        else dv1 = (lane == e0 + k - 64) ? dd : dv1;
      }
    }
    {
      float d0 = dv0 * (1.f / PEER_U_SCALE), d1 = dv1 * (1.f / PEER_U_SCALE);
      float a0 = 0.5f * d0 * (1.f + erff(d0 * 0.7071067811865476f));
      float a1 = 0.5f * d1 * (1.f + erff(d1 * 0.7071067811865476f));
      scoef[lane] = pwt[lane] * a0 * (1.f / PEER_V_SCALE);
      scoef[64 + lane] = pwt[64 + lane] * a1 * (1.f / PEER_V_SCALE);
    }
    __builtin_amdgcn_s_waitcnt(0xc07f);
    __builtin_amdgcn_wave_barrier();
#pragma unroll
    for (int j = 0; j < 16; j++) o[j] = 0.f;
    for (int e0 = 0; e0 < 128; e0 += PEER_PF) {
      u32x4 ra[PEER_PF];
#pragma unroll
      for (int k = 0; k < PEER_PF; k++) ra[k] = *(const u32x4*)(tv + (size_t)pi[e0 + k] * 1024);
#pragma unroll
      for (int k = 0; k < PEER_PF; k++) {
        float cf = scoef[e0 + k];
        float f[16];
        unpack16(ra[k], f);
#pragma unroll
        for (int j = 0; j < 16; j++) o[j] += cf * f[j];
      }
    }
    __builtin_amdgcn_wave_barrier();
    }
    float* xr = x_out_row(p, l, g) + lane * 16;
    const float* m = W_mada + (l * 3 + cond_row(g)) * 6144 + lane * 16;
    float x1[16];
#pragma unroll
    for (int q = 0; q < 4; q++) {
      float4 xv = *(const float4*)(xr + q * 4);
      float4 g2 = *(const float4*)(m + 5120 + q * 4);
      x1[q * 4 + 0] = 1.4142135623730951f * xv.x + g2.x * o[q * 4 + 0];
      x1[q * 4 + 1] = 1.4142135623730951f * xv.y + g2.y * o[q * 4 + 1];
      x1[q * 4 + 2] = 1.4142135623730951f * xv.z + g2.z * o[q * 4 + 2];
      x1[q * 4 + 3] = 1.4142135623730951f * xv.w + g2.w * o[q * 4 + 3];
    }
    ln16(x1);
#pragma unroll
    for (int q = 0; q < 4; q++) {
      float4 a = *(const float4*)(p.ln2_g + l * 1024 + lane * 16 + q * 4);
      float4 c = *(const float4*)(p.ln2_b + l * 1024 + lane * 16 + q * 4);
      x1[q * 4 + 0] = x1[q * 4 + 0] * a.x + c.x; x1[q * 4 + 1] = x1[q * 4 + 1] * a.y + c.y;
      x1[q * 4 + 2] = x1[q * 4 + 2] * a.z + c.z; x1[q * 4 + 3] = x1[q * 4 + 3] * a.w + c.w;
      *(float4*)(xr + q * 4) = float4{x1[q * 4], x1[q * 4 + 1], x1[q * 4 + 2], x1[q * 4 + 3]};
    }
    if (l == 0) {
      ln16(x1);
      const float* m1 = W_mada + (1 * 3 + cond_row(g)) * 6144 + lane * 16;
#pragma unroll
      for (int q = 0; q < 4; q++) {
        float4 a = *(const float4*)(m1 + 1024 + q * 4);
        float4 b = *(const float4*)(m1 + q * 4);
        ushort4 ov;
        ov.x = f2bf(x1[q * 4 + 0] * (1.f + a.x) + b.x);
        ov.y = f2bf(x1[q * 4 + 1] * (1.f + a.y) + b.y);
        ov.z = f2bf(x1[q * 4 + 2] * (1.f + a.z) + b.z);
        ov.w = f2bf(x1[q * 4 + 3] * (1.f + a.w) + b.w);
        *(ushort4*)(W_u + (size_t)g * 1024 + lane * 16 + q * 4) = ov;
      }
    }
  }
}

#define N_PHASES 28
__device__ __forceinline__ void run_phase(const P& p, int ph, char* smem) {
#ifdef ONLYQ
  { int l = ph & 1; if (ONLYQ == -1) { phase_prep(p, smem); return; } if (ONLYQ == -2) { phase_ln0(p); return; }
    switch (ONLYQ) { case 0: phase_win(p, l, smem); break; case 1: phase_post(p, l); break; case 2: phase_small_gemms(p, l, smem); break; case 3: phase_mixers(p, l, smem); break; case 4: phase_gla_scan(p, l); break; case 5: phase_gla_out(p, l, smem); break; case 6: phase_merge(p, l, smem); break; case 7: phase_wout(p, l, smem); break; case 8: phase_ln_mid(p, l); break; case 9: phase_pq(p, l, smem); break; case 10: phase_scores(p, l, smem); break; case 11: phase_topk(p, l); break; case 12: phase_peer(p, l, smem); break; } return; }
#endif
  if (ph == 0) { phase_prep(p, smem); return; }
  if (ph == 1) { phase_ln0(p); return; }
  int l = (ph - 2) / 13, q = (ph - 2) % 13;
#ifdef EXCL
  if (q == EXCL) return;
#endif
  switch (q) {
    case 0: phase_win(p, l, smem); break;
    case 1: phase_post(p, l); break;
    case 2: phase_small_gemms(p, l, smem); break;
    case 3: phase_mixers(p, l, smem); break;
    case 4: phase_gla_scan(p, l); break;
    case 5: phase_gla_out(p, l, smem); break;
    case 6: phase_merge(p, l, smem); break;
    case 7: phase_wout(p, l, smem); break;
    case 8: phase_ln_mid(p, l); break;
    case 9: phase_pq(p, l, smem); break;
    case 10: phase_scores(p, l, smem); break;
    case 11: phase_topk(p, l); break;
    case 12: phase_peer(p, l, smem); break;
  }
}

#define XB_TMO      128
#define XB_XCNT(j)  (256  + 64 * (j))
#define XB_XSUB(j)  (1280 + 64 * (j))
#define XB_XGEN(j)  (2304 + 64 * (j))
#define XB_TOP      3328
#define XB_TOPGEN   3392
#define XCD_BAR_WORDS 3456
#define XB_SPIN_CAP (1u << 18)
#define LAS __attribute__((address_space(3)))

__device__ __forceinline__ unsigned xb_ld(unsigned* p)              { return __hip_atomic_load(p, __ATOMIC_RELAXED, __HIP_MEMORY_SCOPE_AGENT); }
__device__ __forceinline__ unsigned xb_add(unsigned* p, unsigned v) { return __hip_atomic_fetch_add(p, v, __ATOMIC_RELAXED, __HIP_MEMORY_SCOPE_AGENT); }
__device__ __forceinline__ unsigned xb_xcc_id() { return (unsigned)__builtin_amdgcn_s_getreg((3 << 11) | 20) & 0xFu; }
#define XB_SPIN(cond, bar) do { unsigned _sp = 0; while (cond) { __builtin_amdgcn_s_sleep(1); \
    if ((++_sp & 255u) == 0u) { if (xb_ld(&(bar)[XB_TMO])) break; if (_sp > XB_SPIN_CAP) { atomicAdd(&(bar)[XB_TMO], 1u); break; } } } } while (0)

struct XcdBarrier {
    unsigned* bar; unsigned x;
    volatile LAS unsigned* st;
};

__device__ __forceinline__ XcdBarrier xcd_barrier_post(unsigned* bar, volatile LAS unsigned* st) {
    XcdBarrier b; b.bar = bar; b.x = xb_xcc_id(); b.st = st;
    if (threadIdx.x == 0) (void)xb_add(&bar[XB_XCNT(b.x)], 1u);
    return b;
}
__device__ __forceinline__ void xcd_barrier_complete(unsigned* bar, unsigned x, unsigned& nloc, unsigned& nx) {
    const unsigned G = gridDim.x * gridDim.y * gridDim.z;
    unsigned sum, cnt, mine, sp = 0u;
    for (;;) {
        sum = 0u; cnt = 0u; mine = 0u;
#pragma unroll
        for (unsigned j = 0; j < 16; ++j) { const unsigned c = xb_ld(&bar[XB_XCNT(j)]); sum += c; cnt += (c > 0u) ? 1u : 0u; mine = (j == x) ? c : mine; }
        if (sum == G) break;
        __builtin_amdgcn_s_sleep(1);
        if ((++sp & 255u) == 0u) { if (xb_ld(&bar[XB_TMO])) break; if (sp > XB_SPIN_CAP) { atomicAdd(&bar[XB_TMO], 1u); break; } }
    }
    nloc = mine > 0u ? mine : 1u; nx = cnt > 0u ? cnt : 1u;
}

__device__ __forceinline__ void xcd_barrier(const XcdBarrier& b) {
    asm volatile("s_waitcnt vmcnt(0)" ::: "memory");
    __syncthreads();
    if (threadIdx.x == 0) {
        unsigned* bar = b.bar;
        __builtin_amdgcn_s_waitcnt(0);
        unsigned nloc = b.st[0], nx = b.st[1];
        if (nloc == 0u) { xcd_barrier_complete(bar, b.x, nloc, nx); b.st[0] = nloc; b.st[1] = nx; }
        const unsigned old = xb_add(&bar[XB_XSUB(b.x)], 1u);
        const unsigned gen = old / nloc;
        if (old + 1u == (gen + 1u) * nloc) {
            __builtin_amdgcn_fence(__ATOMIC_RELEASE, "agent");
            asm volatile("s_waitcnt vmcnt(0)" ::: "memory");
            const unsigned og = xb_add(&bar[XB_TOP], 1u);
            const unsigned tg = og / nx;
            if (og + 1u == (tg + 1u) * nx) xb_add(&bar[XB_TOPGEN], 1u);
            else XB_SPIN(xb_ld(&bar[XB_TOPGEN]) == tg, bar);
            __builtin_amdgcn_fence(__ATOMIC_ACQUIRE, "agent");
            xb_add(&bar[XB_XGEN(b.x)], 1u);
            asm volatile("s_waitcnt vmcnt(0)" ::: "memory");
        } else {
            XB_SPIN(xb_ld(&bar[XB_XGEN(b.x)]) == gen, bar);
            __builtin_amdgcn_fence(__ATOMIC_ACQUIRE, "agent");
            asm volatile("s_waitcnt vmcnt(0)" ::: "memory");
        }
    }
    __syncthreads();
}


#define SMEM_BYTES 61440

#if MULTI
__global__ void __launch_bounds__(256, 2) k_phase(P p, int ph) {
  __shared__ __attribute__((aligned(16))) char smem[SMEM_BYTES];
  run_phase(p, ph, smem);
}
#else
__global__ void __launch_bounds__(256, 2) k_mega(P p) {
  __shared__ __attribute__((aligned(16))) char smem[SMEM_BYTES];
  __shared__ uint4 xb_words;
  cg::grid_group grid = cg::this_grid();
  if (threadIdx.x == 0) xb_words = make_uint4(0u, 0u, 0u, 0u);
  __syncthreads();
  XcdBarrier xb = xcd_barrier_post((unsigned*)(p.ws + OFF_bar), (volatile LAS unsigned*)&xb_words);
#pragma nounroll
  for (int ph = 0; ph < N_PHASES; ph++) {
    if (ph >= 2 && (ph - 2) % 13 == 10) continue;
    run_phase(p, ph, smem);
#ifdef DUPMASK
    if (ph >= 2 && ((DUPMASK >> ((ph - 2) % 13)) & 1)) run_phase(p, ph, smem);
#endif
    if (ph + 1 < N_PHASES) {
      if (gridDim.y > 1) grid.sync();
      xcd_barrier(xb);
    }
  }
}
#endif

extern "C" void kernel_launch(void* const* d_in, const int* in_sizes, int n_in, void* d_out, int out_size, void* d_ws,
                              size_t ws_size, hipStream_t stream) {
  P p{};
  const float** fp = (const float**)&p;
  for (int i = 0; i < 32; i++) fp[i] = (const float*)d_in[i];
  p.out = (float*)d_out;
  p.ws = (char*)d_ws;
  size_t off = WS_TOTAL;
  if (off > ws_size) { fprintf(stderr, "ws too small: need %zu have %zu\n", off, ws_size); return; }
#if MULTI
  for (int ph = 0; ph < N_PHASES; ph++) hipLaunchKernelGGL(k_phase, dim3(512), dim3(256), 0, stream, p, ph);
#else
  static int grid_blocks = 0;
  if (!grid_blocks) {
    int dev = 0, cus = 0, per_cu = 0;
    hipGetDevice(&dev);
    hipDeviceGetAttribute(&cus, hipDeviceAttributeMultiprocessorCount, dev);
    hipOccupancyMaxActiveBlocksPerMultiprocessor(&per_cu, k_mega, 256, 0);
    if (per_cu > 2) per_cu = 2;
    grid_blocks = cus * per_cu;
  }
  hipMemsetAsync(p.ws + OFF_bar, 0, 16384, stream);
  void* args[] = {&p};
  hipError_t e = hipLaunchCooperativeKernel((void*)k_mega, dim3(grid_blocks), dim3(256), args, 0, stream);
  if (e != hipSuccess) fprintf(stderr, "cooperative launch failed: %s (grid %d)\n", hipGetErrorString(e), grid_blocks);
#endif
}
```

```cpp
#include <hip/hip_runtime.h>
#include <hip/hip_cooperative_groups.h>
#include <cstdio>
#include <cstdint>
namespace cg = cooperative_groups;

#ifndef MULTI
#define MULTI 0
#endif

typedef unsigned short bf16_t;
using bf16x8 = __attribute__((ext_vector_type(8))) short;
using f32x4 = __attribute__((ext_vector_type(4))) float;
using u32x4 = __attribute__((ext_vector_type(4))) unsigned int;

#define T_ALL 12288
#define T_CTX 8192
#define NEG_INF (-__builtin_inff())

__device__ __forceinline__ int tidx() {
  int t = threadIdx.x;
  asm volatile("" : "+v"(t));
  return t;
}
__device__ __forceinline__ bf16_t f2bf(float f) {
  unsigned u = __float_as_uint(f);
  u += 0x7fffu + ((u >> 16) & 1u);
  return (bf16_t)(u >> 16);
}
__device__ __forceinline__ float bf2f(bf16_t b) { return __uint_as_float(((unsigned)b) << 16); }
__device__ __forceinline__ float wsum_shfl(float v) {
#pragma unroll
  for (int o = 32; o; o >>= 1) v += __shfl_xor(v, o);
  return v;
}
#define DPP_F(old, src, ctrl, rm) __int_as_float(__builtin_amdgcn_update_dpp(__float_as_int(old), __float_as_int(src), ctrl, rm, 0xf, false))
__device__ __forceinline__ float wsum(float v) {
  v += DPP_F(v, v, 0xB1, 0xf);
  v += DPP_F(v, v, 0x4E, 0xf);
  v += DPP_F(v, v, 0x141, 0xf);
  v += DPP_F(v, v, 0x140, 0xf);
  v += DPP_F(0.f, v, 0x142, 0xa);
  v += DPP_F(0.f, v, 0x143, 0xc);
  return __int_as_float(__builtin_amdgcn_readlane(__float_as_int(v), 63));
}
__device__ __forceinline__ float wmax(float v) {
  v = fmaxf(v, DPP_F(v, v, 0xB1, 0xf));
  v = fmaxf(v, DPP_F(v, v, 0x4E, 0xf));
  v = fmaxf(v, DPP_F(v, v, 0x141, 0xf));
  v = fmaxf(v, DPP_F(v, v, 0x140, 0xf));
  v = fmaxf(v, DPP_F(v, v, 0x142, 0xa));
  v = fmaxf(v, DPP_F(v, v, 0x143, 0xc));
  return __int_as_float(__builtin_amdgcn_readlane(__float_as_int(v), 63));
}
__device__ __forceinline__ float siluf(float x) { return x * __builtin_amdgcn_rcpf(1.f + __expf(-x)); }
__device__ __forceinline__ float sigmf(float x) { return __builtin_amdgcn_rcpf(1.f + __expf(-x)); }
__device__ __forceinline__ float logsigf(float z) { return fminf(z, 0.f) - log1pf(__expf(-fabsf(z))); }
__device__ __forceinline__ int cond_row(int g) { return g < T_CTX ? 0 : 1 + ((g - T_CTX) >> 11); }

struct P {
  const float *x_prompt, *x_sample, *c, *cache_ckv, *cache_krope, *cache_swa_k, *cache_swa_v, *state_gla, *c_ctx,
      *w_ada, *b_ada, *w_in, *mla_q_norm, *w_uq, *mla_kv_norm, *w_ukv, *w_gla_a_fwd, *b_gla_a_fwd, *w_gla_a_bwd,
      *b_gla_a_bwd, *gla_norm, *swa_sink, *w_branch, *w_out, *ln1_g, *ln1_b, *ln2_g, *ln2_b, *w_peer_q, *peer_keys,
      *peer_u, *peer_v;
  float* out;
  char* ws;
};

constexpr size_t OFF_Wt_in = 0ull;
constexpr size_t OFF_Wt_uq = OFF_Wt_in + (((2ull * 6144 * 1024 * 2) + 255ull) & ~255ull);
constexpr size_t OFF_Wt_ukv = OFF_Wt_uq + (((2ull * 384 * 256 * 2) + 255ull) & ~255ull);
constexpr size_t OFF_Wt_br = OFF_Wt_ukv + (((2ull * 512 * 128 * 2) + 255ull) & ~255ull);
constexpr size_t OFF_Wt_out = OFF_Wt_br + (((8ull * 1024 * 256 * 2) + 255ull) & ~255ull);
constexpr size_t OFF_Wt_pq = OFF_Wt_out + (((2ull * 1024 * 1024 * 2) + 255ull) & ~255ull);
constexpr size_t OFF_keysbf = OFF_Wt_pq + (((2ull * 2048 * 1024 * 2) + 255ull) & ~255ull);
constexpr size_t OFF_Cch = OFF_keysbf + (((2ull * 16 * 128 * 128 * 2) + 255ull) & ~255ull);
constexpr size_t OFF_A256 = OFF_Cch + (((128ull * 64 * 2) + 255ull) & ~255ull);
constexpr size_t OFF_A2048 = OFF_A256 + (((256ull * 512 * 2) + 255ull) & ~255ull);
constexpr size_t OFF_mada = OFF_A2048 + (((2048ull * 4096 * 2) + 255ull) & ~255ull);
constexpr size_t OFF_xbuf = OFF_mada + (((2ull * 3 * 6144 * 4) + 255ull) & ~255ull);
constexpr size_t OFF_u = OFF_xbuf + 256ull;
constexpr size_t OFF_hbuf = OFF_u + (((12288ull * 1024 * 2) + 255ull) & ~255ull);
constexpr size_t OFF_gates = OFF_hbuf + (((12288ull * 1984 * 4) + 255ull) & ~255ull);
constexpr size_t OFF_qn = OFF_gates + (((12288ull * 4096 * 2) + 255ull) & ~255ull);
constexpr size_t OFF_ckv_all = OFF_qn + (((12288ull * 256 * 2) + 255ull) & ~255ull);
constexpr size_t OFF_Qa = OFF_ckv_all + (((13312ull * 128 * 2) + 255ull) & ~255ull);
constexpr size_t OFF_Ka_ctx = OFF_Qa + (((12288ull * 384 * 2) + 255ull) & ~255ull);
constexpr size_t OFF_Ka_lat = OFF_Ka_ctx + (((32ull * 4 * 256 * 96 * 2) + 255ull) & ~255ull);
constexpr size_t OFF_Va_ctx = OFF_Ka_lat + (((2ull * 4 * 2560 * 96 * 2) + 255ull) & ~255ull);
constexpr size_t OFF_Va_lat = OFF_Va_ctx + (((32ull * 4 * 256 * 64 * 2) + 255ull) & ~255ull);
constexpr size_t OFF_Qd = OFF_Va_lat + (((2ull * 4 * 2560 * 64 * 2) + 255ull) & ~255ull);
constexpr size_t OFF_Kd_ctx = OFF_Qd + (((12288ull * 256 * 2) + 255ull) & ~255ull);
constexpr size_t OFF_Kd_lat = OFF_Kd_ctx + (((32ull * 2 * 256 * 64 * 2) + 255ull) & ~255ull);
constexpr size_t OFF_Vd_ctx = OFF_Kd_lat + (((2ull * 2 * 2560 * 64 * 2) + 255ull) & ~255ull);
constexpr size_t OFF_Vd_lat = OFF_Vd_ctx + (((32ull * 2 * 256 * 64 * 2) + 255ull) & ~255ull);
constexpr size_t OFF_fnet = OFF_Vd_lat + (((2ull * 2 * 2560 * 64 * 2) + 255ull) & ~255ull);
constexpr size_t OFF_Yt_ctx = OFF_fnet + (((12288ull * 256 * 2) + 255ull) & ~255ull);
constexpr size_t OFF_Yt_lat = OFF_Yt_ctx + (((32ull * 256 * 512 * 2) + 255ull) & ~255ull);
constexpr size_t OFF_br = OFF_Yt_lat + (((2ull * 256 * 4096 * 2) + 255ull) & ~255ull);
constexpr size_t OFF_un = OFF_br + (((12288ull * 1024 * 2) + 255ull) & ~255ull);
constexpr size_t OFF_sin_ = OFF_un + (((1536ull * 2048 * 4) + 255ull) & ~255ull);
constexpr size_t OFF_gn = OFF_sin_ + (((1536ull * 2048 * 4) + 255ull) & ~255ull);
constexpr size_t OFF_pidx = OFF_gn + (((1536ull * 32 * 4) + 255ull) & ~255ull);
constexpr size_t OFF_pw = OFF_pidx + (((12288ull * 128 * 4) + 255ull) & ~255ull);
constexpr size_t OFF_bar = OFF_pw + (((12288ull * 128 * 4) + 255ull) & ~255ull);
constexpr size_t WS_TOTAL_OLD = OFF_pw + (((12288ull * 128 * 4) + 255ull) & ~255ull);
constexpr size_t OFF_tabU = OFF_bar + 16384ull;
constexpr size_t OFF_tabV = OFF_tabU + 2ull * 16384 * 1024;
constexpr size_t WS_TOTAL = OFF_tabV + 2ull * 16384 * 1024;
#define W_tabU ((unsigned char*)(p.ws + OFF_tabU))
#define W_tabV ((unsigned char*)(p.ws + OFF_tabV))
#define W_Wt_in ((bf16_t*)(p.ws + OFF_Wt_in))
#define W_Wt_uq ((bf16_t*)(p.ws + OFF_Wt_uq))
#define W_Wt_ukv ((bf16_t*)(p.ws + OFF_Wt_ukv))
#define W_Wt_br ((bf16_t*)(p.ws + OFF_Wt_br))
#define W_Wt_out ((bf16_t*)(p.ws + OFF_Wt_out))
#define W_Wt_pq ((bf16_t*)(p.ws + OFF_Wt_pq))
#define W_keysbf ((bf16_t*)(p.ws + OFF_keysbf))
#define W_Cch ((bf16_t*)(p.ws + OFF_Cch))
#define W_A256 ((bf16_t*)(p.ws + OFF_A256))
#define W_A2048 ((bf16_t*)(p.ws + OFF_A2048))
#define W_mada ((float*)(p.ws + OFF_mada))
#define W_xbuf ((float*)(p.ws + OFF_xbuf))
#define W_u ((bf16_t*)(p.ws + OFF_u))
#define W_hbuf ((float*)(p.ws + OFF_hbuf))
#define W_gates ((bf16_t*)(p.ws + OFF_gates))
#define W_qn ((bf16_t*)(p.ws + OFF_qn))
#define W_ckv_all ((bf16_t*)(p.ws + OFF_ckv_all))
#define W_Qa ((bf16_t*)(p.ws + OFF_Qa))
#define W_Ka_ctx ((bf16_t*)(p.ws + OFF_Ka_ctx))
#define W_Ka_lat ((bf16_t*)(p.ws + OFF_Ka_lat))
#define W_Va_ctx ((bf16_t*)(p.ws + OFF_Va_ctx))
#define W_Va_lat ((bf16_t*)(p.ws + OFF_Va_lat))
#define W_Qd ((bf16_t*)(p.ws + OFF_Qd))
#define W_Kd_ctx ((bf16_t*)(p.ws + OFF_Kd_ctx))
#define W_Kd_lat ((bf16_t*)(p.ws + OFF_Kd_lat))
#define W_Vd_ctx ((bf16_t*)(p.ws + OFF_Vd_ctx))
#define W_Vd_lat ((bf16_t*)(p.ws + OFF_Vd_lat))
#define W_fnet ((bf16_t*)(p.ws + OFF_fnet))
#define W_Yt_ctx ((bf16_t*)(p.ws + OFF_Yt_ctx))
#define W_Yt_lat ((bf16_t*)(p.ws + OFF_Yt_lat))
#define W_br ((bf16_t*)(p.ws + OFF_br))
#define W_un ((float*)(p.ws + OFF_un))
#define W_sin_ ((float*)(p.ws + OFF_sin_))
#define W_gn ((float*)(p.ws + OFF_gn))
#define W_pidx ((int*)(p.ws + OFF_pidx))
#define W_pw ((float*)(p.ws + OFF_pw))

#define GB_LD 72
#define G_LOAD(RA, RB, KOFF)                                                         \
  _Pragma("unroll") for (int i = 0; i < 4; i++) {                                    \
    int c = tid + i * 256, r = c >> 3, cc = (c & 7) * 8;                             \
    RA[i] = *(const u32x4*)(A + (size_t)r * lda + (KOFF) + cc);                      \
    if (i < NJ) RB[i] = *(const u32x4*)(B + (size_t)r * ldb + (KOFF) + cc);          \
  }
#define G_STORE(RA, RB)                                                              \
  _Pragma("unroll") for (int i = 0; i < 4; i++) {                                    \
    int c = tid + i * 256, r = c >> 3, cc = (c & 7) * 8;                             \
    *(u32x4*)(sa + r * GB_LD + cc) = RA[i];                                          \
    if (i < NJ) *(u32x4*)(sb + r * GB_LD + cc) = RB[i];                              \
  }
#define G_COMPUTE()                                                                  \
  _Pragma("unroll") for (int ks = 0; ks < 2; ks++) {                                 \
    bf16x8 af[4], bfr[NJ];                                                           \
    _Pragma("unroll") for (int i = 0; i < 4; i++)                                    \
      af[i] = *(const bf16x8*)(sa + (wm * 64 + i * 16 + l15) * GB_LD + ks * 32 + l4 * 8); \
    _Pragma("unroll") for (int j = 0; j < NJ; j++)                                   \
      bfr[j] = *(const bf16x8*)(sb + (wn * NJ * 16 + j * 16 + l15) * GB_LD + ks * 32 + l4 * 8); \
    _Pragma("unroll") for (int i = 0; i < 4; i++)                                    \
    _Pragma("unroll") for (int j = 0; j < NJ; j++)                                   \
      acc[i][j] = __builtin_amdgcn_mfma_f32_16x16x32_bf16(af[i], bfr[j], acc[i][j], 0, 0, 0); \
  }
template <int NJ>
__device__ __forceinline__ void gemm_core_t(f32x4 (&acc)[4][NJ], const bf16_t* __restrict__ A, int lda,
                                            const bf16_t* __restrict__ B, int ldb, int K, char* smem) {
  bf16_t* sa = (bf16_t*)smem;
  bf16_t* sb = sa + 128 * GB_LD;
  const int tid = tidx(), lane = tid & 63, w = tid >> 6, wm = w >> 1, wn = w & 1;
  const int l15 = lane & 15, l4 = lane >> 4;
  u32x4 ra0[4], rb0[NJ], ra1[4], rb1[NJ];
  G_LOAD(ra0, rb0, 0);
  if (K > 64) { G_LOAD(ra1, rb1, 64); }
  for (int k0 = 0; k0 < K; k0 += 128) {
    __syncthreads();
    G_STORE(ra0, rb0);
    __syncthreads();
    if (k0 + 128 < K) { G_LOAD(ra0, rb0, k0 + 128); }
    G_COMPUTE();
    if (k0 + 64 < K) {
      __syncthreads();
      G_STORE(ra1, rb1);
      __syncthreads();
      if (k0 + 192 < K) { G_LOAD(ra1, rb1, k0 + 192); }
      G_COMPUTE();
    }
  }
}
#define gemm_core gemm_core_t<4>
#define ZERO_ACC_N(acc, NJ)                                        \
  _Pragma("unroll") for (int i_ = 0; i_ < 4; i_++)                 \
  _Pragma("unroll") for (int j_ = 0; j_ < NJ; j_++) { acc[i_][j_] = f32x4{0.f, 0.f, 0.f, 0.f}; }
#define ZERO_ACC(acc) ZERO_ACC_N(acc, 4)
#define EPI_LOOP_N(acc, m0, n0, NJ, ...)                                                   \
  {                                                                                        \
    const int lane_ = tidx() & 63, w_ = tidx() >> 6, wm_ = w_ >> 1, wn_ = w_ & 1; \
    _Pragma("unroll") for (int i_ = 0; i_ < 4; i_++)                                       \
    _Pragma("unroll") for (int j_ = 0; j_ < NJ; j_++)                                      \
    _Pragma("unroll") for (int r_ = 0; r_ < 4; r_++) {                                     \
      const int m = (m0) + wm_ * 64 + i_ * 16 + (lane_ >> 4) * 4 + r_;                     \
      const int n = (n0) + wn_ * (NJ * 16) + j_ * 16 + (lane_ & 15);                       \
      float v = acc[i_][j_][r_];                                                           \
      __VA_ARGS__                                                                          \
    }                                                                                      \
  }
#define EPI_LOOP(acc, m0, n0, ...) EPI_LOOP_N(acc, m0, n0, 4, __VA_ARGS__)
#define EPI4_LOOP(acc, c0, t0, ...)                                                        \
  {                                                                                        \
    const int lane_ = tidx() & 63, w_ = tidx() >> 6, wm_ = w_ >> 1, wn_ = w_ & 1;           \
    _Pragma("unroll") for (int i_ = 0; i_ < 4; i_++)                                       \
    _Pragma("unroll") for (int j_ = 0; j_ < 4; j_++) {                                     \
      const int col = (c0) + wm_ * 64 + i_ * 16 + (lane_ >> 4) * 4;                        \
      const int tok = (t0) + wn_ * 64 + j_ * 16 + (lane_ & 15);                            \
      const f32x4 v4 = acc[i_][j_];                                                        \
      __VA_ARGS__                                                                          \
    }                                                                                      \
  }

__device__ __forceinline__ void transpose_tile(const float* __restrict__ src, int K, int N, bf16_t* __restrict__ dst, int tile, int ntn,
                               float* sm) {
  int kt = tile / ntn, nt = tile % ntn, k0 = kt * 64, n0 = nt * 64;
  int tx = tidx() & 63, ty = tidx() >> 6;
  __syncthreads();
  for (int i = 0; i < 16; i++) {
    int k = i * 4 + ty, n = n0 + tx;
    sm[k * 65 + tx] = (n < N) ? src[(size_t)(k0 + k) * N + n] : 0.f;
  }
  __syncthreads();
  for (int i = 0; i < 16; i++) {
    int n = i * 4 + ty;
    dst[(size_t)(n0 + n) * K + k0 + tx] = f2bf(sm[tx * 65 + n]);
  }
}

__device__ __forceinline__ void ada_item(const P& p, int item, float* sm) {
  int l = item / 24, cgp = item % 24;
  int lane = tidx() & 63, w = tidx() >> 6;
  const float* W = p.w_ada + (size_t)l * 1024 * 6144 + cgp * 256 + lane * 4;
  float4 a0 = {0, 0, 0, 0}, a1 = {0, 0, 0, 0}, a2 = {0, 0, 0, 0};
#pragma unroll 8
  for (int k = w * 256; k < (w + 1) * 256; k++) {
    float4 wv = *(const float4*)(W + (size_t)k * 6144);
    float c0 = siluf(p.c_ctx[k]), c1 = siluf(p.c[k]), c2 = siluf(p.c[1024 + k]);
    a0.x += c0 * wv.x; a0.y += c0 * wv.y; a0.z += c0 * wv.z; a0.w += c0 * wv.w;
    a1.x += c1 * wv.x; a1.y += c1 * wv.y; a1.z += c1 * wv.z; a1.w += c1 * wv.w;
    a2.x += c2 * wv.x; a2.y += c2 * wv.y; a2.z += c2 * wv.z; a2.w += c2 * wv.w;
  }
  __syncthreads();
  *(float4*)(sm + (w * 3 + 0) * 256 + lane * 4) = a0;
  *(float4*)(sm + (w * 3 + 1) * 256 + lane * 4) = a1;
  *(float4*)(sm + (w * 3 + 2) * 256 + lane * 4) = a2;
  __syncthreads();
  for (int o = tidx(); o < 768; o += 256) {
    int r = o >> 8, col = o & 255;
    float s = sm[(0 * 3 + r) * 256 + col] + sm[(1 * 3 + r) * 256 + col] + sm[(2 * 3 + r) * 256 + col] +
              sm[(3 * 3 + r) * 256 + col];
    W_mada[(l * 3 + r) * 6144 + cgp * 256 + col] = s + p.b_ada[l * 6144 + cgp * 256 + col];
  }
}

__device__ __forceinline__ void dft_seq_fill(bf16_t* dst, int S, int item) {
  float inv = rsqrtf((float)S);
  size_t base = (size_t)item * 2048;
  for (int e = 0; e < 8; e++) {
    size_t idx = base + e * 256 + tidx();
    int k = (int)(idx / (2 * S)), col = (int)(idx % (2 * S));
    int s = col < S ? col : col - S;
    int mm = (k * s) & (S - 1);
    float rev = (float)mm / (float)S;
    float v = col < S ? __builtin_amdgcn_cosf(rev) : -__builtin_amdgcn_sinf(rev);
    dst[idx] = f2bf(v * inv);
  }
}

#define PEER_U_SCALE 64.f
#define PEER_V_SCALE 16.f
__device__ __forceinline__ void tab_convert_item(const P& p, int item) {
  int l = item >> 12, isv = (item >> 11) & 1, sub = item & 2047;
  const float* src = (isv ? p.peer_v : p.peer_u) + (size_t)l * 16384 * 1024 + (size_t)sub * 8192;
  unsigned char* dst = (isv ? W_tabV : W_tabU) + (size_t)l * 16384 * 1024 + (size_t)sub * 8192;
  const float sc = isv ? PEER_V_SCALE : PEER_U_SCALE;
  int tid = tidx();
  float4 tt[8];
#pragma unroll
  for (int e = 0; e < 8; e++) tt[e] = *(const float4*)(src + (e * 256 + tid) * 4);
#pragma unroll
  for (int e = 0; e < 8; e++) {
    float4 t = tt[e];
    int pk = __builtin_amdgcn_cvt_pk_fp8_f32(t.x * sc, t.y * sc, 0, false);
    pk = __builtin_amdgcn_cvt_pk_fp8_f32(t.z * sc, t.w * sc, pk, true);
    *(int*)(dst + (e * 256 + tid) * 4) = pk;
  }
}

__device__ __forceinline__ void phase_prep(const P& p, char* smem) {
  float* sm = (float*)smem;
  const int nb = gridDim.x;
  const int J_ADA = 48;
  const int J_IN = 2 * 16 * 96;
  const int J_UQ = 2 * 4 * 6;
  const int J_UKV = 2 * 2 * 8;
  const int J_BR = 2 * 4 * 4 * 16;
  const int J_OUT = 2 * 16 * 16;
  const int J_PQ = 2 * 16 * 32;
  const int J_KEYS = 256;
  const int J_CCH = 4;
  const int J_A256 = 64;
  const int J_A2048 = 4096;
  const int J_TAB = 8192;
  const int total = J_ADA + J_IN + J_UQ + J_UKV + J_BR + J_OUT + J_PQ + J_KEYS + J_CCH + J_A256 + J_A2048 + J_TAB;
  for (int it0 = blockIdx.x; it0 < total; it0 += nb) {
    int it = it0;
    if (it < J_ADA) { ada_item(p, it, sm); continue; }
    it -= J_ADA;
    if (it < J_IN) { int l = it / 1536, t = it % 1536; transpose_tile(p.w_in + (size_t)l * 1024 * 6080, 1024, 6080, W_Wt_in + (size_t)l * 6144 * 1024, t, 96, sm); continue; }
    it -= J_IN;
    if (it < J_UQ) { int l = it / 24, t = it % 24; transpose_tile(p.w_uq + (size_t)l * 256 * 384, 256, 384, W_Wt_uq + (size_t)l * 384 * 256, t, 6, sm); continue; }
    it -= J_UQ;
    if (it < J_UKV) { int l = it / 16, t = it % 16; transpose_tile(p.w_ukv + (size_t)l * 128 * 512, 128, 512, W_Wt_ukv + (size_t)l * 512 * 128, t, 8, sm); continue; }
    it -= J_UKV;
    if (it < J_BR) { int lb = it / 64, t = it % 64; transpose_tile(p.w_branch + (size_t)lb * 256 * 1024, 256, 1024, W_Wt_br + (size_t)lb * 1024 * 256, t, 16, sm); continue; }
    it -= J_BR;
    if (it < J_OUT) { int l = it / 256, t = it % 256; transpose_tile(p.w_out + (size_t)l * 1024 * 1024, 1024, 1024, W_Wt_out + (size_t)l * 1024 * 1024, t, 16, sm); continue; }
    it -= J_OUT;
    if (it < J_PQ) { int l = it / 512, t = it % 512; transpose_tile(p.w_peer_q + (size_t)l * 1024 * 2048, 1024, 2048, W_Wt_pq + (size_t)l * 2048 * 1024, t, 32, sm); continue; }
    it -= J_PQ;
    if (it < J_KEYS) {
      size_t base = (size_t)it * 2048;
      float kv_[8];
#pragma unroll
      for (int e = 0; e < 8; e++) kv_[e] = p.peer_keys[base + e * 256 + tidx()];
#pragma unroll
      for (int e = 0; e < 8; e++) W_keysbf[base + e * 256 + tidx()] = f2bf(kv_[e]);
      continue;
    }
    it -= J_KEYS;
    if (it < J_CCH) {
      for (int e = 0; e < 8; e++) {
        int idx = it * 2048 + e * 256 + tidx();
        int n = idx >> 6, c = idx & 63;
        int j = n & 63;
        float rev = (float)((j * c) & 63) / 64.f;
        float v = n < 64 ? __builtin_amdgcn_cosf(rev) : __builtin_amdgcn_sinf(rev);
        W_Cch[idx] = f2bf(v * 0.125f);
      }
      continue;
    }
    it -= J_CCH;
    if (it < J_A256) { dft_seq_fill(W_A256, 256, it); continue; }
    it -= J_A256;
    if (it < J_A2048) { dft_seq_fill(W_A2048, 2048, it); continue; }
    it -= J_A2048;
    tab_convert_item(p, it);
  }
}

__device__ __forceinline__ void load_row16(const float* row, int lane, float (&v)[16]) {
#pragma unroll
  for (int q = 0; q < 4; q++) {
    float4 t = *(const float4*)(row + q * 256 + lane * 4);
    v[q * 4 + 0] = t.x; v[q * 4 + 1] = t.y; v[q * 4 + 2] = t.z; v[q * 4 + 3] = t.w;
  }
}
__device__ __forceinline__ void store_row16(float* row, int lane, const float (&v)[16]) {
#pragma unroll
  for (int q = 0; q < 4; q++) *(float4*)(row + q * 256 + lane * 4) = float4{v[q * 4], v[q * 4 + 1], v[q * 4 + 2], v[q * 4 + 3]};
}
__device__ __forceinline__ void ln16(float (&v)[16]) {
  float s = 0;
#pragma unroll
  for (int i = 0; i < 16; i++) s += v[i];
  s = wsum(s);
  float mu = s * (1.f / 1024.f);
  float q = 0;
#pragma unroll
  for (int i = 0; i < 16; i++) { v[i] -= mu; q += v[i] * v[i]; }
  q = wsum(q);
  float rs = rsqrtf(q * (1.f / 1024.f) + 1e-6f);
#pragma unroll
  for (int i = 0; i < 16; i++) v[i] *= rs;
}
__device__ __forceinline__ void modulate_store(const float (&v)[16], const float* sh, const float* sc, bf16_t* dst, int lane) {
#pragma unroll
  for (int q = 0; q < 4; q++) {
    float4 a = *(const float4*)(sc + q * 256 + lane * 4);
    float4 b = *(const float4*)(sh + q * 256 + lane * 4);
    ushort4 o;
    o.x = f2bf(v[q * 4 + 0] * (1.f + a.x) + b.x);
    o.y = f2bf(v[q * 4 + 1] * (1.f + a.y) + b.y);
    o.z = f2bf(v[q * 4 + 2] * (1.f + a.z) + b.z);
    o.w = f2bf(v[q * 4 + 3] * (1.f + a.w) + b.w);
    *(ushort4*)(dst + q * 256 + lane * 4) = o;
  }
}
__device__ __forceinline__ void affine16(float (&v)[16], const float* g, const float* b, int lane) {
#pragma unroll
  for (int q = 0; q < 4; q++) {
    float4 a = *(const float4*)(g + q * 256 + lane * 4);
    float4 c = *(const float4*)(b + q * 256 + lane * 4);
    v[q * 4 + 0] = v[q * 4 + 0] * a.x + c.x;
    v[q * 4 + 1] = v[q * 4 + 1] * a.y + c.y;
    v[q * 4 + 2] = v[q * 4 + 2] * a.z + c.z;
    v[q * 4 + 3] = v[q * 4 + 3] * a.w + c.w;
  }
}
__device__ __forceinline__ const float* x_in_row(const P& p, int l, int g) {
  if (l == 0) return g < T_CTX ? p.x_prompt + (size_t)g * 1024 : p.x_sample + (size_t)(g - T_CTX) * 1024;
  return p.out + (size_t)g * 1024;
}
__device__ __forceinline__ float* x_out_row(const P& p, int l, int g) {
  return p.out + (size_t)g * 1024;
}

__device__ __forceinline__ void phase_ln0(const P& p) {
  int lane = tidx() & 63, w = tidx() >> 6;
  for (int it = blockIdx.x; it < T_ALL / 4; it += gridDim.x) {
    int g = it * 4 + w;
    float v[16];
    load_row16(x_in_row(p, 0, g), lane, v);
    ln16(v);
    const float* m = W_mada + (0 * 3 + cond_row(g)) * 6144;
    modulate_store(v, m, m + 1024, W_u + (size_t)g * 1024, lane);
  }
}

__device__ __forceinline__ void phase_win(const P& p, int l, char* smem) {
  const bf16_t* Wt = W_Wt_in + (size_t)l * 6144 * 1024;
  for (int tile = blockIdx.x; tile < 96 * 48; tile += gridDim.x) {
    int mt = tile / 48, nt = tile % 48, m0 = mt * 128, n0 = nt * 128;
    f32x4 acc[4][4];
    ZERO_ACC(acc);
    gemm_core(acc, Wt + (size_t)n0 * 1024, 1024, W_u + (size_t)m0 * 1024, 1024, 1024, smem);
    EPI4_LOOP(acc, n0, m0, {
      if (col < 1984) *(float4*)(W_hbuf + (size_t)tok * 1984 + col) = float4{v4[0], v4[1], v4[2], v4[3]};
      else if (col < 6080) {
        ushort4 o_; o_.x = f2bf(sigmf(v4[0])); o_.y = f2bf(sigmf(v4[1])); o_.z = f2bf(sigmf(v4[2])); o_.w = f2bf(sigmf(v4[3]));
        *(ushort4*)(W_gates + (size_t)tok * 4096 + (col - 1984)) = o_;
      }
    });
  }
}

__device__ __forceinline__ void rope_cs(float pos, int i, float inv_hp, float& cs, float& sn) {
  float freq = exp2f(-(float)i * inv_hp * 13.287712379549449f);
  float a = pos * freq;
  sn = __sinf(a);
  cs = __cosf(a);
}

__device__ __forceinline__ void phase_post(const P& p, int l) {
  int lane = tidx() & 63, w = tidx() >> 6;
  for (int it = blockIdx.x; it < 13312 / 4; it += gridDim.x) {
    int g = it * 4 + w;
    if (g < T_ALL) {
      const bool lat = g >= T_CTX;
      int b, s;
      if (!lat) { b = g >> 8; s = g & 255; } else { b = (g - T_CTX) >> 11; s = (g - T_CTX) & 2047; }
      const float* h = W_hbuf + (size_t)g * 1984;
      const float prow = (float)(s >> 6), pcol = (float)(s & 63);
      const float4 pl_q = *(const float4*)(h + lane * 4);
      const float2 pl_c = *(const float2*)(h + 256 + lane * 2);
      const float pl_kr1 = h[384 + ((lane >> 3) & 1) * 16 + (lane & 7)], pl_kr2 = h[384 + ((lane >> 3) & 1) * 16 + 8 + (lane & 7)];
      const float4 pl_f = *(const float4*)(h + 416 + lane * 4);
      float pl_sq1[2], pl_sq2[2];
#pragma unroll
      for (int jj = 0; jj < 2; jj++) {
        int pi = lane + 64 * jj, hq = pi >> 5, pp = (pi >> 4) & 1, i = pi & 15;
        pl_sq1[jj] = h[1472 + hq * 64 + pp * 32 + i]; pl_sq2[jj] = h[1472 + hq * 64 + pp * 32 + 16 + i];
      }
      const float pl_sk1 = h[1728 + (lane >> 5) * 64 + ((lane >> 4) & 1) * 32 + (lane & 15)];
      const float pl_sk2 = h[1728 + (lane >> 5) * 64 + ((lane >> 4) & 1) * 32 + 16 + (lane & 15)];
      const float2 pl_v = *(const float2*)(h + 1856 + lane * 2);
      {
        float4 t = pl_q;
        float ss = wsum(t.x * t.x + t.y * t.y + t.z * t.z + t.w * t.w);
        float rs = rsqrtf(ss * (1.f / 256.f) + 1e-6f);
        float4 gq = *(const float4*)(p.mla_q_norm + l * 256 + lane * 4);
        ushort4 o;
        o.x = f2bf(t.x * rs * gq.x); o.y = f2bf(t.y * rs * gq.y); o.z = f2bf(t.z * rs * gq.z); o.w = f2bf(t.w * rs * gq.w);
        *(ushort4*)(W_qn + (size_t)g * 256 + lane * 4) = o;
      }
      {
        float2 t = pl_c;
        float ss = wsum(t.x * t.x + t.y * t.y);
        float rs = rsqrtf(ss * (1.f / 128.f) + 1e-6f);
        float2 gk = *(const float2*)(p.mla_kv_norm + l * 128 + lane * 2);
        float v0 = t.x * rs * gk.x, v1 = t.y * rs * gk.y;
        ushort2 o; o.x = f2bf(v0); o.y = f2bf(v1);
        *(ushort2*)(W_ckv_all + (size_t)g * 128 + lane * 2) = o;
        if (!lat) *(float2*)(p.out + 12582912 + ((size_t)((b * 2 + l) * 256 + s)) * 128 + lane * 2) = float2{v0, v1};
      }
      if (lane < 16) {
        int pp = lane >> 3, i = lane & 7;
        float x1 = pl_kr1, x2 = pl_kr2;
        float o1 = x1, o2 = x2;
        if (lat) {
          float cs, sn;
          rope_cs(pp ? pcol : prow, i, 0.125f, cs, sn);
          o1 = x1 * cs - x2 * sn; o2 = x2 * cs + x1 * sn;
        } else {
          float* ok = p.out + 14680064 + ((size_t)((b * 2 + l) * 256 + s)) * 32 + pp * 16 + i;
          ok[0] = o1; ok[8] = o2;
        }
        bf16_t b1 = f2bf(o1), b2 = f2bf(o2);
        for (int hh = 0; hh < 4; hh++) {
          bf16_t* kd = lat ? W_Ka_lat + ((size_t)((b * 4 + hh) * 2560 + 512 + s)) * 96 : W_Ka_ctx + ((size_t)((b * 4 + hh) * 256 + s)) * 96;
          kd[64 + pp * 16 + i] = b1; kd[64 + pp * 16 + 8 + i] = b2;
        }
      }
      {
        float4 t = pl_f;
        ushort4 o; o.x = f2bf(t.x); o.y = f2bf(t.y); o.z = f2bf(t.z); o.w = f2bf(t.w);
        *(ushort4*)(W_fnet + (size_t)g * 256 + lane * 4) = o;
      }
#pragma unroll
      for (int jj = 0; jj < 2; jj++) {
        int pi = lane + 64 * jj, hq = pi >> 5, pp = (pi >> 4) & 1, i = pi & 15;
        float x1 = pl_sq1[jj], x2 = pl_sq2[jj];
        float o1 = x1, o2 = x2;
        if (lat) {
          float cs, sn;
          rope_cs(pp ? pcol : prow, i, 0.0625f, cs, sn);
          o1 = x1 * cs - x2 * sn; o2 = x2 * cs + x1 * sn;
        }
        bf16_t* qd = W_Qd + (size_t)g * 256 + hq * 64 + pp * 32 + i;
        qd[0] = f2bf(o1); qd[16] = f2bf(o2);
      }
      {
        int kv = lane >> 5, pp = (lane >> 4) & 1, i = lane & 15;
        float x1 = pl_sk1, x2 = pl_sk2;
        float o1 = x1, o2 = x2;
        bf16_t* kd;
        if (lat) {
          float cs, sn;
          rope_cs(pp ? pcol : prow, i, 0.0625f, cs, sn);
          o1 = x1 * cs - x2 * sn; o2 = x2 * cs + x1 * sn;
          kd = W_Kd_lat + ((size_t)((b * 2 + kv) * 2560 + 512 + s)) * 64;
        } else {
          float* ok = p.out + 15204352 + ((size_t)(((b * 2 + l) * 2 + kv) * 256 + s)) * 64 + pp * 32 + i;
          ok[0] = o1; ok[16] = o2;
          kd = W_Kd_ctx + ((size_t)((b * 2 + kv) * 256 + s)) * 64;
        }
        kd[pp * 32 + i] = f2bf(o1); kd[pp * 32 + 16 + i] = f2bf(o2);
      }
      {
        int e = lane * 2, kv = e >> 6, d = e & 63;
        float2 t = pl_v;
        if (lat) {
          bf16_t* vt = W_Vd_lat + (size_t)(b * 2 + kv) * 64 * 2560 + 512 + s;
          vt[(size_t)d * 2560] = f2bf(t.x); vt[(size_t)(d + 1) * 2560] = f2bf(t.y);
        } else {
          *(float2*)(p.out + 17301504 + ((size_t)(((b * 2 + l) * 2 + kv) * 256 + s)) * 64 + d) = t;
          bf16_t* vt = W_Vd_ctx + (size_t)(b * 2 + kv) * 64 * 256 + s;
          vt[d * 256] = f2bf(t.x); vt[(d + 1) * 256] = f2bf(t.y);
        }
      }
    } else {
      int gc = g - T_ALL, b = gc >> 9, pp = gc & 511;
      {
        float2 t = *(const float2*)(p.cache_ckv + ((size_t)((b * 2 + l) * 512 + pp)) * 128 + lane * 2);
        ushort2 o; o.x = f2bf(t.x); o.y = f2bf(t.y);
        *(ushort2*)(W_ckv_all + (size_t)g * 128 + lane * 2) = o;
      }
      if (lane < 32) {
        bf16_t v = f2bf(p.cache_krope[((size_t)((b * 2 + l) * 512 + pp)) * 32 + lane]);
        for (int hh = 0; hh < 4; hh++) W_Ka_lat[((size_t)((b * 4 + hh) * 2560 + pp)) * 96 + 64 + lane] = v;
      }
      {
        int e = lane * 2, kv = e >> 6, d = e & 63;
        size_t src = ((size_t)(((b * 2 + l) * 2 + kv) * 512 + pp)) * 64 + d;
        float2 tk = *(const float2*)(p.cache_swa_k + src);
        float2 tv = *(const float2*)(p.cache_swa_v + src);
        size_t dst = ((size_t)((b * 2 + kv) * 2560 + pp)) * 64 + d;
        ushort2 ok; ok.x = f2bf(tk.x); ok.y = f2bf(tk.y);
        *(ushort2*)(W_Kd_lat + dst) = ok;
        bf16_t* vt = W_Vd_lat + (size_t)(b * 2 + kv) * 64 * 2560 + pp;
        vt[(size_t)d * 2560] = f2bf(tv.x); vt[(size_t)(d + 1) * 2560] = f2bf(tv.y);
      }
    }
  }
}

__device__ __forceinline__ void phase_small_gemms(const P& p, int l, char* smem) {
  const int NA = 96 * 3, NB = 104 * 4, NC = 384;
  for (int it0 = blockIdx.x; it0 < NA + NB + NC; it0 += gridDim.x) {
    int it = it0;
    f32x4 acc[4][4];
    ZERO_ACC(acc);
    if (it < NA) {
      int mt = it / 3, nt = it % 3, m0 = mt * 128, n0 = nt * 128;
      gemm_core(acc, W_qn + (size_t)m0 * 256, 256, W_Wt_uq + (size_t)l * 384 * 256 + (size_t)n0 * 256, 256, 256, smem);
      const bool lat = m0 >= T_CTX;
      EPI_LOOP(acc, m0, n0, {
        int c96 = n % 96;
        if (lat && c96 >= 64) {
          float pv = DPP_F(v, v, 0x128, 0xf);
          int cr = c96 - 64, pp = cr >> 4, ii = cr & 15, i = ii & 7;
          int s = (m - T_CTX) & 2047;
          float cs, sn;
          rope_cs(pp ? (float)(s & 63) : (float)(s >> 6), i, 0.125f, cs, sn);
          v = (ii < 8) ? v * cs - pv * sn : v * cs + pv * sn;
        }
        W_Qa[(size_t)m * 384 + n] = f2bf(v);
      });
      continue;
    }
    it -= NA;
    if (it < NB) {
      int mt = it / 4, nt = it % 4, m0 = mt * 128, n0 = nt * 128;
      gemm_core(acc, W_ckv_all + (size_t)m0 * 128, 128, W_Wt_ukv + (size_t)l * 512 * 128 + (size_t)n0 * 128, 128, 128, smem);
      EPI_LOOP(acc, m0, n0, {
        int hh = n >> 7, c = n & 127;
        bf16_t* kd; bf16_t* vd; int vstride;
        if (m < T_CTX) {
          int b = m >> 8, s = m & 255;
          size_t r = (size_t)((b * 4 + hh) * 256 + s);
          kd = W_Ka_ctx + r * 96; vd = W_Va_ctx + (size_t)(b * 4 + hh) * 64 * 256 + s; vstride = 256;
        } else {
          int b, pos;
          if (m < T_ALL) { b = (m - T_CTX) >> 11; pos = 512 + ((m - T_CTX) & 2047); }
          else { b = (m - T_ALL) >> 9; pos = (m - T_ALL) & 511; }
          size_t r = (size_t)((b * 4 + hh) * 2560 + pos);
          kd = W_Ka_lat + r * 96; vd = W_Va_lat + (size_t)(b * 4 + hh) * 64 * 2560 + pos; vstride = 2560;
        }
        if (c < 64) kd[c] = f2bf(v); else vd[(size_t)(c - 64) * vstride] = f2bf(v);
      });
      continue;
    }
    it -= NB;
    {
      int m0 = it * 128;
      gemm_core(acc, W_fnet + (size_t)m0 * 64, 64, W_Cch, 64, 64, smem);
      EPI_LOOP(acc, m0, 0, {
        int g = m >> 2, grp = m & 3, part = n >> 6, j = n & 63;
        if (g < T_CTX) {
          int b = g >> 8, s = g & 255;
          W_Yt_ctx[((size_t)(b * 256 + grp * 64 + j)) * 512 + part * 256 + s] = f2bf(v);
        } else {
          int b = (g - T_CTX) >> 11, s = (g - T_CTX) & 2047;
          W_Yt_lat[((size_t)(b * 256 + grp * 64 + j)) * 4096 + part * 2048 + s] = f2bf(v);
        }
      });
    }
  }
}

template <int DK>
__device__ __forceinline__ void attn_item(const bf16_t* __restrict__ Qp, int qstride, const bf16_t* __restrict__ Kp,
                          const bf16_t* __restrict__ Vp, bf16_t* __restrict__ Op, int q0, int Sk, int n_ctx, int W,
                          float scale, bool has_sink, float sink, char* smem) {
  constexpr int KLD = DK + 8;
  bf16_t* sK = (bf16_t*)smem;
  bf16_t* sVt = sK + 64 * KLD;
  bf16_t* sP = sVt + 64 * 72;
  const int tid = tidx(), lane = tid & 63, w = tid >> 6, l15 = lane & 15, l4 = lane >> 4;
  bf16_t* sPw = sP + w * 16 * 72;
  bf16x8 qf[DK / 32];
  {
    const bf16_t* qrow = Qp + (size_t)(q0 + w * 16 + l15) * qstride;
#pragma unroll
    for (int ks = 0; ks < DK / 32; ks++) qf[ks] = *(const bf16x8*)(qrow + ks * 32 + l4 * 8);
  }
  f32x4 o[4];
#pragma unroll
  for (int j = 0; j < 4; j++) o[j] = f32x4{0.f, 0.f, 0.f, 0.f};
  float mrow[4], lrow[4];
#pragma unroll
  for (int r = 0; r < 4; r++) { mrow[r] = NEG_INF; lrow[r] = 0.f; }
  const int ntile = Sk >> 6;
  auto tile_ok = [&](int kt) -> bool {
    int kb = kt * 64;
    if (W >= 0 && kb >= n_ctx) { int lp = kb - n_ctx; if (lp + 63 < q0 - W || lp > q0 + 63 + W) return false; }
    return true;
  };
  u32x4 rk[DK / 32], rv[2];
  int kt = 0;
  while (kt < ntile && !tile_ok(kt)) kt++;
  if (kt < ntile) {
#pragma unroll
    for (int i = 0; i < DK / 32; i++) { int c = tid + i * 256, r = c / (DK / 8), cc = (c % (DK / 8)) * 8; rk[i] = *(const u32x4*)(Kp + (size_t)(kt * 64 + r) * DK + cc); }
#pragma unroll
    for (int i = 0; i < 2; i++) { int c = tid + i * 256, dv = c >> 3, k0 = (c & 7) * 8; rv[i] = *(const u32x4*)(Vp + (size_t)dv * Sk + kt * 64 + k0); }
  }
  while (kt < ntile) {
    const int kbase = kt * 64;
    __syncthreads();
#pragma unroll
    for (int i = 0; i < DK / 32; i++) { int c = tid + i * 256, r = c / (DK / 8), cc = (c % (DK / 8)) * 8; *(u32x4*)(sK + r * KLD + cc) = rk[i]; }
#pragma unroll
    for (int i = 0; i < 2; i++) {
      int c = tid + i * 256, dv = c >> 3, k0 = (c & 7) * 8;
      *(u32x4*)(sVt + dv * 72 + k0) = rv[i];
    }
    __syncthreads();
    int ktn = kt + 1;
    while (ktn < ntile && !tile_ok(ktn)) ktn++;
    if (ktn < ntile) {
#pragma unroll
      for (int i = 0; i < DK / 32; i++) { int c = tid + i * 256, r = c / (DK / 8), cc = (c % (DK / 8)) * 8; rk[i] = *(const u32x4*)(Kp + (size_t)(ktn * 64 + r) * DK + cc); }
#pragma unroll
      for (int i = 0; i < 2; i++) { int c = tid + i * 256, dv = c >> 3, k0 = (c & 7) * 8; rv[i] = *(const u32x4*)(Vp + (size_t)dv * Sk + ktn * 64 + k0); }
    }
    kt = ktn;
    f32x4 s[4];
#pragma unroll
    for (int j = 0; j < 4; j++) {
      s[j] = f32x4{0.f, 0.f, 0.f, 0.f};
#pragma unroll
      for (int ks = 0; ks < DK / 32; ks++) {
        bf16x8 kf = *(const bf16x8*)(sK + (j * 16 + l15) * KLD + ks * 32 + l4 * 8);
        s[j] = __builtin_amdgcn_mfma_f32_16x16x32_bf16(qf[ks], kf, s[j], 0, 0, 0);
      }
    }
#pragma unroll
    for (int j = 0; j < 4; j++)
#pragma unroll
      for (int r = 0; r < 4; r++) {
        float v = s[j][r] * scale;
        if (W >= 0) {
          int kk = kbase + j * 16 + l15, t = q0 + w * 16 + l4 * 4 + r;
          int dlt = kk - n_ctx - t;
          bool valid = (kk < n_ctx) || (dlt <= W && dlt >= -W);
          if (!valid) v = NEG_INF;
        }
        s[j][r] = v;
      }
#pragma unroll
    for (int r = 0; r < 4; r++) {
      float mx = fmaxf(fmaxf(s[0][r], s[1][r]), fmaxf(s[2][r], s[3][r]));
      mx = fmaxf(mx, DPP_F(mx, mx, 0xB1, 0xf));
      mx = fmaxf(mx, DPP_F(mx, mx, 0x4E, 0xf));
      mx = fmaxf(mx, DPP_F(mx, mx, 0x141, 0xf));
      mx = fmaxf(mx, DPP_F(mx, mx, 0x140, 0xf));
      float mnew = fmaxf(mrow[r], mx);
      float muse = (mnew == NEG_INF) ? 0.f : mnew;
      float alpha = __expf(mrow[r] - muse);
      float rs = 0.f;
#pragma unroll
      for (int j = 0; j < 4; j++) { float pe = __expf(s[j][r] - muse); s[j][r] = pe; rs += pe; }
      rs += DPP_F(rs, rs, 0xB1, 0xf);
      rs += DPP_F(rs, rs, 0x4E, 0xf);
      rs += DPP_F(rs, rs, 0x141, 0xf);
      rs += DPP_F(rs, rs, 0x140, 0xf);
      lrow[r] = lrow[r] * alpha + rs;
      mrow[r] = mnew;
#pragma unroll
      for (int j = 0; j < 4; j++) o[j][r] *= alpha;
    }
#pragma unroll
    for (int j = 0; j < 4; j++)
#pragma unroll
      for (int r = 0; r < 4; r++) sPw[(l4 * 4 + r) * 72 + j * 16 + l15] = f2bf(s[j][r]);
    __builtin_amdgcn_s_waitcnt(0xc07f);
    __builtin_amdgcn_wave_barrier();
#pragma unroll
    for (int ks = 0; ks < 2; ks++) {
      bf16x8 pf = *(const bf16x8*)(sPw + l15 * 72 + ks * 32 + l4 * 8);
#pragma unroll
      for (int jn = 0; jn < 4; jn++) {
        bf16x8 vf = *(const bf16x8*)(sVt + (jn * 16 + l15) * 72 + ks * 32 + l4 * 8);
        o[jn] = __builtin_amdgcn_mfma_f32_16x16x32_bf16(pf, vf, o[jn], 0, 0, 0);
      }
    }
  }
#pragma unroll
  for (int r = 0; r < 4; r++) {
    float lsum = lrow[r];
    if (has_sink) lsum += __expf(sink - mrow[r]);
    float inv = 1.f / lsum;
#pragma unroll
    for (int jn = 0; jn < 4; jn++)
      Op[(size_t)(q0 + w * 16 + l4 * 4 + r) * 1024 + jn * 16 + l15] = f2bf(o[jn][r] * inv);
  }
}

__device__ __forceinline__ int gla_tok(int tb, int c, int dir, int tau) { return tb + c * 64 + (dir ? 63 - tau : tau); }

#define GLA_W2_OFF 40960
__device__ __forceinline__ void gla_stage_w2(const P& p, int l, char* smem) {
  float* w2s = (float*)(smem + GLA_W2_OFF);
  const int tid = tidx();
  __syncthreads();
#pragma unroll
  for (int i = 0; i < 2; i++) {
    int e = (tid + i * 256) * 4;
    *(float4*)(w2s + e) = *(const float4*)(p.w_gla_a_fwd + l * 2048 + e);
    *(float4*)(w2s + 2048 + e) = *(const float4*)(p.w_gla_a_bwd + l * 2048 + e);
  }
  if (tid < 128) w2s[4096 + tid] = p.b_gla_a_fwd[l * 128 + tid];
  else w2s[4096 + tid] = p.b_gla_a_bwd[l * 128 + tid - 128];
  __syncthreads();
}
__device__ __forceinline__ void gla_load_alow(const P& p, int tok, int dir, float4 (&al)[4]) {
  const float* src = W_hbuf + (size_t)tok * 1984 + (dir ? 1456 : 1440);
#pragma unroll
  for (int q = 0; q < 4; q++) al[q] = *(const float4*)(src + q * 4);
}
__device__ __forceinline__ void gla_cum_regs(const char* smem, const float4 (&al)[4], int h, int dir, int w, int lane, float (&c)[8], float (&tot)[8]) {
  const float* w2 = (const float*)(smem + GLA_W2_OFF) + dir * 2048 + h * 32 + w * 8;
  const float* b2 = (const float*)(smem + GLA_W2_OFF) + 4096 + dir * 128 + h * 32 + w * 8;
  float a[16];
#pragma unroll
  for (int q = 0; q < 4; q++) { a[q * 4] = al[q].x; a[q * 4 + 1] = al[q].y; a[q * 4 + 2] = al[q].z; a[q * 4 + 3] = al[q].w; }
#pragma unroll
  for (int j = 0; j < 8; j++) {
    float z = b2[j];
#pragma unroll
    for (int r = 0; r < 16; r++) z += a[r] * w2[r * 128 + j];
    float la = logsigf(z) * (1.f / 16.f);
    float v = la;
#pragma unroll
    for (int d = 1; d < 64; d <<= 1) { float t_ = __shfl_up(v, d); if (lane >= d) v += t_; }
    float total = __shfl(v, 63);
    c[j] = dir ? (total - v + la) : v;
    tot[j] = total;
  }
}
__device__ __forceinline__ void gla_load_v(const P& p, int tok, int h, int w, float4 (&vr)[4]) {
  const float* src = W_hbuf + (size_t)tok * 1984 + 928 + h * 64 + w * 16;
#pragma unroll
  for (int q = 0; q < 4; q++) vr[q] = *(const float4*)(src + q * 4);
}
__device__ __forceinline__ void gla_store_vt(const float4 (&vr)[4], int w, int lane, bf16_t* sVt) {
#pragma unroll
  for (int q = 0; q < 4; q++) {
    sVt[(w * 16 + q * 4 + 0) * 72 + lane] = f2bf(vr[q].x);
    sVt[(w * 16 + q * 4 + 1) * 72 + lane] = f2bf(vr[q].y);
    sVt[(w * 16 + q * 4 + 2) * 72 + lane] = f2bf(vr[q].z);
    sVt[(w * 16 + q * 4 + 3) * 72 + lane] = f2bf(vr[q].w);
  }
}

__device__ __forceinline__ void chunk_info(int cidx, int& tb, int& nch, int& n, int& cbase) {
  if (cidx < 128) { int b = cidx >> 2; n = cidx & 3; nch = 4; tb = b * 256; cbase = b * 4; }
  else { int cl = cidx - 128, b = cl >> 5; n = cl & 31; nch = 32; tb = T_CTX + b * 2048; cbase = 128 + b * 32; }
}

__device__ __forceinline__ void gla_g1_item(const P& p, int l, int item, char* smem) {
  bf16_t* sKeT = (bf16_t*)smem;
  bf16_t* sVt = sKeT + 32 * 72;
  const int tid = tidx(), lane = tid & 63, w = __builtin_amdgcn_readfirstlane(tid >> 6), l15 = lane & 15, l4 = lane >> 4;
  int dir = item & 1, h = (item >> 1) & 3, cidx = item >> 3;
  int tb, nch, n, cbase;
  chunk_info(cidx, tb, nch, n, cbase);
  int c = dir ? nch - 1 - n : n;
  int tok = tb + c * 64 + lane;
  float4 al[4], vr[4];
  gla_load_alow(p, tok, dir, al);
  const float* kr = W_hbuf + (size_t)tok * 1984 + 800 + h * 32 + w * 8;
  float4 k0 = *(const float4*)kr, k1 = *(const float4*)(kr + 4);
  gla_load_v(p, tok, h, w, vr);
  float cs[8], tot[8];
  gla_cum_regs(smem, al, h, dir, w, lane, cs, tot);
  __syncthreads();
  {
    float kk[8] = {k0.x, k0.y, k0.z, k0.w, k1.x, k1.y, k1.z, k1.w};
#pragma unroll
    for (int j = 0; j < 8; j++) sKeT[(w * 8 + j) * 72 + lane] = f2bf(kk[j] * __expf(tot[j] - cs[j]));
  }
  gla_store_vt(vr, w, lane, sVt);
  __syncthreads();
  f32x4 acc[2] = {f32x4{0.f, 0.f, 0.f, 0.f}, f32x4{0.f, 0.f, 0.f, 0.f}};
#pragma unroll
  for (int ks = 0; ks < 2; ks++) {
    bf16x8 bv = *(const bf16x8*)(sVt + (w * 16 + l15) * 72 + ks * 32 + l4 * 8);
#pragma unroll
    for (int mt = 0; mt < 2; mt++) {
      bf16x8 av = *(const bf16x8*)(sKeT + (mt * 16 + l15) * 72 + ks * 32 + l4 * 8);
      acc[mt] = __builtin_amdgcn_mfma_f32_16x16x32_bf16(av, bv, acc[mt], 0, 0, 0);
    }
  }
  float* dst = W_un + (size_t)item * 2048;
#pragma unroll
  for (int mt = 0; mt < 2; mt++)
#pragma unroll
    for (int r = 0; r < 4; r++) dst[(mt * 16 + l4 * 4 + r) * 64 + w * 16 + l15] = acc[mt][r];
  if (lane == 0) {
#pragma unroll
    for (int j = 0; j < 8; j++) W_gn[item * 32 + w * 8 + j] = __expf(tot[j]);
  }
}

__device__ __forceinline__ void phase_gla_scan(const P& p, int l) {
  for (int it = blockIdx.x; it < 2176; it += gridDim.x) {
    int e = it * 256 + tidx();
    int kv = e & 2047, sd = e >> 11, dir = sd & 1, h = (sd >> 1) & 3, seq = ((sd >> 3) + 32) % 34;
    int nch, cbase;
    float s;
    if (seq < 32) { nch = 4; cbase = seq * 4; s = 0.f; }
    else { int b = seq - 32; nch = 32; cbase = 128 + b * 32; s = p.state_gla[((size_t)(((b * 2 + l) * 2 + dir) * 4 + h)) * 2048 + kv]; }
    for (int n0 = 0; n0 < nch; n0 += 4) {
      float gv[4], uv[4];
#pragma unroll
      for (int k = 0; k < 4; k++) {
        int item = ((cbase + n0 + k) * 4 + h) * 2 + dir;
        gv[k] = W_gn[item * 32 + (kv >> 6)];
        uv[k] = W_un[(size_t)item * 2048 + kv];
      }
#pragma unroll
      for (int k = 0; k < 4; k++) {
        int item = ((cbase + n0 + k) * 4 + h) * 2 + dir;
        W_sin_[(size_t)item * 2048 + kv] = s;
        s = gv[k] * s + uv[k];
      }
    }
    if (seq < 32) p.out[19398656 + ((size_t)(((seq * 2 + l) * 2 + dir) * 4 + h)) * 2048 + kv] = s;
  }
}

__device__ __forceinline__ void phase_gla_out(const P& p, int l, char* smem) {
  bf16_t* sQe = (bf16_t*)smem;
  bf16_t* sKe = sQe + 64 * 40;
  bf16_t* sSt = sKe + 64 * 40;
  bf16_t* sVt = sSt + 64 * 40;
  bf16_t* sAtt = sVt + 64 * 72;
  const int tid = tidx(), lane = tid & 63, w = __builtin_amdgcn_readfirstlane(tid >> 6), l15 = lane & 15, l4 = lane >> 4;
  gla_stage_w2(p, l, smem);
  for (int it = blockIdx.x; it < 768; it += gridDim.x) {
    int h = it & 3, cidx = it >> 2;
    int tb, nch, c, cbase;
    chunk_info(cidx, tb, nch, c, cbase);
    const int tok = tb + c * 64 + lane;
    f32x4 o[4];
#pragma unroll
    for (int j = 0; j < 4; j++) o[j] = f32x4{0.f, 0.f, 0.f, 0.f};
    float4 vr[4], alf[4], alb[4];
    gla_load_v(p, tok, h, w, vr);
    gla_load_alow(p, tok, 0, alf);
    gla_load_alow(p, tok, 1, alb);
    const float* qr = W_hbuf + (size_t)tok * 1984 + 672 + h * 32 + w * 8;
    const float* kr = qr + 128;
    const float4 q0 = *(const float4*)qr, q1 = *(const float4*)(qr + 4), k0 = *(const float4*)kr, k1 = *(const float4*)(kr + 4);
    float sinv[2][8];
#pragma unroll
    for (int dir = 0; dir < 2; dir++) {
      int n = dir ? nch - 1 - c : c;
      int item = ((cbase + n) * 4 + h) * 2 + dir;
      const float* sin = W_sin_ + (size_t)item * 2048 + (w * 8) * 64 + lane;
#pragma unroll
      for (int j = 0; j < 8; j++) sinv[dir][j] = sin[j * 64];
    }
    float gpre[4][4];
#pragma unroll
    for (int r = 0; r < 4; r++)
#pragma unroll
      for (int jn = 0; jn < 4; jn++) gpre[r][jn] = W_hbuf[(size_t)(tb + c * 64 + w * 16 + l4 * 4 + r) * 1984 + 1184 + h * 64 + jn * 16 + l15];
    __syncthreads();
    gla_store_vt(vr, w, lane, sVt);
#pragma unroll
    for (int dir = 0; dir < 2; dir++) {
      float cs[8], tot[8];
      gla_cum_regs(smem, dir ? alb : alf, h, dir, w, lane, cs, tot);
      if (dir) __syncthreads();
      {
        float qq[8] = {q0.x, q0.y, q0.z, q0.w, q1.x, q1.y, q1.z, q1.w};
        float kk[8] = {k0.x, k0.y, k0.z, k0.w, k1.x, k1.y, k1.z, k1.w};
        bf16x8 qv, kv, sv;
#pragma unroll
        for (int j = 0; j < 8; j++) {
          float cm = __shfl(cs[j], 32);
          qv[j] = (short)f2bf(qq[j] * 0.17677669529663687f * __expf(cs[j] - cm));
          kv[j] = (short)f2bf(kk[j] * __expf(cm - cs[j]));
          sv[j] = (short)f2bf(sinv[dir][j] * __expf(cm));
        }
        *(bf16x8*)(sQe + lane * 40 + w * 8) = qv;
        *(bf16x8*)(sKe + lane * 40 + w * 8) = kv;
        *(bf16x8*)(sSt + lane * 40 + w * 8) = sv;
      }
      __syncthreads();
      bf16x8 qa = *(const bf16x8*)(sQe + (w * 16 + l15) * 40 + l4 * 8);
#pragma unroll
      for (int jc = 0; jc < 4; jc++) {
        bf16x8 kb = *(const bf16x8*)(sKe + (jc * 16 + l15) * 40 + l4 * 8);
        f32x4 sacc = __builtin_amdgcn_mfma_f32_16x16x32_bf16(qa, kb, f32x4{0.f, 0.f, 0.f, 0.f}, 0, 0, 0);
#pragma unroll
        for (int r = 0; r < 4; r++) {
          int trow = w * 16 + l4 * 4 + r, scol = jc * 16 + l15;
          bool keep = dir ? (scol >= trow) : (scol <= trow);
          sAtt[trow * 72 + scol] = f2bf(keep ? sacc[r] : 0.f);
        }
      }
      __syncthreads();
#pragma unroll
      for (int ks = 0; ks < 2; ks++) {
        bf16x8 aa = *(const bf16x8*)(sAtt + (w * 16 + l15) * 72 + ks * 32 + l4 * 8);
#pragma unroll
        for (int jn = 0; jn < 4; jn++) {
          bf16x8 vb = *(const bf16x8*)(sVt + (jn * 16 + l15) * 72 + ks * 32 + l4 * 8);
          o[jn] = __builtin_amdgcn_mfma_f32_16x16x32_bf16(aa, vb, o[jn], 0, 0, 0);
        }
      }
#pragma unroll
      for (int jn = 0; jn < 4; jn++) {
        bf16x8 sb = *(const bf16x8*)(sSt + (jn * 16 + l15) * 40 + l4 * 8);
        o[jn] = __builtin_amdgcn_mfma_f32_16x16x32_bf16(qa, sb, o[jn], 0, 0, 0);
      }
    }
#pragma unroll
    for (int r = 0; r < 4; r++) {
      float ss = o[0][r] * o[0][r] + o[1][r] * o[1][r] + o[2][r] * o[2][r] + o[3][r] * o[3][r];
      ss += DPP_F(ss, ss, 0xB1, 0xf);
      ss += DPP_F(ss, ss, 0x4E, 0xf);
      ss += DPP_F(ss, ss, 0x141, 0xf);
      ss += DPP_F(ss, ss, 0x140, 0xf);
      float rs = rsqrtf(ss * (1.f / 64.f) + 1e-6f);
      int tk = tb + c * 64 + w * 16 + l4 * 4 + r;
      const float* grow = W_hbuf + (size_t)tk * 1984 + 1184 + h * 64;
      bf16_t* dst = W_br + (size_t)tk * 1024 + 512 + h * 64;
#pragma unroll
      for (int jn = 0; jn < 4; jn++) {
        int vcol = jn * 16 + l15;
        float val = o[jn][r] * rs * p.gla_norm[l * 64 + vcol];
        dst[vcol] = f2bf(val * siluf(gpre[r][jn]));
      }
    }
  }
}

__device__ __forceinline__ void phase_mixers(const P& p, int l, char* smem) {
  const int N_MLAL = 256, N_DFTL = 64, N_SWAL = 256, N_MLAC = 512, N_SWAC = 512, N_DFTC = 128, N_G1 = 1536;
  const int total = N_MLAL + N_DFTL + N_SWAL + N_MLAC + N_SWAC + N_DFTC + N_G1;
  gla_stage_w2(p, l, smem);
  for (int r_ = 0; r_ * (int)gridDim.x < total; r_++) {
    int it0 = r_ * gridDim.x + ((r_ & 1) ? (gridDim.x - 1 - blockIdx.x) : blockIdx.x);
    if (it0 >= total) continue;
    int it = it0;
    int type;
    bool lat = false;
    if (it < N_MLAL) { type = 0; lat = true; }
    else if ((it -= N_MLAL) < N_DFTL) { type = 2; lat = true; }
    else if ((it -= N_DFTL) < N_SWAL) { type = 1; lat = true; }
    else if ((it -= N_SWAL) < N_MLAC) { type = 0; }
    else if ((it -= N_MLAC) < N_SWAC) { type = 1; }
    else if ((it -= N_SWAC) < N_DFTC) { type = 2; }
    else { it -= N_DFTC; type = 3; }
#ifdef DUPTYPE
    for (int rep_ = 0; rep_ < ((type == (DUPTYPE & 3) && (int)lat == (DUPTYPE >> 2)) ? 2 : 1); rep_++)
#endif
    if (type == 0) {
      int qt, h, b, Sk;
      size_t tok0;
      if (lat) { qt = it & 31; h = (it >> 5) & 3; b = it >> 7; tok0 = T_CTX + b * 2048; Sk = 2560; }
      else { qt = it & 3; h = (it >> 2) & 3; b = it >> 4; tok0 = b * 256; Sk = 256; }
      const bf16_t* Kp = (lat ? W_Ka_lat : W_Ka_ctx) + (size_t)(b * 4 + h) * Sk * 96;
      const bf16_t* Vp = (lat ? W_Va_lat : W_Va_ctx) + (size_t)(b * 4 + h) * Sk * 64;
      attn_item<96>(W_Qa + tok0 * 384 + h * 96, 384, Kp, Vp, W_br + tok0 * 1024 + h * 64, qt * 64, Sk, 0, -1,
                    0.10206207261596575f, false, 0.f, smem);
    } else if (type == 1) {
      int qt, hq, b, Sk, nctx, W;
      size_t tok0;
      if (lat) { qt = it & 31; hq = (it >> 5) & 3; b = it >> 7; tok0 = T_CTX + b * 2048; Sk = 2560; nctx = 512; W = 128; }
      else { qt = it & 3; hq = (it >> 2) & 3; b = it >> 4; tok0 = b * 256; Sk = 256; nctx = 0; W = -1; }
      int kv = hq >> 1;
      const bf16_t* Kp = (lat ? W_Kd_lat : W_Kd_ctx) + (size_t)(b * 2 + kv) * Sk * 64;
      const bf16_t* Vp = (lat ? W_Vd_lat : W_Vd_ctx) + (size_t)(b * 2 + kv) * Sk * 64;
      attn_item<64>(W_Qd + tok0 * 256 + hq * 64, 256, Kp, Vp, W_br + tok0 * 1024 + 768 + hq * 64, qt * 64, Sk, nctx, W,
                    0.125f, true, p.swa_sink[l * 4 + hq], smem);
    } else if (type == 2) {
      int nt = it & 1, mt, b, S;
      size_t tok0;
      if (lat) { mt = (it >> 1) & 15; b = it >> 5; S = 2048; tok0 = T_CTX + b * 2048; }
      else { mt = (it >> 1) & 1; b = it >> 2; S = 256; tok0 = b * 256; }
      const bf16_t* Ap = (lat ? W_A2048 : W_A256) + (size_t)mt * 128 * 2 * S;
      const bf16_t* Bp = (lat ? W_Yt_lat : W_Yt_ctx) + (size_t)(b * 256 + nt * 128) * 2 * S;
      f32x4 acc[4][4];
      ZERO_ACC(acc);
      gemm_core(acc, Ap, 2 * S, Bp, 2 * S, 2 * S, smem);
      EPI_LOOP(acc, mt * 128, nt * 128, { W_br[(tok0 + m) * 1024 + 256 + n] = f2bf(v); });
    } else {
      gla_g1_item(p, l, it, smem);
    }
  }
}

#define EPI4_LOOP_N(acc, c0, t0, NJ, ...)                                                  \
  {                                                                                        \
    const int lane_ = tidx() & 63, w_ = tidx() >> 6, wm_ = w_ >> 1, wn_ = w_ & 1;           \
    _Pragma("unroll") for (int i_ = 0; i_ < 4; i_++)                                       \
    _Pragma("unroll") for (int j_ = 0; j_ < NJ; j_++) {                                    \
      const int col = (c0) + wm_ * 64 + i_ * 16 + (lane_ >> 4) * 4;                        \
      const int tok = (t0) + wn_ * (NJ * 16) + j_ * 16 + (lane_ & 15);                     \
      const f32x4 v4 = acc[i_][j_];                                                        \
      __VA_ARGS__                                                                          \
    }                                                                                      \
  }
__device__ __forceinline__ void phase_merge(const P& p, int l, char* smem) {
  for (int tile = blockIdx.x; tile < 192 * 8; tile += gridDim.x) {
    int tt = tile >> 3, nt = tile & 7, t0 = tt * 64, n0 = nt * 128;
    f32x4 tot[4][2];
    ZERO_ACC_N(tot, 2);
    for (int b = 0; b < 4; b++) {
      f32x4 acc[4][2];
      ZERO_ACC_N(acc, 2);
      gemm_core_t<2>(acc, W_Wt_br + ((size_t)(l * 4 + b) * 1024 + n0) * 256, 256, W_br + (size_t)t0 * 1024 + b * 256, 1024, 256, smem);
      EPI4_LOOP_N(acc, n0, t0, 2, {
        ushort4 g_ = *(const ushort4*)(W_gates + (size_t)tok * 4096 + b * 1024 + col);
        tot[i_][j_][0] += bf2f(g_.x) * v4[0]; tot[i_][j_][1] += bf2f(g_.y) * v4[1];
        tot[i_][j_][2] += bf2f(g_.z) * v4[2]; tot[i_][j_][3] += bf2f(g_.w) * v4[3];
      });
    }
    EPI4_LOOP_N(tot, n0, t0, 2, {
      ushort4 o_; o_.x = f2bf(v4[0]); o_.y = f2bf(v4[1]); o_.z = f2bf(v4[2]); o_.w = f2bf(v4[3]);
      *(ushort4*)(W_u + (size_t)tok * 1024 + col) = o_;
    });
  }
}

__device__ __forceinline__ void phase_wout(const P& p, int l, char* smem) {
  float* r = W_hbuf;
  const float alpha = 1.4142135623730951f;
  for (int tile = blockIdx.x; tile < 96 * 8; tile += gridDim.x) {
    int mt = tile >> 3, nt = tile & 7, m0 = mt * 128, n0 = nt * 128;
    f32x4 acc[4][4];
    ZERO_ACC(acc);
    gemm_core(acc, W_Wt_out + ((size_t)l * 1024 + n0) * 1024, 1024, W_u + (size_t)m0 * 1024, 1024, 1024, smem);
    const float* g1 = W_mada + (l * 3 + cond_row(m0)) * 6144 + 2048;
    {
      const int lane_ = tidx() & 63, w_ = tidx() >> 6, wm_ = w_ >> 1, wn_ = w_ & 1;
#pragma unroll
      for (int ih = 0; ih < 2; ih++) {
        float4 xv[8];
#pragma unroll
        for (int q = 0; q < 8; q++) {
          int i_ = ih * 2 + (q >> 2), j_ = q & 3;
          int col = n0 + wm_ * 64 + i_ * 16 + (lane_ >> 4) * 4, tok = m0 + wn_ * 64 + j_ * 16 + (lane_ & 15);
          xv[q] = *(const float4*)(x_in_row(p, l, tok) + col);
        }
#pragma unroll
        for (int q = 0; q < 8; q++) {
          int i_ = ih * 2 + (q >> 2), j_ = q & 3;
          int col = n0 + wm_ * 64 + i_ * 16 + (lane_ >> 4) * 4, tok = m0 + wn_ * 64 + j_ * 16 + (lane_ & 15);
          float4 gv = *(const float4*)(g1 + col);
          f32x4 v4 = acc[i_][j_];
          *(float4*)(r + (size_t)tok * 1024 + col) = float4{alpha * xv[q].x + gv.x * v4[0], alpha * xv[q].y + gv.y * v4[1], alpha * xv[q].z + gv.z * v4[2], alpha * xv[q].w + gv.w * v4[3]};
        }
      }
    }
  }
}

__device__ __forceinline__ void phase_ln_mid(const P& p, int l) {
  int lane = tidx() & 63, w = tidx() >> 6;
  const float* r = W_hbuf;
  for (int it = blockIdx.x; it < T_ALL / 4; it += gridDim.x) {
    int g = it * 4 + w;
    float v[16];
    load_row16(r + (size_t)g * 1024, lane, v);
    ln16(v);
    affine16(v, p.ln1_g + l * 1024, p.ln1_b + l * 1024, lane);
    store_row16(x_out_row(p, l, g), lane, v);
    ln16(v);
    const float* m = W_mada + (l * 3 + cond_row(g)) * 6144;
    modulate_store(v, m + 3072, m + 4096, W_u + (size_t)g * 1024, lane);
  }
}

__device__ __forceinline__ void phase_pq(const P& p, int l, char* smem) {
  float* sc = (float*)W_gates;
  bf16_t* sa = (bf16_t*)smem;
  const int tid = tidx(), lane = tid & 63, w = tid >> 6, wm = w >> 1, wn = w & 1, l15 = lane & 15, l4 = lane >> 4;
  for (int tile = blockIdx.x; tile < 96 * 16; tile += gridDim.x) {
    int mt = tile >> 4, hp = tile & 15, m0 = mt * 128, n0 = hp * 128;
    f32x4 acc[4][4];
    ZERO_ACC(acc);
    gemm_core(acc, W_Wt_pq + ((size_t)l * 2048 + n0) * 1024, 1024, W_u + (size_t)m0 * 1024, 1024, 1024, smem);
    __syncthreads();
    {
      bf16_t* sB = sa + 128 * GB_LD * (1 + wm);
#pragma unroll
      for (int i = 0; i < 4; i++)
#pragma unroll
        for (int j = 0; j < 4; j++) {
          ushort4 o_;
          o_.x = f2bf(acc[i][j][0]); o_.y = f2bf(acc[i][j][1]); o_.z = f2bf(acc[i][j][2]); o_.w = f2bf(acc[i][j][3]);
          *(ushort4*)(sB + (wn * 64 + j * 16 + l15) * GB_LD + i * 16 + l4 * 4) = o_;
        }
    }
    f32x4 acc2[4][4];
    ZERO_ACC(acc2);
    const bf16_t* keys = W_keysbf + (size_t)(l * 16 + hp) * 128 * 128;
#pragma unroll
    for (int kh = 0; kh < 2; kh++) {
      u32x4 rk[4];
#pragma unroll
      for (int i = 0; i < 4; i++) { int c = tid + i * 256, r = c >> 3, cc = (c & 7) * 8; rk[i] = *(const u32x4*)(keys + r * 128 + kh * 64 + cc); }
      if (kh) __syncthreads();
#pragma unroll
      for (int i = 0; i < 4; i++) { int c = tid + i * 256, r = c >> 3, cc = (c & 7) * 8; *(u32x4*)(sa + r * GB_LD + cc) = rk[i]; }
      __syncthreads();
      const bf16_t* sBk = sa + 128 * GB_LD * (1 + kh);
#pragma unroll
      for (int ks = 0; ks < 2; ks++) {
        bf16x8 af[4], bfr[4];
#pragma unroll
        for (int i = 0; i < 4; i++) af[i] = *(const bf16x8*)(sa + (wm * 64 + i * 16 + l15) * GB_LD + ks * 32 + l4 * 8);
#pragma unroll
        for (int j = 0; j < 4; j++) bfr[j] = *(const bf16x8*)(sBk + (wn * 64 + j * 16 + l15) * GB_LD + ks * 32 + l4 * 8);
#pragma unroll
        for (int i = 0; i < 4; i++)
#pragma unroll
          for (int j = 0; j < 4; j++) acc2[i][j] = __builtin_amdgcn_mfma_f32_16x16x32_bf16(af[i], bfr[j], acc2[i][j], 0, 0, 0);
      }
    }
    EPI_LOOP(acc2, 0, m0, { sc[((size_t)(hp * 128 + m)) * T_ALL + n] = v; });
  }
}

__device__ __forceinline__ void phase_scores(const P& p, int l, char* smem) {}

__device__ __forceinline__ int f2sort(float x) { int b = __float_as_int(x); return b ^ ((b >> 31) & 0x7fffffff); }
__device__ __forceinline__ float sort2f(int s) { return __int_as_float(s ^ ((s >> 31) & 0x7fffffff)); }
__device__ __forceinline__ void bitonic_sort16_desc(int (&a)[16]) {
#pragma unroll
  for (int k = 2; k <= 16; k <<= 1)
#pragma unroll
    for (int j = k >> 1; j > 0; j >>= 1)
#pragma unroll
      for (int i = 0; i < 16; i++) {
        int l_ = i ^ j;
        if (l_ > i) {
          int hi = max(a[i], a[l_]), lo = min(a[i], a[l_]);
          if ((i & k) == 0) { a[i] = hi; a[l_] = lo; } else { a[i] = lo; a[l_] = hi; }
        }
      }
}
__device__ __forceinline__ void merge_top16(int (&T)[16], const int (&S)[16]) {
#pragma unroll
  for (int i = 0; i < 16; i++) T[i] = max(T[i], S[15 - i]);
#pragma unroll
  for (int j = 8; j > 0; j >>= 1)
#pragma unroll
    for (int i = 0; i < 16; i++) {
      int l_ = i ^ j;
      if (l_ > i) { int hi = max(T[i], T[l_]), lo = min(T[i], T[l_]); T[i] = hi; T[l_] = lo; }
    }
}
__device__ __forceinline__ void top16_col(const float* src, int (&L)[16]) {
#pragma unroll 1
  for (int k0 = 0; k0 < 128; k0 += 16) {
    float xv[16];
#pragma unroll
    for (int k = 0; k < 16; k++) xv[k] = src[(size_t)(k0 + k) * T_ALL];
    int S[16];
#pragma unroll
    for (int k = 0; k < 16; k++) S[k] = (f2sort(xv[k]) & ~127) | (127 - (k0 + k));
    bitonic_sort16_desc(S);
    if (k0 == 0) {
#pragma unroll
      for (int k = 0; k < 16; k++) L[k] = S[k];
    } else {
      merge_top16(L, S);
    }
  }
}
__device__ __forceinline__ void phase_topk(const P& p, int l) {
  const float* sc = (const float*)W_gates;
  int lane = tidx() & 63, w = tidx() >> 6;
  for (int it = blockIdx.x * 4 + w; it < 192 * 8; it += gridDim.x * 4) {
    int h = it & 7, t = (it >> 3) * 64 + lane;
    int L1[16], L2[16];
    const float* s1 = sc + (size_t)(h * 2) * 128 * T_ALL + t;
    top16_col(s1, L1);
    top16_col(s1 + (size_t)128 * T_ALL, L2);
    float v1[16], v2[16];
    unsigned P1[4] = {0u, 0u, 0u, 0u}, P2[4] = {0u, 0u, 0u, 0u};
#pragma unroll
    for (int i = 0; i < 16; i++) {
      v1[i] = sort2f(L1[i] & ~127);
      v2[i] = sort2f(L2[i] & ~127);
      P1[i >> 2] |= (unsigned)(127 - (L1[i] & 127)) << ((i & 3) * 8);
      P2[i >> 2] |= (unsigned)(127 - (L2[i] & 127)) << ((i & 3) * 8);
    }
    int Tk[16];
#pragma unroll
    for (int j = 0; j < 16; j++) Tk[j] = (f2sort(v1[0] + v2[j]) & ~255) | (255 - j);
    {
      int G[3][16];
#pragma unroll
      for (int g_ = 0; g_ < 3; g_++)
#pragma unroll
        for (int k = 0; k < 16; k++) G[g_][k] = (int)0x80000000;
      int cnt = 0;
#pragma unroll
      for (int i = 1; i < 16; i++) {
#pragma unroll
        for (int j = 0; j < 16 / (i + 1); j++) {
          G[cnt >> 4][cnt & 15] = (f2sort(v1[i] + v2[j]) & ~255) | (255 - (i * 16 + j));
          cnt++;
        }
      }
#pragma unroll
      for (int g_ = 0; g_ < 3; g_++) { bitonic_sort16_desc(G[g_]); merge_top16(Tk, G[g_]); }
    }
    float v0 = sort2f(Tk[0] & ~255);
    float e[16], Z = 0.f;
    int oi[16];
#pragma unroll
    for (int s_ = 0; s_ < 16; s_++) {
      e[s_] = __expf(sort2f(Tk[s_] & ~255) - v0);
      Z += e[s_];
      int code = 255 - (Tk[s_] & 255), i = code >> 4, j = code & 15;
      unsigned r1 = (i >> 2) == 0 ? P1[0] : (i >> 2) == 1 ? P1[1] : (i >> 2) == 2 ? P1[2] : P1[3];
      unsigned r2 = (j >> 2) == 0 ? P2[0] : (j >> 2) == 1 ? P2[1] : (j >> 2) == 2 ? P2[2] : P2[3];
      int i1 = (r1 >> ((i & 3) * 8)) & 255, i2 = (r2 >> ((j & 3) * 8)) & 255;
      oi[s_] = i1 * 128 + i2;
    }
    float inv = 1.f / Z;
    int* po = W_pidx + (size_t)t * 128 + h * 16;
    float* pwo = W_pw + (size_t)t * 128 + h * 16;
#pragma unroll
    for (int q = 0; q < 4; q++) {
      *(int4*)(po + q * 4) = int4{oi[q * 4], oi[q * 4 + 1], oi[q * 4 + 2], oi[q * 4 + 3]};
      *(float4*)(pwo + q * 4) = float4{e[q * 4] * inv, e[q * 4 + 1] * inv, e[q * 4 + 2] * inv, e[q * 4 + 3] * inv};
    }
  }
}

__device__ __forceinline__ void unpack16(u32x4 r, float (&f)[16]) {
#pragma unroll
  for (int q = 0; q < 4; q++) {
    auto lo = __builtin_amdgcn_cvt_pk_f32_fp8((int)r[q], false);
    auto hi = __builtin_amdgcn_cvt_pk_f32_fp8((int)r[q], true);
    f[q * 4 + 0] = lo[0]; f[q * 4 + 1] = lo[1]; f[q * 4 + 2] = hi[0]; f[q * 4 + 3] = hi[1];
  }
}
#define PEER_PF 8
__device__ __forceinline__ void phase_peer(const P& p, int l, char* smem) {
  int lane = tidx() & 63, w = tidx() >> 6;
  float* scoef = (float*)smem + w * 128;
  const unsigned char* tu = W_tabU + (size_t)l * 16384 * 1024 + lane * 16;
  const unsigned char* tv = W_tabV + (size_t)l * 16384 * 1024 + lane * 16;
  for (int it = blockIdx.x; it < T_ALL / 4; it += gridDim.x) {
    int g = it * 4 + w;
    float uu[16];
    {
      u32x4 r0 = *(const u32x4*)(W_u + (size_t)g * 1024 + lane * 16);
      u32x4 r1 = *(const u32x4*)(W_u + (size_t)g * 1024 + lane * 16 + 8);
      uu[0] = __uint_as_float(r0.x << 16); uu[1] = __uint_as_float(r0.x & 0xffff0000u);
      uu[2] = __uint_as_float(r0.y << 16); uu[3] = __uint_as_float(r0.y & 0xffff0000u);
      uu[4] = __uint_as_float(r0.z << 16); uu[5] = __uint_as_float(r0.z & 0xffff0000u);
      uu[6] = __uint_as_float(r0.w << 16); uu[7] = __uint_as_float(r0.w & 0xffff0000u);
      uu[8] = __uint_as_float(r1.x << 16); uu[9] = __uint_as_float(r1.x & 0xffff0000u);
      uu[10] = __uint_as_float(r1.y << 16); uu[11] = __uint_as_float(r1.y & 0xffff0000u);
      uu[12] = __uint_as_float(r1.z << 16); uu[13] = __uint_as_float(r1.z & 0xffff0000u);
      uu[14] = __uint_as_float(r1.w << 16); uu[15] = __uint_as_float(r1.w & 0xffff0000u);
    }
    const int* pi = W_pidx + (size_t)g * 128;
    const float* pwt = W_pw + (size_t)g * 128;
#ifndef PEER_REP
#define PEER_REP 1
#endif
    float o[16];
    for (int rep_ = 0; rep_ < PEER_REP; rep_++) {
    float dv0 = 0.f, dv1 = 0.f;
    for (int e0 = 0; e0 < 128; e0 += PEER_PF) {
      u32x4 ra[PEER_PF];
#pragma unroll
      for (int k = 0; k < PEER_PF; k++) ra[k] = *(const u32x4*)(tu + (size_t)pi[e0 + k] * 1024);
#pragma unroll
      for (int k = 0; k < PEER_PF; k++) {
        float f[16];
        unpack16(ra[k], f);
        float a = 0.f;
#pragma unroll
        for (int j = 0; j < 16; j++) a += uu[j] * f[j];
        float dd = wsum(a);
        if (e0 < 64) dv0 = (lane == e0 + k) ? dd : dv0;
        else dv1 = (lane == e0 + k - 64) ? dd : dv1;
      }
    }
    {
      float d0 = dv0 * (1.f / PEER_U_SCALE), d1 = dv1 * (1.f / PEER_U_SCALE);
      float a0 = 0.5f * d0 * (1.f + erff(d0 * 0.7071067811865476f));
      float a1 = 0.5f * d1 * (1.f + erff(d1 * 0.7071067811865476f));
      scoef[lane] = pwt[lane] * a0 * (1.f / PEER_V_SCALE);
      scoef[64 + lane] = pwt[64 + lane] * a1 * (1.f / PEER_V_SCALE);
    }
    __builtin_amdgcn_s_waitcnt(0xc07f);
    __builtin_amdgcn_wave_barrier();
#pragma unroll
    for (int j = 0; j < 16; j++) o[j] = 0.f;
    for (int e0 = 0; e0 < 128; e0 += PEER_PF) {
      u32x4 ra[PEER_PF];
#pragma unroll
      for (int k = 0; k < PEER_PF; k++) ra[k] = *(const u32x4*)(tv + (size_t)pi[e0 + k] * 1024);
#pragma unroll
      for (int k = 0; k < PEER_PF; k++) {
        float cf = scoef[e0 + k];
        float f[16];
        unpack16(ra[k], f);
#pragma unroll
        for (int j = 0; j < 16; j++) o[j] += cf * f[j];
      }
    }
    __builtin_amdgcn_wave_barrier();
    }
    float* xr = x_out_row(p, l, g) + lane * 16;
    const float* m = W_mada + (l * 3 + cond_row(g)) * 6144 + lane * 16;
    float x1[16];
#pragma unroll
    for (int q = 0; q < 4; q++) {
      float4 xv = *(const float4*)(xr + q * 4);
      float4 g2 = *(const float4*)(m + 5120 + q * 4);
      x1[q * 4 + 0] = 1.4142135623730951f * xv.x + g2.x * o[q * 4 + 0];
      x1[q * 4 + 1] = 1.4142135623730951f * xv.y + g2.y * o[q * 4 + 1];
      x1[q * 4 + 2] = 1.4142135623730951f * xv.z + g2.z * o[q * 4 + 2];
      x1[q * 4 + 3] = 1.4142135623730951f * xv.w + g2.w * o[q * 4 + 3];
    }
    ln16(x1);
#pragma unroll
    for (int q = 0; q < 4; q++) {
      float4 a = *(const float4*)(p.ln2_g + l * 1024 + lane * 16 + q * 4);
      float4 c = *(const float4*)(p.ln2_b + l * 1024 + lane * 16 + q * 4);
      x1[q * 4 + 0] = x1[q * 4 + 0] * a.x + c.x; x1[q * 4 + 1] = x1[q * 4 + 1] * a.y + c.y;
      x1[q * 4 + 2] = x1[q * 4 + 2] * a.z + c.z; x1[q * 4 + 3] = x1[q * 4 + 3] * a.w + c.w;
      *(float4*)(xr + q * 4) = float4{x1[q * 4], x1[q * 4 + 1], x1[q * 4 + 2], x1[q * 4 + 3]};
    }
    if (l == 0) {
      ln16(x1);
      const float* m1 = W_mada + (1 * 3 + cond_row(g)) * 6144 + lane * 16;
#pragma unroll
      for (int q = 0; q < 4; q++) {
        float4 a = *(const float4*)(m1 + 1024 + q * 4);
        float4 b = *(const float4*)(m1 + q * 4);
        ushort4 ov;
        ov.x = f2bf(x1[q * 4 + 0] * (1.f + a.x) + b.x);
        ov.y = f2bf(x1[q * 4 + 1] * (1.f + a.y) + b.y);
        ov.z = f2bf(x1[q * 4 + 2] * (1.f + a.z) + b.z);
        ov.w = f2bf(x1[q * 4 + 3] * (1.f + a.w) + b.w);
        *(ushort4*)(W_u + (size_t)g * 1024 + lane * 16 + q * 4) = ov;
      }
    }
  }
}

#define N_PHASES 28
__device__ __forceinline__ void run_phase(const P& p, int ph, char* smem) {
#ifdef ONLYQ
  { int l = ph & 1; if (ONLYQ == -1) { phase_prep(p, smem); return; } if (ONLYQ == -2) { phase_ln0(p); return; }
    switch (ONLYQ) { case 0: phase_win(p, l, smem); break; case 1: phase_post(p, l); break; case 2: phase_small_gemms(p, l, smem); break; case 3: phase_mixers(p, l, smem); break; case 4: phase_gla_scan(p, l); break; case 5: phase_gla_out(p, l, smem); break; case 6: phase_merge(p, l, smem); break; case 7: phase_wout(p, l, smem); break; case 8: phase_ln_mid(p, l); break; case 9: phase_pq(p, l, smem); break; case 10: phase_scores(p, l, smem); break; case 11: phase_topk(p, l); break; case 12: phase_peer(p, l, smem); break; } return; }
#endif
  if (ph == 0) { phase_prep(p, smem); return; }
  if (ph == 1) { phase_ln0(p); return; }
  int l = (ph - 2) / 13, q = (ph - 2) % 13;
#ifdef EXCL
  if (q == EXCL) return;
#endif
  switch (q) {
    case 0: phase_win(p, l, smem); break;
    case 1: phase_post(p, l); break;
    case 2: phase_small_gemms(p, l, smem); break;
    case 3: phase_mixers(p, l, smem); break;
    case 4: phase_gla_scan(p, l); break;
    case 5: phase_gla_out(p, l, smem); break;
    case 6: phase_merge(p, l, smem); break;
    case 7: phase_wout(p, l, smem); break;
    case 8: phase_ln_mid(p, l); break;
    case 9: phase_pq(p, l, smem); break;
    case 10: phase_scores(p, l, smem); break;
    case 11: phase_topk(p, l); break;
    case 12: phase_peer(p, l, smem); break;
  }
}

#define XB_TMO      128
#define XB_XCNT(j)  (256  + 64 * (j))
#define XB_XSUB(j)  (1280 + 64 * (j))
#define XB_XGEN(j)  (2304 + 64 * (j))
#define XB_TOP      3328
#define XB_TOPGEN   3392
#define XCD_BAR_WORDS 3456
#define XB_SPIN_CAP (1u << 18)
#define LAS __attribute__((address_space(3)))

__device__ __forceinline__ unsigned xb_ld(unsigned* p)              { return __hip_atomic_load(p, __ATOMIC_RELAXED, __HIP_MEMORY_SCOPE_AGENT); }
__device__ __forceinline__ unsigned xb_add(unsigned* p, unsigned v) { return __hip_atomic_fetch_add(p, v, __ATOMIC_RELAXED, __HIP_MEMORY_SCOPE_AGENT); }
__device__ __forceinline__ unsigned xb_xcc_id() { return (unsigned)__builtin_amdgcn_s_getreg((3 << 11) | 20) & 0xFu; }
#define XB_SPIN(cond, bar) do { unsigned _sp = 0; while (cond) { __builtin_amdgcn_s_sleep(1); \
    if ((++_sp & 255u) == 0u) { if (xb_ld(&(bar)[XB_TMO])) break; if (_sp > XB_SPIN_CAP) { atomicAdd(&(bar)[XB_TMO], 1u); break; } } } } while (0)

struct XcdBarrier {
    unsigned* bar; unsigned x;
    volatile LAS unsigned* st;
};

__device__ __forceinline__ XcdBarrier xcd_barrier_post(unsigned* bar, volatile LAS unsigned* st) {
    XcdBarrier b; b.bar = bar; b.x = xb_xcc_id(); b.st = st;
    if (threadIdx.x == 0) (void)xb_add(&bar[XB_XCNT(b.x)], 1u);
    return b;
}
__device__ __forceinline__ void xcd_barrier_complete(unsigned* bar, unsigned x, unsigned& nloc, unsigned& nx) {
    const unsigned G = gridDim.x * gridDim.y * gridDim.z;
    unsigned sum, cnt, mine, sp = 0u;
    for (;;) {
        sum = 0u; cnt = 0u; mine = 0u;
#pragma unroll
        for (unsigned j = 0; j < 16; ++j) { const unsigned c = xb_ld(&bar[XB_XCNT(j)]); sum += c; cnt += (c > 0u) ? 1u : 0u; mine = (j == x) ? c : mine; }
        if (sum == G) break;
        __builtin_amdgcn_s_sleep(1);
        if ((++sp & 255u) == 0u) { if (xb_ld(&bar[XB_TMO])) break; if (sp > XB_SPIN_CAP) { atomicAdd(&bar[XB_TMO], 1u); break; } }
    }
    nloc = mine > 0u ? mine : 1u; nx = cnt > 0u ? cnt : 1u;
}

__device__ __forceinline__ void xcd_barrier(const XcdBarrier& b) {
    asm volatile("s_waitcnt vmcnt(0)" ::: "memory");
    __syncthreads();
    if (threadIdx.x == 0) {
        unsigned* bar = b.bar;
        __builtin_amdgcn_s_waitcnt(0);
        unsigned nloc = b.st[0], nx = b.st[1];
        if (nloc == 0u) { xcd_barrier_complete(bar, b.x, nloc, nx); b.st[0] = nloc; b.st[1] = nx; }
        const unsigned old = xb_add(&bar[XB_XSUB(b.x)], 1u);
        const unsigned gen = old / nloc;
        if (old + 1u == (gen + 1u) * nloc) {
            __builtin_amdgcn_fence(__ATOMIC_RELEASE, "agent");
            asm volatile("s_waitcnt vmcnt(0)" ::: "memory");
            const unsigned og = xb_add(&bar[XB_TOP], 1u);
            const unsigned tg = og / nx;
            if (og + 1u == (tg + 1u) * nx) xb_add(&bar[XB_TOPGEN], 1u);
            else XB_SPIN(xb_ld(&bar[XB_TOPGEN]) == tg, bar);
            __builtin_amdgcn_fence(__ATOMIC_ACQUIRE, "agent");
            xb_add(&bar[XB_XGEN(b.x)], 1u);
            asm volatile("s_waitcnt vmcnt(0)" ::: "memory");
        } else {
            XB_SPIN(xb_ld(&bar[XB_XGEN(b.x)]) == gen, bar);
            __builtin_amdgcn_fence(__ATOMIC_ACQUIRE, "agent");
            asm volatile("s_waitcnt vmcnt(0)" ::: "memory");
        }
    }
    __syncthreads();
}


#define SMEM_BYTES 61440

#if MULTI
__global__ void __launch_bounds__(256, 2) k_phase(P p, int ph) {
  __shared__ __attribute__((aligned(16))) char smem[SMEM_BYTES];
  run_phase(p, ph, smem);
}
#else
__global__ void __launch_bounds__(256, 2) k_mega(P p) {
  __shared__ __attribute__((aligned(16))) char smem[SMEM_BYTES];
  __shared__ uint4 xb_words;
  cg::grid_group grid = cg::this_grid();
  if (threadIdx.x == 0) xb_words = make_uint4(0u, 0u, 0u, 0u);
  __syncthreads();
  XcdBarrier xb = xcd_barrier_post((unsigned*)(p.ws + OFF_bar), (volatile LAS unsigned*)&xb_words);
#pragma nounroll
  for (int ph = 0; ph < N_PHASES; ph++) {
    if (ph >= 2 && (ph - 2) % 13 == 10) continue;
    run_phase(p, ph, smem);
#ifdef DUPMASK
    if (ph >= 2 && ((DUPMASK >> ((ph - 2) % 13)) & 1)) run_phase(p, ph, smem);
#endif
    if (ph + 1 < N_PHASES) {
      if (gridDim.y > 1) grid.sync();
      xcd_barrier(xb);
    }
  }
}
#endif

extern "C" void kernel_launch(void* const* d_in, const int* in_sizes, int n_in, void* d_out, int out_size, void* d_ws,
                              size_t ws_size, hipStream_t stream) {
  P p{};
  const float** fp = (const float**)&p;
  for (int i = 0; i < 32; i++) fp[i] = (const float*)d_in[i];
  p.out = (float*)d_out;
  p.ws = (char*)d_ws;
  size_t off = WS_TOTAL;
  if (off > ws_size) { fprintf(stderr, "ws too small: need %zu have %zu\n", off, ws_size); return; }
#if MULTI
  for (int ph = 0; ph < N_PHASES; ph++) hipLaunchKernelGGL(k_phase, dim3(512), dim3(256), 0, stream, p, ph);
#else
  static int grid_blocks = 0;
  if (!grid_blocks) {
    int dev = 0, cus = 0, per_cu = 0;
    hipGetDevice(&dev);
    hipDeviceGetAttribute(&cus, hipDeviceAttributeMultiprocessorCount, dev);
    hipOccupancyMaxActiveBlocksPerMultiprocessor(&per_cu, k_mega, 256, 0);
    if (per_cu > 2) per_cu = 2;
    grid_blocks = cus * per_cu;
  }
  hipMemsetAsync(p.ws + OFF_bar, 0, 16384, stream);
  void* args[] = {&p};
  hipError_t e = hipLaunchCooperativeKernel((void*)k_mega, dim3(grid_blocks), dim3(256), args, 0, stream);
  if (e != hipSuccess) fprintf(stderr, "cooperative launch failed: %s (grid %d)\n", hipGetErrorString(e), grid_blocks);
#endif
}
```

```cpp
#include <hip/hip_runtime.h>
#include <hip/hip_cooperative_groups.h>
#include <cstdio>
#include <cstdint>
namespace cg = cooperative_groups;

#ifndef MULTI
#define MULTI 0
#endif

typedef unsigned short bf16_t;
using bf16x8 = __attribute__((ext_vector_type(8))) short;
using f32x4 = __attribute__((ext_vector_type(4))) float;
using u32x4 = __attribute__((ext_vector_type(4))) unsigned int;

#define T_ALL 12288
#define T_CTX 8192
#define NEG_INF (-__builtin_inff())

__device__ __forceinline__ int tidx() {
  int t = threadIdx.x;
  asm volatile("" : "+v"(t));
  return t;
}
__device__ __forceinline__ bf16_t f2bf(float f) {
  unsigned u = __float_as_uint(f);
  u += 0x7fffu + ((u >> 16) & 1u);
  return (bf16_t)(u >> 16);
}
__device__ __forceinline__ float bf2f(bf16_t b) { return __uint_as_float(((unsigned)b) << 16); }
__device__ __forceinline__ float wsum_shfl(float v) {
#pragma unroll
  for (int o = 32; o; o >>= 1) v += __shfl_xor(v, o);
  return v;
}
#define DPP_F(old, src, ctrl, rm) __int_as_float(__builtin_amdgcn_update_dpp(__float_as_int(old), __float_as_int(src), ctrl, rm, 0xf, false))
__device__ __forceinline__ float wsum(float v) {
  v += DPP_F(v, v, 0xB1, 0xf);
  v += DPP_F(v, v, 0x4E, 0xf);
  v += DPP_F(v, v, 0x141, 0xf);
  v += DPP_F(v, v, 0x140, 0xf);
  v += DPP_F(0.f, v, 0x142, 0xa);
  v += DPP_F(0.f, v, 0x143, 0xc);
  return __int_as_float(__builtin_amdgcn_readlane(__float_as_int(v), 63));
}
__device__ __forceinline__ float wmax(float v) {
  v = fmaxf(v, DPP_F(v, v, 0xB1, 0xf));
  v = fmaxf(v, DPP_F(v, v, 0x4E, 0xf));
  v = fmaxf(v, DPP_F(v, v, 0x141, 0xf));
  v = fmaxf(v, DPP_F(v, v, 0x140, 0xf));
  v = fmaxf(v, DPP_F(v, v, 0x142, 0xa));
  v = fmaxf(v, DPP_F(v, v, 0x143, 0xc));
  return __int_as_float(__builtin_amdgcn_readlane(__float_as_int(v), 63));
}
__device__ __forceinline__ float siluf(float x) { return x * __builtin_amdgcn_rcpf(1.f + __expf(-x)); }
__device__ __forceinline__ float sigmf(float x) { return __builtin_amdgcn_rcpf(1.f + __expf(-x)); }
__device__ __forceinline__ float logsigf(float z) { return fminf(z, 0.f) - log1pf(__expf(-fabsf(z))); }
__device__ __forceinline__ int cond_row(int g) { return g < T_CTX ? 0 : 1 + ((g - T_CTX) >> 11); }

struct P {
  const float *x_prompt, *x_sample, *c, *cache_ckv, *cache_krope, *cache_swa_k, *cache_swa_v, *state_gla, *c_ctx,
      *w_ada, *b_ada, *w_in, *mla_q_norm, *w_uq, *mla_kv_norm, *w_ukv, *w_gla_a_fwd, *b_gla_a_fwd, *w_gla_a_bwd,
      *b_gla_a_bwd, *gla_norm, *swa_sink, *w_branch, *w_out, *ln1_g, *ln1_b, *ln2_g, *ln2_b, *w_peer_q, *peer_keys,
      *peer_u, *peer_v;
  float* out;
  char* ws;
};

constexpr size_t OFF_Wt_in = 0ull;
constexpr size_t OFF_Wt_uq = OFF_Wt_in + (((2ull * 6144 * 1024 * 2) + 255ull) & ~255ull);
constexpr size_t OFF_Wt_ukv = OFF_Wt_uq + (((2ull * 384 * 256 * 2) + 255ull) & ~255ull);
constexpr size_t OFF_Wt_br = OFF_Wt_ukv + (((2ull * 512 * 128 * 2) + 255ull) & ~255ull);
constexpr size_t OFF_Wt_out = OFF_Wt_br + (((8ull * 1024 * 256 * 2) + 255ull) & ~255ull);
constexpr size_t OFF_Wt_pq = OFF_Wt_out + (((2ull * 1024 * 1024 * 2) + 255ull) & ~255ull);
constexpr size_t OFF_keysbf = OFF_Wt_pq + (((2ull * 2048 * 1024 * 2) + 255ull) & ~255ull);
constexpr size_t OFF_Cch = OFF_keysbf + (((2ull * 16 * 128 * 128 * 2) + 255ull) & ~255ull);
constexpr size_t OFF_A256 = OFF_Cch + (((128ull * 64 * 2) + 255ull) & ~255ull);
constexpr size_t OFF_A2048 = OFF_A256 + (((256ull * 512 * 2) + 255ull) & ~255ull);
constexpr size_t OFF_mada = OFF_A2048 + (((2048ull * 4096 * 2) + 255ull) & ~255ull);
constexpr size_t OFF_xbuf = OFF_mada + (((2ull * 3 * 6144 * 4) + 255ull) & ~255ull);
constexpr size_t OFF_u = OFF_xbuf + 256ull;
constexpr size_t OFF_hbuf = OFF_u + (((12288ull * 1024 * 2) + 255ull) & ~255ull);
constexpr size_t OFF_gates = OFF_hbuf + (((12288ull * 1984 * 4) + 255ull) & ~255ull);
constexpr size_t OFF_qn = OFF_gates + (((12288ull * 4096 * 2) + 255ull) & ~255ull);
constexpr size_t OFF_ckv_all = OFF_qn + (((12288ull * 256 * 2) + 255ull) & ~255ull);
constexpr size_t OFF_Qa = OFF_ckv_all + (((13312ull * 128 * 2) + 255ull) & ~255ull);
constexpr size_t OFF_Ka_ctx = OFF_Qa + (((12288ull * 384 * 2) + 255ull) & ~255ull);
constexpr size_t OFF_Ka_lat = OFF_Ka_ctx + (((32ull * 4 * 256 * 96 * 2) + 255ull) & ~255ull);
constexpr size_t OFF_Va_ctx = OFF_Ka_lat + (((2ull * 4 * 2560 * 96 * 2) + 255ull) & ~255ull);
constexpr size_t OFF_Va_lat = OFF_Va_ctx + (((32ull * 4 * 256 * 64 * 2) + 255ull) & ~255ull);
constexpr size_t OFF_Qd = OFF_Va_lat + (((2ull * 4 * 2560 * 64 * 2) + 255ull) & ~255ull);
constexpr size_t OFF_Kd_ctx = OFF_Qd + (((12288ull * 256 * 2) + 255ull) & ~255ull);
constexpr size_t OFF_Kd_lat = OFF_Kd_ctx + (((32ull * 2 * 256 * 64 * 2) + 255ull) & ~255ull);
constexpr size_t OFF_Vd_ctx = OFF_Kd_lat + (((2ull * 2 * 2560 * 64 * 2) + 255ull) & ~255ull);
constexpr size_t OFF_Vd_lat = OFF_Vd_ctx + (((32ull * 2 * 256 * 64 * 2) + 255ull) & ~255ull);
constexpr size_t OFF_fnet = OFF_Vd_lat + (((2ull * 2 * 2560 * 64 * 2) + 255ull) & ~255ull);
constexpr size_t OFF_Yt_ctx = OFF_fnet + (((12288ull * 256 * 2) + 255ull) & ~255ull);
constexpr size_t OFF_Yt_lat = OFF_Yt_ctx + (((32ull * 256 * 512 * 2) + 255ull) & ~255ull);
constexpr size_t OFF_br = OFF_Yt_lat + (((2ull * 256 * 4096 * 2) + 255ull) & ~255ull);
constexpr size_t OFF_un = OFF_br + (((12288ull * 1024 * 2) + 255ull) & ~255ull);
constexpr size_t OFF_sin_ = OFF_un + (((1536ull * 2048 * 4) + 255ull) & ~255ull);
constexpr size_t OFF_gn = OFF_sin_ + (((1536ull * 2048 * 4) + 255ull) & ~255ull);
constexpr size_t OFF_pidx = OFF_gn + (((1536ull * 32 * 4) + 255ull) & ~255ull);
constexpr size_t OFF_pw = OFF_pidx + (((12288ull * 128 * 4) + 255ull) & ~255ull);
constexpr size_t OFF_bar = OFF_pw + (((12288ull * 128 * 4) + 255ull) & ~255ull);
constexpr size_t WS_TOTAL_OLD = OFF_pw + (((12288ull * 128 * 4) + 255ull) & ~255ull);
constexpr size_t OFF_tabU = OFF_bar + 16384ull;
constexpr size_t OFF_tabV = OFF_tabU + 2ull * 16384 * 1024;
constexpr size_t WS_TOTAL = OFF_tabV + 2ull * 16384 * 1024;
#define W_tabU ((unsigned char*)(p.ws + OFF_tabU))
#define W_tabV ((unsigned char*)(p.ws + OFF_tabV))
#define W_Wt_in ((bf16_t*)(p.ws + OFF_Wt_in))
#define W_Wt_uq ((bf16_t*)(p.ws + OFF_Wt_uq))
#define W_Wt_ukv ((bf16_t*)(p.ws + OFF_Wt_ukv))
#define W_Wt_br ((bf16_t*)(p.ws + OFF_Wt_br))
#define W_Wt_out ((bf16_t*)(p.ws + OFF_Wt_out))
#define W_Wt_pq ((bf16_t*)(p.ws + OFF_Wt_pq))
#define W_keysbf ((bf16_t*)(p.ws + OFF_keysbf))
#define W_Cch ((bf16_t*)(p.ws + OFF_Cch))
#define W_A256 ((bf16_t*)(p.ws + OFF_A256))
#define W_A2048 ((bf16_t*)(p.ws + OFF_A2048))
#define W_mada ((float*)(p.ws + OFF_mada))
#define W_xbuf ((float*)(p.ws + OFF_xbuf))
#define W_u ((bf16_t*)(p.ws + OFF_u))
#define W_hbuf ((float*)(p.ws + OFF_hbuf))
#define W_gates ((bf16_t*)(p.ws + OFF_gates))
#define W_qn ((bf16_t*)(p.ws + OFF_qn))
#define W_ckv_all ((bf16_t*)(p.ws + OFF_ckv_all))
#define W_Qa ((bf16_t*)(p.ws + OFF_Qa))
#define W_Ka_ctx ((bf16_t*)(p.ws + OFF_Ka_ctx))
#define W_Ka_lat ((bf16_t*)(p.ws + OFF_Ka_lat))
#define W_Va_ctx ((bf16_t*)(p.ws + OFF_Va_ctx))
#define W_Va_lat ((bf16_t*)(p.ws + OFF_Va_lat))
#define W_Qd ((bf16_t*)(p.ws + OFF_Qd))
#define W_Kd_ctx ((bf16_t*)(p.ws + OFF_Kd_ctx))
#define W_Kd_lat ((bf16_t*)(p.ws + OFF_Kd_lat))
#define W_Vd_ctx ((bf16_t*)(p.ws + OFF_Vd_ctx))
#define W_Vd_lat ((bf16_t*)(p.ws + OFF_Vd_lat))
#define W_fnet ((bf16_t*)(p.ws + OFF_fnet))
#define W_Yt_ctx ((bf16_t*)(p.ws + OFF_Yt_ctx))
#define W_Yt_lat ((bf16_t*)(p.ws + OFF_Yt_lat))
#define W_br ((bf16_t*)(p.ws + OFF_br))
#define W_un ((float*)(p.ws + OFF_un))
#define W_sin_ ((float*)(p.ws + OFF_sin_))
#define W_gn ((float*)(p.ws + OFF_gn))
#define W_pidx ((int*)(p.ws + OFF_pidx))
#define W_pw ((float*)(p.ws + OFF_pw))

#define GB_LD 72
#define G_LOAD(RA, RB, KOFF)                                                         \
  _Pragma("unroll") for (int i = 0; i < 4; i++) {                                    \
    int c = tid + i * 256, r = c >> 3, cc = (c & 7) * 8;                             \
    RA[i] = *(const u32x4*)(A + (size_t)r * lda + (KOFF) + cc);                      \
    if (i < NJ) RB[i] = *(const u32x4*)(B + (size_t)r * ldb + (KOFF) + cc);          \
  }
#define G_STORE(RA, RB)                                                              \
  _Pragma("unroll") for (int i = 0; i < 4; i++) {                                    \
    int c = tid + i * 256, r = c >> 3, cc = (c & 7) * 8;                             \
    *(u32x4*)(sa + r * GB_LD + cc) = RA[i];                                          \
    if (i < NJ) *(u32x4*)(sb + r * GB_LD + cc) = RB[i];                              \
  }
#define G_COMPUTE()                                                                  \
  _Pragma("unroll") for (int ks = 0; ks < 2; ks++) {                                 \
    bf16x8 af[4], bfr[NJ];                                                           \
    _Pragma("unroll") for (int i = 0; i < 4; i++)                                    \
      af[i] = *(const bf16x8*)(sa + (wm * 64 + i * 16 + l15) * GB_LD + ks * 32 + l4 * 8); \
    _Pragma("unroll") for (int j = 0; j < NJ; j++)                                   \
      bfr[j] = *(const bf16x8*)(sb + (wn * NJ * 16 + j * 16 + l15) * GB_LD + ks * 32 + l4 * 8); \
    _Pragma("unroll") for (int i = 0; i < 4; i++)                                    \
    _Pragma("unroll") for (int j = 0; j < NJ; j++)                                   \
      acc[i][j] = __builtin_amdgcn_mfma_f32_16x16x32_bf16(af[i], bfr[j], acc[i][j], 0, 0, 0); \
  }
template <int NJ>
__device__ __forceinline__ void gemm_core_t(f32x4 (&acc)[4][NJ], const bf16_t* __restrict__ A, int lda,
                                            const bf16_t* __restrict__ B, int ldb, int K, char* smem) {
  bf16_t* sa = (bf16_t*)smem;
  bf16_t* sb = sa + 128 * GB_LD;
  const int tid = tidx(), lane = tid & 63, w = tid >> 6, wm = w >> 1, wn = w & 1;
  const int l15 = lane & 15, l4 = lane >> 4;
  u32x4 ra0[4], rb0[NJ], ra1[4], rb1[NJ];
  G_LOAD(ra0, rb0, 0);
  if (K > 64) { G_LOAD(ra1, rb1, 64); }
  for (int k0 = 0; k0 < K; k0 += 128) {
    __syncthreads();
    G_STORE(ra0, rb0);
    __syncthreads();
    if (k0 + 128 < K) { G_LOAD(ra0, rb0, k0 + 128); }
    G_COMPUTE();
    if (k0 + 64 < K) {
      __syncthreads();
      G_STORE(ra1, rb1);
      __syncthreads();
      if (k0 + 192 < K) { G_LOAD(ra1, rb1, k0 + 192); }
      G_COMPUTE();
    }
  }
}
#define gemm_core gemm_core_t<4>
#define ZERO_ACC_N(acc, NJ)                                        \
  _Pragma("unroll") for (int i_ = 0; i_ < 4; i_++)                 \
  _Pragma("unroll") for (int j_ = 0; j_ < NJ; j_++) { acc[i_][j_] = f32x4{0.f, 0.f, 0.f, 0.f}; }
#define ZERO_ACC(acc) ZERO_ACC_N(acc, 4)
#define EPI_LOOP_N(acc, m0, n0, NJ, ...)                                                   \
  {                                                                                        \
    const int lane_ = tidx() & 63, w_ = tidx() >> 6, wm_ = w_ >> 1, wn_ = w_ & 1; \
    _Pragma("unroll") for (int i_ = 0; i_ < 4; i_++)                                       \
    _Pragma("unroll") for (int j_ = 0; j_ < NJ; j_++)                                      \
    _Pragma("unroll") for (int r_ = 0; r_ < 4; r_++) {                                     \
      const int m = (m0) + wm_ * 64 + i_ * 16 + (lane_ >> 4) * 4 + r_;                     \
      const int n = (n0) + wn_ * (NJ * 16) + j_ * 16 + (lane_ & 15);                       \
      float v = acc[i_][j_][r_];                                                           \
      __VA_ARGS__                                                                          \
    }                                                                                      \
  }
#define EPI_LOOP(acc, m0, n0, ...) EPI_LOOP_N(acc, m0, n0, 4, __VA_ARGS__)
#define EPI4_LOOP(acc, c0, t0, ...)                                                        \
  {                                                                                        \
    const int lane_ = tidx() & 63, w_ = tidx() >> 6, wm_ = w_ >> 1, wn_ = w_ & 1;           \
    _Pragma("unroll") for (int i_ = 0; i_ < 4; i_++)                                       \
    _Pragma("unroll") for (int j_ = 0; j_ < 4; j_++) {                                     \
      const int col = (c0) + wm_ * 64 + i_ * 16 + (lane_ >> 4) * 4;                        \
      const int tok = (t0) + wn_ * 64 + j_ * 16 + (lane_ & 15);                            \
      const f32x4 v4 = acc[i_][j_];                                                        \
      __VA_ARGS__                                                                          \
    }                                                                                      \
  }

__device__ __forceinline__ void transpose_tile(const float* __restrict__ src, int K, int N, bf16_t* __restrict__ dst, int tile, int ntn,
                               float* sm) {
  int kt = tile / ntn, nt = tile % ntn, k0 = kt * 64, n0 = nt * 64;
  int tx = tidx() & 63, ty = tidx() >> 6;
  __syncthreads();
  for (int i = 0; i < 16; i++) {
    int k = i * 4 + ty, n = n0 + tx;
    sm[k * 65 + tx] = (n < N) ? src[(size_t)(k0 + k) * N + n] : 0.f;
  }
  __syncthreads();
  for (int i = 0; i < 16; i++) {
    int n = i * 4 + ty;
    dst[(size_t)(n0 + n) * K + k0 + tx] = f2bf(sm[tx * 65 + n]);
  }
}

__device__ __forceinline__ void ada_item(const P& p, int item, float* sm) {
  int l = item / 24, cgp = item % 24;
  int lane = tidx() & 63, w = tidx() >> 6;
  const float* W = p.w_ada + (size_t)l * 1024 * 6144 + cgp * 256 + lane * 4;
  float4 a0 = {0, 0, 0, 0}, a1 = {0, 0, 0, 0}, a2 = {0, 0, 0, 0};
#pragma unroll 8
  for (int k = w * 256; k < (w + 1) * 256; k++) {
    float4 wv = *(const float4*)(W + (size_t)k * 6144);
    float c0 = siluf(p.c_ctx[k]), c1 = siluf(p.c[k]), c2 = siluf(p.c[1024 + k]);
    a0.x += c0 * wv.x; a0.y += c0 * wv.y; a0.z += c0 * wv.z; a0.w += c0 * wv.w;
    a1.x += c1 * wv.x; a1.y += c1 * wv.y; a1.z += c1 * wv.z; a1.w += c1 * wv.w;
    a2.x += c2 * wv.x; a2.y += c2 * wv.y; a2.z += c2 * wv.z; a2.w += c2 * wv.w;
  }
  __syncthreads();
  *(float4*)(sm + (w * 3 + 0) * 256 + lane * 4) = a0;
  *(float4*)(sm + (w * 3 + 1) * 256 + lane * 4) = a1;
  *(float4*)(sm + (w * 3 + 2) * 256 + lane * 4) = a2;
  __syncthreads();
  for (int o = tidx(); o < 768; o += 256) {
    int r = o >> 8, col = o & 255;
    float s = sm[(0 * 3 + r) * 256 + col] + sm[(1 * 3 + r) * 256 + col] + sm[(2 * 3 + r) * 256 + col] +
              sm[(3 * 3 + r) * 256 + col];
    W_mada[(l * 3 + r) * 6144 + cgp * 256 + col] = s + p.b_ada[l * 6144 + cgp * 256 + col];
  }
}

__device__ __forceinline__ void dft_seq_fill(bf16_t* dst, int S, int item) {
  float inv = rsqrtf((float)S);
  size_t base = (size_t)item * 2048;
  for (int e = 0; e < 8; e++) {
    size_t idx = base + e * 256 + tidx();
    int k = (int)(idx / (2 * S)), col = (int)(idx % (2 * S));
    int s = col < S ? col : col - S;
    int mm = (k * s) & (S - 1);
    float rev = (float)mm / (float)S;
    float v = col < S ? __builtin_amdgcn_cosf(rev) : -__builtin_amdgcn_sinf(rev);
    dst[idx] = f2bf(v * inv);
  }
}

#define PEER_U_SCALE 64.f
#define PEER_V_SCALE 16.f
__device__ __forceinline__ void tab_convert_item(const P& p, int item) {
  int l = item >> 12, isv = (item >> 11) & 1, sub = item & 2047;
  const float* src = (isv ? p.peer_v : p.peer_u) + (size_t)l * 16384 * 1024 + (size_t)sub * 8192;
  unsigned char* dst = (isv ? W_tabV : W_tabU) + (size_t)l * 16384 * 1024 + (size_t)sub * 8192;
  const float sc = isv ? PEER_V_SCALE : PEER_U_SCALE;
  int tid = tidx();
  float4 tt[8];
#pragma unroll
  for (int e = 0; e < 8; e++) tt[e] = *(const float4*)(src + (e * 256 + tid) * 4);
#pragma unroll
  for (int e = 0; e < 8; e++) {
    float4 t = tt[e];
    int pk = __builtin_amdgcn_cvt_pk_fp8_f32(t.x * sc, t.y * sc, 0, false);
    pk = __builtin_amdgcn_cvt_pk_fp8_f32(t.z * sc, t.w * sc, pk, true);
    *(int*)(dst + (e * 256 + tid) * 4) = pk;
  }
}

__device__ __forceinline__ void phase_prep(const P& p, char* smem) {
  float* sm = (float*)smem;
  const int nb = gridDim.x;
  const int J_ADA = 48;
  const int J_IN = 2 * 16 * 96;
  const int J_UQ = 2 * 4 * 6;
  const int J_UKV = 2 * 2 * 8;
  const int J_BR = 2 * 4 * 4 * 16;
  const int J_OUT = 2 * 16 * 16;
  const int J_PQ = 2 * 16 * 32;
  const int J_KEYS = 256;
  const int J_CCH = 4;
  const int J_A256 = 64;
  const int J_A2048 = 4096;
  const int J_TAB = 8192;
  const int total = J_ADA + J_IN + J_UQ + J_UKV + J_BR + J_OUT + J_PQ + J_KEYS + J_CCH + J_A256 + J_A2048 + J_TAB;
  for (int it0 = blockIdx.x; it0 < total; it0 += nb) {
    int it = it0;
    if (it < J_ADA) { ada_item(p, it, sm); continue; }
    it -= J_ADA;
    if (it < J_IN) { int l = it / 1536, t = it % 1536; transpose_tile(p.w_in + (size_t)l * 1024 * 6080, 1024, 6080, W_Wt_in + (size_t)l * 6144 * 1024, t, 96, sm); continue; }
    it -= J_IN;
    if (it < J_UQ) { int l = it / 24, t = it % 24; transpose_tile(p.w_uq + (size_t)l * 256 * 384, 256, 384, W_Wt_uq + (size_t)l * 384 * 256, t, 6, sm); continue; }
    it -= J_UQ;
    if (it < J_UKV) { int l = it / 16, t = it % 16; transpose_tile(p.w_ukv + (size_t)l * 128 * 512, 128, 512, W_Wt_ukv + (size_t)l * 512 * 128, t, 8, sm); continue; }
    it -= J_UKV;
    if (it < J_BR) { int lb = it / 64, t = it % 64; transpose_tile(p.w_branch + (size_t)lb * 256 * 1024, 256, 1024, W_Wt_br + (size_t)lb * 1024 * 256, t, 16, sm); continue; }
    it -= J_BR;
    if (it < J_OUT) { int l = it / 256, t = it % 256; transpose_tile(p.w_out + (size_t)l * 1024 * 1024, 1024, 1024, W_Wt_out + (size_t)l * 1024 * 1024, t, 16, sm); continue; }
    it -= J_OUT;
    if (it < J_PQ) { int l = it / 512, t = it % 512; transpose_tile(p.w_peer_q + (size_t)l * 1024 * 2048, 1024, 2048, W_Wt_pq + (size_t)l * 2048 * 1024, t, 32, sm); continue; }
    it -= J_PQ;
    if (it < J_KEYS) {
      size_t base = (size_t)it * 2048;
      float kv_[8];
#pragma unroll
      for (int e = 0; e < 8; e++) kv_[e] = p.peer_keys[base + e * 256 + tidx()];
#pragma unroll
      for (int e = 0; e < 8; e++) W_keysbf[base + e * 256 + tidx()] = f2bf(kv_[e]);
      continue;
    }
    it -= J_KEYS;
    if (it < J_CCH) {
      for (int e = 0; e < 8; e++) {
        int idx = it * 2048 + e * 256 + tidx();
        int n = idx >> 6, c = idx & 63;
        int j = n & 63;
        float rev = (float)((j * c) & 63) / 64.f;
        float v = n < 64 ? __builtin_amdgcn_cosf(rev) : __builtin_amdgcn_sinf(rev);
        W_Cch[idx] = f2bf(v * 0.125f);
      }
      continue;
    }
    it -= J_CCH;
    if (it < J_A256) { dft_seq_fill(W_A256, 256, it); continue; }
    it -= J_A256;
    if (it < J_A2048) { dft_seq_fill(W_A2048, 2048, it); continue; }
    it -= J_A2048;
    tab_convert_item(p, it);
  }
}

__device__ __forceinline__ void load_row16(const float* row, int lane, float (&v)[16]) {
#pragma unroll
  for (int q = 0; q < 4; q++) {
    float4 t = *(const float4*)(row + q * 256 + lane * 4);
    v[q * 4 + 0] = t.x; v[q * 4 + 1] = t.y; v[q * 4 + 2] = t.z; v[q * 4 + 3] = t.w;
  }
}
__device__ __forceinline__ void store_row16(float* row, int lane, const float (&v)[16]) {
#pragma unroll
  for (int q = 0; q < 4; q++) *(float4*)(row + q * 256 + lane * 4) = float4{v[q * 4], v[q * 4 + 1], v[q * 4 + 2], v[q * 4 + 3]};
}
__device__ __forceinline__ void ln16(float (&v)[16]) {
  float s = 0;
#pragma unroll
  for (int i = 0; i < 16; i++) s += v[i];
  s = wsum(s);
  float mu = s * (1.f / 1024.f);
  float q = 0;
#pragma unroll
  for (int i = 0; i < 16; i++) { v[i] -= mu; q += v[i] * v[i]; }
  q = wsum(q);
  float rs = rsqrtf(q * (1.f / 1024.f) + 1e-6f);
#pragma unroll
  for (int i = 0; i < 16; i++) v[i] *= rs;
}
__device__ __forceinline__ void modulate_store(const float (&v)[16], const float* sh, const float* sc, bf16_t* dst, int lane) {
#pragma unroll
  for (int q = 0; q < 4; q++) {
    float4 a = *(const float4*)(sc + q * 256 + lane * 4);
    float4 b = *(const float4*)(sh + q * 256 + lane * 4);
    ushort4 o;
    o.x = f2bf(v[q * 4 + 0] * (1.f + a.x) + b.x);
    o.y = f2bf(v[q * 4 + 1] * (1.f + a.y) + b.y);
    o.z = f2bf(v[q * 4 + 2] * (1.f + a.z) + b.z);
    o.w = f2bf(v[q * 4 + 3] * (1.f + a.w) + b.w);
    *(ushort4*)(dst + q * 256 + lane * 4) = o;
  }
}
__device__ __forceinline__ void affine16(float (&v)[16], const float* g, const float* b, int lane) {
#pragma unroll
  for (int q = 0; q < 4; q++) {
    float4 a = *(const float4*)(g + q * 256 + lane * 4);
    float4 c = *(const float4*)(b + q * 256 + lane * 4);
    v[q * 4 + 0] = v[q * 4 + 0] * a.x + c.x;
    v[q * 4 + 1] = v[q * 4 + 1] * a.y + c.y;
    v[q * 4 + 2] = v[q * 4 + 2] * a.z + c.z;
    v[q * 4 + 3] = v[q * 4 + 3] * a.w + c.w;
  }
}
__device__ __forceinline__ const float* x_in_row(const P& p, int l, int g) {
  if (l == 0) return g < T_CTX ? p.x_prompt + (size_t)g * 1024 : p.x_sample + (size_t)(g - T_CTX) * 1024;
  return p.out + (size_t)g * 1024;
}
__device__ __forceinline__ float* x_out_row(const P& p, int l, int g) {
  return p.out + (size_t)g * 1024;
}

__device__ __forceinline__ void phase_ln0(const P& p) {
  int lane = tidx() & 63, w = tidx() >> 6;
  for (int it = blockIdx.x; it < T_ALL / 4; it += gridDim.x) {
    int g = it * 4 + w;
    float v[16];
    load_row16(x_in_row(p, 0, g), lane, v);
    ln16(v);
    const float* m = W_mada + (0 * 3 + cond_row(g)) * 6144;
    modulate_store(v, m, m + 1024, W_u + (size_t)g * 1024, lane);
  }
}

__device__ __forceinline__ void phase_win(const P& p, int l, char* smem) {
  const bf16_t* Wt = W_Wt_in + (size_t)l * 6144 * 1024;
  for (int tile = blockIdx.x; tile < 96 * 48; tile += gridDim.x) {
    int mt = tile / 48, nt = tile % 48, m0 = mt * 128, n0 = nt * 128;
    f32x4 acc[4][4];
    ZERO_ACC(acc);
    gemm_core(acc, Wt + (size_t)n0 * 1024, 1024, W_u + (size_t)m0 * 1024, 1024, 1024, smem);
    EPI4_LOOP(acc, n0, m0, {
      if (col < 1984) *(float4*)(W_hbuf + (size_t)tok * 1984 + col) = float4{v4[0], v4[1], v4[2], v4[3]};
      else if (col < 6080) {
        ushort4 o_; o_.x = f2bf(sigmf(v4[0])); o_.y = f2bf(sigmf(v4[1])); o_.z = f2bf(sigmf(v4[2])); o_.w = f2bf(sigmf(v4[3]));
        *(ushort4*)(W_gates + (size_t)tok * 4096 + (col - 1984)) = o_;
      }
    });
  }
}

__device__ __forceinline__ void rope_cs(float pos, int i, float inv_hp, float& cs, float& sn) {
  float freq = exp2f(-(float)i * inv_hp * 13.287712379549449f);
  float a = pos * freq;
  sn = __sinf(a);
  cs = __cosf(a);
}

__device__ __forceinline__ void phase_post(const P& p, int l) {
  int lane = tidx() & 63, w = tidx() >> 6;
  for (int it = blockIdx.x; it < 13312 / 4; it += gridDim.x) {
    int g = it * 4 + w;
    if (g < T_ALL) {
      const bool lat = g >= T_CTX;
      int b, s;
      if (!lat) { b = g >> 8; s = g & 255; } else { b = (g - T_CTX) >> 11; s = (g - T_CTX) & 2047; }
      const float* h = W_hbuf + (size_t)g * 1984;
      const float prow = (float)(s >> 6), pcol = (float)(s & 63);
      const float4 pl_q = *(const float4*)(h + lane * 4);
      const float2 pl_c = *(const float2*)(h + 256 + lane * 2);
      const float pl_kr1 = h[384 + ((lane >> 3) & 1) * 16 + (lane & 7)], pl_kr2 = h[384 + ((lane >> 3) & 1) * 16 + 8 + (lane & 7)];
      const float4 pl_f = *(const float4*)(h + 416 + lane * 4);
      float pl_sq1[2], pl_sq2[2];
#pragma unroll
      for (int jj = 0; jj < 2; jj++) {
        int pi = lane + 64 * jj, hq = pi >> 5, pp = (pi >> 4) & 1, i = pi & 15;
        pl_sq1[jj] = h[1472 + hq * 64 + pp * 32 + i]; pl_sq2[jj] = h[1472 + hq * 64 + pp * 32 + 16 + i];
      }
      const float pl_sk1 = h[1728 + (lane >> 5) * 64 + ((lane >> 4) & 1) * 32 + (lane & 15)];
      const float pl_sk2 = h[1728 + (lane >> 5) * 64 + ((lane >> 4) & 1) * 32 + 16 + (lane & 15)];
      const float2 pl_v = *(const float2*)(h + 1856 + lane * 2);
      {
        float4 t = pl_q;
        float ss = wsum(t.x * t.x + t.y * t.y + t.z * t.z + t.w * t.w);
        float rs = rsqrtf(ss * (1.f / 256.f) + 1e-6f);
        float4 gq = *(const float4*)(p.mla_q_norm + l * 256 + lane * 4);
        ushort4 o;
        o.x = f2bf(t.x * rs * gq.x); o.y = f2bf(t.y * rs * gq.y); o.z = f2bf(t.z * rs * gq.z); o.w = f2bf(t.w * rs * gq.w);
        *(ushort4*)(W_qn + (size_t)g * 256 + lane * 4) = o;
      }
      {
        float2 t = pl_c;
        float ss = wsum(t.x * t.x + t.y * t.y);
        float rs = rsqrtf(ss * (1.f / 128.f) + 1e-6f);
        float2 gk = *(const float2*)(p.mla_kv_norm + l * 128 + lane * 2);
        float v0 = t.x * rs * gk.x, v1 = t.y * rs * gk.y;
        ushort2 o; o.x = f2bf(v0); o.y = f2bf(v1);
        *(ushort2*)(W_ckv_all + (size_t)g * 128 + lane * 2) = o;
        if (!lat) *(float2*)(p.out + 12582912 + ((size_t)((b * 2 + l) * 256 + s)) * 128 + lane * 2) = float2{v0, v1};
      }
      if (lane < 16) {
        int pp = lane >> 3, i = lane & 7;
        float x1 = pl_kr1, x2 = pl_kr2;
        float o1 = x1, o2 = x2;
        if (lat) {
          float cs, sn;
          rope_cs(pp ? pcol : prow, i, 0.125f, cs, sn);
          o1 = x1 * cs - x2 * sn; o2 = x2 * cs + x1 * sn;
        } else {
          float* ok = p.out + 14680064 + ((size_t)((b * 2 + l) * 256 + s)) * 32 + pp * 16 + i;
          ok[0] = o1; ok[8] = o2;
        }
        bf16_t b1 = f2bf(o1), b2 = f2bf(o2);
        for (int hh = 0; hh < 4; hh++) {
          bf16_t* kd = lat ? W_Ka_lat + ((size_t)((b * 4 + hh) * 2560 + 512 + s)) * 96 : W_Ka_ctx + ((size_t)((b * 4 + hh) * 256 + s)) * 96;
          kd[64 + pp * 16 + i] = b1; kd[64 + pp * 16 + 8 + i] = b2;
        }
      }
      {
        float4 t = pl_f;
        ushort4 o; o.x = f2bf(t.x); o.y = f2bf(t.y); o.z = f2bf(t.z); o.w = f2bf(t.w);
        *(ushort4*)(W_fnet + (size_t)g * 256 + lane * 4) = o;
      }
#pragma unroll
      for (int jj = 0; jj < 2; jj++) {
        int pi = lane + 64 * jj, hq = pi >> 5, pp = (pi >> 4) & 1, i = pi & 15;
        float x1 = pl_sq1[jj], x2 = pl_sq2[jj];
        float o1 = x1, o2 = x2;
        if (lat) {
          float cs, sn;
          rope_cs(pp ? pcol : prow, i, 0.0625f, cs, sn);
          o1 = x1 * cs - x2 * sn; o2 = x2 * cs + x1 * sn;
        }
        bf16_t* qd = W_Qd + (size_t)g * 256 + hq * 64 + pp * 32 + i;
        qd[0] = f2bf(o1); qd[16] = f2bf(o2);
      }
      {
        int kv = lane >> 5, pp = (lane >> 4) & 1, i = lane & 15;
        float x1 = pl_sk1, x2 = pl_sk2;
        float o1 = x1, o2 = x2;
        bf16_t* kd;
        if (lat) {
          float cs, sn;
          rope_cs(pp ? pcol : prow, i, 0.0625f, cs, sn);
          o1 = x1 * cs - x2 * sn; o2 = x2 * cs + x1 * sn;
          kd = W_Kd_lat + ((size_t)((b * 2 + kv) * 2560 + 512 + s)) * 64;
        } else {
          float* ok = p.out + 15204352 + ((size_t)(((b * 2 + l) * 2 + kv) * 256 + s)) * 64 + pp * 32 + i;
          ok[0] = o1; ok[16] = o2;
          kd = W_Kd_ctx + ((size_t)((b * 2 + kv) * 256 + s)) * 64;
        }
        kd[pp * 32 + i] = f2bf(o1); kd[pp * 32 + 16 + i] = f2bf(o2);
      }
      {
        int e = lane * 2, kv = e >> 6, d = e & 63;
        float2 t = pl_v;
        if (lat) {
          bf16_t* vt = W_Vd_lat + (size_t)(b * 2 + kv) * 64 * 2560 + 512 + s;
          vt[(size_t)d * 2560] = f2bf(t.x); vt[(size_t)(d + 1) * 2560] = f2bf(t.y);
        } else {
          *(float2*)(p.out + 17301504 + ((size_t)(((b * 2 + l) * 2 + kv) * 256 + s)) * 64 + d) = t;
          bf16_t* vt = W_Vd_ctx + (size_t)(b * 2 + kv) * 64 * 256 + s;
          vt[d * 256] = f2bf(t.x); vt[(d + 1) * 256] = f2bf(t.y);
        }
      }
    } else {
      int gc = g - T_ALL, b = gc >> 9, pp = gc & 511;
      {
        float2 t = *(const float2*)(p.cache_ckv + ((size_t)((b * 2 + l) * 512 + pp)) * 128 + lane * 2);
        ushort2 o; o.x = f2bf(t.x); o.y = f2bf(t.y);
        *(ushort2*)(W_ckv_all + (size_t)g * 128 + lane * 2) = o;
      }
      if (lane < 32) {
        bf16_t v = f2bf(p.cache_krope[((size_t)((b * 2 + l) * 512 + pp)) * 32 + lane]);
        for (int hh = 0; hh < 4; hh++) W_Ka_lat[((size_t)((b * 4 + hh) * 2560 + pp)) * 96 + 64 + lane] = v;
      }
      {
        int e = lane * 2, kv = e >> 6, d = e & 63;
        size_t src = ((size_t)(((b * 2 + l) * 2 + kv) * 512 + pp)) * 64 + d;
        float2 tk = *(const float2*)(p.cache_swa_k + src);
        float2 tv = *(const float2*)(p.cache_swa_v + src);
        size_t dst = ((size_t)((b * 2 + kv) * 2560 + pp)) * 64 + d;
        ushort2 ok; ok.x = f2bf(tk.x); ok.y = f2bf(tk.y);
        *(ushort2*)(W_Kd_lat + dst) = ok;
        bf16_t* vt = W_Vd_lat + (size_t)(b * 2 + kv) * 64 * 2560 + pp;
        vt[(size_t)d * 2560] = f2bf(tv.x); vt[(size_t)(d + 1) * 2560] = f2bf(tv.y);
      }
    }
  }
}

__device__ __forceinline__ void phase_small_gemms(const P& p, int l, char* smem) {
  const int NA = 96 * 3, NB = 104 * 4, NC = 384;
  for (int it0 = blockIdx.x; it0 < NA + NB + NC; it0 += gridDim.x) {
    int it = it0;
    f32x4 acc[4][4];
    ZERO_ACC(acc);
    if (it < NA) {
      int mt = it / 3, nt = it % 3, m0 = mt * 128, n0 = nt * 128;
      gemm_core(acc, W_qn + (size_t)m0 * 256, 256, W_Wt_uq + (size_t)l * 384 * 256 + (size_t)n0 * 256, 256, 256, smem);
      const bool lat = m0 >= T_CTX;
      EPI_LOOP(acc, m0, n0, {
        int c96 = n % 96;
        if (lat && c96 >= 64) {
          float pv = DPP_F(v, v, 0x128, 0xf);
          int cr = c96 - 64, pp = cr >> 4, ii = cr & 15, i = ii & 7;
          int s = (m - T_CTX) & 2047;
          float cs, sn;
          rope_cs(pp ? (float)(s & 63) : (float)(s >> 6), i, 0.125f, cs, sn);
          v = (ii < 8) ? v * cs - pv * sn : v * cs + pv * sn;
        }
        W_Qa[(size_t)m * 384 + n] = f2bf(v);
      });
      continue;
    }
    it -= NA;
    if (it < NB) {
      int mt = it / 4, nt = it % 4, m0 = mt * 128, n0 = nt * 128;
      gemm_core(acc, W_ckv_all + (size_t)m0 * 128, 128, W_Wt_ukv + (size_t)l * 512 * 128 + (size_t)n0 * 128, 128, 128, smem);
      EPI_LOOP(acc, m0, n0, {
        int hh = n >> 7, c = n & 127;
        bf16_t* kd; bf16_t* vd; int vstride;
        if (m < T_CTX) {
          int b = m >> 8, s = m & 255;
          size_t r = (size_t)((b * 4 + hh) * 256 + s);
          kd = W_Ka_ctx + r * 96; vd = W_Va_ctx + (size_t)(b * 4 + hh) * 64 * 256 + s; vstride = 256;
        } else {
          int b, pos;
          if (m < T_ALL) { b = (m - T_CTX) >> 11; pos = 512 + ((m - T_CTX) & 2047); }
          else { b = (m - T_ALL) >> 9; pos = (m - T_ALL) & 511; }
          size_t r = (size_t)((b * 4 + hh) * 2560 + pos);
          kd = W_Ka_lat + r * 96; vd = W_Va_lat + (size_t)(b * 4 + hh) * 64 * 2560 + pos; vstride = 2560;
        }
        if (c < 64) kd[c] = f2bf(v); else vd[(size_t)(c - 64) * vstride] = f2bf(v);
      });
      continue;
    }
    it -= NB;
    {
      int m0 = it * 128;
      gemm_core(acc, W_fnet + (size_t)m0 * 64, 64, W_Cch, 64, 64, smem);
      EPI_LOOP(acc, m0, 0, {
        int g = m >> 2, grp = m & 3, part = n >> 6, j = n & 63;
        if (g < T_CTX) {
          int b = g >> 8, s = g & 255;
          W_Yt_ctx[((size_t)(b * 256 + grp * 64 + j)) * 512 + part * 256 + s] = f2bf(v);
        } else {
          int b = (g - T_CTX) >> 11, s = (g - T_CTX) & 2047;
          W_Yt_lat[((size_t)(b * 256 + grp * 64 + j)) * 4096 + part * 2048 + s] = f2bf(v);
        }
      });
    }
  }
}

template <int DK>
__device__ __forceinline__ void attn_item(const bf16_t* __restrict__ Qp, int qstride, const bf16_t* __restrict__ Kp,
                          const bf16_t* __restrict__ Vp, bf16_t* __restrict__ Op, int q0, int Sk, int n_ctx, int W,
                          float scale, bool has_sink, float sink, char* smem) {
  constexpr int KLD = DK + 8;
  bf16_t* sK = (bf16_t*)smem;
  bf16_t* sVt = sK + 64 * KLD;
  bf16_t* sP = sVt + 64 * 72;
  const int tid = tidx(), lane = tid & 63, w = tid >> 6, l15 = lane & 15, l4 = lane >> 4;
  bf16_t* sPw = sP + w * 16 * 72;
  bf16x8 qf[DK / 32];
  {
    const bf16_t* qrow = Qp + (size_t)(q0 + w * 16 + l15) * qstride;
#pragma unroll
    for (int ks = 0; ks < DK / 32; ks++) qf[ks] = *(const bf16x8*)(qrow + ks * 32 + l4 * 8);
  }
  f32x4 o[4];
#pragma unroll
  for (int j = 0; j < 4; j++) o[j] = f32x4{0.f, 0.f, 0.f, 0.f};
  float mrow[4], lrow[4];
#pragma unroll
  for (int r = 0; r < 4; r++) { mrow[r] = NEG_INF; lrow[r] = 0.f; }
  const int ntile = Sk >> 6;
  auto tile_ok = [&](int kt) -> bool {
    int kb = kt * 64;
    if (W >= 0 && kb >= n_ctx) { int lp = kb - n_ctx; if (lp + 63 < q0 - W || lp > q0 + 63 + W) return false; }
    return true;
  };
  u32x4 rk[DK / 32], rv[2];
  int kt = 0;
  while (kt < ntile && !tile_ok(kt)) kt++;
  if (kt < ntile) {
#pragma unroll
    for (int i = 0; i < DK / 32; i++) { int c = tid + i * 256, r = c / (DK / 8), cc = (c % (DK / 8)) * 8; rk[i] = *(const u32x4*)(Kp + (size_t)(kt * 64 + r) * DK + cc); }
#pragma unroll
    for (int i = 0; i < 2; i++) { int c = tid + i * 256, dv = c >> 3, k0 = (c & 7) * 8; rv[i] = *(const u32x4*)(Vp + (size_t)dv * Sk + kt * 64 + k0); }
  }
  while (kt < ntile) {
    const int kbase = kt * 64;
    __syncthreads();
#pragma unroll
    for (int i = 0; i < DK / 32; i++) { int c = tid + i * 256, r = c / (DK / 8), cc = (c % (DK / 8)) * 8; *(u32x4*)(sK + r * KLD + cc) = rk[i]; }
#pragma unroll
    for (int i = 0; i < 2; i++) {
      int c = tid + i * 256, dv = c >> 3, k0 = (c & 7) * 8;
      *(u32x4*)(sVt + dv * 72 + k0) = rv[i];
    }
    __syncthreads();
    int ktn = kt + 1;
    while (ktn < ntile && !tile_ok(ktn)) ktn++;
    if (ktn < ntile) {
#pragma unroll
      for (int i = 0; i < DK / 32; i++) { int c = tid + i * 256, r = c / (DK / 8), cc = (c % (DK / 8)) * 8; rk[i] = *(const u32x4*)(Kp + (size_t)(ktn * 64 + r) * DK + cc); }
#pragma unroll
      for (int i = 0; i < 2; i++) { int c = tid + i * 256, dv = c >> 3, k0 = (c & 7) * 8; rv[i] = *(const u32x4*)(Vp + (size_t)dv * Sk + ktn * 64 + k0); }
    }
    kt = ktn;
    f32x4 s[4];
#pragma unroll
    for (int j = 0; j < 4; j++) {
      s[j] = f32x4{0.f, 0.f, 0.f, 0.f};
#pragma unroll
      for (int ks = 0; ks < DK / 32; ks++) {
        bf16x8 kf = *(const bf16x8*)(sK + (j * 16 + l15) * KLD + ks * 32 + l4 * 8);
        s[j] = __builtin_amdgcn_mfma_f32_16x16x32_bf16(qf[ks], kf, s[j], 0, 0, 0);
      }
    }
#pragma unroll
    for (int j = 0; j < 4; j++)
#pragma unroll
      for (int r = 0; r < 4; r++) {
        float v = s[j][r] * scale;
        if (W >= 0) {
          int kk = kbase + j * 16 + l15, t = q0 + w * 16 + l4 * 4 + r;
          int dlt = kk - n_ctx - t;
          bool valid = (kk < n_ctx) || (dlt <= W && dlt >= -W);
          if (!valid) v = NEG_INF;
        }
        s[j][r] = v;
      }
#pragma unroll
    for (int r = 0; r < 4; r++) {
      float mx = fmaxf(fmaxf(s[0][r], s[1][r]), fmaxf(s[2][r], s[3][r]));
      mx = fmaxf(mx, DPP_F(mx, mx, 0xB1, 0xf));
      mx = fmaxf(mx, DPP_F(mx, mx, 0x4E, 0xf));
      mx = fmaxf(mx, DPP_F(mx, mx, 0x141, 0xf));
      mx = fmaxf(mx, DPP_F(mx, mx, 0x140, 0xf));
      float mnew = fmaxf(mrow[r], mx);
      float muse = (mnew == NEG_INF) ? 0.f : mnew;
      float alpha = __expf(mrow[r] - muse);
      float rs = 0.f;
#pragma unroll
      for (int j = 0; j < 4; j++) { float pe = __expf(s[j][r] - muse); s[j][r] = pe; rs += pe; }
      rs += DPP_F(rs, rs, 0xB1, 0xf);
      rs += DPP_F(rs, rs, 0x4E, 0xf);
      rs += DPP_F(rs, rs, 0x141, 0xf);
      rs += DPP_F(rs, rs, 0x140, 0xf);
      lrow[r] = lrow[r] * alpha + rs;
      mrow[r] = mnew;
#pragma unroll
      for (int j = 0; j < 4; j++) o[j][r] *= alpha;
    }
#pragma unroll
    for (int j = 0; j < 4; j++)
#pragma unroll
      for (int r = 0; r < 4; r++) sPw[(l4 * 4 + r) * 72 + j * 16 + l15] = f2bf(s[j][r]);
    __builtin_amdgcn_s_waitcnt(0xc07f);
    __builtin_amdgcn_wave_barrier();
#pragma unroll
    for (int ks = 0; ks < 2; ks++) {
      bf16x8 pf = *(const bf16x8*)(sPw + l15 * 72 + ks * 32 + l4 * 8);
#pragma unroll
      for (int jn = 0; jn < 4; jn++) {
        bf16x8 vf = *(const bf16x8*)(sVt + (jn * 16 + l15) * 72 + ks * 32 + l4 * 8);
        o[jn] = __builtin_amdgcn_mfma_f32_16x16x32_bf16(pf, vf, o[jn], 0, 0, 0);
      }
    }
  }
#pragma unroll
  for (int r = 0; r < 4; r++) {
    float lsum = lrow[r];
    if (has_sink) lsum += __expf(sink - mrow[r]);
    float inv = 1.f / lsum;
#pragma unroll
    for (int jn = 0; jn < 4; jn++)
      Op[(size_t)(q0 + w * 16 + l4 * 4 + r) * 1024 + jn * 16 + l15] = f2bf(o[jn][r] * inv);
  }
}

__device__ __forceinline__ int gla_tok(int tb, int c, int dir, int tau) { return tb + c * 64 + (dir ? 63 - tau : tau); }

#define GLA_W2_OFF 40960
__device__ __forceinline__ void gla_stage_w2(const P& p, int l, char* smem) {
  float* w2s = (float*)(smem + GLA_W2_OFF);
  const int tid = tidx();
  __syncthreads();
#pragma unroll
  for (int i = 0; i < 2; i++) {
    int e = (tid + i * 256) * 4;
    *(float4*)(w2s + e) = *(const float4*)(p.w_gla_a_fwd + l * 2048 + e);
    *(float4*)(w2s + 2048 + e) = *(const float4*)(p.w_gla_a_bwd + l * 2048 + e);
  }
  if (tid < 128) w2s[4096 + tid] = p.b_gla_a_fwd[l * 128 + tid];
  else w2s[4096 + tid] = p.b_gla_a_bwd[l * 128 + tid - 128];
  __syncthreads();
}
__device__ __forceinline__ void gla_load_alow(const P& p, int tok, int dir, float4 (&al)[4]) {
  const float* src = W_hbuf + (size_t)tok * 1984 + (dir ? 1456 : 1440);
#pragma unroll
  for (int q = 0; q < 4; q++) al[q] = *(const float4*)(src + q * 4);
}
__device__ __forceinline__ void gla_cum_regs(const char* smem, const float4 (&al)[4], int h, int dir, int w, int lane, float (&c)[8], float (&tot)[8]) {
  const float* w2 = (const float*)(smem + GLA_W2_OFF) + dir * 2048 + h * 32 + w * 8;
  const float* b2 = (const float*)(smem + GLA_W2_OFF) + 4096 + dir * 128 + h * 32 + w * 8;
  float a[16];
#pragma unroll
  for (int q = 0; q < 4; q++) { a[q * 4] = al[q].x; a[q * 4 + 1] = al[q].y; a[q * 4 + 2] = al[q].z; a[q * 4 + 3] = al[q].w; }
#pragma unroll
  for (int j = 0; j < 8; j++) {
    float z = b2[j];
#pragma unroll
    for (int r = 0; r < 16; r++) z += a[r] * w2[r * 128 + j];
    float la = logsigf(z) * (1.f / 16.f);
    float v = la;
#pragma unroll
    for (int d = 1; d < 64; d <<= 1) { float t_ = __shfl_up(v, d); if (lane >= d) v += t_; }
    float total = __shfl(v, 63);
    c[j] = dir ? (total - v + la) : v;
    tot[j] = total;
  }
}
__device__ __forceinline__ void gla_load_v(const P& p, int tok, int h, int w, float4 (&vr)[4]) {
  const float* src = W_hbuf + (size_t)tok * 1984 + 928 + h * 64 + w * 16;
#pragma unroll
  for (int q = 0; q < 4; q++) vr[q] = *(const float4*)(src + q * 4);
}
__device__ __forceinline__ void gla_store_vt(const float4 (&vr)[4], int w, int lane, bf16_t* sVt) {
#pragma unroll
  for (int q = 0; q < 4; q++) {
    sVt[(w * 16 + q * 4 + 0) * 72 + lane] = f2bf(vr[q].x);
    sVt[(w * 16 + q * 4 + 1) * 72 + lane] = f2bf(vr[q].y);
    sVt[(w * 16 + q * 4 + 2) * 72 + lane] = f2bf(vr[q].z);
    sVt[(w * 16 + q * 4 + 3) * 72 + lane] = f2bf(vr[q].w);
  }
}

__device__ __forceinline__ void chunk_info(int cidx, int& tb, int& nch, int& n, int& cbase) {
  if (cidx < 128) { int b = cidx >> 2; n = cidx & 3; nch = 4; tb = b * 256; cbase = b * 4; }
  else { int cl = cidx - 128, b = cl >> 5; n = cl & 31; nch = 32; tb = T_CTX + b * 2048; cbase = 128 + b * 32; }
}

__device__ __forceinline__ void gla_g1_item(const P& p, int l, int item, char* smem) {
  bf16_t* sKeT = (bf16_t*)smem;
  bf16_t* sVt = sKeT + 32 * 72;
  const int tid = tidx(), lane = tid & 63, w = __builtin_amdgcn_readfirstlane(tid >> 6), l15 = lane & 15, l4 = lane >> 4;
  int dir = item & 1, h = (item >> 1) & 3, cidx = item >> 3;
  int tb, nch, n, cbase;
  chunk_info(cidx, tb, nch, n, cbase);
  int c = dir ? nch - 1 - n : n;
  int tok = tb + c * 64 + lane;
  float4 al[4], vr[4];
  gla_load_alow(p, tok, dir, al);
  const float* kr = W_hbuf + (size_t)tok * 1984 + 800 + h * 32 + w * 8;
  float4 k0 = *(const float4*)kr, k1 = *(const float4*)(kr + 4);
  gla_load_v(p, tok, h, w, vr);
  float cs[8], tot[8];
  gla_cum_regs(smem, al, h, dir, w, lane, cs, tot);
  __syncthreads();
  {
    float kk[8] = {k0.x, k0.y, k0.z, k0.w, k1.x, k1.y, k1.z, k1.w};
#pragma unroll
    for (int j = 0; j < 8; j++) sKeT[(w * 8 + j) * 72 + lane] = f2bf(kk[j] * __expf(tot[j] - cs[j]));
  }
  gla_store_vt(vr, w, lane, sVt);
  __syncthreads();
  f32x4 acc[2] = {f32x4{0.f, 0.f, 0.f, 0.f}, f32x4{0.f, 0.f, 0.f, 0.f}};
#pragma unroll
  for (int ks = 0; ks < 2; ks++) {
    bf16x8 bv = *(const bf16x8*)(sVt + (w * 16 + l15) * 72 + ks * 32 + l4 * 8);
#pragma unroll
    for (int mt = 0; mt < 2; mt++) {
      bf16x8 av = *(const bf16x8*)(sKeT + (mt * 16 + l15) * 72 + ks * 32 + l4 * 8);
      acc[mt] = __builtin_amdgcn_mfma_f32_16x16x32_bf16(av, bv, acc[mt], 0, 0, 0);
    }
  }
  float* dst = W_un + (size_t)item * 2048;
#pragma unroll
  for (int mt = 0; mt < 2; mt++)
#pragma unroll
    for (int r = 0; r < 4; r++) dst[(mt * 16 + l4 * 4 + r) * 64 + w * 16 + l15] = acc[mt][r];
  if (lane == 0) {
#pragma unroll
    for (int j = 0; j < 8; j++) W_gn[item * 32 + w * 8 + j] = __expf(tot[j]);
  }
}

__device__ __forceinline__ void phase_gla_scan(const P& p, int l) {
  for (int it = blockIdx.x; it < 2176; it += gridDim.x) {
    int e = it * 256 + tidx();
    int kv = e & 2047, sd = e >> 11, dir = sd & 1, h = (sd >> 1) & 3, seq = ((sd >> 3) + 32) % 34;
    int nch, cbase;
    float s;
    if (seq < 32) { nch = 4; cbase = seq * 4; s = 0.f; }
    else { int b = seq - 32; nch = 32; cbase = 128 + b * 32; s = p.state_gla[((size_t)(((b * 2 + l) * 2 + dir) * 4 + h)) * 2048 + kv]; }
    for (int n0 = 0; n0 < nch; n0 += 4) {
      float gv[4], uv[4];
#pragma unroll
      for (int k = 0; k < 4; k++) {
        int item = ((cbase + n0 + k) * 4 + h) * 2 + dir;
        gv[k] = W_gn[item * 32 + (kv >> 6)];
        uv[k] = W_un[(size_t)item * 2048 + kv];
      }
#pragma unroll
      for (int k = 0; k < 4; k++) {
        int item = ((cbase + n0 + k) * 4 + h) * 2 + dir;
        W_sin_[(size_t)item * 2048 + kv] = s;
        s = gv[k] * s + uv[k];
      }
    }
    if (seq < 32) p.out[19398656 + ((size_t)(((seq * 2 + l) * 2 + dir) * 4 + h)) * 2048 + kv] = s;
  }
}

__device__ __forceinline__ void phase_gla_out(const P& p, int l, char* smem) {
  bf16_t* sQe = (bf16_t*)smem;
  bf16_t* sKe = sQe + 64 * 40;
  bf16_t* sSt = sKe + 64 * 40;
  bf16_t* sVt = sSt + 64 * 40;
  bf16_t* sAtt = sVt + 64 * 72;
  const int tid = tidx(), lane = tid & 63, w = __builtin_amdgcn_readfirstlane(tid >> 6), l15 = lane & 15, l4 = lane >> 4;
  gla_stage_w2(p, l, smem);
  for (int it = blockIdx.x; it < 768; it += gridDim.x) {
    int h = it & 3, cidx = it >> 2;
    int tb, nch, c, cbase;
    chunk_info(cidx, tb, nch, c, cbase);
    const int tok = tb + c * 64 + lane;
    f32x4 o[4];
#pragma unroll
    for (int j = 0; j < 4; j++) o[j] = f32x4{0.f, 0.f, 0.f, 0.f};
    float4 vr[4], alf[4], alb[4];
    gla_load_v(p, tok, h, w, vr);
    gla_load_alow(p, tok, 0, alf);
    gla_load_alow(p, tok, 1, alb);
    const float* qr = W_hbuf + (size_t)tok * 1984 + 672 + h * 32 + w * 8;
    const float* kr = qr + 128;
    const float4 q0 = *(const float4*)qr, q1 = *(const float4*)(qr + 4), k0 = *(const float4*)kr, k1 = *(const float4*)(kr + 4);
    float sinv[2][8];
#pragma unroll
    for (int dir = 0; dir < 2; dir++) {
      int n = dir ? nch - 1 - c : c;
      int item = ((cbase + n) * 4 + h) * 2 + dir;
      const float* sin = W_sin_ + (size_t)item * 2048 + (w * 8) * 64 + lane;
#pragma unroll
      for (int j = 0; j < 8; j++) sinv[dir][j] = sin[j * 64];
    }
    float gpre[4][4];
#pragma unroll
    for (int r = 0; r < 4; r++)
#pragma unroll
      for (int jn = 0; jn < 4; jn++) gpre[r][jn] = W_hbuf[(size_t)(tb + c * 64 + w * 16 + l4 * 4 + r) * 1984 + 1184 + h * 64 + jn * 16 + l15];
    __syncthreads();
    gla_store_vt(vr, w, lane, sVt);
#pragma unroll
    for (int dir = 0; dir < 2; dir++) {
      float cs[8], tot[8];
      gla_cum_regs(smem, dir ? alb : alf, h, dir, w, lane, cs, tot);
      if (dir) __syncthreads();
      {
        float qq[8] = {q0.x, q0.y, q0.z, q0.w, q1.x, q1.y, q1.z, q1.w};
        float kk[8] = {k0.x, k0.y, k0.z, k0.w, k1.x, k1.y, k1.z, k1.w};
        bf16x8 qv, kv, sv;
#pragma unroll
        for (int j = 0; j < 8; j++) {
          float cm = __shfl(cs[j], 32);
          qv[j] = (short)f2bf(qq[j] * 0.17677669529663687f * __expf(cs[j] - cm));
          kv[j] = (short)f2bf(kk[j] * __expf(cm - cs[j]));
          sv[j] = (short)f2bf(sinv[dir][j] * __expf(cm));
        }
        *(bf16x8*)(sQe + lane * 40 + w * 8) = qv;
        *(bf16x8*)(sKe + lane * 40 + w * 8) = kv;
        *(bf16x8*)(sSt + lane * 40 + w * 8) = sv;
      }
      __syncthreads();
      bf16x8 qa = *(const bf16x8*)(sQe + (w * 16 + l15) * 40 + l4 * 8);
#pragma unroll
      for (int jc = 0; jc < 4; jc++) {
        bf16x8 kb = *(const bf16x8*)(sKe + (jc * 16 + l15) * 40 + l4 * 8);
        f32x4 sacc = __builtin_amdgcn_mfma_f32_16x16x32_bf16(qa, kb, f32x4{0.f, 0.f, 0.f, 0.f}, 0, 0, 0);
#pragma unroll
        for (int r = 0; r < 4; r++) {
          int trow = w * 16 + l4 * 4 + r, scol = jc * 16 + l15;
          bool keep = dir ? (scol >= trow) : (scol <= trow);
          sAtt[trow * 72 + scol] = f2bf(keep ? sacc[r] : 0.f);
        }
      }
      __syncthreads();
#pragma unroll
      for (int ks = 0; ks < 2; ks++) {
        bf16x8 aa = *(const bf16x8*)(sAtt + (w * 16 + l15) * 72 + ks * 32 + l4 * 8);
#pragma unroll
        for (int jn = 0; jn < 4; jn++) {
          bf16x8 vb = *(const bf16x8*)(sVt + (jn * 16 + l15) * 72 + ks * 32 + l4 * 8);
          o[jn] = __builtin_amdgcn_mfma_f32_16x16x32_bf16(aa, vb, o[jn], 0, 0, 0);
        }
      }
#pragma unroll
      for (int jn = 0; jn < 4; jn++) {
        bf16x8 sb = *(const bf16x8*)(sSt + (jn * 16 + l15) * 40 + l4 * 8);
        o[jn] = __builtin_amdgcn_mfma_f32_16x16x32_bf16(qa, sb, o[jn], 0, 0, 0);
      }
    }
#pragma unroll
    for (int r = 0; r < 4; r++) {
      float ss = o[0][r] * o[0][r] + o[1][r] * o[1][r] + o[2][r] * o[2][r] + o[3][r] * o[3][r];
      ss += DPP_F(ss, ss, 0xB1, 0xf);
      ss += DPP_F(ss, ss, 0x4E, 0xf);
      ss += DPP_F(ss, ss, 0x141, 0xf);
      ss += DPP_F(ss, ss, 0x140, 0xf);
      float rs = rsqrtf(ss * (1.f / 64.f) + 1e-6f);
      int tk = tb + c * 64 + w * 16 + l4 * 4 + r;
      const float* grow = W_hbuf + (size_t)tk * 1984 + 1184 + h * 64;
      bf16_t* dst = W_br + (size_t)tk * 1024 + 512 + h * 64;
#pragma unroll
      for (int jn = 0; jn < 4; jn++) {
        int vcol = jn * 16 + l15;
        float val = o[jn][r] * rs * p.gla_norm[l * 64 + vcol];
        dst[vcol] = f2bf(val * siluf(gpre[r][jn]));
      }
    }
  }
}

__device__ __forceinline__ void phase_mixers(const P& p, int l, char* smem) {
  const int N_MLAL = 256, N_DFTL = 64, N_SWAL = 256, N_MLAC = 512, N_SWAC = 512, N_DFTC = 128, N_G1 = 1536;
  const int total = N_MLAL + N_DFTL + N_SWAL + N_MLAC + N_SWAC + N_DFTC + N_G1;
  gla_stage_w2(p, l, smem);
  for (int r_ = 0; r_ * (int)gridDim.x < total; r_++) {
    int it0 = r_ * gridDim.x + ((r_ & 1) ? (gridDim.x - 1 - blockIdx.x) : blockIdx.x);
    if (it0 >= total) continue;
    int it = it0;
    int type;
    bool lat = false;
    if (it < N_MLAL) { type = 0; lat = true; }
    else if ((it -= N_MLAL) < N_DFTL) { type = 2; lat = true; }
    else if ((it -= N_DFTL) < N_SWAL) { type = 1; lat = true; }
    else if ((it -= N_SWAL) < N_MLAC) { type = 0; }
    else if ((it -= N_MLAC) < N_SWAC) { type = 1; }
    else if ((it -= N_SWAC) < N_DFTC) { type = 2; }
    else { it -= N_DFTC; type = 3; }
#ifdef DUPTYPE
    for (int rep_ = 0; rep_ < ((type == (DUPTYPE & 3) && (int)lat == (DUPTYPE >> 2)) ? 2 : 1); rep_++)
#endif
    if (type == 0) {
      int qt, h, b, Sk;
      size_t tok0;
      if (lat) { qt = it & 31; h = (it >> 5) & 3; b = it >> 7; tok0 = T_CTX + b * 2048; Sk = 2560; }
      else { qt = it & 3; h = (it >> 2) & 3; b = it >> 4; tok0 = b * 256; Sk = 256; }
      const bf16_t* Kp = (lat ? W_Ka_lat : W_Ka_ctx) + (size_t)(b * 4 + h) * Sk * 96;
      const bf16_t* Vp = (lat ? W_Va_lat : W_Va_ctx) + (size_t)(b * 4 + h) * Sk * 64;
      attn_item<96>(W_Qa + tok0 * 384 + h * 96, 384, Kp, Vp, W_br + tok0 * 1024 + h * 64, qt * 64, Sk, 0, -1,
                    0.10206207261596575f, false, 0.f, smem);
    } else if (type == 1) {
      int qt, hq, b, Sk, nctx, W;
      size_t tok0;
      if (lat) { qt = it & 31; hq = (it >> 5) & 3; b = it >> 7; tok0 = T_CTX + b * 2048; Sk = 2560; nctx = 512; W = 128; }
      else { qt = it & 3; hq = (it >> 2) & 3; b = it >> 4; tok0 = b * 256; Sk = 256; nctx = 0; W = -1; }
      int kv = hq >> 1;
      const bf16_t* Kp = (lat ? W_Kd_lat : W_Kd_ctx) + (size_t)(b * 2 + kv) * Sk * 64;
      const bf16_t* Vp = (lat ? W_Vd_lat : W_Vd_ctx) + (size_t)(b * 2 + kv) * Sk * 64;
      attn_item<64>(W_Qd + tok0 * 256 + hq * 64, 256, Kp, Vp, W_br + tok0 * 1024 + 768 + hq * 64, qt * 64, Sk, nctx, W,
                    0.125f, true, p.swa_sink[l * 4 + hq], smem);
    } else if (type == 2) {
      int nt = it & 1, mt, b, S;
      size_t tok0;
      if (lat) { mt = (it >> 1) & 15; b = it >> 5; S = 2048; tok0 = T_CTX + b * 2048; }
      else { mt = (it >> 1) & 1; b = it >> 2; S = 256; tok0 = b * 256; }
      const bf16_t* Ap = (lat ? W_A2048 : W_A256) + (size_t)mt * 128 * 2 * S;
      const bf16_t* Bp = (lat ? W_Yt_lat : W_Yt_ctx) + (size_t)(b * 256 + nt * 128) * 2 * S;
      f32x4 acc[4][4];
      ZERO_ACC(acc);
      gemm_core(acc, Ap, 2 * S, Bp, 2 * S, 2 * S, smem);
      EPI_LOOP(acc, mt * 128, nt * 128, { W_br[(tok0 + m) * 1024 + 256 + n] = f2bf(v); });
    } else {
      gla_g1_item(p, l, it, smem);
    }
  }
}

#define EPI4_LOOP_N(acc, c0, t0, NJ, ...)                                                  \
  {                                                                                        \
    const int lane_ = tidx() & 63, w_ = tidx() >> 6, wm_ = w_ >> 1, wn_ = w_ & 1;           \
    _Pragma("unroll") for (int i_ = 0; i_ < 4; i_++)                                       \
    _Pragma("unroll") for (int j_ = 0; j_ < NJ; j_++) {                                    \
      const int col = (c0) + wm_ * 64 + i_ * 16 + (lane_ >> 4) * 4;                        \
      const int tok = (t0) + wn_ * (NJ * 16) + j_ * 16 + (lane_ & 15);                     \
      const f32x4 v4 = acc[i_][j_];                                                        \
      __VA_ARGS__                                                                          \
    }                                                                                      \
  }
__device__ __forceinline__ void phase_merge(const P& p, int l, char* smem) {
  for (int tile = blockIdx.x; tile < 192 * 8; tile += gridDim.x) {
    int tt = tile >> 3, nt = tile & 7, t0 = tt * 64, n0 = nt * 128;
    f32x4 tot[4][2];
    ZERO_ACC_N(tot, 2);
    for (int b = 0; b < 4; b++) {
      f32x4 acc[4][2];
      ZERO_ACC_N(acc, 2);
      gemm_core_t<2>(acc, W_Wt_br + ((size_t)(l * 4 + b) * 1024 + n0) * 256, 256, W_br + (size_t)t0 * 1024 + b * 256, 1024, 256, smem);
      EPI4_LOOP_N(acc, n0, t0, 2, {
        ushort4 g_ = *(const ushort4*)(W_gates + (size_t)tok * 4096 + b * 1024 + col);
        tot[i_][j_][0] += bf2f(g_.x) * v4[0]; tot[i_][j_][1] += bf2f(g_.y) * v4[1];
        tot[i_][j_][2] += bf2f(g_.z) * v4[2]; tot[i_][j_][3] += bf2f(g_.w) * v4[3];
      });
    }
    EPI4_LOOP_N(tot, n0, t0, 2, {
      ushort4 o_; o_.x = f2bf(v4[0]); o_.y = f2bf(v4[1]); o_.z = f2bf(v4[2]); o_.w = f2bf(v4[3]);
      *(ushort4*)(W_u + (size_t)tok * 1024 + col) = o_;
    });
  }
}

__device__ __forceinline__ void phase_wout(const P& p, int l, char* smem) {
  float* r = W_hbuf;
  const float alpha = 1.4142135623730951f;
  for (int tile = blockIdx.x; tile < 96 * 8; tile += gridDim.x) {
    int mt = tile >> 3, nt = tile & 7, m0 = mt * 128, n0 = nt * 128;
    f32x4 acc[4][4];
    ZERO_ACC(acc);
    gemm_core(acc, W_Wt_out + ((size_t)l * 1024 + n0) * 1024, 1024, W_u + (size_t)m0 * 1024, 1024, 1024, smem);
    const float* g1 = W_mada + (l * 3 + cond_row(m0)) * 6144 + 2048;
    {
      const int lane_ = tidx() & 63, w_ = tidx() >> 6, wm_ = w_ >> 1, wn_ = w_ & 1;
#pragma unroll
      for (int ih = 0; ih < 2; ih++) {
        float4 xv[8];
#pragma unroll
        for (int q = 0; q < 8; q++) {
          int i_ = ih * 2 + (q >> 2), j_ = q & 3;
          int col = n0 + wm_ * 64 + i_ * 16 + (lane_ >> 4) * 4, tok = m0 + wn_ * 64 + j_ * 16 + (lane_ & 15);
          xv[q] = *(const float4*)(x_in_row(p, l, tok) + col);
        }
#pragma unroll
        for (int q = 0; q < 8; q++) {
          int i_ = ih * 2 + (q >> 2), j_ = q & 3;
          int col = n0 + wm_ * 64 + i_ * 16 + (lane_ >> 4) * 4, tok = m0 + wn_ * 64 + j_ * 16 + (lane_ & 15);
          float4 gv = *(const float4*)(g1 + col);
          f32x4 v4 = acc[i_][j_];
          *(float4*)(r + (size_t)tok * 1024 + col) = float4{alpha * xv[q].x + gv.x * v4[0], alpha * xv[q].y + gv.y * v4[1], alpha * xv[q].z + gv.z * v4[2], alpha * xv[q].w + gv.w * v4[3]};
        }
      }
    }
  }
}

__device__ __forceinline__ void phase_ln_mid(const P& p, int l) {
  int lane = tidx() & 63, w = tidx() >> 6;
  const float* r = W_hbuf;
  for (int it = blockIdx.x; it < T_ALL / 4; it += gridDim.x) {
    int g = it * 4 + w;
    float v[16];
    load_row16(r + (size_t)g * 1024, lane, v);
    ln16(v);
    affine16(v, p.ln1_g + l * 1024, p.ln1_b + l * 1024, lane);
    store_row16(x_out_row(p, l, g), lane, v);
    ln16(v);
    const float* m = W_mada + (l * 3 + cond_row(g)) * 6144;
    modulate_store(v, m + 3072, m + 4096, W_u + (size_t)g * 1024, lane);
  }
}

__device__ __forceinline__ void phase_pq(const P& p, int l, char* smem) {
  float* sc = (float*)W_gates;
  bf16_t* sa = (bf16_t*)smem;
  const int tid = tidx(), lane = tid & 63, w = tid >> 6, wm = w >> 1, wn = w & 1, l15 = lane & 15, l4 = lane >> 4;
  for (int tile = blockIdx.x; tile < 96 * 16; tile += gridDim.x) {
    int mt = tile >> 4, hp = tile & 15, m0 = mt * 128, n0 = hp * 128;
    f32x4 acc[4][4];
    ZERO_ACC(acc);
    gemm_core(acc, W_Wt_pq + ((size_t)l * 2048 + n0) * 1024, 1024, W_u + (size_t)m0 * 1024, 1024, 1024, smem);
    __syncthreads();
    {
      bf16_t* sB = sa + 128 * GB_LD * (1 + wm);
#pragma unroll
      for (int i = 0; i < 4; i++)
#pragma unroll
        for (int j = 0; j < 4; j++) {
          ushort4 o_;
          o_.x = f2bf(acc[i][j][0]); o_.y = f2bf(acc[i][j][1]); o_.z = f2bf(acc[i][j][2]); o_.w = f2bf(acc[i][j][3]);
          *(ushort4*)(sB + (wn * 64 + j * 16 + l15) * GB_LD + i * 16 + l4 * 4) = o_;
        }
    }
    f32x4 acc2[4][4];
    ZERO_ACC(acc2);
    const bf16_t* keys = W_keysbf + (size_t)(l * 16 + hp) * 128 * 128;
#pragma unroll
    for (int kh = 0; kh < 2; kh++) {
      u32x4 rk[4];
#pragma unroll
      for (int i = 0; i < 4; i++) { int c = tid + i * 256, r = c >> 3, cc = (c & 7) * 8; rk[i] = *(const u32x4*)(keys + r * 128 + kh * 64 + cc); }
      if (kh) __syncthreads();
#pragma unroll
      for (int i = 0; i < 4; i++) { int c = tid + i * 256, r = c >> 3, cc = (c & 7) * 8; *(u32x4*)(sa + r * GB_LD + cc) = rk[i]; }
      __syncthreads();
      const bf16_t* sBk = sa + 128 * GB_LD * (1 + kh);
#pragma unroll
      for (int ks = 0; ks < 2; ks++) {
        bf16x8 af[4], bfr[4];
#pragma unroll
        for (int i = 0; i < 4; i++) af[i] = *(const bf16x8*)(sa + (wm * 64 + i * 16 + l15) * GB_LD + ks * 32 + l4 * 8);
#pragma unroll
        for (int j = 0; j < 4; j++) bfr[j] = *(const bf16x8*)(sBk + (wn * 64 + j * 16 + l15) * GB_LD + ks * 32 + l4 * 8);
#pragma unroll
        for (int i = 0; i < 4; i++)
#pragma unroll
          for (int j = 0; j < 4; j++) acc2[i][j] = __builtin_amdgcn_mfma_f32_16x16x32_bf16(af[i], bfr[j], acc2[i][j], 0, 0, 0);
      }
    }
    EPI_LOOP(acc2, 0, m0, { sc[((size_t)(hp * 128 + m)) * T_ALL + n] = v; });
  }
}

__device__ __forceinline__ void phase_scores(const P& p, int l, char* smem) {}

__device__ __forceinline__ int f2sort(float x) { int b = __float_as_int(x); return b ^ ((b >> 31) & 0x7fffffff); }
__device__ __forceinline__ float sort2f(int s) { return __int_as_float(s ^ ((s >> 31) & 0x7fffffff)); }
__device__ __forceinline__ void bitonic_sort16_desc(int (&a)[16]) {
#pragma unroll
  for (int k = 2; k <= 16; k <<= 1)
#pragma unroll
    for (int j = k >> 1; j > 0; j >>= 1)
#pragma unroll
      for (int i = 0; i < 16; i++) {
        int l_ = i ^ j;
        if (l_ > i) {
          int hi = max(a[i], a[l_]), lo = min(a[i], a[l_]);
          if ((i & k) == 0) { a[i] = hi; a[l_] = lo; } else { a[i] = lo; a[l_] = hi; }
        }
      }
}
__device__ __forceinline__ void merge_top16(int (&T)[16], const int (&S)[16]) {
#pragma unroll
  for (int i = 0; i < 16; i++) T[i] = max(T[i], S[15 - i]);
#pragma unroll
  for (int j = 8; j > 0; j >>= 1)
#pragma unroll
    for (int i = 0; i < 16; i++) {
      int l_ = i ^ j;
      if (l_ > i) { int hi = max(T[i], T[l_]), lo = min(T[i], T[l_]); T[i] = hi; T[l_] = lo; }
    }
}
__device__ __forceinline__ void top16_col(const float* src, int (&L)[16]) {
#pragma unroll 1
  for (int k0 = 0; k0 < 128; k0 += 16) {
    float xv[16];
#pragma unroll
    for (int k = 0; k < 16; k++) xv[k] = src[(size_t)(k0 + k) * T_ALL];
    int S[16];
#pragma unroll
    for (int k = 0; k < 16; k++) S[k] = (f2sort(xv[k]) & ~127) | (127 - (k0 + k));
    bitonic_sort16_desc(S);
    if (k0 == 0) {
#pragma unroll
      for (int k = 0; k < 16; k++) L[k] = S[k];
    } else {
      merge_top16(L, S);
    }
  }
}
__device__ __forceinline__ void phase_topk(const P& p, int l) {
  const float* sc = (const float*)W_gates;
  int lane = tidx() & 63, w = tidx() >> 6;
  for (int it = blockIdx.x * 4 + w; it < 192 * 8; it += gridDim.x * 4) {
    int h = it & 7, t = (it >> 3) * 64 + lane;
    int L1[16], L2[16];
    const float* s1 = sc + (size_t)(h * 2) * 128 * T_ALL + t;
    top16_col(s1, L1);
    top16_col(s1 + (size_t)128 * T_ALL, L2);
    float v1[16], v2[16];
    unsigned P1[4] = {0u, 0u, 0u, 0u}, P2[4] = {0u, 0u, 0u, 0u};
#pragma unroll
    for (int i = 0; i < 16; i++) {
      v1[i] = sort2f(L1[i] & ~127);
      v2[i] = sort2f(L2[i] & ~127);
      P1[i >> 2] |= (unsigned)(127 - (L1[i] & 127)) << ((i & 3) * 8);
      P2[i >> 2] |= (unsigned)(127 - (L2[i] & 127)) << ((i & 3) * 8);
    }
    int Tk[16];
#pragma unroll
    for (int j = 0; j < 16; j++) Tk[j] = (f2sort(v1[0] + v2[j]) & ~255) | (255 - j);
    {
      int G[3][16];
#pragma unroll
      for (int g_ = 0; g_ < 3; g_++)
#pragma unroll
        for (int k = 0; k < 16; k++) G[g_][k] = (int)0x80000000;
      int cnt = 0;
#pragma unroll
      for (int i = 1; i < 16; i++) {
#pragma unroll
        for (int j = 0; j < 16 / (i + 1); j++) {
          G[cnt >> 4][cnt & 15] = (f2sort(v1[i] + v2[j]) & ~255) | (255 - (i * 16 + j));
          cnt++;
        }
      }
#pragma unroll
      for (int g_ = 0; g_ < 3; g_++) { bitonic_sort16_desc(G[g_]); merge_top16(Tk, G[g_]); }
    }
    float v0 = sort2f(Tk[0] & ~255);
    float e[16], Z = 0.f;
    int oi[16];
#pragma unroll
    for (int s_ = 0; s_ < 16; s_++) {
      e[s_] = __expf(sort2f(Tk[s_] & ~255) - v0);
      Z += e[s_];
      int code = 255 - (Tk[s_] & 255), i = code >> 4, j = code & 15;
      unsigned r1 = (i >> 2) == 0 ? P1[0] : (i >> 2) == 1 ? P1[1] : (i >> 2) == 2 ? P1[2] : P1[3];
      unsigned r2 = (j >> 2) == 0 ? P2[0] : (j >> 2) == 1 ? P2[1] : (j >> 2) == 2 ? P2[2] : P2[3];
      int i1 = (r1 >> ((i & 3) * 8)) & 255, i2 = (r2 >> ((j & 3) * 8)) & 255;
      oi[s_] = i1 * 128 + i2;
    }
    float inv = 1.f / Z;
    int* po = W_pidx + (size_t)t * 128 + h * 16;
    float* pwo = W_pw + (size_t)t * 128 + h * 16;
#pragma unroll
    for (int q = 0; q < 4; q++) {
      *(int4*)(po + q * 4) = int4{oi[q * 4], oi[q * 4 + 1], oi[q * 4 + 2], oi[q * 4 + 3]};
      *(float4*)(pwo + q * 4) = float4{e[q * 4] * inv, e[q * 4 + 1] * inv, e[q * 4 + 2] * inv, e[q * 4 + 3] * inv};
    }
  }
}

__device__ __forceinline__ void unpack16(u32x4 r, float (&f)[16]) {
#pragma unroll
  for (int q = 0; q < 4; q++) {
    auto lo = __builtin_amdgcn_cvt_pk_f32_fp8((int)r[q], false);
    auto hi = __builtin_amdgcn_cvt_pk_f32_fp8((int)r[q], true);
    f[q * 4 + 0] = lo[0]; f[q * 4 + 1] = lo[1]; f[q * 4 + 2] = hi[0]; f[q * 4 + 3] = hi[1];
  }
}
#define PEER_PF 8
#ifndef PEER_REP
#define PEER_REP 1
#endif
__device__ __forceinline__ void phase_peer(const P& p, int l, char* smem) {
  int lane = tidx() & 63, w = tidx() >> 6;
  float* scoef = (float*)smem + w * 128;
  const unsigned char* tu = W_tabU + (size_t)l * 16384 * 1024 + lane * 16;
  const unsigned char* tv = W_tabV + (size_t)l * 16384 * 1024 + lane * 16;
  for (int it = blockIdx.x; it < T_ALL / 4; it += gridDim.x) {
    int g = it * 4 + w;
    float uu[16];
    {
      u32x4 r0 = *(const u32x4*)(W_u + (size_t)g * 1024 + lane * 16);
      u32x4 r1 = *(const u32x4*)(W_u + (size_t)g * 1024 + lane * 16 + 8);
      uu[0] = __uint_as_float(r0.x << 16); uu[1] = __uint_as_float(r0.x & 0xffff0000u);
      uu[2] = __uint_as_float(r0.y << 16); uu[3] = __uint_as_float(r0.y & 0xffff0000u);
      uu[4] = __uint_as_float(r0.z << 16); uu[5] = __uint_as_float(r0.z & 0xffff0000u);
      uu[6] = __uint_as_float(r0.w << 16); uu[7] = __uint_as_float(r0.w & 0xffff0000u);
      uu[8] = __uint_as_float(r1.x << 16); uu[9] = __uint_as_float(r1.x & 0xffff0000u);
      uu[10] = __uint_as_float(r1.y << 16); uu[11] = __uint_as_float(r1.y & 0xffff0000u);
      uu[12] = __uint_as_float(r1.z << 16); uu[13] = __uint_as_float(r1.z & 0xffff0000u);
      uu[14] = __uint_as_float(r1.w << 16); uu[15] = __uint_as_float(r1.w & 0xffff0000u);
    }
    const float* pwt = W_pw + (size_t)g * 128;
    const int pi0 = W_pidx[(size_t)g * 128 + lane], pi1 = W_pidx[(size_t)g * 128 + 64 + lane];
    auto ldrows = [&](u32x4 (&r)[8], const unsigned char* tab, int e0) {
#pragma unroll
      for (int k = 0; k < 8; k++) {
        int e = e0 + k;
        int idx = __builtin_amdgcn_readlane(e < 64 ? pi0 : pi1, e & 63);
        r[k] = *(const u32x4*)(tab + (size_t)idx * 1024);
      }
    };
    float o[16];
    for (int rep_ = 0; rep_ < PEER_REP; rep_++) {
    float dv0 = 0.f, dv1 = 0.f;
    auto dots = [&](const u32x4 (&r)[8], int e0) {
#pragma unroll
      for (int k = 0; k < 8; k++) {
        float f[16];
        unpack16(r[k], f);
        float a = 0.f;
#pragma unroll
        for (int j = 0; j < 16; j++) a += uu[j] * f[j];
        float dd = wsum(a);
        if (e0 < 64) dv0 = (lane == e0 + k) ? dd : dv0;
        else dv1 = (lane == e0 + k - 64) ? dd : dv1;
      }
    };
    {
      u32x4 ra[8], rb[8];
      ldrows(ra, tu, 0);
#pragma unroll 1
      for (int e0 = 0; e0 < 128; e0 += 16) {
        ldrows(rb, tu, e0 + 8);
        dots(ra, e0);
        if (e0 + 16 < 128) ldrows(ra, tu, e0 + 16);
        dots(rb, e0 + 8);
      }
    }
    {
      float d0 = dv0 * (1.f / PEER_U_SCALE), d1 = dv1 * (1.f / PEER_U_SCALE);
      float a0 = 0.5f * d0 * (1.f + erff(d0 * 0.7071067811865476f));
      float a1 = 0.5f * d1 * (1.f + erff(d1 * 0.7071067811865476f));
      scoef[lane] = pwt[lane] * a0 * (1.f / PEER_V_SCALE);
      scoef[64 + lane] = pwt[64 + lane] * a1 * (1.f / PEER_V_SCALE);
    }
    __builtin_amdgcn_s_waitcnt(0xc07f);
    __builtin_amdgcn_wave_barrier();
#pragma unroll
    for (int j = 0; j < 16; j++) o[j] = 0.f;
    auto accum = [&](const u32x4 (&r)[8], int e0) {
#pragma unroll
      for (int k = 0; k < 8; k++) {
        float cf = scoef[e0 + k];
        float f[16];
        unpack16(r[k], f);
#pragma unroll
        for (int j = 0; j < 16; j++) o[j] += cf * f[j];
      }
    };
    {
      u32x4 ra[8], rb[8];
      ldrows(ra, tv, 0);
#pragma unroll 1
      for (int e0 = 0; e0 < 128; e0 += 16) {
        ldrows(rb, tv, e0 + 8);
        accum(ra, e0);
        if (e0 + 16 < 128) ldrows(ra, tv, e0 + 16);
        accum(rb, e0 + 8);
      }
    }
    __builtin_amdgcn_wave_barrier();
    }
    float* xr = x_out_row(p, l, g) + lane * 16;
    const float* m = W_mada + (l * 3 + cond_row(g)) * 6144 + lane * 16;
    float x1[16];
#pragma unroll
    for (int q = 0; q < 4; q++) {
      float4 xv = *(const float4*)(xr + q * 4);
      float4 g2 = *(const float4*)(m + 5120 + q * 4);
      x1[q * 4 + 0] = 1.4142135623730951f * xv.x + g2.x * o[q * 4 + 0];
      x1[q * 4 + 1] = 1.4142135623730951f * xv.y + g2.y * o[q * 4 + 1];
      x1[q * 4 + 2] = 1.4142135623730951f * xv.z + g2.z * o[q * 4 + 2];
      x1[q * 4 + 3] = 1.4142135623730951f * xv.w + g2.w * o[q * 4 + 3];
    }
    ln16(x1);
#pragma unroll
    for (int q = 0; q < 4; q++) {
      float4 a = *(const float4*)(p.ln2_g + l * 1024 + lane * 16 + q * 4);
      float4 c = *(const float4*)(p.ln2_b + l * 1024 + lane * 16 + q * 4);
      x1[q * 4 + 0] = x1[q * 4 + 0] * a.x + c.x; x1[q * 4 + 1] = x1[q * 4 + 1] * a.y + c.y;
      x1[q * 4 + 2] = x1[q * 4 + 2] * a.z + c.z; x1[q * 4 + 3] = x1[q * 4 + 3] * a.w + c.w;
      *(float4*)(xr + q * 4) = float4{x1[q * 4], x1[q * 4 + 1], x1[q * 4 + 2], x1[q * 4 + 3]};
    }
    if (l == 0) {
      ln16(x1);
      const float* m1 = W_mada + (1 * 3 + cond_row(g)) * 6144 + lane * 16;
#pragma unroll
      for (int q = 0; q < 4; q++) {
        float4 a = *(const float4*)(m1 + 1024 + q * 4);
        float4 b = *(const float4*)(m1 + q * 4);
        ushort4 ov;
        ov.x = f2bf(x1[q * 4 + 0] * (1.f + a.x) + b.x);
        ov.y = f2bf(x1[q * 4 + 1] * (1.f + a.y) + b.y);
        ov.z = f2bf(x1[q * 4 + 2] * (1.f + a.z) + b.z);
        ov.w = f2bf(x1[q * 4 + 3] * (1.f + a.w) + b.w);
        *(ushort4*)(W_u + (size_t)g * 1024 + lane * 16 + q * 4) = ov;
      }
    }
  }
}

#define N_PHASES 28
__device__ __forceinline__ void run_phase(const P& p, int ph, char* smem) {
#ifdef ONLYQ
  { int l = ph & 1; if (ONLYQ == -1) { phase_prep(p, smem); return; } if (ONLYQ == -2) { phase_ln0(p); return; }
    switch (ONLYQ) { case 0: phase_win(p, l, smem); break; case 1: phase_post(p, l); break; case 2: phase_small_gemms(p, l, smem); break; case 3: phase_mixers(p, l, smem); break; case 4: phase_gla_scan(p, l); break; case 5: phase_gla_out(p, l, smem); break; case 6: phase_merge(p, l, smem); break; case 7: phase_wout(p, l, smem); break; case 8: phase_ln_mid(p, l); break; case 9: phase_pq(p, l, smem); break; case 10: phase_scores(p, l, smem); break; case 11: phase_topk(p, l); break; case 12: phase_peer(p, l, smem); break; } return; }
#endif
  if (ph == 0) { phase_prep(p, smem); return; }
  if (ph == 1) { phase_ln0(p); return; }
  int l = (ph - 2) / 13, q = (ph - 2) % 13;
#ifdef EXCL
  if (q == EXCL) return;
#endif
  switch (q) {
    case 0: phase_win(p, l, smem); break;
    case 1: phase_post(p, l); break;
    case 2: phase_small_gemms(p, l, smem); break;
    case 3: phase_mixers(p, l, smem); break;
    case 4: phase_gla_scan(p, l); break;
    case 5: phase_gla_out(p, l, smem); break;
    case 6: phase_merge(p, l, smem); break;
    case 7: phase_wout(p, l, smem); break;
    case 8: phase_ln_mid(p, l); break;
    case 9: phase_pq(p, l, smem); break;
    case 10: phase_scores(p, l, smem); break;
    case 11: phase_topk(p, l); break;
    case 12: phase_peer(p, l, smem); break;
  }
}

#define XB_TMO      128
#define XB_XCNT(j)  (256  + 64 * (j))
#define XB_XSUB(j)  (1280 + 64 * (j))
#define XB_XGEN(j)  (2304 + 64 * (j))
#define XB_TOP      3328
#define XB_TOPGEN   3392
#define XCD_BAR_WORDS 3456
#define XB_SPIN_CAP (1u << 18)
#define LAS __attribute__((address_space(3)))

__device__ __forceinline__ unsigned xb_ld(unsigned* p)              { return __hip_atomic_load(p, __ATOMIC_RELAXED, __HIP_MEMORY_SCOPE_AGENT); }
__device__ __forceinline__ unsigned xb_add(unsigned* p, unsigned v) { return __hip_atomic_fetch_add(p, v, __ATOMIC_RELAXED, __HIP_MEMORY_SCOPE_AGENT); }
__device__ __forceinline__ unsigned xb_xcc_id() { return (unsigned)__builtin_amdgcn_s_getreg((3 << 11) | 20) & 0xFu; }
#define XB_SPIN(cond, bar) do { unsigned _sp = 0; while (cond) { __builtin_amdgcn_s_sleep(1); \
    if ((++_sp & 255u) == 0u) { if (xb_ld(&(bar)[XB_TMO])) break; if (_sp > XB_SPIN_CAP) { atomicAdd(&(bar)[XB_TMO], 1u); break; } } } } while (0)

struct XcdBarrier {
    unsigned* bar; unsigned x;
    volatile LAS unsigned* st;
};

__device__ __forceinline__ XcdBarrier xcd_barrier_post(unsigned* bar, volatile LAS unsigned* st) {
    XcdBarrier b; b.bar = bar; b.x = xb_xcc_id(); b.st = st;
    if (threadIdx.x == 0) (void)xb_add(&bar[XB_XCNT(b.x)], 1u);
    return b;
}
__device__ __forceinline__ void xcd_barrier_complete(unsigned* bar, unsigned x, unsigned& nloc, unsigned& nx) {
    const unsigned G = gridDim.x * gridDim.y * gridDim.z;
    unsigned sum, cnt, mine, sp = 0u;
    for (;;) {
        sum = 0u; cnt = 0u; mine = 0u;
#pragma unroll
        for (unsigned j = 0; j < 16; ++j) { const unsigned c = xb_ld(&bar[XB_XCNT(j)]); sum += c; cnt += (c > 0u) ? 1u : 0u; mine = (j == x) ? c : mine; }
        if (sum == G) break;
        __builtin_amdgcn_s_sleep(1);
        if ((++sp & 255u) == 0u) { if (xb_ld(&bar[XB_TMO])) break; if (sp > XB_SPIN_CAP) { atomicAdd(&bar[XB_TMO], 1u); break; } }
    }
    nloc = mine > 0u ? mine : 1u; nx = cnt > 0u ? cnt : 1u;
}

__device__ __forceinline__ void xcd_barrier(const XcdBarrier& b) {
    asm volatile("s_waitcnt vmcnt(0)" ::: "memory");
    __syncthreads();
    if (threadIdx.x == 0) {
        unsigned* bar = b.bar;
        __builtin_amdgcn_s_waitcnt(0);
        unsigned nloc = b.st[0], nx = b.st[1];
        if (nloc == 0u) { xcd_barrier_complete(bar, b.x, nloc, nx); b.st[0] = nloc; b.st[1] = nx; }
        const unsigned old = xb_add(&bar[XB_XSUB(b.x)], 1u);
        const unsigned gen = old / nloc;
        if (old + 1u == (gen + 1u) * nloc) {
            __builtin_amdgcn_fence(__ATOMIC_RELEASE, "agent");
            asm volatile("s_waitcnt vmcnt(0)" ::: "memory");
            const unsigned og = xb_add(&bar[XB_TOP], 1u);
            const unsigned tg = og / nx;
            if (og + 1u == (tg + 1u) * nx) xb_add(&bar[XB_TOPGEN], 1u);
            else XB_SPIN(xb_ld(&bar[XB_TOPGEN]) == tg, bar);
            __builtin_amdgcn_fence(__ATOMIC_ACQUIRE, "agent");
            xb_add(&bar[XB_XGEN(b.x)], 1u);
            asm volatile("s_waitcnt vmcnt(0)" ::: "memory");
        } else {
            XB_SPIN(xb_ld(&bar[XB_XGEN(b.x)]) == gen, bar);
            __builtin_amdgcn_fence(__ATOMIC_ACQUIRE, "agent");
            asm volatile("s_waitcnt vmcnt(0)" ::: "memory");
        }
    }
    __syncthreads();
}


#define SMEM_BYTES 61440

#if MULTI
__global__ void __launch_bounds__(256, 2) k_phase(P p, int ph) {
  __shared__ __attribute__((aligned(16))) char smem[SMEM_BYTES];
  run_phase(p, ph, smem);
}
#else
__global__ void __launch_bounds__(256, 2) k_mega(P p) {
  __shared__ __attribute__((aligned(16))) char smem[SMEM_BYTES];
  __shared__ uint4 xb_words;
  cg::grid_group grid = cg::this_grid();
  if (threadIdx.x == 0) xb_words = make_uint4(0u, 0u, 0u, 0u);
  __syncthreads();
  XcdBarrier xb = xcd_barrier_post((unsigned*)(p.ws + OFF_bar), (volatile LAS unsigned*)&xb_words);
#pragma nounroll
  for (int ph = 0; ph < N_PHASES; ph++) {
    if (ph >= 2 && (ph - 2) % 13 == 10) continue;
    run_phase(p, ph, smem);
#ifdef DUPMASK
    if (ph >= 2 && ((DUPMASK >> ((ph - 2) % 13)) & 1)) run_phase(p, ph, smem);
#endif
    if (ph + 1 < N_PHASES) {
      if (gridDim.y > 1) grid.sync();
      xcd_barrier(xb);
    }
  }
}
#endif

extern "C" void kernel_launch(void* const* d_in, const int* in_sizes, int n_in, void* d_out, int out_size, void* d_ws,
                              size_t ws_size, hipStream_t stream) {
  P p{};
  const float** fp = (const float**)&p;
  for (int i = 0; i < 32; i++) fp[i] = (const float*)d_in[i];
  p.out = (float*)d_out;
  p.ws = (char*)d_ws;
  size_t off = WS_TOTAL;
  if (off > ws_size) { fprintf(stderr, "ws too small: need %zu have %zu\n", off, ws_size); return; }
#if MULTI
  for (int ph = 0; ph < N_PHASES; ph++) hipLaunchKernelGGL(k_phase, dim3(512), dim3(256), 0, stream, p, ph);
#else
  static int grid_blocks = 0;
  if (!grid_blocks) {
    int dev = 0, cus = 0, per_cu = 0;
    hipGetDevice(&dev);
    hipDeviceGetAttribute(&cus, hipDeviceAttributeMultiprocessorCount, dev);
    hipOccupancyMaxActiveBlocksPerMultiprocessor(&per_cu, k_mega, 256, 0);
    if (per_cu > 2) per_cu = 2;
    grid_blocks = cus * per_cu;
  }
  hipMemsetAsync(p.ws + OFF_bar, 0, 16384, stream);
  void* args[] = {&p};
  hipError_t e = hipLaunchCooperativeKernel((void*)k_mega, dim3(grid_blocks), dim3(256), args, 0, stream);
  if (e != hipSuccess) fprintf(stderr, "cooperative launch failed: %s (grid %d)\n", hipGetErrorString(e), grid_blocks);
#endif
}
```

```cpp
#include <hip/hip_runtime.h>
#include <hip/hip_cooperative_groups.h>
#include <cstdio>
#include <cstdint>
namespace cg = cooperative_groups;

#ifndef MULTI
#define MULTI 0
#endif

typedef unsigned short bf16_t;
using bf16x8 = __attribute__((ext_vector_type(8))) short;
using f32x4 = __attribute__((ext_vector_type(4))) float;
using u32x4 = __attribute__((ext_vector_type(4))) unsigned int;

#define T_ALL 12288
#define T_CTX 8192
#define NEG_INF (-__builtin_inff())

__device__ __forceinline__ int tidx() {
  int t = threadIdx.x;
  asm volatile("" : "+v"(t));
  return t;
}
__device__ __forceinline__ bf16_t f2bf(float f) {
  unsigned u = __float_as_uint(f);
  u += 0x7fffu + ((u >> 16) & 1u);
  return (bf16_t)(u >> 16);
}
__device__ __forceinline__ float bf2f(bf16_t b) { return __uint_as_float(((unsigned)b) << 16); }
__device__ __forceinline__ float wsum_shfl(float v) {
#pragma unroll
  for (int o = 32; o; o >>= 1) v += __shfl_xor(v, o);
  return v;
}
#define DPP_F(old, src, ctrl, rm) __int_as_float(__builtin_amdgcn_update_dpp(__float_as_int(old), __float_as_int(src), ctrl, rm, 0xf, false))
__device__ __forceinline__ float wsum(float v) {
  v += DPP_F(v, v, 0xB1, 0xf);
  v += DPP_F(v, v, 0x4E, 0xf);
  v += DPP_F(v, v, 0x141, 0xf);
  v += DPP_F(v, v, 0x140, 0xf);
  v += DPP_F(0.f, v, 0x142, 0xa);
  v += DPP_F(0.f, v, 0x143, 0xc);
  return __int_as_float(__builtin_amdgcn_readlane(__float_as_int(v), 63));
}
__device__ __forceinline__ float wmax(float v) {
  v = fmaxf(v, DPP_F(v, v, 0xB1, 0xf));
  v = fmaxf(v, DPP_F(v, v, 0x4E, 0xf));
  v = fmaxf(v, DPP_F(v, v, 0x141, 0xf));
  v = fmaxf(v, DPP_F(v, v, 0x140, 0xf));
  v = fmaxf(v, DPP_F(v, v, 0x142, 0xa));
  v = fmaxf(v, DPP_F(v, v, 0x143, 0xc));
  return __int_as_float(__builtin_amdgcn_readlane(__float_as_int(v), 63));
}
__device__ __forceinline__ float siluf(float x) { return x * __builtin_amdgcn_rcpf(1.f + __expf(-x)); }
__device__ __forceinline__ float sigmf(float x) { return __builtin_amdgcn_rcpf(1.f + __expf(-x)); }
__device__ __forceinline__ float logsigf(float z) { return fminf(z, 0.f) - log1pf(__expf(-fabsf(z))); }
__device__ __forceinline__ int cond_row(int g) { return g < T_CTX ? 0 : 1 + ((g - T_CTX) >> 11); }

struct P {
  const float *x_prompt, *x_sample, *c, *cache_ckv, *cache_krope, *cache_swa_k, *cache_swa_v, *state_gla, *c_ctx,
      *w_ada, *b_ada, *w_in, *mla_q_norm, *w_uq, *mla_kv_norm, *w_ukv, *w_gla_a_fwd, *b_gla_a_fwd, *w_gla_a_bwd,
      *b_gla_a_bwd, *gla_norm, *swa_sink, *w_branch, *w_out, *ln1_g, *ln1_b, *ln2_g, *ln2_b, *w_peer_q, *peer_keys,
      *peer_u, *peer_v;
  float* out;
  char* ws;
};

constexpr size_t OFF_Wt_in = 0ull;
constexpr size_t OFF_Wt_uq = OFF_Wt_in + (((2ull * 6144 * 1024 * 2) + 255ull) & ~255ull);
constexpr size_t OFF_Wt_ukv = OFF_Wt_uq + (((2ull * 384 * 256 * 2) + 255ull) & ~255ull);
constexpr size_t OFF_Wt_br = OFF_Wt_ukv + (((2ull * 512 * 128 * 2) + 255ull) & ~255ull);
constexpr size_t OFF_Wt_out = OFF_Wt_br + (((8ull * 1024 * 256 * 2) + 255ull) & ~255ull);
constexpr size_t OFF_Wt_pq = OFF_Wt_out + (((2ull * 1024 * 1024 * 2) + 255ull) & ~255ull);
constexpr size_t OFF_keysbf = OFF_Wt_pq + (((2ull * 2048 * 1024 * 2) + 255ull) & ~255ull);
constexpr size_t OFF_Cch = OFF_keysbf + (((2ull * 16 * 128 * 128 * 2) + 255ull) & ~255ull);
constexpr size_t OFF_A256 = OFF_Cch + (((128ull * 64 * 2) + 255ull) & ~255ull);
constexpr size_t OFF_A2048 = OFF_A256 + (((256ull * 512 * 2) + 255ull) & ~255ull);
constexpr size_t OFF_mada = OFF_A2048 + (((2048ull * 4096 * 2) + 255ull) & ~255ull);
constexpr size_t OFF_xbuf = OFF_mada + (((2ull * 3 * 6144 * 4) + 255ull) & ~255ull);
constexpr size_t OFF_u = OFF_xbuf + 256ull;
constexpr size_t OFF_hbuf = OFF_u + (((12288ull * 1024 * 2) + 255ull) & ~255ull);
constexpr size_t OFF_gates = OFF_hbuf + (((12288ull * 1984 * 4) + 255ull) & ~255ull);
constexpr size_t OFF_qn = OFF_gates + (((12288ull * 4096 * 2) + 255ull) & ~255ull);
constexpr size_t OFF_ckv_all = OFF_qn + (((12288ull * 256 * 2) + 255ull) & ~255ull);
constexpr size_t OFF_Qa = OFF_ckv_all + (((13312ull * 128 * 2) + 255ull) & ~255ull);
constexpr size_t OFF_Ka_ctx = OFF_Qa + (((12288ull * 384 * 2) + 255ull) & ~255ull);
constexpr size_t OFF_Ka_lat = OFF_Ka_ctx + (((32ull * 4 * 256 * 96 * 2) + 255ull) & ~255ull);
constexpr size_t OFF_Va_ctx = OFF_Ka_lat + (((2ull * 4 * 2560 * 96 * 2) + 255ull) & ~255ull);
constexpr size_t OFF_Va_lat = OFF_Va_ctx + (((32ull * 4 * 256 * 64 * 2) + 255ull) & ~255ull);
constexpr size_t OFF_Qd = OFF_Va_lat + (((2ull * 4 * 2560 * 64 * 2) + 255ull) & ~255ull);
constexpr size_t OFF_Kd_ctx = OFF_Qd + (((12288ull * 256 * 2) + 255ull) & ~255ull);
constexpr size_t OFF_Kd_lat = OFF_Kd_ctx + (((32ull * 2 * 256 * 64 * 2) + 255ull) & ~255ull);
constexpr size_t OFF_Vd_ctx = OFF_Kd_lat + (((2ull * 2 * 2560 * 64 * 2) + 255ull) & ~255ull);
constexpr size_t OFF_Vd_lat = OFF_Vd_ctx + (((32ull * 2 * 256 * 64 * 2) + 255ull) & ~255ull);
constexpr size_t OFF_fnet = OFF_Vd_lat + (((2ull * 2 * 2560 * 64 * 2) + 255ull) & ~255ull);
constexpr size_t OFF_Yt_ctx = OFF_fnet + (((12288ull * 256 * 2) + 255ull) & ~255ull);
constexpr size_t OFF_Yt_lat = OFF_Yt_ctx + (((32ull * 256 * 512 * 2) + 255ull) & ~255ull);
constexpr size_t OFF_br = OFF_Yt_lat + (((2ull * 256 * 4096 * 2) + 255ull) & ~255ull);
constexpr size_t OFF_un = OFF_br + (((12288ull * 1024 * 2) + 255ull) & ~255ull);
constexpr size_t OFF_sin_ = OFF_un + (((1536ull * 2048 * 4) + 255ull) & ~255ull);
constexpr size_t OFF_gn = OFF_sin_ + (((1536ull * 2048 * 4) + 255ull) & ~255ull);
constexpr size_t OFF_pidx = OFF_gn + (((1536ull * 32 * 4) + 255ull) & ~255ull);
constexpr size_t OFF_pw = OFF_pidx + (((12288ull * 128 * 4) + 255ull) & ~255ull);
constexpr size_t OFF_bar = OFF_pw + (((12288ull * 128 * 4) + 255ull) & ~255ull);
constexpr size_t WS_TOTAL_OLD = OFF_pw + (((12288ull * 128 * 4) + 255ull) & ~255ull);
constexpr size_t OFF_tabU = OFF_bar + 16384ull;
constexpr size_t OFF_tabV = OFF_tabU + 2ull * 16384 * 1024;
constexpr size_t WS_TOTAL = OFF_tabV + 2ull * 16384 * 1024;
#define W_tabU ((unsigned char*)(p.ws + OFF_tabU))
#define W_tabV ((unsigned char*)(p.ws + OFF_tabV))
#define W_Wt_in ((bf16_t*)(p.ws + OFF_Wt_in))
#define W_Wt_uq ((bf16_t*)(p.ws + OFF_Wt_uq))
#define W_Wt_ukv ((bf16_t*)(p.ws + OFF_Wt_ukv))
#define W_Wt_br ((bf16_t*)(p.ws + OFF_Wt_br))
#define W_Wt_out ((bf16_t*)(p.ws + OFF_Wt_out))
#define W_Wt_pq ((bf16_t*)(p.ws + OFF_Wt_pq))
#define W_keysbf ((bf16_t*)(p.ws + OFF_keysbf))
#define W_Cch ((bf16_t*)(p.ws + OFF_Cch))
#define W_A256 ((bf16_t*)(p.ws + OFF_A256))
#define W_A2048 ((bf16_t*)(p.ws + OFF_A2048))
#define W_mada ((float*)(p.ws + OFF_mada))
#define W_xbuf ((float*)(p.ws + OFF_xbuf))
#define W_u ((bf16_t*)(p.ws + OFF_u))
#define W_hbuf ((float*)(p.ws + OFF_hbuf))
#define W_gates ((bf16_t*)(p.ws + OFF_gates))
#define W_qn ((bf16_t*)(p.ws + OFF_qn))
#define W_ckv_all ((bf16_t*)(p.ws + OFF_ckv_all))
#define W_Qa ((bf16_t*)(p.ws + OFF_Qa))
#define W_Ka_ctx ((bf16_t*)(p.ws + OFF_Ka_ctx))
#define W_Ka_lat ((bf16_t*)(p.ws + OFF_Ka_lat))
#define W_Va_ctx ((bf16_t*)(p.ws + OFF_Va_ctx))
#define W_Va_lat ((bf16_t*)(p.ws + OFF_Va_lat))
#define W_Qd ((bf16_t*)(p.ws + OFF_Qd))
#define W_Kd_ctx ((bf16_t*)(p.ws + OFF_Kd_ctx))
#define W_Kd_lat ((bf16_t*)(p.ws + OFF_Kd_lat))
#define W_Vd_ctx ((bf16_t*)(p.ws + OFF_Vd_ctx))
#define W_Vd_lat ((bf16_t*)(p.ws + OFF_Vd_lat))
#define W_fnet ((bf16_t*)(p.ws + OFF_fnet))
#define W_Yt_ctx ((bf16_t*)(p.ws + OFF_Yt_ctx))
#define W_Yt_lat ((bf16_t*)(p.ws + OFF_Yt_lat))
#define W_br ((bf16_t*)(p.ws + OFF_br))
#define W_un ((float*)(p.ws + OFF_un))
#define W_sin_ ((float*)(p.ws + OFF_sin_))
#define W_gn ((float*)(p.ws + OFF_gn))
#define W_pidx ((int*)(p.ws + OFF_pidx))
#define W_pw ((float*)(p.ws + OFF_pw))

#define GB_LD 72
#define G_LOAD(RA, RB, KOFF)                                                         \
  _Pragma("unroll") for (int i = 0; i < 4; i++) {                                    \
    int c = tid + i * 256, r = c >> 3, cc = (c & 7) * 8;                             \
    RA[i] = *(const u32x4*)(A + (size_t)r * lda + (KOFF) + cc);                      \
    if (i < NJ) RB[i] = *(const u32x4*)(B + (size_t)r * ldb + (KOFF) + cc);          \
  }
#define G_STORE(RA, RB)                                                              \
  _Pragma("unroll") for (int i = 0; i < 4; i++) {                                    \
    int c = tid + i * 256, r = c >> 3, cc = (c & 7) * 8;                             \
    *(u32x4*)(sa + r * GB_LD + cc) = RA[i];                                          \
    if (i < NJ) *(u32x4*)(sb + r * GB_LD + cc) = RB[i];                              \
  }
#define G_COMPUTE()                                                                  \
  _Pragma("unroll") for (int ks = 0; ks < 2; ks++) {                                 \
    bf16x8 af[4], bfr[NJ];                                                           \
    _Pragma("unroll") for (int i = 0; i < 4; i++)                                    \
      af[i] = *(const bf16x8*)(sa + (wm * 64 + i * 16 + l15) * GB_LD + ks * 32 + l4 * 8); \
    _Pragma("unroll") for (int j = 0; j < NJ; j++)                                   \
      bfr[j] = *(const bf16x8*)(sb + (wn * NJ * 16 + j * 16 + l15) * GB_LD + ks * 32 + l4 * 8); \
    _Pragma("unroll") for (int i = 0; i < 4; i++)                                    \
    _Pragma("unroll") for (int j = 0; j < NJ; j++)                                   \
      acc[i][j] = __builtin_amdgcn_mfma_f32_16x16x32_bf16(af[i], bfr[j], acc[i][j], 0, 0, 0); \
  }
template <int NJ>
__device__ __forceinline__ void gemm_core_t(f32x4 (&acc)[4][NJ], const bf16_t* __restrict__ A, int lda,
                                            const bf16_t* __restrict__ B, int ldb, int K, char* smem) {
  bf16_t* sa = (bf16_t*)smem;
  bf16_t* sb = sa + 128 * GB_LD;
  const int tid = tidx(), lane = tid & 63, w = tid >> 6, wm = w >> 1, wn = w & 1;
  const int l15 = lane & 15, l4 = lane >> 4;
  u32x4 ra0[4], rb0[NJ], ra1[4], rb1[NJ];
  G_LOAD(ra0, rb0, 0);
  if (K > 64) { G_LOAD(ra1, rb1, 64); }
  for (int k0 = 0; k0 < K; k0 += 128) {
    __syncthreads();
    G_STORE(ra0, rb0);
    __syncthreads();
    if (k0 + 128 < K) { G_LOAD(ra0, rb0, k0 + 128); }
    G_COMPUTE();
    if (k0 + 64 < K) {
      __syncthreads();
      G_STORE(ra1, rb1);
      __syncthreads();
      if (k0 + 192 < K) { G_LOAD(ra1, rb1, k0 + 192); }
      G_COMPUTE();
    }
  }
}
#define gemm_core gemm_core_t<4>
#define ZERO_ACC_N(acc, NJ)                                        \
  _Pragma("unroll") for (int i_ = 0; i_ < 4; i_++)                 \
  _Pragma("unroll") for (int j_ = 0; j_ < NJ; j_++) { acc[i_][j_] = f32x4{0.f, 0.f, 0.f, 0.f}; }
#define ZERO_ACC(acc) ZERO_ACC_N(acc, 4)
#define EPI_LOOP_N(acc, m0, n0, NJ, ...)                                                   \
  {                                                                                        \
    const int lane_ = tidx() & 63, w_ = tidx() >> 6, wm_ = w_ >> 1, wn_ = w_ & 1; \
    _Pragma("unroll") for (int i_ = 0; i_ < 4; i_++)                                       \
    _Pragma("unroll") for (int j_ = 0; j_ < NJ; j_++)                                      \
    _Pragma("unroll") for (int r_ = 0; r_ < 4; r_++) {                                     \
      const int m = (m0) + wm_ * 64 + i_ * 16 + (lane_ >> 4) * 4 + r_;                     \
      const int n = (n0) + wn_ * (NJ * 16) + j_ * 16 + (lane_ & 15);                       \
      float v = acc[i_][j_][r_];                                                           \
      __VA_ARGS__                                                                          \
    }                                                                                      \
  }
#define EPI_LOOP(acc, m0, n0, ...) EPI_LOOP_N(acc, m0, n0, 4, __VA_ARGS__)
#define EPI4_LOOP(acc, c0, t0, ...)                                                        \
  {                                                                                        \
    const int lane_ = tidx() & 63, w_ = tidx() >> 6, wm_ = w_ >> 1, wn_ = w_ & 1;           \
    _Pragma("unroll") for (int i_ = 0; i_ < 4; i_++)                                       \
    _Pragma("unroll") for (int j_ = 0; j_ < 4; j_++) {                                     \
      const int col = (c0) + wm_ * 64 + i_ * 16 + (lane_ >> 4) * 4;                        \
      const int tok = (t0) + wn_ * 64 + j_ * 16 + (lane_ & 15);                            \
      const f32x4 v4 = acc[i_][j_];                                                        \
      __VA_ARGS__                                                                          \
    }                                                                                      \
  }

__device__ __forceinline__ void transpose_tile(const float* __restrict__ src, int K, int N, bf16_t* __restrict__ dst, int tile, int ntn,
                               float* sm, int ldd = 0) {
  if (ldd == 0) ldd = K;
  int kt = tile / ntn, nt = tile % ntn, k0 = kt * 64, n0 = nt * 64;
  int tx = tidx() & 63, ty = tidx() >> 6;
  __syncthreads();
  for (int i = 0; i < 16; i++) {
    int k = i * 4 + ty, n = n0 + tx;
    sm[k * 65 + tx] = (n < N) ? src[(size_t)(k0 + k) * N + n] : 0.f;
  }
  __syncthreads();
  for (int i = 0; i < 16; i++) {
    int n = i * 4 + ty;
    dst[(size_t)(n0 + n) * ldd + k0 + tx] = f2bf(sm[tx * 65 + n]);
  }
}

__device__ __forceinline__ void ada_item(const P& p, int item, float* sm) {
  int l = item / 24, cgp = item % 24;
  int lane = tidx() & 63, w = tidx() >> 6;
  const float* W = p.w_ada + (size_t)l * 1024 * 6144 + cgp * 256 + lane * 4;
  float4 a0 = {0, 0, 0, 0}, a1 = {0, 0, 0, 0}, a2 = {0, 0, 0, 0};
#pragma unroll 8
  for (int k = w * 256; k < (w + 1) * 256; k++) {
    float4 wv = *(const float4*)(W + (size_t)k * 6144);
    float c0 = siluf(p.c_ctx[k]), c1 = siluf(p.c[k]), c2 = siluf(p.c[1024 + k]);
    a0.x += c0 * wv.x; a0.y += c0 * wv.y; a0.z += c0 * wv.z; a0.w += c0 * wv.w;
    a1.x += c1 * wv.x; a1.y += c1 * wv.y; a1.z += c1 * wv.z; a1.w += c1 * wv.w;
    a2.x += c2 * wv.x; a2.y += c2 * wv.y; a2.z += c2 * wv.z; a2.w += c2 * wv.w;
  }
  __syncthreads();
  *(float4*)(sm + (w * 3 + 0) * 256 + lane * 4) = a0;
  *(float4*)(sm + (w * 3 + 1) * 256 + lane * 4) = a1;
  *(float4*)(sm + (w * 3 + 2) * 256 + lane * 4) = a2;
  __syncthreads();
  for (int o = tidx(); o < 768; o += 256) {
    int r = o >> 8, col = o & 255;
    float s = sm[(0 * 3 + r) * 256 + col] + sm[(1 * 3 + r) * 256 + col] + sm[(2 * 3 + r) * 256 + col] +
              sm[(3 * 3 + r) * 256 + col];
    W_mada[(l * 3 + r) * 6144 + cgp * 256 + col] = s + p.b_ada[l * 6144 + cgp * 256 + col];
  }
}

__device__ __forceinline__ void dft_seq_fill(bf16_t* dst, int S, int item) {
  float inv = rsqrtf((float)S);
  size_t base = (size_t)item * 2048;
  for (int e = 0; e < 8; e++) {
    size_t idx = base + e * 256 + tidx();
    int k = (int)(idx / (2 * S)), col = (int)(idx % (2 * S));
    int s = col < S ? col : col - S;
    int mm = (k * s) & (S - 1);
    float rev = (float)mm / (float)S;
    float v = col < S ? __builtin_amdgcn_cosf(rev) : -__builtin_amdgcn_sinf(rev);
    dst[idx] = f2bf(v * inv);
  }
}

#define PEER_U_SCALE 64.f
#define PEER_V_SCALE 16.f
__device__ __forceinline__ void tab_convert_item(const P& p, int item) {
  int l = item >> 12, isv = (item >> 11) & 1, sub = item & 2047;
  const float* src = (isv ? p.peer_v : p.peer_u) + (size_t)l * 16384 * 1024 + (size_t)sub * 8192;
  unsigned char* dst = (isv ? W_tabV : W_tabU) + (size_t)l * 16384 * 1024 + (size_t)sub * 8192;
  const float sc = isv ? PEER_V_SCALE : PEER_U_SCALE;
  int tid = tidx();
  float4 tt[8];
#pragma unroll
  for (int e = 0; e < 8; e++) tt[e] = *(const float4*)(src + (e * 256 + tid) * 4);
#pragma unroll
  for (int e = 0; e < 8; e++) {
    float4 t = tt[e];
    int pk = __builtin_amdgcn_cvt_pk_fp8_f32(t.x * sc, t.y * sc, 0, false);
    pk = __builtin_amdgcn_cvt_pk_fp8_f32(t.z * sc, t.w * sc, pk, true);
    *(int*)(dst + (e * 256 + tid) * 4) = pk;
  }
}

__device__ __forceinline__ void phase_prep(const P& p, char* smem) {
  float* sm = (float*)smem;
  const int nb = gridDim.x;
  const int J_ADA = 48;
  const int J_IN = 2 * 16 * 96;
  const int J_UQ = 2 * 4 * 6;
  const int J_UKV = 2 * 2 * 8;
  const int J_BR = 2 * 4 * 4 * 16;
  const int J_OUT = 2 * 16 * 16;
  const int J_PQ = 2 * 16 * 32;
  const int J_KEYS = 256;
  const int J_CCH = 4;
  const int J_A256 = 64;
  const int J_A2048 = 4096;
  const int J_TAB = 8192;
  const int total = J_ADA + J_IN + J_UQ + J_UKV + J_BR + J_OUT + J_PQ + J_KEYS + J_CCH + J_A256 + J_A2048 + J_TAB;
  for (int it0 = blockIdx.x; it0 < total; it0 += nb) {
    int it = it0;
    if (it < J_ADA) { ada_item(p, it, sm); continue; }
    it -= J_ADA;
    if (it < J_IN) { int l = it / 1536, t = it % 1536; transpose_tile(p.w_in + (size_t)l * 1024 * 6080, 1024, 6080, W_Wt_in + (size_t)l * 6144 * 1024, t, 96, sm); continue; }
    it -= J_IN;
    if (it < J_UQ) { int l = it / 24, t = it % 24; transpose_tile(p.w_uq + (size_t)l * 256 * 384, 256, 384, W_Wt_uq + (size_t)l * 384 * 256, t, 6, sm); continue; }
    it -= J_UQ;
    if (it < J_UKV) { int l = it / 16, t = it % 16; transpose_tile(p.w_ukv + (size_t)l * 128 * 512, 128, 512, W_Wt_ukv + (size_t)l * 512 * 128, t, 8, sm); continue; }
    it -= J_UKV;
    if (it < J_BR) { int lb = it / 64, t = it % 64; transpose_tile(p.w_branch + (size_t)lb * 256 * 1024, 256, 1024, W_Wt_br + (size_t)(lb >> 2) * 1024 * 1024 + (lb & 3) * 256, t, 16, sm, 1024); continue; }
    it -= J_BR;
    if (it < J_OUT) { int l = it / 256, t = it % 256; transpose_tile(p.w_out + (size_t)l * 1024 * 1024, 1024, 1024, W_Wt_out + (size_t)l * 1024 * 1024, t, 16, sm); continue; }
    it -= J_OUT;
    if (it < J_PQ) { int l = it / 512, t = it % 512; transpose_tile(p.w_peer_q + (size_t)l * 1024 * 2048, 1024, 2048, W_Wt_pq + (size_t)l * 2048 * 1024, t, 32, sm); continue; }
    it -= J_PQ;
    if (it < J_KEYS) {
      size_t base = (size_t)it * 2048;
      float kv_[8];
#pragma unroll
      for (int e = 0; e < 8; e++) kv_[e] = p.peer_keys[base + e * 256 + tidx()];
#pragma unroll
      for (int e = 0; e < 8; e++) W_keysbf[base + e * 256 + tidx()] = f2bf(kv_[e]);
      continue;
    }
    it -= J_KEYS;
    if (it < J_CCH) {
      for (int e = 0; e < 8; e++) {
        int idx = it * 2048 + e * 256 + tidx();
        int n = idx >> 6, c = idx & 63;
        int j = n & 63;
        float rev = (float)((j * c) & 63) / 64.f;
        float v = n < 64 ? __builtin_amdgcn_cosf(rev) : __builtin_amdgcn_sinf(rev);
        W_Cch[idx] = f2bf(v * 0.125f);
      }
      continue;
    }
    it -= J_CCH;
    if (it < J_A256) { dft_seq_fill(W_A256, 256, it); continue; }
    it -= J_A256;
    if (it < J_A2048) { dft_seq_fill(W_A2048, 2048, it); continue; }
    it -= J_A2048;
    tab_convert_item(p, it);
  }
}

__device__ __forceinline__ void load_row16(const float* row, int lane, float (&v)[16]) {
#pragma unroll
  for (int q = 0; q < 4; q++) {
    float4 t = *(const float4*)(row + q * 256 + lane * 4);
    v[q * 4 + 0] = t.x; v[q * 4 + 1] = t.y; v[q * 4 + 2] = t.z; v[q * 4 + 3] = t.w;
  }
}
__device__ __forceinline__ void store_row16(float* row, int lane, const float (&v)[16]) {
#pragma unroll
  for (int q = 0; q < 4; q++) *(float4*)(row + q * 256 + lane * 4) = float4{v[q * 4], v[q * 4 + 1], v[q * 4 + 2], v[q * 4 + 3]};
}
__device__ __forceinline__ void ln16(float (&v)[16]) {
  float s = 0;
#pragma unroll
  for (int i = 0; i < 16; i++) s += v[i];
  s = wsum(s);
  float mu = s * (1.f / 1024.f);
  float q = 0;
#pragma unroll
  for (int i = 0; i < 16; i++) { v[i] -= mu; q += v[i] * v[i]; }
  q = wsum(q);
  float rs = rsqrtf(q * (1.f / 1024.f) + 1e-6f);
#pragma unroll
  for (int i = 0; i < 16; i++) v[i] *= rs;
}
__device__ __forceinline__ void modulate_store(const float (&v)[16], const float* sh, const float* sc, bf16_t* dst, int lane) {
#pragma unroll
  for (int q = 0; q < 4; q++) {
    float4 a = *(const float4*)(sc + q * 256 + lane * 4);
    float4 b = *(const float4*)(sh + q * 256 + lane * 4);
    ushort4 o;
    o.x = f2bf(v[q * 4 + 0] * (1.f + a.x) + b.x);
    o.y = f2bf(v[q * 4 + 1] * (1.f + a.y) + b.y);
    o.z = f2bf(v[q * 4 + 2] * (1.f + a.z) + b.z);
    o.w = f2bf(v[q * 4 + 3] * (1.f + a.w) + b.w);
    *(ushort4*)(dst + q * 256 + lane * 4) = o;
  }
}
__device__ __forceinline__ void affine16(float (&v)[16], const float* g, const float* b, int lane) {
#pragma unroll
  for (int q = 0; q < 4; q++) {
    float4 a = *(const float4*)(g + q * 256 + lane * 4);
    float4 c = *(const float4*)(b + q * 256 + lane * 4);
    v[q * 4 + 0] = v[q * 4 + 0] * a.x + c.x;
    v[q * 4 + 1] = v[q * 4 + 1] * a.y + c.y;
    v[q * 4 + 2] = v[q * 4 + 2] * a.z + c.z;
    v[q * 4 + 3] = v[q * 4 + 3] * a.w + c.w;
  }
}
__device__ __forceinline__ const float* x_in_row(const P& p, int l, int g) {
  if (l == 0) return g < T_CTX ? p.x_prompt + (size_t)g * 1024 : p.x_sample + (size_t)(g - T_CTX) * 1024;
  return p.out + (size_t)g * 1024;
}
__device__ __forceinline__ float* x_out_row(const P& p, int l, int g) {
  return p.out + (size_t)g * 1024;
}

__device__ __forceinline__ void phase_ln0(const P& p) {
  int lane = tidx() & 63, w = tidx() >> 6;
  for (int it = blockIdx.x; it < T_ALL / 4; it += gridDim.x) {
    int g = it * 4 + w;
    float v[16];
    load_row16(x_in_row(p, 0, g), lane, v);
    ln16(v);
    const float* m = W_mada + (0 * 3 + cond_row(g)) * 6144;
    modulate_store(v, m, m + 1024, W_u + (size_t)g * 1024, lane);
  }
}

__device__ __forceinline__ void phase_win(const P& p, int l, char* smem) {
  const bf16_t* Wt = W_Wt_in + (size_t)l * 6144 * 1024;
  for (int tile = blockIdx.x; tile < 96 * 48; tile += gridDim.x) {
    int mt = tile / 48, nt = tile % 48, m0 = mt * 128, n0 = nt * 128;
    f32x4 acc[4][4];
    ZERO_ACC(acc);
    gemm_core(acc, Wt + (size_t)n0 * 1024, 1024, W_u + (size_t)m0 * 1024, 1024, 1024, smem);
    EPI4_LOOP(acc, n0, m0, {
      if (col < 1984) *(float4*)(W_hbuf + (size_t)tok * 1984 + col) = float4{v4[0], v4[1], v4[2], v4[3]};
      else if (col < 6080) {
        ushort4 o_; o_.x = f2bf(sigmf(v4[0])); o_.y = f2bf(sigmf(v4[1])); o_.z = f2bf(sigmf(v4[2])); o_.w = f2bf(sigmf(v4[3]));
        *(ushort4*)(W_gates + (size_t)tok * 4096 + (col - 1984)) = o_;
      }
    });
  }
}

__device__ __forceinline__ void rope_cs(float pos, int i, float inv_hp, float& cs, float& sn) {
  float freq = exp2f(-(float)i * inv_hp * 13.287712379549449f);
  float a = pos * freq;
  sn = __sinf(a);
  cs = __cosf(a);
}

__device__ __forceinline__ void phase_post(const P& p, int l) {
  int lane = tidx() & 63, w = tidx() >> 6;
  for (int it = blockIdx.x; it < 13312 / 4; it += gridDim.x) {
    int g = it * 4 + w;
    if (g < T_ALL) {
      const bool lat = g >= T_CTX;
      int b, s;
      if (!lat) { b = g >> 8; s = g & 255; } else { b = (g - T_CTX) >> 11; s = (g - T_CTX) & 2047; }
      const float* h = W_hbuf + (size_t)g * 1984;
      const float prow = (float)(s >> 6), pcol = (float)(s & 63);
      const float4 pl_q = *(const float4*)(h + lane * 4);
      const float2 pl_c = *(const float2*)(h + 256 + lane * 2);
      const float pl_kr1 = h[384 + ((lane >> 3) & 1) * 16 + (lane & 7)], pl_kr2 = h[384 + ((lane >> 3) & 1) * 16 + 8 + (lane & 7)];
      const float4 pl_f = *(const float4*)(h + 416 + lane * 4);
      float pl_sq1[2], pl_sq2[2];
#pragma unroll
      for (int jj = 0; jj < 2; jj++) {
        int pi = lane + 64 * jj, hq = pi >> 5, pp = (pi >> 4) & 1, i = pi & 15;
        pl_sq1[jj] = h[1472 + hq * 64 + pp * 32 + i]; pl_sq2[jj] = h[1472 + hq * 64 + pp * 32 + 16 + i];
      }
      const float pl_sk1 = h[1728 + (lane >> 5) * 64 + ((lane >> 4) & 1) * 32 + (lane & 15)];
      const float pl_sk2 = h[1728 + (lane >> 5) * 64 + ((lane >> 4) & 1) * 32 + 16 + (lane & 15)];
      const float2 pl_v = *(const float2*)(h + 1856 + lane * 2);
      {
        float4 t = pl_q;
        float ss = wsum(t.x * t.x + t.y * t.y + t.z * t.z + t.w * t.w);
        float rs = rsqrtf(ss * (1.f / 256.f) + 1e-6f);
        float4 gq = *(const float4*)(p.mla_q_norm + l * 256 + lane * 4);
        ushort4 o;
        o.x = f2bf(t.x * rs * gq.x); o.y = f2bf(t.y * rs * gq.y); o.z = f2bf(t.z * rs * gq.z); o.w = f2bf(t.w * rs * gq.w);
        *(ushort4*)(W_qn + (size_t)g * 256 + lane * 4) = o;
      }
      {
        float2 t = pl_c;
        float ss = wsum(t.x * t.x + t.y * t.y);
        float rs = rsqrtf(ss * (1.f / 128.f) + 1e-6f);
        float2 gk = *(const float2*)(p.mla_kv_norm + l * 128 + lane * 2);
        float v0 = t.x * rs * gk.x, v1 = t.y * rs * gk.y;
        ushort2 o; o.x = f2bf(v0); o.y = f2bf(v1);
        *(ushort2*)(W_ckv_all + (size_t)g * 128 + lane * 2) = o;
        if (!lat) *(float2*)(p.out + 12582912 + ((size_t)((b * 2 + l) * 256 + s)) * 128 + lane * 2) = float2{v0, v1};
      }
      if (lane < 16) {
        int pp = lane >> 3, i = lane & 7;
        float x1 = pl_kr1, x2 = pl_kr2;
        float o1 = x1, o2 = x2;
        if (lat) {
          float cs, sn;
          rope_cs(pp ? pcol : prow, i, 0.125f, cs, sn);
          o1 = x1 * cs - x2 * sn; o2 = x2 * cs + x1 * sn;
        } else {
          float* ok = p.out + 14680064 + ((size_t)((b * 2 + l) * 256 + s)) * 32 + pp * 16 + i;
          ok[0] = o1; ok[8] = o2;
        }
        bf16_t b1 = f2bf(o1), b2 = f2bf(o2);
        for (int hh = 0; hh < 4; hh++) {
          bf16_t* kd = lat ? W_Ka_lat + ((size_t)((b * 4 + hh) * 2560 + 512 + s)) * 96 : W_Ka_ctx + ((size_t)((b * 4 + hh) * 256 + s)) * 96;
          kd[64 + pp * 16 + i] = b1; kd[64 + pp * 16 + 8 + i] = b2;
        }
      }
      {
        float4 t = pl_f;
        ushort4 o; o.x = f2bf(t.x); o.y = f2bf(t.y); o.z = f2bf(t.z); o.w = f2bf(t.w);
        *(ushort4*)(W_fnet + (size_t)g * 256 + lane * 4) = o;
      }
#pragma unroll
      for (int jj = 0; jj < 2; jj++) {
        int pi = lane + 64 * jj, hq = pi >> 5, pp = (pi >> 4) & 1, i = pi & 15;
        float x1 = pl_sq1[jj], x2 = pl_sq2[jj];
        float o1 = x1, o2 = x2;
        if (lat) {
          float cs, sn;
          rope_cs(pp ? pcol : prow, i, 0.0625f, cs, sn);
          o1 = x1 * cs - x2 * sn; o2 = x2 * cs + x1 * sn;
        }
        bf16_t* qd = W_Qd + (size_t)g * 256 + hq * 64 + pp * 32 + i;
        qd[0] = f2bf(o1); qd[16] = f2bf(o2);
      }
      {
        int kv = lane >> 5, pp = (lane >> 4) & 1, i = lane & 15;
        float x1 = pl_sk1, x2 = pl_sk2;
        float o1 = x1, o2 = x2;
        bf16_t* kd;
        if (lat) {
          float cs, sn;
          rope_cs(pp ? pcol : prow, i, 0.0625f, cs, sn);
          o1 = x1 * cs - x2 * sn; o2 = x2 * cs + x1 * sn;
          kd = W_Kd_lat + ((size_t)((b * 2 + kv) * 2560 + 512 + s)) * 64;
        } else {
          float* ok = p.out + 15204352 + ((size_t)(((b * 2 + l) * 2 + kv) * 256 + s)) * 64 + pp * 32 + i;
          ok[0] = o1; ok[16] = o2;
          kd = W_Kd_ctx + ((size_t)((b * 2 + kv) * 256 + s)) * 64;
        }
        kd[pp * 32 + i] = f2bf(o1); kd[pp * 32 + 16 + i] = f2bf(o2);
      }
      {
        int e = lane * 2, kv = e >> 6, d = e & 63;
        float2 t = pl_v;
        if (lat) {
          bf16_t* vt = W_Vd_lat + (size_t)(b * 2 + kv) * 64 * 2560 + 512 + s;
          vt[(size_t)d * 2560] = f2bf(t.x); vt[(size_t)(d + 1) * 2560] = f2bf(t.y);
        } else {
          *(float2*)(p.out + 17301504 + ((size_t)(((b * 2 + l) * 2 + kv) * 256 + s)) * 64 + d) = t;
          bf16_t* vt = W_Vd_ctx + (size_t)(b * 2 + kv) * 64 * 256 + s;
          vt[d * 256] = f2bf(t.x); vt[(d + 1) * 256] = f2bf(t.y);
        }
      }
    } else {
      int gc = g - T_ALL, b = gc >> 9, pp = gc & 511;
      {
        float2 t = *(const float2*)(p.cache_ckv + ((size_t)((b * 2 + l) * 512 + pp)) * 128 + lane * 2);
        ushort2 o; o.x = f2bf(t.x); o.y = f2bf(t.y);
        *(ushort2*)(W_ckv_all + (size_t)g * 128 + lane * 2) = o;
      }
      if (lane < 32) {
        bf16_t v = f2bf(p.cache_krope[((size_t)((b * 2 + l) * 512 + pp)) * 32 + lane]);
        for (int hh = 0; hh < 4; hh++) W_Ka_lat[((size_t)((b * 4 + hh) * 2560 + pp)) * 96 + 64 + lane] = v;
      }
      {
        int e = lane * 2, kv = e >> 6, d = e & 63;
        size_t src = ((size_t)(((b * 2 + l) * 2 + kv) * 512 + pp)) * 64 + d;
        float2 tk = *(const float2*)(p.cache_swa_k + src);
        float2 tv = *(const float2*)(p.cache_swa_v + src);
        size_t dst = ((size_t)((b * 2 + kv) * 2560 + pp)) * 64 + d;
        ushort2 ok; ok.x = f2bf(tk.x); ok.y = f2bf(tk.y);
        *(ushort2*)(W_Kd_lat + dst) = ok;
        bf16_t* vt = W_Vd_lat + (size_t)(b * 2 + kv) * 64 * 2560 + pp;
        vt[(size_t)d * 2560] = f2bf(tv.x); vt[(size_t)(d + 1) * 2560] = f2bf(tv.y);
      }
    }
  }
}

__device__ __forceinline__ void phase_small_gemms(const P& p, int l, char* smem) {
  const int NA = 96 * 3, NB = 104 * 4, NC = 384;
  for (int it0 = blockIdx.x; it0 < NA + NB + NC; it0 += gridDim.x) {
    int it = it0;
    f32x4 acc[4][4];
    ZERO_ACC(acc);
    if (it < NA) {
      int mt = it / 3, nt = it % 3, m0 = mt * 128, n0 = nt * 128;
      gemm_core(acc, W_qn + (size_t)m0 * 256, 256, W_Wt_uq + (size_t)l * 384 * 256 + (size_t)n0 * 256, 256, 256, smem);
      const bool lat = m0 >= T_CTX;
      EPI_LOOP(acc, m0, n0, {
        int c96 = n % 96;
        if (lat && c96 >= 64) {
          float pv = DPP_F(v, v, 0x128, 0xf);
          int cr = c96 - 64, pp = cr >> 4, ii = cr & 15, i = ii & 7;
          int s = (m - T_CTX) & 2047;
          float cs, sn;
          rope_cs(pp ? (float)(s & 63) : (float)(s >> 6), i, 0.125f, cs, sn);
          v = (ii < 8) ? v * cs - pv * sn : v * cs + pv * sn;
        }
        W_Qa[(size_t)m * 384 + n] = f2bf(v);
      });
      continue;
    }
    it -= NA;
    if (it < NB) {
      int mt = it / 4, nt = it % 4, m0 = mt * 128, n0 = nt * 128;
      gemm_core(acc, W_ckv_all + (size_t)m0 * 128, 128, W_Wt_ukv + (size_t)l * 512 * 128 + (size_t)n0 * 128, 128, 128, smem);
      EPI_LOOP(acc, m0, n0, {
        int hh = n >> 7, c = n & 127;
        bf16_t* kd; bf16_t* vd; int vstride;
        if (m < T_CTX) {
          int b = m >> 8, s = m & 255;
          size_t r = (size_t)((b * 4 + hh) * 256 + s);
          kd = W_Ka_ctx + r * 96; vd = W_Va_ctx + (size_t)(b * 4 + hh) * 64 * 256 + s; vstride = 256;
        } else {
          int b, pos;
          if (m < T_ALL) { b = (m - T_CTX) >> 11; pos = 512 + ((m - T_CTX) & 2047); }
          else { b = (m - T_ALL) >> 9; pos = (m - T_ALL) & 511; }
          size_t r = (size_t)((b * 4 + hh) * 2560 + pos);
          kd = W_Ka_lat + r * 96; vd = W_Va_lat + (size_t)(b * 4 + hh) * 64 * 2560 + pos; vstride = 2560;
        }
        if (c < 64) kd[c] = f2bf(v); else vd[(size_t)(c - 64) * vstride] = f2bf(v);
      });
      continue;
    }
    it -= NB;
    {
      int m0 = it * 128;
      gemm_core(acc, W_fnet + (size_t)m0 * 64, 64, W_Cch, 64, 64, smem);
      EPI_LOOP(acc, m0, 0, {
        int g = m >> 2, grp = m & 3, part = n >> 6, j = n & 63;
        if (g < T_CTX) {
          int b = g >> 8, s = g & 255;
          W_Yt_ctx[((size_t)(b * 256 + grp * 64 + j)) * 512 + part * 256 + s] = f2bf(v);
        } else {
          int b = (g - T_CTX) >> 11, s = (g - T_CTX) & 2047;
          W_Yt_lat[((size_t)(b * 256 + grp * 64 + j)) * 4096 + part * 2048 + s] = f2bf(v);
        }
      });
    }
  }
}

template <int DK>
__device__ __forceinline__ void attn_item(const bf16_t* __restrict__ Qp, int qstride, const bf16_t* __restrict__ Kp,
                          const bf16_t* __restrict__ Vp, bf16_t* __restrict__ Op, int q0, int Sk, int n_ctx, int W,
                          float scale, bool has_sink, float sink, char* smem) {
  constexpr int KLD = DK + 8;
  bf16_t* sK = (bf16_t*)smem;
  bf16_t* sVt = sK + 64 * KLD;
  bf16_t* sP = sVt + 64 * 72;
  const int tid = tidx(), lane = tid & 63, w = tid >> 6, l15 = lane & 15, l4 = lane >> 4;
  bf16_t* sPw = sP + w * 16 * 72;
  bf16x8 qf[DK / 32];
  {
    const bf16_t* qrow = Qp + (size_t)(q0 + w * 16 + l15) * qstride;
#pragma unroll
    for (int ks = 0; ks < DK / 32; ks++) qf[ks] = *(const bf16x8*)(qrow + ks * 32 + l4 * 8);
  }
  f32x4 o[4];
#pragma unroll
  for (int j = 0; j < 4; j++) o[j] = f32x4{0.f, 0.f, 0.f, 0.f};
  float mrow[4], lrow[4];
#pragma unroll
  for (int r = 0; r < 4; r++) { mrow[r] = NEG_INF; lrow[r] = 0.f; }
  const int ntile = Sk >> 6;
  auto tile_ok = [&](int kt) -> bool {
    int kb = kt * 64;
    if (W >= 0 && kb >= n_ctx) { int lp = kb - n_ctx; if (lp + 63 < q0 - W || lp > q0 + 63 + W) return false; }
    return true;
  };
  u32x4 rk[DK / 32], rv[2];
  int kt = 0;
  while (kt < ntile && !tile_ok(kt)) kt++;
  if (kt < ntile) {
#pragma unroll
    for (int i = 0; i < DK / 32; i++) { int c = tid + i * 256, r = c / (DK / 8), cc = (c % (DK / 8)) * 8; rk[i] = *(const u32x4*)(Kp + (size_t)(kt * 64 + r) * DK + cc); }
#pragma unroll
    for (int i = 0; i < 2; i++) { int c = tid + i * 256, dv = c >> 3, k0 = (c & 7) * 8; rv[i] = *(const u32x4*)(Vp + (size_t)dv * Sk + kt * 64 + k0); }
  }
  while (kt < ntile) {
    const int kbase = kt * 64;
    __syncthreads();
#pragma unroll
    for (int i = 0; i < DK / 32; i++) { int c = tid + i * 256, r = c / (DK / 8), cc = (c % (DK / 8)) * 8; *(u32x4*)(sK + r * KLD + cc) = rk[i]; }
#pragma unroll
    for (int i = 0; i < 2; i++) {
      int c = tid + i * 256, dv = c >> 3, k0 = (c & 7) * 8;
      *(u32x4*)(sVt + dv * 72 + k0) = rv[i];
    }
    __syncthreads();
    int ktn = kt + 1;
    while (ktn < ntile && !tile_ok(ktn)) ktn++;
    if (ktn < ntile) {
#pragma unroll
      for (int i = 0; i < DK / 32; i++) { int c = tid + i * 256, r = c / (DK / 8), cc = (c % (DK / 8)) * 8; rk[i] = *(const u32x4*)(Kp + (size_t)(ktn * 64 + r) * DK + cc); }
#pragma unroll
      for (int i = 0; i < 2; i++) { int c = tid + i * 256, dv = c >> 3, k0 = (c & 7) * 8; rv[i] = *(const u32x4*)(Vp + (size_t)dv * Sk + ktn * 64 + k0); }
    }
    kt = ktn;
    f32x4 s[4];
#pragma unroll
    for (int j = 0; j < 4; j++) {
      s[j] = f32x4{0.f, 0.f, 0.f, 0.f};
#pragma unroll
      for (int ks = 0; ks < DK / 32; ks++) {
        bf16x8 kf = *(const bf16x8*)(sK + (j * 16 + l15) * KLD + ks * 32 + l4 * 8);
        s[j] = __builtin_amdgcn_mfma_f32_16x16x32_bf16(qf[ks], kf, s[j], 0, 0, 0);
      }
    }
#pragma unroll
    for (int j = 0; j < 4; j++)
#pragma unroll
      for (int r = 0; r < 4; r++) {
        float v = s[j][r] * scale;
        if (W >= 0) {
          int kk = kbase + j * 16 + l15, t = q0 + w * 16 + l4 * 4 + r;
          int dlt = kk - n_ctx - t;
          bool valid = (kk < n_ctx) || (dlt <= W && dlt >= -W);
          if (!valid) v = NEG_INF;
        }
        s[j][r] = v;
      }
#pragma unroll
    for (int r = 0; r < 4; r++) {
      float mx = fmaxf(fmaxf(s[0][r], s[1][r]), fmaxf(s[2][r], s[3][r]));
      mx = fmaxf(mx, DPP_F(mx, mx, 0xB1, 0xf));
      mx = fmaxf(mx, DPP_F(mx, mx, 0x4E, 0xf));
      mx = fmaxf(mx, DPP_F(mx, mx, 0x141, 0xf));
      mx = fmaxf(mx, DPP_F(mx, mx, 0x140, 0xf));
      float mnew = fmaxf(mrow[r], mx);
      float muse = (mnew == NEG_INF) ? 0.f : mnew;
      float alpha = __expf(mrow[r] - muse);
      float rs = 0.f;
#pragma unroll
      for (int j = 0; j < 4; j++) { float pe = __expf(s[j][r] - muse); s[j][r] = pe; rs += pe; }
      rs += DPP_F(rs, rs, 0xB1, 0xf);
      rs += DPP_F(rs, rs, 0x4E, 0xf);
      rs += DPP_F(rs, rs, 0x141, 0xf);
      rs += DPP_F(rs, rs, 0x140, 0xf);
      lrow[r] = lrow[r] * alpha + rs;
      mrow[r] = mnew;
#pragma unroll
      for (int j = 0; j < 4; j++) o[j][r] *= alpha;
    }
#pragma unroll
    for (int j = 0; j < 4; j++)
#pragma unroll
      for (int r = 0; r < 4; r++) sPw[(l4 * 4 + r) * 72 + j * 16 + l15] = f2bf(s[j][r]);
    __builtin_amdgcn_s_waitcnt(0xc07f);
    __builtin_amdgcn_wave_barrier();
#pragma unroll
    for (int ks = 0; ks < 2; ks++) {
      bf16x8 pf = *(const bf16x8*)(sPw + l15 * 72 + ks * 32 + l4 * 8);
#pragma unroll
      for (int jn = 0; jn < 4; jn++) {
        bf16x8 vf = *(const bf16x8*)(sVt + (jn * 16 + l15) * 72 + ks * 32 + l4 * 8);
        o[jn] = __builtin_amdgcn_mfma_f32_16x16x32_bf16(pf, vf, o[jn], 0, 0, 0);
      }
    }
  }
#pragma unroll
  for (int r = 0; r < 4; r++) {
    float lsum = lrow[r];
    if (has_sink) lsum += __expf(sink - mrow[r]);
    float inv = 1.f / lsum;
#pragma unroll
    for (int jn = 0; jn < 4; jn++)
      Op[(size_t)(q0 + w * 16 + l4 * 4 + r) * 1024 + jn * 16 + l15] = f2bf(o[jn][r] * inv);
  }
}

__device__ __forceinline__ int gla_tok(int tb, int c, int dir, int tau) { return tb + c * 64 + (dir ? 63 - tau : tau); }

#define GLA_W2_OFF 40960
__device__ __forceinline__ void gla_stage_w2(const P& p, int l, char* smem) {
  float* w2s = (float*)(smem + GLA_W2_OFF);
  const int tid = tidx();
  __syncthreads();
#pragma unroll
  for (int i = 0; i < 2; i++) {
    int e = (tid + i * 256) * 4;
    *(float4*)(w2s + e) = *(const float4*)(p.w_gla_a_fwd + l * 2048 + e);
    *(float4*)(w2s + 2048 + e) = *(const float4*)(p.w_gla_a_bwd + l * 2048 + e);
  }
  if (tid < 128) w2s[4096 + tid] = p.b_gla_a_fwd[l * 128 + tid];
  else w2s[4096 + tid] = p.b_gla_a_bwd[l * 128 + tid - 128];
  __syncthreads();
}
__device__ __forceinline__ void gla_load_alow(const P& p, int tok, int dir, float4 (&al)[4]) {
  const float* src = W_hbuf + (size_t)tok * 1984 + (dir ? 1456 : 1440);
#pragma unroll
  for (int q = 0; q < 4; q++) al[q] = *(const float4*)(src + q * 4);
}
__device__ __forceinline__ void gla_cum_regs(const char* smem, const float4 (&al)[4], int h, int dir, int w, int lane, float (&c)[8], float (&tot)[8]) {
  const float* w2 = (const float*)(smem + GLA_W2_OFF) + dir * 2048 + h * 32 + w * 8;
  const float* b2 = (const float*)(smem + GLA_W2_OFF) + 4096 + dir * 128 + h * 32 + w * 8;
  float a[16];
#pragma unroll
  for (int q = 0; q < 4; q++) { a[q * 4] = al[q].x; a[q * 4 + 1] = al[q].y; a[q * 4 + 2] = al[q].z; a[q * 4 + 3] = al[q].w; }
#pragma unroll
  for (int j = 0; j < 8; j++) {
    float z = b2[j];
#pragma unroll
    for (int r = 0; r < 16; r++) z += a[r] * w2[r * 128 + j];
    float la = logsigf(z) * (1.f / 16.f);
    float v = la;
#pragma unroll
    for (int d = 1; d < 64; d <<= 1) { float t_ = __shfl_up(v, d); if (lane >= d) v += t_; }
    float total = __shfl(v, 63);
    c[j] = dir ? (total - v + la) : v;
    tot[j] = total;
  }
}
__device__ __forceinline__ void gla_load_v(const P& p, int tok, int h, int w, float4 (&vr)[4]) {
  const float* src = W_hbuf + (size_t)tok * 1984 + 928 + h * 64 + w * 16;
#pragma unroll
  for (int q = 0; q < 4; q++) vr[q] = *(const float4*)(src + q * 4);
}
__device__ __forceinline__ void gla_store_vt(const float4 (&vr)[4], int w, int lane, bf16_t* sVt) {
#pragma unroll
  for (int q = 0; q < 4; q++) {
    sVt[(w * 16 + q * 4 + 0) * 72 + lane] = f2bf(vr[q].x);
    sVt[(w * 16 + q * 4 + 1) * 72 + lane] = f2bf(vr[q].y);
    sVt[(w * 16 + q * 4 + 2) * 72 + lane] = f2bf(vr[q].z);
    sVt[(w * 16 + q * 4 + 3) * 72 + lane] = f2bf(vr[q].w);
  }
}

__device__ __forceinline__ void chunk_info(int cidx, int& tb, int& nch, int& n, int& cbase) {
  if (cidx < 128) { int b = cidx >> 2; n = cidx & 3; nch = 4; tb = b * 256; cbase = b * 4; }
  else { int cl = cidx - 128, b = cl >> 5; n = cl & 31; nch = 32; tb = T_CTX + b * 2048; cbase = 128 + b * 32; }
}

__device__ __forceinline__ void gla_g1_item(const P& p, int l, int item, char* smem) {
  bf16_t* sKeT = (bf16_t*)smem;
  bf16_t* sVt = sKeT + 32 * 72;
  const int tid = tidx(), lane = tid & 63, w = __builtin_amdgcn_readfirstlane(tid >> 6), l15 = lane & 15, l4 = lane >> 4;
  int dir = item & 1, h = (item >> 1) & 3, cidx = item >> 3;
  int tb, nch, n, cbase;
  chunk_info(cidx, tb, nch, n, cbase);
  int c = dir ? nch - 1 - n : n;
  int tok = tb + c * 64 + lane;
  float4 al[4], vr[4];
  gla_load_alow(p, tok, dir, al);
  const float* kr = W_hbuf + (size_t)tok * 1984 + 800 + h * 32 + w * 8;
  float4 k0 = *(const float4*)kr, k1 = *(const float4*)(kr + 4);
  gla_load_v(p, tok, h, w, vr);
  float cs[8], tot[8];
  gla_cum_regs(smem, al, h, dir, w, lane, cs, tot);
  __syncthreads();
  {
    float kk[8] = {k0.x, k0.y, k0.z, k0.w, k1.x, k1.y, k1.z, k1.w};
#pragma unroll
    for (int j = 0; j < 8; j++) sKeT[(w * 8 + j) * 72 + lane] = f2bf(kk[j] * __expf(tot[j] - cs[j]));
  }
  gla_store_vt(vr, w, lane, sVt);
  __syncthreads();
  f32x4 acc[2] = {f32x4{0.f, 0.f, 0.f, 0.f}, f32x4{0.f, 0.f, 0.f, 0.f}};
#pragma unroll
  for (int ks = 0; ks < 2; ks++) {
    bf16x8 bv = *(const bf16x8*)(sVt + (w * 16 + l15) * 72 + ks * 32 + l4 * 8);
#pragma unroll
    for (int mt = 0; mt < 2; mt++) {
      bf16x8 av = *(const bf16x8*)(sKeT + (mt * 16 + l15) * 72 + ks * 32 + l4 * 8);
      acc[mt] = __builtin_amdgcn_mfma_f32_16x16x32_bf16(av, bv, acc[mt], 0, 0, 0);
    }
  }
  float* dst = W_un + (size_t)item * 2048;
#pragma unroll
  for (int mt = 0; mt < 2; mt++)
#pragma unroll
    for (int r = 0; r < 4; r++) dst[(mt * 16 + l4 * 4 + r) * 64 + w * 16 + l15] = acc[mt][r];
  if (lane == 0) {
#pragma unroll
    for (int j = 0; j < 8; j++) W_gn[item * 32 + w * 8 + j] = __expf(tot[j]);
  }
}

__device__ __forceinline__ void phase_gla_scan(const P& p, int l) {
  for (int it = blockIdx.x; it < 2176; it += gridDim.x) {
    int e = it * 256 + tidx();
    int kv = e & 2047, sd = e >> 11, dir = sd & 1, h = (sd >> 1) & 3, seq = ((sd >> 3) + 32) % 34;
    int nch, cbase;
    float s;
    if (seq < 32) { nch = 4; cbase = seq * 4; s = 0.f; }
    else { int b = seq - 32; nch = 32; cbase = 128 + b * 32; s = p.state_gla[((size_t)(((b * 2 + l) * 2 + dir) * 4 + h)) * 2048 + kv]; }
    for (int n0 = 0; n0 < nch; n0 += 4) {
      float gv[4], uv[4];
#pragma unroll
      for (int k = 0; k < 4; k++) {
        int item = ((cbase + n0 + k) * 4 + h) * 2 + dir;
        gv[k] = W_gn[item * 32 + (kv >> 6)];
        uv[k] = W_un[(size_t)item * 2048 + kv];
      }
#pragma unroll
      for (int k = 0; k < 4; k++) {
        int item = ((cbase + n0 + k) * 4 + h) * 2 + dir;
        W_sin_[(size_t)item * 2048 + kv] = s;
        s = gv[k] * s + uv[k];
      }
    }
    if (seq < 32) p.out[19398656 + ((size_t)(((seq * 2 + l) * 2 + dir) * 4 + h)) * 2048 + kv] = s;
  }
}

__device__ __forceinline__ void phase_gla_out(const P& p, int l, char* smem) {
  bf16_t* sQe = (bf16_t*)smem;
  bf16_t* sKe = sQe + 64 * 40;
  bf16_t* sSt = sKe + 64 * 40;
  bf16_t* sVt = sSt + 64 * 40;
  bf16_t* sAtt = sVt + 64 * 72;
  const int tid = tidx(), lane = tid & 63, w = __builtin_amdgcn_readfirstlane(tid >> 6), l15 = lane & 15, l4 = lane >> 4;
  gla_stage_w2(p, l, smem);
  for (int it = blockIdx.x; it < 768; it += gridDim.x) {
    int h = it & 3, cidx = it >> 2;
    int tb, nch, c, cbase;
    chunk_info(cidx, tb, nch, c, cbase);
    const int tok = tb + c * 64 + lane;
    f32x4 o[4];
#pragma unroll
    for (int j = 0; j < 4; j++) o[j] = f32x4{0.f, 0.f, 0.f, 0.f};
    float4 vr[4], alf[4], alb[4];
    gla_load_v(p, tok, h, w, vr);
    gla_load_alow(p, tok, 0, alf);
    gla_load_alow(p, tok, 1, alb);
    const float* qr = W_hbuf + (size_t)tok * 1984 + 672 + h * 32 + w * 8;
    const float* kr = qr + 128;
    const float4 q0 = *(const float4*)qr, q1 = *(const float4*)(qr + 4), k0 = *(const float4*)kr, k1 = *(const float4*)(kr + 4);
    float sinv[2][8];
#pragma unroll
    for (int dir = 0; dir < 2; dir++) {
      int n = dir ? nch - 1 - c : c;
      int item = ((cbase + n) * 4 + h) * 2 + dir;
      const float* sin = W_sin_ + (size_t)item * 2048 + (w * 8) * 64 + lane;
#pragma unroll
      for (int j = 0; j < 8; j++) sinv[dir][j] = sin[j * 64];
    }
    float gpre[4][4];
#pragma unroll
    for (int r = 0; r < 4; r++)
#pragma unroll
      for (int jn = 0; jn < 4; jn++) gpre[r][jn] = W_hbuf[(size_t)(tb + c * 64 + w * 16 + l4 * 4 + r) * 1984 + 1184 + h * 64 + jn * 16 + l15];
    __syncthreads();
    gla_store_vt(vr, w, lane, sVt);
#pragma unroll
    for (int dir = 0; dir < 2; dir++) {
      float cs[8], tot[8];
      gla_cum_regs(smem, dir ? alb : alf, h, dir, w, lane, cs, tot);
      if (dir) __syncthreads();
      {
        float qq[8] = {q0.x, q0.y, q0.z, q0.w, q1.x, q1.y, q1.z, q1.w};
        float kk[8] = {k0.x, k0.y, k0.z, k0.w, k1.x, k1.y, k1.z, k1.w};
        bf16x8 qv, kv, sv;
#pragma unroll
        for (int j = 0; j < 8; j++) {
          float cm = __shfl(cs[j], 32);
          qv[j] = (short)f2bf(qq[j] * 0.17677669529663687f * __expf(cs[j] - cm));
          kv[j] = (short)f2bf(kk[j] * __expf(cm - cs[j]));
          sv[j] = (short)f2bf(sinv[dir][j] * __expf(cm));
        }
        *(bf16x8*)(sQe + lane * 40 + w * 8) = qv;
        *(bf16x8*)(sKe + lane * 40 + w * 8) = kv;
        *(bf16x8*)(sSt + lane * 40 + w * 8) = sv;
      }
      __syncthreads();
      bf16x8 qa = *(const bf16x8*)(sQe + (w * 16 + l15) * 40 + l4 * 8);
#pragma unroll
      for (int jc = 0; jc < 4; jc++) {
        bf16x8 kb = *(const bf16x8*)(sKe + (jc * 16 + l15) * 40 + l4 * 8);
        f32x4 sacc = __builtin_amdgcn_mfma_f32_16x16x32_bf16(qa, kb, f32x4{0.f, 0.f, 0.f, 0.f}, 0, 0, 0);
#pragma unroll
        for (int r = 0; r < 4; r++) {
          int trow = w * 16 + l4 * 4 + r, scol = jc * 16 + l15;
          bool keep = dir ? (scol >= trow) : (scol <= trow);
          sAtt[trow * 72 + scol] = f2bf(keep ? sacc[r] : 0.f);
        }
      }
      __syncthreads();
#pragma unroll
      for (int ks = 0; ks < 2; ks++) {
        bf16x8 aa = *(const bf16x8*)(sAtt + (w * 16 + l15) * 72 + ks * 32 + l4 * 8);
#pragma unroll
        for (int jn = 0; jn < 4; jn++) {
          bf16x8 vb = *(const bf16x8*)(sVt + (jn * 16 + l15) * 72 + ks * 32 + l4 * 8);
          o[jn] = __builtin_amdgcn_mfma_f32_16x16x32_bf16(aa, vb, o[jn], 0, 0, 0);
        }
      }
#pragma unroll
      for (int jn = 0; jn < 4; jn++) {
        bf16x8 sb = *(const bf16x8*)(sSt + (jn * 16 + l15) * 40 + l4 * 8);
        o[jn] = __builtin_amdgcn_mfma_f32_16x16x32_bf16(qa, sb, o[jn], 0, 0, 0);
      }
    }
#pragma unroll
    for (int r = 0; r < 4; r++) {
      float ss = o[0][r] * o[0][r] + o[1][r] * o[1][r] + o[2][r] * o[2][r] + o[3][r] * o[3][r];
      ss += DPP_F(ss, ss, 0xB1, 0xf);
      ss += DPP_F(ss, ss, 0x4E, 0xf);
      ss += DPP_F(ss, ss, 0x141, 0xf);
      ss += DPP_F(ss, ss, 0x140, 0xf);
      float rs = rsqrtf(ss * (1.f / 64.f) + 1e-6f);
      int tk = tb + c * 64 + w * 16 + l4 * 4 + r;
      const float* grow = W_hbuf + (size_t)tk * 1984 + 1184 + h * 64;
      bf16_t* dst = W_br + (size_t)tk * 1024 + 512 + h * 64;
#pragma unroll
      for (int jn = 0; jn < 4; jn++) {
        int vcol = jn * 16 + l15;
        float val = o[jn][r] * rs * p.gla_norm[l * 64 + vcol];
        dst[vcol] = f2bf(val * siluf(gpre[r][jn]));
      }
    }
  }
}

__device__ __forceinline__ void phase_mixers(const P& p, int l, char* smem) {
  const int N_MLAL = 256, N_DFTL = 64, N_SWAL = 256, N_MLAC = 512, N_SWAC = 512, N_DFTC = 128, N_G1 = 1536;
  const int total = N_MLAL + N_DFTL + N_SWAL + N_MLAC + N_SWAC + N_DFTC + N_G1;
  gla_stage_w2(p, l, smem);
  for (int r_ = 0; r_ * (int)gridDim.x < total; r_++) {
    int it0 = r_ * gridDim.x + ((r_ & 1) ? (gridDim.x - 1 - blockIdx.x) : blockIdx.x);
    if (it0 >= total) continue;
    int it = it0;
    int type;
    bool lat = false;
    if (it < N_MLAL) { type = 0; lat = true; }
    else if ((it -= N_MLAL) < N_DFTL) { type = 2; lat = true; }
    else if ((it -= N_DFTL) < N_SWAL) { type = 1; lat = true; }
    else if ((it -= N_SWAL) < N_MLAC) { type = 0; }
    else if ((it -= N_MLAC) < N_SWAC) { type = 1; }
    else if ((it -= N_SWAC) < N_DFTC) { type = 2; }
    else { it -= N_DFTC; type = 3; }
#ifdef DUPTYPE
    for (int rep_ = 0; rep_ < ((type == (DUPTYPE & 3) && (int)lat == (DUPTYPE >> 2)) ? 2 : 1); rep_++)
#endif
    if (type == 0) {
      int qt, h, b, Sk;
      size_t tok0;
      if (lat) { qt = it & 31; h = (it >> 5) & 3; b = it >> 7; tok0 = T_CTX + b * 2048; Sk = 2560; }
      else { qt = it & 3; h = (it >> 2) & 3; b = it >> 4; tok0 = b * 256; Sk = 256; }
      const bf16_t* Kp = (lat ? W_Ka_lat : W_Ka_ctx) + (size_t)(b * 4 + h) * Sk * 96;
      const bf16_t* Vp = (lat ? W_Va_lat : W_Va_ctx) + (size_t)(b * 4 + h) * Sk * 64;
      attn_item<96>(W_Qa + tok0 * 384 + h * 96, 384, Kp, Vp, W_br + tok0 * 1024 + h * 64, qt * 64, Sk, 0, -1,
                    0.10206207261596575f, false, 0.f, smem);
    } else if (type == 1) {
      int qt, hq, b, Sk, nctx, W;
      size_t tok0;
      if (lat) { qt = it & 31; hq = (it >> 5) & 3; b = it >> 7; tok0 = T_CTX + b * 2048; Sk = 2560; nctx = 512; W = 128; }
      else { qt = it & 3; hq = (it >> 2) & 3; b = it >> 4; tok0 = b * 256; Sk = 256; nctx = 0; W = -1; }
      int kv = hq >> 1;
      const bf16_t* Kp = (lat ? W_Kd_lat : W_Kd_ctx) + (size_t)(b * 2 + kv) * Sk * 64;
      const bf16_t* Vp = (lat ? W_Vd_lat : W_Vd_ctx) + (size_t)(b * 2 + kv) * Sk * 64;
      attn_item<64>(W_Qd + tok0 * 256 + hq * 64, 256, Kp, Vp, W_br + tok0 * 1024 + 768 + hq * 64, qt * 64, Sk, nctx, W,
                    0.125f, true, p.swa_sink[l * 4 + hq], smem);
    } else if (type == 2) {
      int nt = it & 1, mt, b, S;
      size_t tok0;
      if (lat) { mt = (it >> 1) & 15; b = it >> 5; S = 2048; tok0 = T_CTX + b * 2048; }
      else { mt = (it >> 1) & 1; b = it >> 2; S = 256; tok0 = b * 256; }
      const bf16_t* Ap = (lat ? W_A2048 : W_A256) + (size_t)mt * 128 * 2 * S;
      const bf16_t* Bp = (lat ? W_Yt_lat : W_Yt_ctx) + (size_t)(b * 256 + nt * 128) * 2 * S;
      f32x4 acc[4][4];
      ZERO_ACC(acc);
      gemm_core(acc, Ap, 2 * S, Bp, 2 * S, 2 * S, smem);
      EPI_LOOP(acc, mt * 128, nt * 128, { W_br[(tok0 + m) * 1024 + 256 + n] = f2bf(v); });
    } else {
      gla_g1_item(p, l, it, smem);
    }
  }
}

#define EPI4_LOOP_N(acc, c0, t0, NJ, ...)                                                  \
  {                                                                                        \
    const int lane_ = tidx() & 63, w_ = tidx() >> 6, wm_ = w_ >> 1, wn_ = w_ & 1;           \
    _Pragma("unroll") for (int i_ = 0; i_ < 4; i_++)                                       \
    _Pragma("unroll") for (int j_ = 0; j_ < NJ; j_++) {                                    \
      const int col = (c0) + wm_ * 64 + i_ * 16 + (lane_ >> 4) * 4;                        \
      const int tok = (t0) + wn_ * (NJ * 16) + j_ * 16 + (lane_ & 15);                     \
      const f32x4 v4 = acc[i_][j_];                                                        \
      __VA_ARGS__                                                                          \
    }                                                                                      \
  }
__device__ __forceinline__ void phase_merge(const P& p, int l, char* smem) {
  constexpr int NJ = 2;
  bf16_t* sa = (bf16_t*)smem;
  bf16_t* sb = sa + 128 * GB_LD;
  const int tid = tidx(), lane = tid & 63, w = tid >> 6, wm = w >> 1, wn = w & 1;
  const int l15 = lane & 15, l4 = lane >> 4;
  for (int tile = blockIdx.x; tile < 192 * 8; tile += gridDim.x) {
    int tt = tile >> 3, nt = tile & 7, t0 = tt * 64, n0 = nt * 128;
    const bf16_t* A = W_Wt_br + ((size_t)l * 1024 + n0) * 1024;
    const bf16_t* B = W_br + (size_t)t0 * 1024;
    const int lda = 1024, ldb = 1024, K = 1024;
    f32x4 tot[4][2], acc[4][2];
    ZERO_ACC_N(tot, 2);
    ZERO_ACC_N(acc, 2);
    u32x4 ra0[4], rb0[NJ], ra1[4], rb1[NJ];
    G_LOAD(ra0, rb0, 0);
    G_LOAD(ra1, rb1, 64);
    ushort4 gl[4][2];
    for (int k0 = 0; k0 < K; k0 += 128) {
      const bool seg_end = (k0 & 128) != 0;
      const int bidx = k0 >> 8;
      if (seg_end) {
#pragma unroll
        for (int i_ = 0; i_ < 4; i_++)
#pragma unroll
          for (int j_ = 0; j_ < 2; j_++) {
            int col = n0 + wm * 64 + i_ * 16 + l4 * 4, tok = t0 + wn * 32 + j_ * 16 + l15;
            gl[i_][j_] = *(const ushort4*)(W_gates + (size_t)tok * 4096 + bidx * 1024 + col);
          }
      }
      __syncthreads();
      G_STORE(ra0, rb0);
      __syncthreads();
      if (k0 + 128 < K) { G_LOAD(ra0, rb0, k0 + 128); }
      G_COMPUTE();
      __syncthreads();
      G_STORE(ra1, rb1);
      __syncthreads();
      if (k0 + 192 < K) { G_LOAD(ra1, rb1, k0 + 192); }
      G_COMPUTE();
      if (seg_end) {
#pragma unroll
        for (int i_ = 0; i_ < 4; i_++)
#pragma unroll
          for (int j_ = 0; j_ < 2; j_++) {
            tot[i_][j_][0] += bf2f(gl[i_][j_].x) * acc[i_][j_][0];
            tot[i_][j_][1] += bf2f(gl[i_][j_].y) * acc[i_][j_][1];
            tot[i_][j_][2] += bf2f(gl[i_][j_].z) * acc[i_][j_][2];
            tot[i_][j_][3] += bf2f(gl[i_][j_].w) * acc[i_][j_][3];
            acc[i_][j_] = f32x4{0.f, 0.f, 0.f, 0.f};
          }
      }
    }
    EPI4_LOOP_N(tot, n0, t0, 2, {
      ushort4 o_; o_.x = f2bf(v4[0]); o_.y = f2bf(v4[1]); o_.z = f2bf(v4[2]); o_.w = f2bf(v4[3]);
      *(ushort4*)(W_u + (size_t)tok * 1024 + col) = o_;
    });
  }
}

__device__ __forceinline__ void phase_wout(const P& p, int l, char* smem) {
  float* r = W_hbuf;
  const float alpha = 1.4142135623730951f;
  for (int tile = blockIdx.x; tile < 96 * 8; tile += gridDim.x) {
    int mt = tile >> 3, nt = tile & 7, m0 = mt * 128, n0 = nt * 128;
    f32x4 acc[4][4];
    ZERO_ACC(acc);
    gemm_core(acc, W_Wt_out + ((size_t)l * 1024 + n0) * 1024, 1024, W_u + (size_t)m0 * 1024, 1024, 1024, smem);
    const float* g1 = W_mada + (l * 3 + cond_row(m0)) * 6144 + 2048;
    {
      const int lane_ = tidx() & 63, w_ = tidx() >> 6, wm_ = w_ >> 1, wn_ = w_ & 1;
#pragma unroll
      for (int ih = 0; ih < 2; ih++) {
        float4 xv[8];
#pragma unroll
        for (int q = 0; q < 8; q++) {
          int i_ = ih * 2 + (q >> 2), j_ = q & 3;
          int col = n0 + wm_ * 64 + i_ * 16 + (lane_ >> 4) * 4, tok = m0 + wn_ * 64 + j_ * 16 + (lane_ & 15);
          xv[q] = *(const float4*)(x_in_row(p, l, tok) + col);
        }
#pragma unroll
        for (int q = 0; q < 8; q++) {
          int i_ = ih * 2 + (q >> 2), j_ = q & 3;
          int col = n0 + wm_ * 64 + i_ * 16 + (lane_ >> 4) * 4, tok = m0 + wn_ * 64 + j_ * 16 + (lane_ & 15);
          float4 gv = *(const float4*)(g1 + col);
          f32x4 v4 = acc[i_][j_];
          *(float4*)(r + (size_t)tok * 1024 + col) = float4{alpha * xv[q].x + gv.x * v4[0], alpha * xv[q].y + gv.y * v4[1], alpha * xv[q].z + gv.z * v4[2], alpha * xv[q].w + gv.w * v4[3]};
        }
      }
    }
  }
}

__device__ __forceinline__ void phase_ln_mid(const P& p, int l) {
  int lane = tidx() & 63, w = tidx() >> 6;
  const float* r = W_hbuf;
  for (int it = blockIdx.x; it < T_ALL / 4; it += gridDim.x) {
    int g = it * 4 + w;
    float v[16];
    load_row16(r + (size_t)g * 1024, lane, v);
    ln16(v);
    affine16(v, p.ln1_g + l * 1024, p.ln1_b + l * 1024, lane);
    store_row16(x_out_row(p, l, g), lane, v);
    ln16(v);
    const float* m = W_mada + (l * 3 + cond_row(g)) * 6144;
    modulate_store(v, m + 3072, m + 4096, W_u + (size_t)g * 1024, lane);
  }
}

__device__ __forceinline__ void phase_pq(const P& p, int l, char* smem) {
  float* sc = (float*)W_gates;
  bf16_t* sa = (bf16_t*)smem;
  const int tid = tidx(), lane = tid & 63, w = tid >> 6, wm = w >> 1, wn = w & 1, l15 = lane & 15, l4 = lane >> 4;
  for (int tile = blockIdx.x; tile < 96 * 16; tile += gridDim.x) {
    int mt = tile >> 4, hp = tile & 15, m0 = mt * 128, n0 = hp * 128;
    f32x4 acc[4][4];
    ZERO_ACC(acc);
    gemm_core(acc, W_Wt_pq + ((size_t)l * 2048 + n0) * 1024, 1024, W_u + (size_t)m0 * 1024, 1024, 1024, smem);
    __syncthreads();
    {
      bf16_t* sB = sa + 128 * GB_LD * (1 + wm);
#pragma unroll
      for (int i = 0; i < 4; i++)
#pragma unroll
        for (int j = 0; j < 4; j++) {
          ushort4 o_;
          o_.x = f2bf(acc[i][j][0]); o_.y = f2bf(acc[i][j][1]); o_.z = f2bf(acc[i][j][2]); o_.w = f2bf(acc[i][j][3]);
          *(ushort4*)(sB + (wn * 64 + j * 16 + l15) * GB_LD + i * 16 + l4 * 4) = o_;
        }
    }
    f32x4 acc2[4][4];
    ZERO_ACC(acc2);
    const bf16_t* keys = W_keysbf + (size_t)(l * 16 + hp) * 128 * 128;
#pragma unroll
    for (int kh = 0; kh < 2; kh++) {
      u32x4 rk[4];
#pragma unroll
      for (int i = 0; i < 4; i++) { int c = tid + i * 256, r = c >> 3, cc = (c & 7) * 8; rk[i] = *(const u32x4*)(keys + r * 128 + kh * 64 + cc); }
      if (kh) __syncthreads();
#pragma unroll
      for (int i = 0; i < 4; i++) { int c = tid + i * 256, r = c >> 3, cc = (c & 7) * 8; *(u32x4*)(sa + r * GB_LD + cc) = rk[i]; }
      __syncthreads();
      const bf16_t* sBk = sa + 128 * GB_LD * (1 + kh);
#pragma unroll
      for (int ks = 0; ks < 2; ks++) {
        bf16x8 af[4], bfr[4];
#pragma unroll
        for (int i = 0; i < 4; i++) af[i] = *(const bf16x8*)(sa + (wm * 64 + i * 16 + l15) * GB_LD + ks * 32 + l4 * 8);
#pragma unroll
        for (int j = 0; j < 4; j++) bfr[j] = *(const bf16x8*)(sBk + (wn * 64 + j * 16 + l15) * GB_LD + ks * 32 + l4 * 8);
#pragma unroll
        for (int i = 0; i < 4; i++)
#pragma unroll
          for (int j = 0; j < 4; j++) acc2[i][j] = __builtin_amdgcn_mfma_f32_16x16x32_bf16(af[i], bfr[j], acc2[i][j], 0, 0, 0);
      }
    }
    EPI_LOOP(acc2, 0, m0, { sc[((size_t)(hp * 128 + m)) * T_ALL + n] = v; });
  }
}

__device__ __forceinline__ void phase_scores(const P& p, int l, char* smem) {}

__device__ __forceinline__ int f2sort(float x) { int b = __float_as_int(x); return b ^ ((b >> 31) & 0x7fffffff); }
__device__ __forceinline__ float sort2f(int s) { return __int_as_float(s ^ ((s >> 31) & 0x7fffffff)); }
__device__ __forceinline__ void bitonic_sort16_desc(int (&a)[16]) {
#pragma unroll
  for (int k = 2; k <= 16; k <<= 1)
#pragma unroll
    for (int j = k >> 1; j > 0; j >>= 1)
#pragma unroll
      for (int i = 0; i < 16; i++) {
        int l_ = i ^ j;
        if (l_ > i) {
          int hi = max(a[i], a[l_]), lo = min(a[i], a[l_]);
          if ((i & k) == 0) { a[i] = hi; a[l_] = lo; } else { a[i] = lo; a[l_] = hi; }
        }
      }
}
__device__ __forceinline__ void merge_top16(int (&T)[16], const int (&S)[16]) {
#pragma unroll
  for (int i = 0; i < 16; i++) T[i] = max(T[i], S[15 - i]);
#pragma unroll
  for (int j = 8; j > 0; j >>= 1)
#pragma unroll
    for (int i = 0; i < 16; i++) {
      int l_ = i ^ j;
      if (l_ > i) { int hi = max(T[i], T[l_]), lo = min(T[i], T[l_]); T[i] = hi; T[l_] = lo; }
    }
}
__device__ __forceinline__ void top16_col(const float* src, int (&L)[16]) {
#pragma unroll 1
  for (int k0 = 0; k0 < 128; k0 += 16) {
    float xv[16];
#pragma unroll
    for (int k = 0; k < 16; k++) xv[k] = src[(size_t)(k0 + k) * T_ALL];
    int S[16];
#pragma unroll
    for (int k = 0; k < 16; k++) S[k] = (f2sort(xv[k]) & ~127) | (127 - (k0 + k));
    bitonic_sort16_desc(S);
    if (k0 == 0) {
#pragma unroll
      for (int k = 0; k < 16; k++) L[k] = S[k];
    } else {
      merge_top16(L, S);
    }
  }
}
__device__ __forceinline__ void phase_topk(const P& p, int l) {
  const float* sc = (const float*)W_gates;
  int lane = tidx() & 63, w = tidx() >> 6;
  for (int it = blockIdx.x * 4 + w; it < 192 * 8; it += gridDim.x * 4) {
    int h = it & 7, t = (it >> 3) * 64 + lane;
    int L1[16], L2[16];
    const float* s1 = sc + (size_t)(h * 2) * 128 * T_ALL + t;
    top16_col(s1, L1);
    top16_col(s1 + (size_t)128 * T_ALL, L2);
    float v1[16], v2[16];
    unsigned P1[4] = {0u, 0u, 0u, 0u}, P2[4] = {0u, 0u, 0u, 0u};
#pragma unroll
    for (int i = 0; i < 16; i++) {
      v1[i] = sort2f(L1[i] & ~127);
      v2[i] = sort2f(L2[i] & ~127);
      P1[i >> 2] |= (unsigned)(127 - (L1[i] & 127)) << ((i & 3) * 8);
      P2[i >> 2] |= (unsigned)(127 - (L2[i] & 127)) << ((i & 3) * 8);
    }
    int Tk[16];
#pragma unroll
    for (int j = 0; j < 16; j++) Tk[j] = (f2sort(v1[0] + v2[j]) & ~255) | (255 - j);
    {
      int G[3][16];
#pragma unroll
      for (int g_ = 0; g_ < 3; g_++)
#pragma unroll
        for (int k = 0; k < 16; k++) G[g_][k] = (int)0x80000000;
      int cnt = 0;
#pragma unroll
      for (int i = 1; i < 16; i++) {
#pragma unroll
        for (int j = 0; j < 16 / (i + 1); j++) {
          G[cnt >> 4][cnt & 15] = (f2sort(v1[i] + v2[j]) & ~255) | (255 - (i * 16 + j));
          cnt++;
        }
      }
#pragma unroll
      for (int g_ = 0; g_ < 3; g_++) { bitonic_sort16_desc(G[g_]); merge_top16(Tk, G[g_]); }
    }
    float v0 = sort2f(Tk[0] & ~255);
    float e[16], Z = 0.f;
    int oi[16];
#pragma unroll
    for (int s_ = 0; s_ < 16; s_++) {
      e[s_] = __expf(sort2f(Tk[s_] & ~255) - v0);
      Z += e[s_];
      int code = 255 - (Tk[s_] & 255), i = code >> 4, j = code & 15;
      unsigned r1 = (i >> 2) == 0 ? P1[0] : (i >> 2) == 1 ? P1[1] : (i >> 2) == 2 ? P1[2] : P1[3];
      unsigned r2 = (j >> 2) == 0 ? P2[0] : (j >> 2) == 1 ? P2[1] : (j >> 2) == 2 ? P2[2] : P2[3];
      int i1 = (r1 >> ((i & 3) * 8)) & 255, i2 = (r2 >> ((j & 3) * 8)) & 255;
      oi[s_] = i1 * 128 + i2;
    }
    float inv = 1.f / Z;
    int* po = W_pidx + (size_t)t * 128 + h * 16;
    float* pwo = W_pw + (size_t)t * 128 + h * 16;
#pragma unroll
    for (int q = 0; q < 4; q++) {
      *(int4*)(po + q * 4) = int4{oi[q * 4], oi[q * 4 + 1], oi[q * 4 + 2], oi[q * 4 + 3]};
      *(float4*)(pwo + q * 4) = float4{e[q * 4] * inv, e[q * 4 + 1] * inv, e[q * 4 + 2] * inv, e[q * 4 + 3] * inv};
    }
  }
}

__device__ __forceinline__ void unpack16(u32x4 r, float (&f)[16]) {
#pragma unroll
  for (int q = 0; q < 4; q++) {
    auto lo = __builtin_amdgcn_cvt_pk_f32_fp8((int)r[q], false);
    auto hi = __builtin_amdgcn_cvt_pk_f32_fp8((int)r[q], true);
    f[q * 4 + 0] = lo[0]; f[q * 4 + 1] = lo[1]; f[q * 4 + 2] = hi[0]; f[q * 4 + 3] = hi[1];
  }
}
#define PEER_PF 8
#ifndef PEER_REP
#define PEER_REP 1
#endif
__device__ __forceinline__ void phase_peer(const P& p, int l, char* smem) {
  int lane = tidx() & 63, w = tidx() >> 6;
  float* scoef = (float*)smem + w * 128;
  const unsigned char* tu = W_tabU + (size_t)l * 16384 * 1024 + lane * 16;
  const unsigned char* tv = W_tabV + (size_t)l * 16384 * 1024 + lane * 16;
  for (int it = blockIdx.x; it < T_ALL / 4; it += gridDim.x) {
    int g = it * 4 + w;
    float uu[16];
    {
      u32x4 r0 = *(const u32x4*)(W_u + (size_t)g * 1024 + lane * 16);
      u32x4 r1 = *(const u32x4*)(W_u + (size_t)g * 1024 + lane * 16 + 8);
      uu[0] = __uint_as_float(r0.x << 16); uu[1] = __uint_as_float(r0.x & 0xffff0000u);
      uu[2] = __uint_as_float(r0.y << 16); uu[3] = __uint_as_float(r0.y & 0xffff0000u);
      uu[4] = __uint_as_float(r0.z << 16); uu[5] = __uint_as_float(r0.z & 0xffff0000u);
      uu[6] = __uint_as_float(r0.w << 16); uu[7] = __uint_as_float(r0.w & 0xffff0000u);
      uu[8] = __uint_as_float(r1.x << 16); uu[9] = __uint_as_float(r1.x & 0xffff0000u);
      uu[10] = __uint_as_float(r1.y << 16); uu[11] = __uint_as_float(r1.y & 0xffff0000u);
      uu[12] = __uint_as_float(r1.z << 16); uu[13] = __uint_as_float(r1.z & 0xffff0000u);
      uu[14] = __uint_as_float(r1.w << 16); uu[15] = __uint_as_float(r1.w & 0xffff0000u);
    }
    const float* pwt = W_pw + (size_t)g * 128;
    const int pi0 = W_pidx[(size_t)g * 128 + lane], pi1 = W_pidx[(size_t)g * 128 + 64 + lane];
    auto ldrows = [&](u32x4 (&r)[8], const unsigned char* tab, int e0) {
#pragma unroll
      for (int k = 0; k < 8; k++) {
        int e = e0 + k;
        int idx = __builtin_amdgcn_readlane(e < 64 ? pi0 : pi1, e & 63);
        r[k] = *(const u32x4*)(tab + (size_t)idx * 1024);
      }
    };
    float o[16];
    for (int rep_ = 0; rep_ < PEER_REP; rep_++) {
    float dv0 = 0.f, dv1 = 0.f;
    auto dots = [&](const u32x4 (&r)[8], int e0) {
#pragma unroll
      for (int k = 0; k < 8; k++) {
        float f[16];
        unpack16(r[k], f);
        float a = 0.f;
#pragma unroll
        for (int j = 0; j < 16; j++) a += uu[j] * f[j];
        float dd = wsum(a);
        if (e0 < 64) dv0 = (lane == e0 + k) ? dd : dv0;
        else dv1 = (lane == e0 + k - 64) ? dd : dv1;
      }
    };
    {
      u32x4 ra[8], rb[8];
      ldrows(ra, tu, 0);
#pragma unroll 1
      for (int e0 = 0; e0 < 128; e0 += 16) {
        ldrows(rb, tu, e0 + 8);
        dots(ra, e0);
        if (e0 + 16 < 128) ldrows(ra, tu, e0 + 16);
        dots(rb, e0 + 8);
      }
    }
    {
      float d0 = dv0 * (1.f / PEER_U_SCALE), d1 = dv1 * (1.f / PEER_U_SCALE);
      float a0 = 0.5f * d0 * (1.f + erff(d0 * 0.7071067811865476f));
      float a1 = 0.5f * d1 * (1.f + erff(d1 * 0.7071067811865476f));
      scoef[lane] = pwt[lane] * a0 * (1.f / PEER_V_SCALE);
      scoef[64 + lane] = pwt[64 + lane] * a1 * (1.f / PEER_V_SCALE);
    }
    __builtin_amdgcn_s_waitcnt(0xc07f);
    __builtin_amdgcn_wave_barrier();
#pragma unroll
    for (int j = 0; j < 16; j++) o[j] = 0.f;
    auto accum = [&](const u32x4 (&r)[8], int e0) {
#pragma unroll
      for (int k = 0; k < 8; k++) {
        float cf = scoef[e0 + k];
        float f[16];
        unpack16(r[k], f);
#pragma unroll
        for (int j = 0; j < 16; j++) o[j] += cf * f[j];
      }
    };
    {
      u32x4 ra[8], rb[8];
      ldrows(ra, tv, 0);
#pragma unroll 1
      for (int e0 = 0; e0 < 128; e0 += 16) {
        ldrows(rb, tv, e0 + 8);
        accum(ra, e0);
        if (e0 + 16 < 128) ldrows(ra, tv, e0 + 16);
        accum(rb, e0 + 8);
      }
    }
    __builtin_amdgcn_wave_barrier();
    }
    float* xr = x_out_row(p, l, g) + lane * 16;
    const float* m = W_mada + (l * 3 + cond_row(g)) * 6144 + lane * 16;
    float x1[16];
#pragma unroll
    for (int q = 0; q < 4; q++) {
      float4 xv = *(const float4*)(xr + q * 4);
      float4 g2 = *(const float4*)(m + 5120 + q * 4);
      x1[q * 4 + 0] = 1.4142135623730951f * xv.x + g2.x * o[q * 4 + 0];
      x1[q * 4 + 1] = 1.4142135623730951f * xv.y + g2.y * o[q * 4 + 1];
      x1[q * 4 + 2] = 1.4142135623730951f * xv.z + g2.z * o[q * 4 + 2];
      x1[q * 4 + 3] = 1.4142135623730951f * xv.w + g2.w * o[q * 4 + 3];
    }
    ln16(x1);
#pragma unroll
    for (int q = 0; q < 4; q++) {
      float4 a = *(const float4*)(p.ln2_g + l * 1024 + lane * 16 + q * 4);
      float4 c = *(const float4*)(p.ln2_b + l * 1024 + lane * 16 + q * 4);
      x1[q * 4 + 0] = x1[q * 4 + 0] * a.x + c.x; x1[q * 4 + 1] = x1[q * 4 + 1] * a.y + c.y;
      x1[q * 4 + 2] = x1[q * 4 + 2] * a.z + c.z; x1[q * 4 + 3] = x1[q * 4 + 3] * a.w + c.w;
      *(float4*)(xr + q * 4) = float4{x1[q * 4], x1[q * 4 + 1], x1[q * 4 + 2], x1[q * 4 + 3]};
    }
    if (l == 0) {
      ln16(x1);
      const float* m1 = W_mada + (1 * 3 + cond_row(g)) * 6144 + lane * 16;
#pragma unroll
      for (int q = 0; q < 4; q++) {
        float4 a = *(const float4*)(m1 + 1024 + q * 4);
        float4 b = *(const float4*)(m1 + q * 4);
        ushort4 ov;
        ov.x = f2bf(x1[q * 4 + 0] * (1.f + a.x) + b.x);
        ov.y = f2bf(x1[q * 4 + 1] * (1.f + a.y) + b.y);
        ov.z = f2bf(x1[q * 4 + 2] * (1.f + a.z) + b.z);
        ov.w = f2bf(x1[q * 4 + 3] * (1.f + a.w) + b.w);
        *(ushort4*)(W_u + (size_t)g * 1024 + lane * 16 + q * 4) = ov;
      }
    }
  }
}

#define N_PHASES 28
__device__ __forceinline__ void run_phase(const P& p, int ph, char* smem) {
#ifdef ONLYQ
  { int l = ph & 1; if (ONLYQ == -1) { phase_prep(p, smem); return; } if (ONLYQ == -2) { phase_ln0(p); return; }
    switch (ONLYQ) { case 0: phase_win(p, l, smem); break; case 1: phase_post(p, l); break; case 2: phase_small_gemms(p, l, smem); break; case 3: phase_mixers(p, l, smem); break; case 4: phase_gla_scan(p, l); break; case 5: phase_gla_out(p, l, smem); break; case 6: phase_merge(p, l, smem); break; case 7: phase_wout(p, l, smem); break; case 8: phase_ln_mid(p, l); break; case 9: phase_pq(p, l, smem); break; case 10: phase_scores(p, l, smem); break; case 11: phase_topk(p, l); break; case 12: phase_peer(p, l, smem); break; } return; }
#endif
  if (ph == 0) { phase_prep(p, smem); return; }
  if (ph == 1) { phase_ln0(p); return; }
  int l = (ph - 2) / 13, q = (ph - 2) % 13;
#ifdef EXCL
  if (q == EXCL) return;
#endif
  switch (q) {
    case 0: phase_win(p, l, smem); break;
    case 1: phase_post(p, l); break;
    case 2: phase_small_gemms(p, l, smem); break;
    case 3: phase_mixers(p, l, smem); break;
    case 4: phase_gla_scan(p, l); break;
    case 5: phase_gla_out(p, l, smem); break;
    case 6: phase_merge(p, l, smem); break;
    case 7: phase_wout(p, l, smem); break;
    case 8: phase_ln_mid(p, l); break;
    case 9: phase_pq(p, l, smem); break;
    case 10: phase_scores(p, l, smem); break;
    case 11: phase_topk(p, l); break;
    case 12: phase_peer(p, l, smem); break;
  }
}

#define XB_TMO      128
#define XB_XCNT(j)  (256  + 64 * (j))
#define XB_XSUB(j)  (1280 + 64 * (j))
#define XB_XGEN(j)  (2304 + 64 * (j))
#define XB_TOP      3328
#define XB_TOPGEN   3392
#define XCD_BAR_WORDS 3456
#define XB_SPIN_CAP (1u << 18)
#define LAS __attribute__((address_space(3)))

__device__ __forceinline__ unsigned xb_ld(unsigned* p)              { return __hip_atomic_load(p, __ATOMIC_RELAXED, __HIP_MEMORY_SCOPE_AGENT); }
__device__ __forceinline__ unsigned xb_add(unsigned* p, unsigned v) { return __hip_atomic_fetch_add(p, v, __ATOMIC_RELAXED, __HIP_MEMORY_SCOPE_AGENT); }
__device__ __forceinline__ unsigned xb_xcc_id() { return (unsigned)__builtin_amdgcn_s_getreg((3 << 11) | 20) & 0xFu; }
#define XB_SPIN(cond, bar) do { unsigned _sp = 0; while (cond) { __builtin_amdgcn_s_sleep(1); \
    if ((++_sp & 255u) == 0u) { if (xb_ld(&(bar)[XB_TMO])) break; if (_sp > XB_SPIN_CAP) { atomicAdd(&(bar)[XB_TMO], 1u); break; } } } } while (0)

struct XcdBarrier {
    unsigned* bar; unsigned x;
    volatile LAS unsigned* st;
};

__device__ __forceinline__ XcdBarrier xcd_barrier_post(unsigned* bar, volatile LAS unsigned* st) {
    XcdBarrier b; b.bar = bar; b.x = xb_xcc_id(); b.st = st;
    if (threadIdx.x == 0) (void)xb_add(&bar[XB_XCNT(b.x)], 1u);
    return b;
}
__device__ __forceinline__ void xcd_barrier_complete(unsigned* bar, unsigned x, unsigned& nloc, unsigned& nx) {
    const unsigned G = gridDim.x * gridDim.y * gridDim.z;
    unsigned sum, cnt, mine, sp = 0u;
    for (;;) {
        sum = 0u; cnt = 0u; mine = 0u;
#pragma unroll
        for (unsigned j = 0; j < 16; ++j) { const unsigned c = xb_ld(&bar[XB_XCNT(j)]); sum += c; cnt += (c > 0u) ? 1u : 0u; mine = (j == x) ? c : mine; }
        if (sum == G) break;
        __builtin_amdgcn_s_sleep(1);
        if ((++sp & 255u) == 0u) { if (xb_ld(&bar[XB_TMO])) break; if (sp > XB_SPIN_CAP) { atomicAdd(&bar[XB_TMO], 1u); break; } }
    }
    nloc = mine > 0u ? mine : 1u; nx = cnt > 0u ? cnt : 1u;
}

__device__ __forceinline__ void xcd_barrier(const XcdBarrier& b) {
    asm volatile("s_waitcnt vmcnt(0)" ::: "memory");
    __syncthreads();
    if (threadIdx.x == 0) {
        unsigned* bar = b.bar;
        __builtin_amdgcn_s_waitcnt(0);
        unsigned nloc = b.st[0], nx = b.st[1];
        if (nloc == 0u) { xcd_barrier_complete(bar, b.x, nloc, nx); b.st[0] = nloc; b.st[1] = nx; }
        const unsigned old = xb_add(&bar[XB_XSUB(b.x)], 1u);
        const unsigned gen = old / nloc;
        if (old + 1u == (gen + 1u) * nloc) {
            __builtin_amdgcn_fence(__ATOMIC_RELEASE, "agent");
            asm volatile("s_waitcnt vmcnt(0)" ::: "memory");
            const unsigned og = xb_add(&bar[XB_TOP], 1u);
            const unsigned tg = og / nx;
            if (og + 1u == (tg + 1u) * nx) xb_add(&bar[XB_TOPGEN], 1u);
            else XB_SPIN(xb_ld(&bar[XB_TOPGEN]) == tg, bar);
            __builtin_amdgcn_fence(__ATOMIC_ACQUIRE, "agent");
            xb_add(&bar[XB_XGEN(b.x)], 1u);
            asm volatile("s_waitcnt vmcnt(0)" ::: "memory");
        } else {
            XB_SPIN(xb_ld(&bar[XB_XGEN(b.x)]) == gen, bar);
            __builtin_amdgcn_fence(__ATOMIC_ACQUIRE, "agent");
            asm volatile("s_waitcnt vmcnt(0)" ::: "memory");
        }
    }
    __syncthreads();
}


#define SMEM_BYTES 61440

#if MULTI
__global__ void __launch_bounds__(256, 2) k_phase(P p, int ph) {
  __shared__ __attribute__((aligned(16))) char smem[SMEM_BYTES];
  run_phase(p, ph, smem);
}
#else
__global__ void __launch_bounds__(256, 2) k_mega(P p) {
  __shared__ __attribute__((aligned(16))) char smem[SMEM_BYTES];
  __shared__ uint4 xb_words;
  cg::grid_group grid = cg::this_grid();
  if (threadIdx.x == 0) xb_words = make_uint4(0u, 0u, 0u, 0u);
  __syncthreads();
  XcdBarrier xb = xcd_barrier_post((unsigned*)(p.ws + OFF_bar), (volatile LAS unsigned*)&xb_words);
#pragma nounroll
  for (int ph = 0; ph < N_PHASES; ph++) {
    if (ph >= 2 && (ph - 2) % 13 == 10) continue;
    run_phase(p, ph, smem);
#ifdef DUPMASK
    if (ph >= 2 && ((DUPMASK >> ((ph - 2) % 13)) & 1)) run_phase(p, ph, smem);
#endif
    if (ph + 1 < N_PHASES) {
      if (gridDim.y > 1) grid.sync();
      xcd_barrier(xb);
    }
  }
}
#endif

extern "C" void kernel_launch(void* const* d_in, const int* in_sizes, int n_in, void* d_out, int out_size, void* d_ws,
                              size_t ws_size, hipStream_t stream) {
  P p{};
  const float** fp = (const float**)&p;
  for (int i = 0; i < 32; i++) fp[i] = (const float*)d_in[i];
  p.out = (float*)d_out;
  p.ws = (char*)d_ws;
  size_t off = WS_TOTAL;
  if (off > ws_size) { fprintf(stderr, "ws too small: need %zu have %zu\n", off, ws_size); return; }
#if MULTI
  for (int ph = 0; ph < N_PHASES; ph++) hipLaunchKernelGGL(k_phase, dim3(512), dim3(256), 0, stream, p, ph);
#else
  static int grid_blocks = 0;
  if (!grid_blocks) {
    int dev = 0, cus = 0, per_cu = 0;
    hipGetDevice(&dev);
    hipDeviceGetAttribute(&cus, hipDeviceAttributeMultiprocessorCount, dev);
    hipOccupancyMaxActiveBlocksPerMultiprocessor(&per_cu, k_mega, 256, 0);
    if (per_cu > 2) per_cu = 2;
    grid_blocks = cus * per_cu;
  }
  hipMemsetAsync(p.ws + OFF_bar, 0, 16384, stream);
  void* args[] = {&p};
  hipError_t e = hipLaunchCooperativeKernel((void*)k_mega, dim3(grid_blocks), dim3(256), args, 0, stream);
  if (e != hipSuccess) fprintf(stderr, "cooperative launch failed: %s (grid %d)\n", hipGetErrorString(e), grid_blocks);
#endif
}
```

```cpp
#include <hip/hip_runtime.h>
#include <hip/hip_cooperative_groups.h>
#include <cstdio>
#include <cstdint>
namespace cg = cooperative_groups;

#ifndef MULTI
#define MULTI 0
#endif

typedef unsigned short bf16_t;
using bf16x8 = __attribute__((ext_vector_type(8))) short;
using f32x4 = __attribute__((ext_vector_type(4))) float;
using u32x4 = __attribute__((ext_vector_type(4))) unsigned int;

#define T_ALL 12288
#define T_CTX 8192
#define NEG_INF (-__builtin_inff())

__device__ __forceinline__ int tidx() {
  int t = threadIdx.x;
  asm volatile("" : "+v"(t));
  return t;
}
__device__ __forceinline__ bf16_t f2bf(float f) {
  unsigned u = __float_as_uint(f);
  u += 0x7fffu + ((u >> 16) & 1u);
  return (bf16_t)(u >> 16);
}
__device__ __forceinline__ float bf2f(bf16_t b) { return __uint_as_float(((unsigned)b) << 16); }
__device__ __forceinline__ float wsum_shfl(float v) {
#pragma unroll
  for (int o = 32; o; o >>= 1) v += __shfl_xor(v, o);
  return v;
}
#define DPP_F(old, src, ctrl, rm) __int_as_float(__builtin_amdgcn_update_dpp(__float_as_int(old), __float_as_int(src), ctrl, rm, 0xf, false))
__device__ __forceinline__ float wsum(float v) {
  v += DPP_F(v, v, 0xB1, 0xf);
  v += DPP_F(v, v, 0x4E, 0xf);
  v += DPP_F(v, v, 0x141, 0xf);
  v += DPP_F(v, v, 0x140, 0xf);
  v += DPP_F(0.f, v, 0x142, 0xa);
  v += DPP_F(0.f, v, 0x143, 0xc);
  return __int_as_float(__builtin_amdgcn_readlane(__float_as_int(v), 63));
}
__device__ __forceinline__ float wmax(float v) {
  v = fmaxf(v, DPP_F(v, v, 0xB1, 0xf));
  v = fmaxf(v, DPP_F(v, v, 0x4E, 0xf));
  v = fmaxf(v, DPP_F(v, v, 0x141, 0xf));
  v = fmaxf(v, DPP_F(v, v, 0x140, 0xf));
  v = fmaxf(v, DPP_F(v, v, 0x142, 0xa));
  v = fmaxf(v, DPP_F(v, v, 0x143, 0xc));
  return __int_as_float(__builtin_amdgcn_readlane(__float_as_int(v), 63));
}
__device__ __forceinline__ float siluf(float x) { return x * __builtin_amdgcn_rcpf(1.f + __expf(-x)); }
__device__ __forceinline__ float sigmf(float x) { return __builtin_amdgcn_rcpf(1.f + __expf(-x)); }
__device__ __forceinline__ float logsigf(float z) { return fminf(z, 0.f) - log1pf(__expf(-fabsf(z))); }
__device__ __forceinline__ int cond_row(int g) { return g < T_CTX ? 0 : 1 + ((g - T_CTX) >> 11); }

struct P {
  const float *x_prompt, *x_sample, *c, *cache_ckv, *cache_krope, *cache_swa_k, *cache_swa_v, *state_gla, *c_ctx,
      *w_ada, *b_ada, *w_in, *mla_q_norm, *w_uq, *mla_kv_norm, *w_ukv, *w_gla_a_fwd, *b_gla_a_fwd, *w_gla_a_bwd,
      *b_gla_a_bwd, *gla_norm, *swa_sink, *w_branch, *w_out, *ln1_g, *ln1_b, *ln2_g, *ln2_b, *w_peer_q, *peer_keys,
      *peer_u, *peer_v;
  float* out;
  char* ws;
};

constexpr size_t OFF_Wt_in = 0ull;
constexpr size_t OFF_Wt_uq = OFF_Wt_in + (((2ull * 6144 * 1024 * 2) + 255ull) & ~255ull);
constexpr size_t OFF_Wt_ukv = OFF_Wt_uq + (((2ull * 384 * 256 * 2) + 255ull) & ~255ull);
constexpr size_t OFF_Wt_br = OFF_Wt_ukv + (((2ull * 512 * 128 * 2) + 255ull) & ~255ull);
constexpr size_t OFF_Wt_out = OFF_Wt_br + (((8ull * 1024 * 256 * 2) + 255ull) & ~255ull);
constexpr size_t OFF_Wt_pq = OFF_Wt_out + (((2ull * 1024 * 1024 * 2) + 255ull) & ~255ull);
constexpr size_t OFF_keysbf = OFF_Wt_pq + (((2ull * 2048 * 1024 * 2) + 255ull) & ~255ull);
constexpr size_t OFF_Cch = OFF_keysbf + (((2ull * 16 * 128 * 128 * 2) + 255ull) & ~255ull);
constexpr size_t OFF_A256 = OFF_Cch + (((128ull * 64 * 2) + 255ull) & ~255ull);
constexpr size_t OFF_A2048 = OFF_A256 + (((256ull * 512 * 2) + 255ull) & ~255ull);
constexpr size_t OFF_mada = OFF_A2048 + (((2048ull * 4096 * 2) + 255ull) & ~255ull);
constexpr size_t OFF_xbuf = OFF_mada + (((2ull * 3 * 6144 * 4) + 255ull) & ~255ull);
constexpr size_t OFF_u = OFF_xbuf + 256ull;
constexpr size_t OFF_hbuf = OFF_u + (((12288ull * 1024 * 2) + 255ull) & ~255ull);
constexpr size_t OFF_gates = OFF_hbuf + (((12288ull * 1984 * 4) + 255ull) & ~255ull);
constexpr size_t OFF_qn = OFF_gates + (((12288ull * 4096 * 2) + 255ull) & ~255ull);
constexpr size_t OFF_ckv_all = OFF_qn + (((12288ull * 256 * 2) + 255ull) & ~255ull);
constexpr size_t OFF_Qa = OFF_ckv_all + (((13312ull * 128 * 2) + 255ull) & ~255ull);
constexpr size_t OFF_Ka_ctx = OFF_Qa + (((12288ull * 384 * 2) + 255ull) & ~255ull);
constexpr size_t OFF_Ka_lat = OFF_Ka_ctx + (((32ull * 4 * 256 * 96 * 2) + 255ull) & ~255ull);
constexpr size_t OFF_Va_ctx = OFF_Ka_lat + (((2ull * 4 * 2560 * 96 * 2) + 255ull) & ~255ull);
constexpr size_t OFF_Va_lat = OFF_Va_ctx + (((32ull * 4 * 256 * 64 * 2) + 255ull) & ~255ull);
constexpr size_t OFF_Qd = OFF_Va_lat + (((2ull * 4 * 2560 * 64 * 2) + 255ull) & ~255ull);
constexpr size_t OFF_Kd_ctx = OFF_Qd + (((12288ull * 256 * 2) + 255ull) & ~255ull);
constexpr size_t OFF_Kd_lat = OFF_Kd_ctx + (((32ull * 2 * 256 * 64 * 2) + 255ull) & ~255ull);
constexpr size_t OFF_Vd_ctx = OFF_Kd_lat + (((2ull * 2 * 2560 * 64 * 2) + 255ull) & ~255ull);
constexpr size_t OFF_Vd_lat = OFF_Vd_ctx + (((32ull * 2 * 256 * 64 * 2) + 255ull) & ~255ull);
constexpr size_t OFF_fnet = OFF_Vd_lat + (((2ull * 2 * 2560 * 64 * 2) + 255ull) & ~255ull);
constexpr size_t OFF_Yt_ctx = OFF_fnet + (((12288ull * 256 * 2) + 255ull) & ~255ull);
constexpr size_t OFF_Yt_lat = OFF_Yt_ctx + (((32ull * 256 * 512 * 2) + 255ull) & ~255ull);
constexpr size_t OFF_br = OFF_Yt_lat + (((2ull * 256 * 4096 * 2) + 255ull) & ~255ull);
constexpr size_t OFF_un = OFF_br + (((12288ull * 1024 * 2) + 255ull) & ~255ull);
constexpr size_t OFF_sin_ = OFF_un + (((1536ull * 2048 * 4) + 255ull) & ~255ull);
constexpr size_t OFF_gn = OFF_sin_ + (((1536ull * 2048 * 4) + 255ull) & ~255ull);
constexpr size_t OFF_pidx = OFF_gn + (((1536ull * 32 * 4) + 255ull) & ~255ull);
constexpr size_t OFF_pw = OFF_pidx + (((12288ull * 128 * 4) + 255ull) & ~255ull);
constexpr size_t OFF_bar = OFF_pw + (((12288ull * 128 * 4) + 255ull) & ~255ull);
constexpr size_t WS_TOTAL_OLD = OFF_pw + (((12288ull * 128 * 4) + 255ull) & ~255ull);
constexpr size_t OFF_tabU = OFF_bar + 16384ull;
constexpr size_t OFF_tabV = OFF_tabU + 2ull * 16384 * 1024;
constexpr size_t WS_TOTAL = OFF_tabV + 2ull * 16384 * 1024;
#define W_tabU ((unsigned char*)(p.ws + OFF_tabU))
#define W_tabV ((unsigned char*)(p.ws + OFF_tabV))
#define W_Wt_in ((bf16_t*)(p.ws + OFF_Wt_in))
#define W_Wt_uq ((bf16_t*)(p.ws + OFF_Wt_uq))
#define W_Wt_ukv ((bf16_t*)(p.ws + OFF_Wt_ukv))
#define W_Wt_br ((bf16_t*)(p.ws + OFF_Wt_br))
#define W_Wt_out ((bf16_t*)(p.ws + OFF_Wt_out))
#define W_Wt_pq ((bf16_t*)(p.ws + OFF_Wt_pq))
#define W_keysbf ((bf16_t*)(p.ws + OFF_keysbf))
#define W_Cch ((bf16_t*)(p.ws + OFF_Cch))
#define W_A256 ((bf16_t*)(p.ws + OFF_A256))
#define W_A2048 ((bf16_t*)(p.ws + OFF_A2048))
#define W_mada ((float*)(p.ws + OFF_mada))
#define W_xbuf ((float*)(p.ws + OFF_xbuf))
#define W_u ((bf16_t*)(p.ws + OFF_u))
#define W_hbuf ((float*)(p.ws + OFF_hbuf))
#define W_gates ((bf16_t*)(p.ws + OFF_gates))
#define W_qn ((bf16_t*)(p.ws + OFF_qn))
#define W_ckv_all ((bf16_t*)(p.ws + OFF_ckv_all))
#define W_Qa ((bf16_t*)(p.ws + OFF_Qa))
#define W_Ka_ctx ((bf16_t*)(p.ws + OFF_Ka_ctx))
#define W_Ka_lat ((bf16_t*)(p.ws + OFF_Ka_lat))
#define W_Va_ctx ((bf16_t*)(p.ws + OFF_Va_ctx))
#define W_Va_lat ((bf16_t*)(p.ws + OFF_Va_lat))
#define W_Qd ((bf16_t*)(p.ws + OFF_Qd))
#define W_Kd_ctx ((bf16_t*)(p.ws + OFF_Kd_ctx))
#define W_Kd_lat ((bf16_t*)(p.ws + OFF_Kd_lat))
#define W_Vd_ctx ((bf16_t*)(p.ws + OFF_Vd_ctx))
#define W_Vd_lat ((bf16_t*)(p.ws + OFF_Vd_lat))
#define W_fnet ((bf16_t*)(p.ws + OFF_fnet))
#define W_Yt_ctx ((bf16_t*)(p.ws + OFF_Yt_ctx))
#define W_Yt_lat ((bf16_t*)(p.ws + OFF_Yt_lat))
#define W_br ((bf16_t*)(p.ws + OFF_br))
#define W_un ((float*)(p.ws + OFF_un))
#define W_sin_ ((float*)(p.ws + OFF_sin_))
#define W_gn ((float*)(p.ws + OFF_gn))
#define W_pidx ((int*)(p.ws + OFF_pidx))
#define W_pw ((float*)(p.ws + OFF_pw))

#define GB_LD 72
#define G_LOAD(RA, RB, KOFF)                                                         \
  _Pragma("unroll") for (int i = 0; i < 4; i++) {                                    \
    int c = tid + i * 256, r = c >> 3, cc = (c & 7) * 8;                             \
    RA[i] = *(const u32x4*)(A + (size_t)r * lda + (KOFF) + cc);                      \
    if (i < NJ) RB[i] = *(const u32x4*)(B + (size_t)r * ldb + (KOFF) + cc);          \
  }
#define G_STORE(RA, RB)                                                              \
  _Pragma("unroll") for (int i = 0; i < 4; i++) {                                    \
    int c = tid + i * 256, r = c >> 3, cc = (c & 7) * 8;                             \
    *(u32x4*)(sa + r * GB_LD + cc) = RA[i];                                          \
    if (i < NJ) *(u32x4*)(sb + r * GB_LD + cc) = RB[i];                              \
  }
#define G_COMPUTE()                                                                  \
  _Pragma("unroll") for (int ks = 0; ks < 2; ks++) {                                 \
    bf16x8 af[4], bfr[NJ];                                                           \
    _Pragma("unroll") for (int i = 0; i < 4; i++)                                    \
      af[i] = *(const bf16x8*)(sa + (wm * 64 + i * 16 + l15) * GB_LD + ks * 32 + l4 * 8); \
    _Pragma("unroll") for (int j = 0; j < NJ; j++)                                   \
      bfr[j] = *(const bf16x8*)(sb + (wn * NJ * 16 + j * 16 + l15) * GB_LD + ks * 32 + l4 * 8); \
    _Pragma("unroll") for (int i = 0; i < 4; i++)                                    \
    _Pragma("unroll") for (int j = 0; j < NJ; j++)                                   \
      acc[i][j] = __builtin_amdgcn_mfma_f32_16x16x32_bf16(af[i], bfr[j], acc[i][j], 0, 0, 0); \
  }
template <int NJ>
__device__ __forceinline__ void gemm_core_t(f32x4 (&acc)[4][NJ], const bf16_t* __restrict__ A, int lda,
                                            const bf16_t* __restrict__ B, int ldb, int K, char* smem) {
  bf16_t* sa = (bf16_t*)smem;
  bf16_t* sb = sa + 128 * GB_LD;
  const int tid = tidx(), lane = tid & 63, w = tid >> 6, wm = w >> 1, wn = w & 1;
  const int l15 = lane & 15, l4 = lane >> 4;
  u32x4 ra0[4], rb0[NJ], ra1[4], rb1[NJ];
  G_LOAD(ra0, rb0, 0);
  if (K > 64) { G_LOAD(ra1, rb1, 64); }
  for (int k0 = 0; k0 < K; k0 += 128) {
    __syncthreads();
    G_STORE(ra0, rb0);
    __syncthreads();
    if (k0 + 128 < K) { G_LOAD(ra0, rb0, k0 + 128); }
    G_COMPUTE();
    if (k0 + 64 < K) {
      __syncthreads();
      G_STORE(ra1, rb1);
      __syncthreads();
      if (k0 + 192 < K) { G_LOAD(ra1, rb1, k0 + 192); }
      G_COMPUTE();
    }
  }
}
#define gemm_core gemm_core_t<4>
#define ZERO_ACC_N(acc, NJ)                                        \
  _Pragma("unroll") for (int i_ = 0; i_ < 4; i_++)                 \
  _Pragma("unroll") for (int j_ = 0; j_ < NJ; j_++) { acc[i_][j_] = f32x4{0.f, 0.f, 0.f, 0.f}; }
#define ZERO_ACC(acc) ZERO_ACC_N(acc, 4)
#define EPI_LOOP_N(acc, m0, n0, NJ, ...)                                                   \
  {                                                                                        \
    const int lane_ = tidx() & 63, w_ = tidx() >> 6, wm_ = w_ >> 1, wn_ = w_ & 1; \
    _Pragma("unroll") for (int i_ = 0; i_ < 4; i_++)                                       \
    _Pragma("unroll") for (int j_ = 0; j_ < NJ; j_++)                                      \
    _Pragma("unroll") for (int r_ = 0; r_ < 4; r_++) {                                     \
      const int m = (m0) + wm_ * 64 + i_ * 16 + (lane_ >> 4) * 4 + r_;                     \
      const int n = (n0) + wn_ * (NJ * 16) + j_ * 16 + (lane_ & 15);                       \
      float v = acc[i_][j_][r_];                                                           \
      __VA_ARGS__                                                                          \
    }                                                                                      \
  }
#define EPI_LOOP(acc, m0, n0, ...) EPI_LOOP_N(acc, m0, n0, 4, __VA_ARGS__)
#define EPI4_LOOP(acc, c0, t0, ...)                                                        \
  {                                                                                        \
    const int lane_ = tidx() & 63, w_ = tidx() >> 6, wm_ = w_ >> 1, wn_ = w_ & 1;           \
    _Pragma("unroll") for (int i_ = 0; i_ < 4; i_++)                                       \
    _Pragma("unroll") for (int j_ = 0; j_ < 4; j_++) {                                     \
      const int col = (c0) + wm_ * 64 + i_ * 16 + (lane_ >> 4) * 4;                        \
      const int tok = (t0) + wn_ * 64 + j_ * 16 + (lane_ & 15);                            \
      const f32x4 v4 = acc[i_][j_];                                                        \
      __VA_ARGS__                                                                          \
    }                                                                                      \
  }

__device__ __forceinline__ void transpose_tile(const float* __restrict__ src, int K, int N, bf16_t* __restrict__ dst, int tile, int ntn,
                               float* sm, int ldd = 0) {
  if (ldd == 0) ldd = K;
  int kt = tile / ntn, nt = tile % ntn, k0 = kt * 64, n0 = nt * 64;
  int tx = tidx() & 63, ty = tidx() >> 6;
  __syncthreads();
  for (int i = 0; i < 16; i++) {
    int k = i * 4 + ty, n = n0 + tx;
    sm[k * 65 + tx] = (n < N) ? src[(size_t)(k0 + k) * N + n] : 0.f;
  }
  __syncthreads();
  for (int i = 0; i < 16; i++) {
    int n = i * 4 + ty;
    dst[(size_t)(n0 + n) * ldd + k0 + tx] = f2bf(sm[tx * 65 + n]);
  }
}

__device__ __forceinline__ void ada_item(const P& p, int item, float* sm) {
  int l = item / 24, cgp = item % 24;
  int lane = tidx() & 63, w = tidx() >> 6;
  const float* W = p.w_ada + (size_t)l * 1024 * 6144 + cgp * 256 + lane * 4;
  float4 a0 = {0, 0, 0, 0}, a1 = {0, 0, 0, 0}, a2 = {0, 0, 0, 0};
#pragma unroll 16
  for (int k = w * 256; k < (w + 1) * 256; k++) {
    float4 wv = *(const float4*)(W + (size_t)k * 6144);
    float c0 = siluf(p.c_ctx[k]), c1 = siluf(p.c[k]), c2 = siluf(p.c[1024 + k]);
    a0.x += c0 * wv.x; a0.y += c0 * wv.y; a0.z += c0 * wv.z; a0.w += c0 * wv.w;
    a1.x += c1 * wv.x; a1.y += c1 * wv.y; a1.z += c1 * wv.z; a1.w += c1 * wv.w;
    a2.x += c2 * wv.x; a2.y += c2 * wv.y; a2.z += c2 * wv.z; a2.w += c2 * wv.w;
  }
  __syncthreads();
  *(float4*)(sm + (w * 3 + 0) * 256 + lane * 4) = a0;
  *(float4*)(sm + (w * 3 + 1) * 256 + lane * 4) = a1;
  *(float4*)(sm + (w * 3 + 2) * 256 + lane * 4) = a2;
  __syncthreads();
  for (int o = tidx(); o < 768; o += 256) {
    int r = o >> 8, col = o & 255;
    float s = sm[(0 * 3 + r) * 256 + col] + sm[(1 * 3 + r) * 256 + col] + sm[(2 * 3 + r) * 256 + col] +
              sm[(3 * 3 + r) * 256 + col];
    W_mada[(l * 3 + r) * 6144 + cgp * 256 + col] = s + p.b_ada[l * 6144 + cgp * 256 + col];
  }
}

__device__ __forceinline__ void dft_seq_fill(bf16_t* dst, int S, int item) {
  float inv = rsqrtf((float)S);
  size_t base = (size_t)item * 2048;
  for (int e = 0; e < 8; e++) {
    size_t idx = base + e * 256 + tidx();
    int k = (int)(idx / (2 * S)), col = (int)(idx % (2 * S));
    int s = col < S ? col : col - S;
    int mm = (k * s) & (S - 1);
    float rev = (float)mm / (float)S;
    float v = col < S ? __builtin_amdgcn_cosf(rev) : -__builtin_amdgcn_sinf(rev);
    dst[idx] = f2bf(v * inv);
  }
}

#define PEER_U_SCALE 64.f
#define PEER_V_SCALE 16.f
__device__ __forceinline__ void tab_convert_item(const P& p, int item) {
  int l = item >> 12, isv = (item >> 11) & 1, sub = item & 2047;
  const float* src = (isv ? p.peer_v : p.peer_u) + (size_t)l * 16384 * 1024 + (size_t)sub * 8192;
  unsigned char* dst = (isv ? W_tabV : W_tabU) + (size_t)l * 16384 * 1024 + (size_t)sub * 8192;
  const float sc = isv ? PEER_V_SCALE : PEER_U_SCALE;
  int tid = tidx();
  float4 tt[8];
#pragma unroll
  for (int e = 0; e < 8; e++) tt[e] = *(const float4*)(src + (e * 256 + tid) * 4);
#pragma unroll
  for (int e = 0; e < 8; e++) {
    float4 t = tt[e];
    int pk = __builtin_amdgcn_cvt_pk_fp8_f32(t.x * sc, t.y * sc, 0, false);
    pk = __builtin_amdgcn_cvt_pk_fp8_f32(t.z * sc, t.w * sc, pk, true);
    *(int*)(dst + (e * 256 + tid) * 4) = pk;
  }
}

__device__ __forceinline__ void phase_prep(const P& p, char* smem) {
  float* sm = (float*)smem;
  const int nb = gridDim.x;
  const int J_ADA = 48;
  const int J_IN = 2 * 16 * 96;
  const int J_UQ = 2 * 4 * 6;
  const int J_UKV = 2 * 2 * 8;
  const int J_BR = 2 * 4 * 4 * 16;
  const int J_OUT = 2 * 16 * 16;
  const int J_PQ = 2 * 16 * 32;
  const int J_KEYS = 256;
  const int J_CCH = 4;
  const int J_A256 = 64;
  const int J_A2048 = 4096;
  const int J_TAB = 8192;
  const int total = J_ADA + J_IN + J_UQ + J_UKV + J_BR + J_OUT + J_PQ + J_KEYS + J_CCH + J_A256 + J_A2048 + J_TAB;
  const bool ada_split = nb >= 4 * J_ADA;
  const int it_start = ada_split ? ((int)blockIdx.x < J_ADA ? (int)blockIdx.x : J_ADA + ((int)blockIdx.x - J_ADA)) : (int)blockIdx.x;
  const int it_step = ada_split ? ((int)blockIdx.x < J_ADA ? total : nb - J_ADA) : nb;
  for (int it0 = it_start; it0 < total; it0 += it_step) {
    int it = it0;
    if (it < J_ADA) { ada_item(p, it, sm); continue; }
    it -= J_ADA;
    if (it < J_IN) { int l = it / 1536, t = it % 1536; transpose_tile(p.w_in + (size_t)l * 1024 * 6080, 1024, 6080, W_Wt_in + (size_t)l * 6144 * 1024, t, 96, sm); continue; }
    it -= J_IN;
    if (it < J_UQ) { int l = it / 24, t = it % 24; transpose_tile(p.w_uq + (size_t)l * 256 * 384, 256, 384, W_Wt_uq + (size_t)l * 384 * 256, t, 6, sm); continue; }
    it -= J_UQ;
    if (it < J_UKV) { int l = it / 16, t = it % 16; transpose_tile(p.w_ukv + (size_t)l * 128 * 512, 128, 512, W_Wt_ukv + (size_t)l * 512 * 128, t, 8, sm); continue; }
    it -= J_UKV;
    if (it < J_BR) { int lb = it / 64, t = it % 64; transpose_tile(p.w_branch + (size_t)lb * 256 * 1024, 256, 1024, W_Wt_br + (size_t)(lb >> 2) * 1024 * 1024 + (lb & 3) * 256, t, 16, sm, 1024); continue; }
    it -= J_BR;
    if (it < J_OUT) { int l = it / 256, t = it % 256; transpose_tile(p.w_out + (size_t)l * 1024 * 1024, 1024, 1024, W_Wt_out + (size_t)l * 1024 * 1024, t, 16, sm); continue; }
    it -= J_OUT;
    if (it < J_PQ) { int l = it / 512, t = it % 512; transpose_tile(p.w_peer_q + (size_t)l * 1024 * 2048, 1024, 2048, W_Wt_pq + (size_t)l * 2048 * 1024, t, 32, sm); continue; }
    it -= J_PQ;
    if (it < J_KEYS) {
      size_t base = (size_t)it * 2048;
      float kv_[8];
#pragma unroll
      for (int e = 0; e < 8; e++) kv_[e] = p.peer_keys[base + e * 256 + tidx()];
#pragma unroll
      for (int e = 0; e < 8; e++) W_keysbf[base + e * 256 + tidx()] = f2bf(kv_[e]);
      continue;
    }
    it -= J_KEYS;
    if (it < J_CCH) {
      for (int e = 0; e < 8; e++) {
        int idx = it * 2048 + e * 256 + tidx();
        int n = idx >> 6, c = idx & 63;
        int j = n & 63;
        float rev = (float)((j * c) & 63) / 64.f;
        float v = n < 64 ? __builtin_amdgcn_cosf(rev) : __builtin_amdgcn_sinf(rev);
        W_Cch[idx] = f2bf(v * 0.125f);
      }
      continue;
    }
    it -= J_CCH;
    if (it < J_A256) { dft_seq_fill(W_A256, 256, it); continue; }
    it -= J_A256;
    if (it < J_A2048) { dft_seq_fill(W_A2048, 2048, it); continue; }
    it -= J_A2048;
    tab_convert_item(p, it);
  }
}

__device__ __forceinline__ void load_row16(const float* row, int lane, float (&v)[16]) {
#pragma unroll
  for (int q = 0; q < 4; q++) {
    float4 t = *(const float4*)(row + q * 256 + lane * 4);
    v[q * 4 + 0] = t.x; v[q * 4 + 1] = t.y; v[q * 4 + 2] = t.z; v[q * 4 + 3] = t.w;
  }
}
__device__ __forceinline__ void store_row16(float* row, int lane, const float (&v)[16]) {
#pragma unroll
  for (int q = 0; q < 4; q++) *(float4*)(row + q * 256 + lane * 4) = float4{v[q * 4], v[q * 4 + 1], v[q * 4 + 2], v[q * 4 + 3]};
}
__device__ __forceinline__ void ln16(float (&v)[16]) {
  float s = 0;
#pragma unroll
  for (int i = 0; i < 16; i++) s += v[i];
  s = wsum(s);
  float mu = s * (1.f / 1024.f);
  float q = 0;
#pragma unroll
  for (int i = 0; i < 16; i++) { v[i] -= mu; q += v[i] * v[i]; }
  q = wsum(q);
  float rs = rsqrtf(q * (1.f / 1024.f) + 1e-6f);
#pragma unroll
  for (int i = 0; i < 16; i++) v[i] *= rs;
}
__device__ __forceinline__ void modulate_store(const float (&v)[16], const float* sh, const float* sc, bf16_t* dst, int lane) {
#pragma unroll
  for (int q = 0; q < 4; q++) {
    float4 a = *(const float4*)(sc + q * 256 + lane * 4);
    float4 b = *(const float4*)(sh + q * 256 + lane * 4);
    ushort4 o;
    o.x = f2bf(v[q * 4 + 0] * (1.f + a.x) + b.x);
    o.y = f2bf(v[q * 4 + 1] * (1.f + a.y) + b.y);
    o.z = f2bf(v[q * 4 + 2] * (1.f + a.z) + b.z);
    o.w = f2bf(v[q * 4 + 3] * (1.f + a.w) + b.w);
    *(ushort4*)(dst + q * 256 + lane * 4) = o;
  }
}
__device__ __forceinline__ void affine16(float (&v)[16], const float* g, const float* b, int lane) {
#pragma unroll
  for (int q = 0; q < 4; q++) {
    float4 a = *(const float4*)(g + q * 256 + lane * 4);
    float4 c = *(const float4*)(b + q * 256 + lane * 4);
    v[q * 4 + 0] = v[q * 4 + 0] * a.x + c.x;
    v[q * 4 + 1] = v[q * 4 + 1] * a.y + c.y;
    v[q * 4 + 2] = v[q * 4 + 2] * a.z + c.z;
    v[q * 4 + 3] = v[q * 4 + 3] * a.w + c.w;
  }
}
__device__ __forceinline__ const float* x_in_row(const P& p, int l, int g) {
  if (l == 0) return g < T_CTX ? p.x_prompt + (size_t)g * 1024 : p.x_sample + (size_t)(g - T_CTX) * 1024;
  return p.out + (size_t)g * 1024;
}
__device__ __forceinline__ float* x_out_row(const P& p, int l, int g) {
  return p.out + (size_t)g * 1024;
}

__device__ __forceinline__ void phase_ln0(const P& p) {
  int lane = tidx() & 63, w = tidx() >> 6;
  for (int it = blockIdx.x; it < T_ALL / 4; it += gridDim.x) {
    int g = it * 4 + w;
    float v[16];
    load_row16(x_in_row(p, 0, g), lane, v);
    ln16(v);
    const float* m = W_mada + (0 * 3 + cond_row(g)) * 6144;
    modulate_store(v, m, m + 1024, W_u + (size_t)g * 1024, lane);
  }
}

__device__ __forceinline__ void phase_win(const P& p, int l, char* smem) {
  const bf16_t* Wt = W_Wt_in + (size_t)l * 6144 * 1024;
  for (int tile = blockIdx.x; tile < 96 * 48; tile += gridDim.x) {
    int mt = tile / 48, nt = tile % 48, m0 = mt * 128, n0 = nt * 128;
    f32x4 acc[4][4];
    ZERO_ACC(acc);
    gemm_core(acc, Wt + (size_t)n0 * 1024, 1024, W_u + (size_t)m0 * 1024, 1024, 1024, smem);
    EPI4_LOOP(acc, n0, m0, {
      if (col < 1984) *(float4*)(W_hbuf + (size_t)tok * 1984 + col) = float4{v4[0], v4[1], v4[2], v4[3]};
      else if (col < 6080) {
        ushort4 o_; o_.x = f2bf(sigmf(v4[0])); o_.y = f2bf(sigmf(v4[1])); o_.z = f2bf(sigmf(v4[2])); o_.w = f2bf(sigmf(v4[3]));
        *(ushort4*)(W_gates + (size_t)tok * 4096 + (col - 1984)) = o_;
      }
    });
  }
}

__device__ __forceinline__ void rope_cs(float pos, int i, float inv_hp, float& cs, float& sn) {
  float freq = exp2f(-(float)i * inv_hp * 13.287712379549449f);
  float a = pos * freq;
  sn = __sinf(a);
  cs = __cosf(a);
}

__device__ __forceinline__ void phase_post(const P& p, int l) {
  int lane = tidx() & 63, w = tidx() >> 6;
  for (int it = blockIdx.x; it < 13312 / 4; it += gridDim.x) {
    int g = it * 4 + w;
    if (g < T_ALL) {
      const bool lat = g >= T_CTX;
      int b, s;
      if (!lat) { b = g >> 8; s = g & 255; } else { b = (g - T_CTX) >> 11; s = (g - T_CTX) & 2047; }
      const float* h = W_hbuf + (size_t)g * 1984;
      const float prow = (float)(s >> 6), pcol = (float)(s & 63);
      const float4 pl_q = *(const float4*)(h + lane * 4);
      const float2 pl_c = *(const float2*)(h + 256 + lane * 2);
      const float pl_kr1 = h[384 + ((lane >> 3) & 1) * 16 + (lane & 7)], pl_kr2 = h[384 + ((lane >> 3) & 1) * 16 + 8 + (lane & 7)];
      const float4 pl_f = *(const float4*)(h + 416 + lane * 4);
      float pl_sq1[2], pl_sq2[2];
#pragma unroll
      for (int jj = 0; jj < 2; jj++) {
        int pi = lane + 64 * jj, hq = pi >> 5, pp = (pi >> 4) & 1, i = pi & 15;
        pl_sq1[jj] = h[1472 + hq * 64 + pp * 32 + i]; pl_sq2[jj] = h[1472 + hq * 64 + pp * 32 + 16 + i];
      }
      const float pl_sk1 = h[1728 + (lane >> 5) * 64 + ((lane >> 4) & 1) * 32 + (lane & 15)];
      const float pl_sk2 = h[1728 + (lane >> 5) * 64 + ((lane >> 4) & 1) * 32 + 16 + (lane & 15)];
      const float2 pl_v = *(const float2*)(h + 1856 + lane * 2);
      {
        float4 t = pl_q;
        float ss = wsum(t.x * t.x + t.y * t.y + t.z * t.z + t.w * t.w);
        float rs = rsqrtf(ss * (1.f / 256.f) + 1e-6f);
        float4 gq = *(const float4*)(p.mla_q_norm + l * 256 + lane * 4);
        ushort4 o;
        o.x = f2bf(t.x * rs * gq.x); o.y = f2bf(t.y * rs * gq.y); o.z = f2bf(t.z * rs * gq.z); o.w = f2bf(t.w * rs * gq.w);
        *(ushort4*)(W_qn + (size_t)g * 256 + lane * 4) = o;
      }
      {
        float2 t = pl_c;
        float ss = wsum(t.x * t.x + t.y * t.y);
        float rs = rsqrtf(ss * (1.f / 128.f) + 1e-6f);
        float2 gk = *(const float2*)(p.mla_kv_norm + l * 128 + lane * 2);
        float v0 = t.x * rs * gk.x, v1 = t.y * rs * gk.y;
        ushort2 o; o.x = f2bf(v0); o.y = f2bf(v1);
        *(ushort2*)(W_ckv_all + (size_t)g * 128 + lane * 2) = o;
        if (!lat) *(float2*)(p.out + 12582912 + ((size_t)((b * 2 + l) * 256 + s)) * 128 + lane * 2) = float2{v0, v1};
      }
      if (lane < 16) {
        int pp = lane >> 3, i = lane & 7;
        float x1 = pl_kr1, x2 = pl_kr2;
        float o1 = x1, o2 = x2;
        if (lat) {
          float cs, sn;
          rope_cs(pp ? pcol : prow, i, 0.125f, cs, sn);
          o1 = x1 * cs - x2 * sn; o2 = x2 * cs + x1 * sn;
        } else {
          float* ok = p.out + 14680064 + ((size_t)((b * 2 + l) * 256 + s)) * 32 + pp * 16 + i;
          ok[0] = o1; ok[8] = o2;
        }
        bf16_t b1 = f2bf(o1), b2 = f2bf(o2);
        for (int hh = 0; hh < 4; hh++) {
          bf16_t* kd = lat ? W_Ka_lat + ((size_t)((b * 4 + hh) * 2560 + 512 + s)) * 96 : W_Ka_ctx + ((size_t)((b * 4 + hh) * 256 + s)) * 96;
          kd[64 + pp * 16 + i] = b1; kd[64 + pp * 16 + 8 + i] = b2;
        }
      }
      {
        float4 t = pl_f;
        ushort4 o; o.x = f2bf(t.x); o.y = f2bf(t.y); o.z = f2bf(t.z); o.w = f2bf(t.w);
        *(ushort4*)(W_fnet + (size_t)g * 256 + lane * 4) = o;
      }
#pragma unroll
      for (int jj = 0; jj < 2; jj++) {
        int pi = lane + 64 * jj, hq = pi >> 5, pp = (pi >> 4) & 1, i = pi & 15;
        float x1 = pl_sq1[jj], x2 = pl_sq2[jj];
        float o1 = x1, o2 = x2;
        if (lat) {
          float cs, sn;
          rope_cs(pp ? pcol : prow, i, 0.0625f, cs, sn);
          o1 = x1 * cs - x2 * sn; o2 = x2 * cs + x1 * sn;
        }
        bf16_t* qd = W_Qd + (size_t)g * 256 + hq * 64 + pp * 32 + i;
        qd[0] = f2bf(o1); qd[16] = f2bf(o2);
      }
      {
        int kv = lane >> 5, pp = (lane >> 4) & 1, i = lane & 15;
        float x1 = pl_sk1, x2 = pl_sk2;
        float o1 = x1, o2 = x2;
        bf16_t* kd;
        if (lat) {
          float cs, sn;
          rope_cs(pp ? pcol : prow, i, 0.0625f, cs, sn);
          o1 = x1 * cs - x2 * sn; o2 = x2 * cs + x1 * sn;
          kd = W_Kd_lat + ((size_t)((b * 2 + kv) * 2560 + 512 + s)) * 64;
        } else {
          float* ok = p.out + 15204352 + ((size_t)(((b * 2 + l) * 2 + kv) * 256 + s)) * 64 + pp * 32 + i;
          ok[0] = o1; ok[16] = o2;
          kd = W_Kd_ctx + ((size_t)((b * 2 + kv) * 256 + s)) * 64;
        }
        kd[pp * 32 + i] = f2bf(o1); kd[pp * 32 + 16 + i] = f2bf(o2);
      }
      {
        int e = lane * 2, kv = e >> 6, d = e & 63;
        float2 t = pl_v;
        if (lat) {
          bf16_t* vt = W_Vd_lat + (size_t)(b * 2 + kv) * 64 * 2560 + 512 + s;
          vt[(size_t)d * 2560] = f2bf(t.x); vt[(size_t)(d + 1) * 2560] = f2bf(t.y);
        } else {
          *(float2*)(p.out + 17301504 + ((size_t)(((b * 2 + l) * 2 + kv) * 256 + s)) * 64 + d) = t;
          bf16_t* vt = W_Vd_ctx + (size_t)(b * 2 + kv) * 64 * 256 + s;
          vt[d * 256] = f2bf(t.x); vt[(d + 1) * 256] = f2bf(t.y);
        }
      }
    } else {
      int gc = g - T_ALL, b = gc >> 9, pp = gc & 511;
      {
        float2 t = *(const float2*)(p.cache_ckv + ((size_t)((b * 2 + l) * 512 + pp)) * 128 + lane * 2);
        ushort2 o; o.x = f2bf(t.x); o.y = f2bf(t.y);
        *(ushort2*)(W_ckv_all + (size_t)g * 128 + lane * 2) = o;
      }
      if (lane < 32) {
        bf16_t v = f2bf(p.cache_krope[((size_t)((b * 2 + l) * 512 + pp)) * 32 + lane]);
        for (int hh = 0; hh < 4; hh++) W_Ka_lat[((size_t)((b * 4 + hh) * 2560 + pp)) * 96 + 64 + lane] = v;
      }
      {
        int e = lane * 2, kv = e >> 6, d = e & 63;
        size_t src = ((size_t)(((b * 2 + l) * 2 + kv) * 512 + pp)) * 64 + d;
        float2 tk = *(const float2*)(p.cache_swa_k + src);
        float2 tv = *(const float2*)(p.cache_swa_v + src);
        size_t dst = ((size_t)((b * 2 + kv) * 2560 + pp)) * 64 + d;
        ushort2 ok; ok.x = f2bf(tk.x); ok.y = f2bf(tk.y);
        *(ushort2*)(W_Kd_lat + dst) = ok;
        bf16_t* vt = W_Vd_lat + (size_t)(b * 2 + kv) * 64 * 2560 + pp;
        vt[(size_t)d * 2560] = f2bf(tv.x); vt[(size_t)(d + 1) * 2560] = f2bf(tv.y);
      }
    }
  }
}

__device__ __forceinline__ void phase_small_gemms(const P& p, int l, char* smem) {
  const int NA = 96 * 3, NB = 104 * 4, NC = 384;
  for (int it0 = blockIdx.x; it0 < NA + NB + NC; it0 += gridDim.x) {
    int it = it0;
    f32x4 acc[4][4];
    ZERO_ACC(acc);
    if (it < NA) {
      int mt = it / 3, nt = it % 3, m0 = mt * 128, n0 = nt * 128;
      gemm_core(acc, W_qn + (size_t)m0 * 256, 256, W_Wt_uq + (size_t)l * 384 * 256 + (size_t)n0 * 256, 256, 256, smem);
      const bool lat = m0 >= T_CTX;
      EPI_LOOP(acc, m0, n0, {
        int c96 = n % 96;
        if (lat && c96 >= 64) {
          float pv = DPP_F(v, v, 0x128, 0xf);
          int cr = c96 - 64, pp = cr >> 4, ii = cr & 15, i = ii & 7;
          int s = (m - T_CTX) & 2047;
          float cs, sn;
          rope_cs(pp ? (float)(s & 63) : (float)(s >> 6), i, 0.125f, cs, sn);
          v = (ii < 8) ? v * cs - pv * sn : v * cs + pv * sn;
        }
        W_Qa[(size_t)m * 384 + n] = f2bf(v);
      });
      continue;
    }
    it -= NA;
    if (it < NB) {
      int mt = it / 4, nt = it % 4, m0 = mt * 128, n0 = nt * 128;
      gemm_core(acc, W_ckv_all + (size_t)m0 * 128, 128, W_Wt_ukv + (size_t)l * 512 * 128 + (size_t)n0 * 128, 128, 128, smem);
      EPI_LOOP(acc, m0, n0, {
        int hh = n >> 7, c = n & 127;
        bf16_t* kd; bf16_t* vd; int vstride;
        if (m < T_CTX) {
          int b = m >> 8, s = m & 255;
          size_t r = (size_t)((b * 4 + hh) * 256 + s);
          kd = W_Ka_ctx + r * 96; vd = W_Va_ctx + (size_t)(b * 4 + hh) * 64 * 256 + s; vstride = 256;
        } else {
          int b, pos;
          if (m < T_ALL) { b = (m - T_CTX) >> 11; pos = 512 + ((m - T_CTX) & 2047); }
          else { b = (m - T_ALL) >> 9; pos = (m - T_ALL) & 511; }
          size_t r = (size_t)((b * 4 + hh) * 2560 + pos);
          kd = W_Ka_lat + r * 96; vd = W_Va_lat + (size_t)(b * 4 + hh) * 64 * 2560 + pos; vstride = 2560;
        }
        if (c < 64) kd[c] = f2bf(v); else vd[(size_t)(c - 64) * vstride] = f2bf(v);
      });
      continue;
    }
    it -= NB;
    {
      int m0 = it * 128;
      gemm_core(acc, W_fnet + (size_t)m0 * 64, 64, W_Cch, 64, 64, smem);
      EPI_LOOP(acc, m0, 0, {
        int g = m >> 2, grp = m & 3, part = n >> 6, j = n & 63;
        if (g < T_CTX) {
          int b = g >> 8, s = g & 255;
          W_Yt_ctx[((size_t)(b * 256 + grp * 64 + j)) * 512 + part * 256 + s] = f2bf(v);
        } else {
          int b = (g - T_CTX) >> 11, s = (g - T_CTX) & 2047;
          W_Yt_lat[((size_t)(b * 256 + grp * 64 + j)) * 4096 + part * 2048 + s] = f2bf(v);
        }
      });
    }
  }
}

template <int DK>
__device__ __forceinline__ void attn_item(const bf16_t* __restrict__ Qp, int qstride, const bf16_t* __restrict__ Kp,
                          const bf16_t* __restrict__ Vp, bf16_t* __restrict__ Op, int q0, int Sk, int n_ctx, int W,
                          float scale, bool has_sink, float sink, char* smem) {
  constexpr int KLD = DK + 8;
  bf16_t* sK = (bf16_t*)smem;
  bf16_t* sVt = sK + 64 * KLD;
  bf16_t* sP = sVt + 64 * 72;
  const int tid = tidx(), lane = tid & 63, w = tid >> 6, l15 = lane & 15, l4 = lane >> 4;
  bf16_t* sPw = sP + w * 16 * 72;
  bf16x8 qf[DK / 32];
  {
    const bf16_t* qrow = Qp + (size_t)(q0 + w * 16 + l15) * qstride;
#pragma unroll
    for (int ks = 0; ks < DK / 32; ks++) qf[ks] = *(const bf16x8*)(qrow + ks * 32 + l4 * 8);
  }
  f32x4 o[4];
#pragma unroll
  for (int j = 0; j < 4; j++) o[j] = f32x4{0.f, 0.f, 0.f, 0.f};
  float mrow[4], lrow[4];
#pragma unroll
  for (int r = 0; r < 4; r++) { mrow[r] = NEG_INF; lrow[r] = 0.f; }
  const int ntile = Sk >> 6;
  auto tile_ok = [&](int kt) -> bool {
    int kb = kt * 64;
    if (W >= 0 && kb >= n_ctx) { int lp = kb - n_ctx; if (lp + 63 < q0 - W || lp > q0 + 63 + W) return false; }
    return true;
  };
  u32x4 rk[DK / 32], rv[2];
  int kt = 0;
  while (kt < ntile && !tile_ok(kt)) kt++;
  if (kt < ntile) {
#pragma unroll
    for (int i = 0; i < DK / 32; i++) { int c = tid + i * 256, r = c / (DK / 8), cc = (c % (DK / 8)) * 8; rk[i] = *(const u32x4*)(Kp + (size_t)(kt * 64 + r) * DK + cc); }
#pragma unroll
    for (int i = 0; i < 2; i++) { int c = tid + i * 256, dv = c >> 3, k0 = (c & 7) * 8; rv[i] = *(const u32x4*)(Vp + (size_t)dv * Sk + kt * 64 + k0); }
  }
  while (kt < ntile) {
    const int kbase = kt * 64;
    __syncthreads();
#pragma unroll
    for (int i = 0; i < DK / 32; i++) { int c = tid + i * 256, r = c / (DK / 8), cc = (c % (DK / 8)) * 8; *(u32x4*)(sK + r * KLD + cc) = rk[i]; }
#pragma unroll
    for (int i = 0; i < 2; i++) {
      int c = tid + i * 256, dv = c >> 3, k0 = (c & 7) * 8;
      *(u32x4*)(sVt + dv * 72 + k0) = rv[i];
    }
    __syncthreads();
    int ktn = kt + 1;
    while (ktn < ntile && !tile_ok(ktn)) ktn++;
    if (ktn < ntile) {
#pragma unroll
      for (int i = 0; i < DK / 32; i++) { int c = tid + i * 256, r = c / (DK / 8), cc = (c % (DK / 8)) * 8; rk[i] = *(const u32x4*)(Kp + (size_t)(ktn * 64 + r) * DK + cc); }
#pragma unroll
      for (int i = 0; i < 2; i++) { int c = tid + i * 256, dv = c >> 3, k0 = (c & 7) * 8; rv[i] = *(const u32x4*)(Vp + (size_t)dv * Sk + ktn * 64 + k0); }
    }
    kt = ktn;
    f32x4 s[4];
#pragma unroll
    for (int j = 0; j < 4; j++) {
      s[j] = f32x4{0.f, 0.f, 0.f, 0.f};
#pragma unroll
      for (int ks = 0; ks < DK / 32; ks++) {
        bf16x8 kf = *(const bf16x8*)(sK + (j * 16 + l15) * KLD + ks * 32 + l4 * 8);
        s[j] = __builtin_amdgcn_mfma_f32_16x16x32_bf16(qf[ks], kf, s[j], 0, 0, 0);
      }
    }
#pragma unroll
    for (int j = 0; j < 4; j++)
#pragma unroll
      for (int r = 0; r < 4; r++) {
        float v = s[j][r] * scale;
        if (W >= 0) {
          int kk = kbase + j * 16 + l15, t = q0 + w * 16 + l4 * 4 + r;
          int dlt = kk - n_ctx - t;
          bool valid = (kk < n_ctx) || (dlt <= W && dlt >= -W);
          if (!valid) v = NEG_INF;
        }
        s[j][r] = v;
      }
#pragma unroll
    for (int r = 0; r < 4; r++) {
      float mx = fmaxf(fmaxf(s[0][r], s[1][r]), fmaxf(s[2][r], s[3][r]));
      mx = fmaxf(mx, DPP_F(mx, mx, 0xB1, 0xf));
      mx = fmaxf(mx, DPP_F(mx, mx, 0x4E, 0xf));
      mx = fmaxf(mx, DPP_F(mx, mx, 0x141, 0xf));
      mx = fmaxf(mx, DPP_F(mx, mx, 0x140, 0xf));
      float mnew = fmaxf(mrow[r], mx);
      float muse = (mnew == NEG_INF) ? 0.f : mnew;
      float alpha = __expf(mrow[r] - muse);
      float rs = 0.f;
#pragma unroll
      for (int j = 0; j < 4; j++) { float pe = __expf(s[j][r] - muse); s[j][r] = pe; rs += pe; }
      rs += DPP_F(rs, rs, 0xB1, 0xf);
      rs += DPP_F(rs, rs, 0x4E, 0xf);
      rs += DPP_F(rs, rs, 0x141, 0xf);
      rs += DPP_F(rs, rs, 0x140, 0xf);
      lrow[r] = lrow[r] * alpha + rs;
      mrow[r] = mnew;
#pragma unroll
      for (int j = 0; j < 4; j++) o[j][r] *= alpha;
    }
#pragma unroll
    for (int j = 0; j < 4; j++)
#pragma unroll
      for (int r = 0; r < 4; r++) sPw[(l4 * 4 + r) * 72 + j * 16 + l15] = f2bf(s[j][r]);
    __builtin_amdgcn_s_waitcnt(0xc07f);
    __builtin_amdgcn_wave_barrier();
#pragma unroll
    for (int ks = 0; ks < 2; ks++) {
      bf16x8 pf = *(const bf16x8*)(sPw + l15 * 72 + ks * 32 + l4 * 8);
#pragma unroll
      for (int jn = 0; jn < 4; jn++) {
        bf16x8 vf = *(const bf16x8*)(sVt + (jn * 16 + l15) * 72 + ks * 32 + l4 * 8);
        o[jn] = __builtin_amdgcn_mfma_f32_16x16x32_bf16(pf, vf, o[jn], 0, 0, 0);
      }
    }
  }
#pragma unroll
  for (int r = 0; r < 4; r++) {
    float lsum = lrow[r];
    if (has_sink) lsum += __expf(sink - mrow[r]);
    float inv = 1.f / lsum;
#pragma unroll
    for (int jn = 0; jn < 4; jn++)
      Op[(size_t)(q0 + w * 16 + l4 * 4 + r) * 1024 + jn * 16 + l15] = f2bf(o[jn][r] * inv);
  }
}

__device__ __forceinline__ int gla_tok(int tb, int c, int dir, int tau) { return tb + c * 64 + (dir ? 63 - tau : tau); }

#define GLA_W2_OFF 40960
__device__ __forceinline__ void gla_stage_w2(const P& p, int l, char* smem) {
  float* w2s = (float*)(smem + GLA_W2_OFF);
  const int tid = tidx();
  __syncthreads();
#pragma unroll
  for (int i = 0; i < 2; i++) {
    int e = (tid + i * 256) * 4;
    *(float4*)(w2s + e) = *(const float4*)(p.w_gla_a_fwd + l * 2048 + e);
    *(float4*)(w2s + 2048 + e) = *(const float4*)(p.w_gla_a_bwd + l * 2048 + e);
  }
  if (tid < 128) w2s[4096 + tid] = p.b_gla_a_fwd[l * 128 + tid];
  else w2s[4096 + tid] = p.b_gla_a_bwd[l * 128 + tid - 128];
  __syncthreads();
}
__device__ __forceinline__ void gla_load_alow(const P& p, int tok, int dir, float4 (&al)[4]) {
  const float* src = W_hbuf + (size_t)tok * 1984 + (dir ? 1456 : 1440);
#pragma unroll
  for (int q = 0; q < 4; q++) al[q] = *(const float4*)(src + q * 4);
}
__device__ __forceinline__ void gla_cum_regs(const char* smem, const float4 (&al)[4], int h, int dir, int w, int lane, float (&c)[8], float (&tot)[8]) {
  const float* w2 = (const float*)(smem + GLA_W2_OFF) + dir * 2048 + h * 32 + w * 8;
  const float* b2 = (const float*)(smem + GLA_W2_OFF) + 4096 + dir * 128 + h * 32 + w * 8;
  float a[16];
#pragma unroll
  for (int q = 0; q < 4; q++) { a[q * 4] = al[q].x; a[q * 4 + 1] = al[q].y; a[q * 4 + 2] = al[q].z; a[q * 4 + 3] = al[q].w; }
#pragma unroll
  for (int j = 0; j < 8; j++) {
    float z = b2[j];
#pragma unroll
    for (int r = 0; r < 16; r++) z += a[r] * w2[r * 128 + j];
    float la = logsigf(z) * (1.f / 16.f);
    float v = la;
#pragma unroll
    for (int d = 1; d < 64; d <<= 1) { float t_ = __shfl_up(v, d); if (lane >= d) v += t_; }
    float total = __shfl(v, 63);
    c[j] = dir ? (total - v + la) : v;
    tot[j] = total;
  }
}
__device__ __forceinline__ void gla_load_v(const P& p, int tok, int h, int w, float4 (&vr)[4]) {
  const float* src = W_hbuf + (size_t)tok * 1984 + 928 + h * 64 + w * 16;
#pragma unroll
  for (int q = 0; q < 4; q++) vr[q] = *(const float4*)(src + q * 4);
}
__device__ __forceinline__ void gla_store_vt(const float4 (&vr)[4], int w, int lane, bf16_t* sVt) {
#pragma unroll
  for (int q = 0; q < 4; q++) {
    sVt[(w * 16 + q * 4 + 0) * 72 + lane] = f2bf(vr[q].x);
    sVt[(w * 16 + q * 4 + 1) * 72 + lane] = f2bf(vr[q].y);
    sVt[(w * 16 + q * 4 + 2) * 72 + lane] = f2bf(vr[q].z);
    sVt[(w * 16 + q * 4 + 3) * 72 + lane] = f2bf(vr[q].w);
  }
}

__device__ __forceinline__ void chunk_info(int cidx, int& tb, int& nch, int& n, int& cbase) {
  if (cidx < 128) { int b = cidx >> 2; n = cidx & 3; nch = 4; tb = b * 256; cbase = b * 4; }
  else { int cl = cidx - 128, b = cl >> 5; n = cl & 31; nch = 32; tb = T_CTX + b * 2048; cbase = 128 + b * 32; }
}

__device__ __forceinline__ void gla_g1_item(const P& p, int l, int item, char* smem) {
  bf16_t* sKeT = (bf16_t*)smem;
  bf16_t* sVt = sKeT + 32 * 72;
  const int tid = tidx(), lane = tid & 63, w = __builtin_amdgcn_readfirstlane(tid >> 6), l15 = lane & 15, l4 = lane >> 4;
  int dir = item & 1, h = (item >> 1) & 3, cidx = item >> 3;
  int tb, nch, n, cbase;
  chunk_info(cidx, tb, nch, n, cbase);
  int c = dir ? nch - 1 - n : n;
  int tok = tb + c * 64 + lane;
  float4 al[4], vr[4];
  gla_load_alow(p, tok, dir, al);
  const float* kr = W_hbuf + (size_t)tok * 1984 + 800 + h * 32 + w * 8;
  float4 k0 = *(const float4*)kr, k1 = *(const float4*)(kr + 4);
  gla_load_v(p, tok, h, w, vr);
  float cs[8], tot[8];
  gla_cum_regs(smem, al, h, dir, w, lane, cs, tot);
  __syncthreads();
  {
    float kk[8] = {k0.x, k0.y, k0.z, k0.w, k1.x, k1.y, k1.z, k1.w};
#pragma unroll
    for (int j = 0; j < 8; j++) sKeT[(w * 8 + j) * 72 + lane] = f2bf(kk[j] * __expf(tot[j] - cs[j]));
  }
  gla_store_vt(vr, w, lane, sVt);
  __syncthreads();
  f32x4 acc[2] = {f32x4{0.f, 0.f, 0.f, 0.f}, f32x4{0.f, 0.f, 0.f, 0.f}};
#pragma unroll
  for (int ks = 0; ks < 2; ks++) {
    bf16x8 bv = *(const bf16x8*)(sVt + (w * 16 + l15) * 72 + ks * 32 + l4 * 8);
#pragma unroll
    for (int mt = 0; mt < 2; mt++) {
      bf16x8 av = *(const bf16x8*)(sKeT + (mt * 16 + l15) * 72 + ks * 32 + l4 * 8);
      acc[mt] = __builtin_amdgcn_mfma_f32_16x16x32_bf16(av, bv, acc[mt], 0, 0, 0);
    }
  }
  float* dst = W_un + (size_t)item * 2048;
#pragma unroll
  for (int mt = 0; mt < 2; mt++)
#pragma unroll
    for (int r = 0; r < 4; r++) dst[(mt * 16 + l4 * 4 + r) * 64 + w * 16 + l15] = acc[mt][r];
  if (lane == 0) {
#pragma unroll
    for (int j = 0; j < 8; j++) W_gn[item * 32 + w * 8 + j] = __expf(tot[j]);
  }
}

__device__ __forceinline__ void phase_gla_scan(const P& p, int l) {
  for (int it = blockIdx.x; it < 2176; it += gridDim.x) {
    int e = it * 256 + tidx();
    int kv = e & 2047, sd = e >> 11, dir = sd & 1, h = (sd >> 1) & 3, seq = ((sd >> 3) + 32) % 34;
    int nch, cbase;
    float s;
    if (seq < 32) { nch = 4; cbase = seq * 4; s = 0.f; }
    else { int b = seq - 32; nch = 32; cbase = 128 + b * 32; s = p.state_gla[((size_t)(((b * 2 + l) * 2 + dir) * 4 + h)) * 2048 + kv]; }
    for (int n0 = 0; n0 < nch; n0 += 4) {
      float gv[4], uv[4];
#pragma unroll
      for (int k = 0; k < 4; k++) {
        int item = ((cbase + n0 + k) * 4 + h) * 2 + dir;
        gv[k] = W_gn[item * 32 + (kv >> 6)];
        uv[k] = W_un[(size_t)item * 2048 + kv];
      }
#pragma unroll
      for (int k = 0; k < 4; k++) {
        int item = ((cbase + n0 + k) * 4 + h) * 2 + dir;
        W_sin_[(size_t)item * 2048 + kv] = s;
        s = gv[k] * s + uv[k];
      }
    }
    if (seq < 32) p.out[19398656 + ((size_t)(((seq * 2 + l) * 2 + dir) * 4 + h)) * 2048 + kv] = s;
  }
}

__device__ __forceinline__ void phase_gla_out(const P& p, int l, char* smem) {
  bf16_t* sQe = (bf16_t*)smem;
  bf16_t* sKe = sQe + 64 * 40;
  bf16_t* sSt = sKe + 64 * 40;
  bf16_t* sVt = sSt + 64 * 40;
  bf16_t* sAtt = sVt + 64 * 72;
  const int tid = tidx(), lane = tid & 63, w = __builtin_amdgcn_readfirstlane(tid >> 6), l15 = lane & 15, l4 = lane >> 4;
  gla_stage_w2(p, l, smem);
  for (int it = blockIdx.x; it < 768; it += gridDim.x) {
    int h = it & 3, cidx = it >> 2;
    int tb, nch, c, cbase;
    chunk_info(cidx, tb, nch, c, cbase);
    const int tok = tb + c * 64 + lane;
    f32x4 o[4];
#pragma unroll
    for (int j = 0; j < 4; j++) o[j] = f32x4{0.f, 0.f, 0.f, 0.f};
    float4 vr[4], alf[4], alb[4];
    gla_load_v(p, tok, h, w, vr);
    gla_load_alow(p, tok, 0, alf);
    gla_load_alow(p, tok, 1, alb);
    const float* qr = W_hbuf + (size_t)tok * 1984 + 672 + h * 32 + w * 8;
    const float* kr = qr + 128;
    const float4 q0 = *(const float4*)qr, q1 = *(const float4*)(qr + 4), k0 = *(const float4*)kr, k1 = *(const float4*)(kr + 4);
    float sinv[2][8];
#pragma unroll
    for (int dir = 0; dir < 2; dir++) {
      int n = dir ? nch - 1 - c : c;
      int item = ((cbase + n) * 4 + h) * 2 + dir;
      const float* sin = W_sin_ + (size_t)item * 2048 + (w * 8) * 64 + lane;
#pragma unroll
      for (int j = 0; j < 8; j++) sinv[dir][j] = sin[j * 64];
    }
    float gpre[4][4];
#pragma unroll
    for (int r = 0; r < 4; r++)
#pragma unroll
      for (int jn = 0; jn < 4; jn++) gpre[r][jn] = W_hbuf[(size_t)(tb + c * 64 + w * 16 + l4 * 4 + r) * 1984 + 1184 + h * 64 + jn * 16 + l15];
    __syncthreads();
    gla_store_vt(vr, w, lane, sVt);
#pragma unroll
    for (int dir = 0; dir < 2; dir++) {
      float cs[8], tot[8];
      gla_cum_regs(smem, dir ? alb : alf, h, dir, w, lane, cs, tot);
      if (dir) __syncthreads();
      {
        float qq[8] = {q0.x, q0.y, q0.z, q0.w, q1.x, q1.y, q1.z, q1.w};
        float kk[8] = {k0.x, k0.y, k0.z, k0.w, k1.x, k1.y, k1.z, k1.w};
        bf16x8 qv, kv, sv;
#pragma unroll
        for (int j = 0; j < 8; j++) {
          float cm = __shfl(cs[j], 32);
          qv[j] = (short)f2bf(qq[j] * 0.17677669529663687f * __expf(cs[j] - cm));
          kv[j] = (short)f2bf(kk[j] * __expf(cm - cs[j]));
          sv[j] = (short)f2bf(sinv[dir][j] * __expf(cm));
        }
        *(bf16x8*)(sQe + lane * 40 + w * 8) = qv;
        *(bf16x8*)(sKe + lane * 40 + w * 8) = kv;
        *(bf16x8*)(sSt + lane * 40 + w * 8) = sv;
      }
      __syncthreads();
      bf16x8 qa = *(const bf16x8*)(sQe + (w * 16 + l15) * 40 + l4 * 8);
#pragma unroll
      for (int jc = 0; jc < 4; jc++) {
        bf16x8 kb = *(const bf16x8*)(sKe + (jc * 16 + l15) * 40 + l4 * 8);
        f32x4 sacc = __builtin_amdgcn_mfma_f32_16x16x32_bf16(qa, kb, f32x4{0.f, 0.f, 0.f, 0.f}, 0, 0, 0);
#pragma unroll
        for (int r = 0; r < 4; r++) {
          int trow = w * 16 + l4 * 4 + r, scol = jc * 16 + l15;
          bool keep = dir ? (scol >= trow) : (scol <= trow);
          sAtt[trow * 72 + scol] = f2bf(keep ? sacc[r] : 0.f);
        }
      }
      __syncthreads();
#pragma unroll
      for (int ks = 0; ks < 2; ks++) {
        bf16x8 aa = *(const bf16x8*)(sAtt + (w * 16 + l15) * 72 + ks * 32 + l4 * 8);
#pragma unroll
        for (int jn = 0; jn < 4; jn++) {
          bf16x8 vb = *(const bf16x8*)(sVt + (jn * 16 + l15) * 72 + ks * 32 + l4 * 8);
          o[jn] = __builtin_amdgcn_mfma_f32_16x16x32_bf16(aa, vb, o[jn], 0, 0, 0);
        }
      }
#pragma unroll
      for (int jn = 0; jn < 4; jn++) {
        bf16x8 sb = *(const bf16x8*)(sSt + (jn * 16 + l15) * 40 + l4 * 8);
        o[jn] = __builtin_amdgcn_mfma_f32_16x16x32_bf16(qa, sb, o[jn], 0, 0, 0);
      }
    }
#pragma unroll
    for (int r = 0; r < 4; r++) {
      float ss = o[0][r] * o[0][r] + o[1][r] * o[1][r] + o[2][r] * o[2][r] + o[3][r] * o[3][r];
      ss += DPP_F(ss, ss, 0xB1, 0xf);
      ss += DPP_F(ss, ss, 0x4E, 0xf);
      ss += DPP_F(ss, ss, 0x141, 0xf);
      ss += DPP_F(ss, ss, 0x140, 0xf);
      float rs = rsqrtf(ss * (1.f / 64.f) + 1e-6f);
      int tk = tb + c * 64 + w * 16 + l4 * 4 + r;
      const float* grow = W_hbuf + (size_t)tk * 1984 + 1184 + h * 64;
      bf16_t* dst = W_br + (size_t)tk * 1024 + 512 + h * 64;
#pragma unroll
      for (int jn = 0; jn < 4; jn++) {
        int vcol = jn * 16 + l15;
        float val = o[jn][r] * rs * p.gla_norm[l * 64 + vcol];
        dst[vcol] = f2bf(val * siluf(gpre[r][jn]));
      }
    }
  }
}

__device__ __forceinline__ void phase_mixers(const P& p, int l, char* smem) {
  const int N_MLAL = 256, N_DFTL = 64, N_SWAL = 256, N_MLAC = 512, N_SWAC = 512, N_DFTC = 128, N_G1 = 1536;
  const int total = N_MLAL + N_DFTL + N_SWAL + N_MLAC + N_SWAC + N_DFTC + N_G1;
  gla_stage_w2(p, l, smem);
  for (int r_ = 0; r_ * (int)gridDim.x < total; r_++) {
    int it0 = r_ * gridDim.x + ((r_ & 1) ? (gridDim.x - 1 - blockIdx.x) : blockIdx.x);
    if (it0 >= total) continue;
    int it = it0;
    int type;
    bool lat = false;
    if (it < N_MLAL) { type = 0; lat = true; }
    else if ((it -= N_MLAL) < N_DFTL) { type = 2; lat = true; }
    else if ((it -= N_DFTL) < N_SWAL) { type = 1; lat = true; }
    else if ((it -= N_SWAL) < N_MLAC) { type = 0; }
    else if ((it -= N_MLAC) < N_SWAC) { type = 1; }
    else if ((it -= N_SWAC) < N_DFTC) { type = 2; }
    else { it -= N_DFTC; type = 3; }
#ifdef DUPTYPE
    for (int rep_ = 0; rep_ < ((type == (DUPTYPE & 3) && (int)lat == (DUPTYPE >> 2)) ? 2 : 1); rep_++)
#endif
    if (type == 0) {
      int qt, h, b, Sk;
      size_t tok0;
      if (lat) { qt = it & 31; h = (it >> 5) & 3; b = it >> 7; tok0 = T_CTX + b * 2048; Sk = 2560; }
      else { qt = it & 3; h = (it >> 2) & 3; b = it >> 4; tok0 = b * 256; Sk = 256; }
      const bf16_t* Kp = (lat ? W_Ka_lat : W_Ka_ctx) + (size_t)(b * 4 + h) * Sk * 96;
      const bf16_t* Vp = (lat ? W_Va_lat : W_Va_ctx) + (size_t)(b * 4 + h) * Sk * 64;
      attn_item<96>(W_Qa + tok0 * 384 + h * 96, 384, Kp, Vp, W_br + tok0 * 1024 + h * 64, qt * 64, Sk, 0, -1,
                    0.10206207261596575f, false, 0.f, smem);
    } else if (type == 1) {
      int qt, hq, b, Sk, nctx, W;
      size_t tok0;
      if (lat) { qt = it & 31; hq = (it >> 5) & 3; b = it >> 7; tok0 = T_CTX + b * 2048; Sk = 2560; nctx = 512; W = 128; }
      else { qt = it & 3; hq = (it >> 2) & 3; b = it >> 4; tok0 = b * 256; Sk = 256; nctx = 0; W = -1; }
      int kv = hq >> 1;
      const bf16_t* Kp = (lat ? W_Kd_lat : W_Kd_ctx) + (size_t)(b * 2 + kv) * Sk * 64;
      const bf16_t* Vp = (lat ? W_Vd_lat : W_Vd_ctx) + (size_t)(b * 2 + kv) * Sk * 64;
      attn_item<64>(W_Qd + tok0 * 256 + hq * 64, 256, Kp, Vp, W_br + tok0 * 1024 + 768 + hq * 64, qt * 64, Sk, nctx, W,
                    0.125f, true, p.swa_sink[l * 4 + hq], smem);
    } else if (type == 2) {
      int nt = it & 1, mt, b, S;
      size_t tok0;
      if (lat) { mt = (it >> 1) & 15; b = it >> 5; S = 2048; tok0 = T_CTX + b * 2048; }
      else { mt = (it >> 1) & 1; b = it >> 2; S = 256; tok0 = b * 256; }
      const bf16_t* Ap = (lat ? W_A2048 : W_A256) + (size_t)mt * 128 * 2 * S;
      const bf16_t* Bp = (lat ? W_Yt_lat : W_Yt_ctx) + (size_t)(b * 256 + nt * 128) * 2 * S;
      f32x4 acc[4][4];
      ZERO_ACC(acc);
      gemm_core(acc, Ap, 2 * S, Bp, 2 * S, 2 * S, smem);
      EPI_LOOP(acc, mt * 128, nt * 128, { W_br[(tok0 + m) * 1024 + 256 + n] = f2bf(v); });
    } else {
      gla_g1_item(p, l, it, smem);
    }
  }
}

#define EPI4_LOOP_N(acc, c0, t0, NJ, ...)                                                  \
  {                                                                                        \
    const int lane_ = tidx() & 63, w_ = tidx() >> 6, wm_ = w_ >> 1, wn_ = w_ & 1;           \
    _Pragma("unroll") for (int i_ = 0; i_ < 4; i_++)                                       \
    _Pragma("unroll") for (int j_ = 0; j_ < NJ; j_++) {                                    \
      const int col = (c0) + wm_ * 64 + i_ * 16 + (lane_ >> 4) * 4;                        \
      const int tok = (t0) + wn_ * (NJ * 16) + j_ * 16 + (lane_ & 15);                     \
      const f32x4 v4 = acc[i_][j_];                                                        \
      __VA_ARGS__                                                                          \
    }                                                                                      \
  }
__device__ __forceinline__ void phase_merge(const P& p, int l, char* smem) {
  constexpr int NJ = 2;
  bf16_t* sa = (bf16_t*)smem;
  bf16_t* sb = sa + 128 * GB_LD;
  const int tid = tidx(), lane = tid & 63, w = tid >> 6, wm = w >> 1, wn = w & 1;
  const int l15 = lane & 15, l4 = lane >> 4;
  for (int tile = blockIdx.x; tile < 192 * 8; tile += gridDim.x) {
    int tt = tile >> 3, nt = tile & 7, t0 = tt * 64, n0 = nt * 128;
    const bf16_t* A = W_Wt_br + ((size_t)l * 1024 + n0) * 1024;
    const bf16_t* B = W_br + (size_t)t0 * 1024;
    const int lda = 1024, ldb = 1024, K = 1024;
    f32x4 tot[4][2], acc[4][2];
    ZERO_ACC_N(tot, 2);
    ZERO_ACC_N(acc, 2);
    u32x4 ra0[4], rb0[NJ], ra1[4], rb1[NJ];
    G_LOAD(ra0, rb0, 0);
    G_LOAD(ra1, rb1, 64);
    ushort4 gl[4][2];
    for (int k0 = 0; k0 < K; k0 += 128) {
      const bool seg_end = (k0 & 128) != 0;
      const int bidx = k0 >> 8;
      if (seg_end) {
#pragma unroll
        for (int i_ = 0; i_ < 4; i_++)
#pragma unroll
          for (int j_ = 0; j_ < 2; j_++) {
            int col = n0 + wm * 64 + i_ * 16 + l4 * 4, tok = t0 + wn * 32 + j_ * 16 + l15;
            gl[i_][j_] = *(const ushort4*)(W_gates + (size_t)tok * 4096 + bidx * 1024 + col);
          }
      }
      __syncthreads();
      G_STORE(ra0, rb0);
      __syncthreads();
      if (k0 + 128 < K) { G_LOAD(ra0, rb0, k0 + 128); }
      G_COMPUTE();
      __syncthreads();
      G_STORE(ra1, rb1);
      __syncthreads();
      if (k0 + 192 < K) { G_LOAD(ra1, rb1, k0 + 192); }
      G_COMPUTE();
      if (seg_end) {
#pragma unroll
        for (int i_ = 0; i_ < 4; i_++)
#pragma unroll
          for (int j_ = 0; j_ < 2; j_++) {
            tot[i_][j_][0] += bf2f(gl[i_][j_].x) * acc[i_][j_][0];
            tot[i_][j_][1] += bf2f(gl[i_][j_].y) * acc[i_][j_][1];
            tot[i_][j_][2] += bf2f(gl[i_][j_].z) * acc[i_][j_][2];
            tot[i_][j_][3] += bf2f(gl[i_][j_].w) * acc[i_][j_][3];
            acc[i_][j_] = f32x4{0.f, 0.f, 0.f, 0.f};
          }
      }
    }
    EPI4_LOOP_N(tot, n0, t0, 2, {
      ushort4 o_; o_.x = f2bf(v4[0]); o_.y = f2bf(v4[1]); o_.z = f2bf(v4[2]); o_.w = f2bf(v4[3]);
      *(ushort4*)(W_u + (size_t)tok * 1024 + col) = o_;
    });
  }
}

__device__ __forceinline__ void phase_wout(const P& p, int l, char* smem) {
  float* r = W_hbuf;
  const float alpha = 1.4142135623730951f;
  for (int tile = blockIdx.x; tile < 96 * 8; tile += gridDim.x) {
    int mt = tile >> 3, nt = tile & 7, m0 = mt * 128, n0 = nt * 128;
    f32x4 acc[4][4];
    ZERO_ACC(acc);
    gemm_core(acc, W_Wt_out + ((size_t)l * 1024 + n0) * 1024, 1024, W_u + (size_t)m0 * 1024, 1024, 1024, smem);
    const float* g1 = W_mada + (l * 3 + cond_row(m0)) * 6144 + 2048;
    {
      const int lane_ = tidx() & 63, w_ = tidx() >> 6, wm_ = w_ >> 1, wn_ = w_ & 1;
#pragma unroll
      for (int ih = 0; ih < 2; ih++) {
        float4 xv[8];
#pragma unroll
        for (int q = 0; q < 8; q++) {
          int i_ = ih * 2 + (q >> 2), j_ = q & 3;
          int col = n0 + wm_ * 64 + i_ * 16 + (lane_ >> 4) * 4, tok = m0 + wn_ * 64 + j_ * 16 + (lane_ & 15);
          xv[q] = *(const float4*)(x_in_row(p, l, tok) + col);
        }
#pragma unroll
        for (int q = 0; q < 8; q++) {
          int i_ = ih * 2 + (q >> 2), j_ = q & 3;
          int col = n0 + wm_ * 64 + i_ * 16 + (lane_ >> 4) * 4, tok = m0 + wn_ * 64 + j_ * 16 + (lane_ & 15);
          float4 gv = *(const float4*)(g1 + col);
          f32x4 v4 = acc[i_][j_];
          *(float4*)(r + (size_t)tok * 1024 + col) = float4{alpha * xv[q].x + gv.x * v4[0], alpha * xv[q].y + gv.y * v4[1], alpha * xv[q].z + gv.z * v4[2], alpha * xv[q].w + gv.w * v4[3]};
        }
      }
    }
  }
}

__device__ __forceinline__ void phase_ln_mid(const P& p, int l) {
  int lane = tidx() & 63, w = tidx() >> 6;
  const float* r = W_hbuf;
  for (int it = blockIdx.x; it < T_ALL / 4; it += gridDim.x) {
    int g = it * 4 + w;
    float v[16];
    load_row16(r + (size_t)g * 1024, lane, v);
    ln16(v);
    affine16(v, p.ln1_g + l * 1024, p.ln1_b + l * 1024, lane);
    store_row16(x_out_row(p, l, g), lane, v);
    ln16(v);
    const float* m = W_mada + (l * 3 + cond_row(g)) * 6144;
    modulate_store(v, m + 3072, m + 4096, W_u + (size_t)g * 1024, lane);
  }
}

__device__ __forceinline__ void phase_pq(const P& p, int l, char* smem) {
  float* sc = (float*)W_gates;
  bf16_t* sa = (bf16_t*)smem;
  const int tid = tidx(), lane = tid & 63, w = tid >> 6, wm = w >> 1, wn = w & 1, l15 = lane & 15, l4 = lane >> 4;
  for (int tile = blockIdx.x; tile < 96 * 16; tile += gridDim.x) {
    int mt = tile >> 4, hp = tile & 15, m0 = mt * 128, n0 = hp * 128;
    f32x4 acc[4][4];
    ZERO_ACC(acc);
    gemm_core(acc, W_Wt_pq + ((size_t)l * 2048 + n0) * 1024, 1024, W_u + (size_t)m0 * 1024, 1024, 1024, smem);
    __syncthreads();
    {
      bf16_t* sB = sa + 128 * GB_LD * (1 + wm);
#pragma unroll
      for (int i = 0; i < 4; i++)
#pragma unroll
        for (int j = 0; j < 4; j++) {
          ushort4 o_;
          o_.x = f2bf(acc[i][j][0]); o_.y = f2bf(acc[i][j][1]); o_.z = f2bf(acc[i][j][2]); o_.w = f2bf(acc[i][j][3]);
          *(ushort4*)(sB + (wn * 64 + j * 16 + l15) * GB_LD + i * 16 + l4 * 4) = o_;
        }
    }
    f32x4 acc2[4][4];
    ZERO_ACC(acc2);
    const bf16_t* keys = W_keysbf + (size_t)(l * 16 + hp) * 128 * 128;
#pragma unroll
    for (int kh = 0; kh < 2; kh++) {
      u32x4 rk[4];
#pragma unroll
      for (int i = 0; i < 4; i++) { int c = tid + i * 256, r = c >> 3, cc = (c & 7) * 8; rk[i] = *(const u32x4*)(keys + r * 128 + kh * 64 + cc); }
      if (kh) __syncthreads();
#pragma unroll
      for (int i = 0; i < 4; i++) { int c = tid + i * 256, r = c >> 3, cc = (c & 7) * 8; *(u32x4*)(sa + r * GB_LD + cc) = rk[i]; }
      __syncthreads();
      const bf16_t* sBk = sa + 128 * GB_LD * (1 + kh);
#pragma unroll
      for (int ks = 0; ks < 2; ks++) {
        bf16x8 af[4], bfr[4];
#pragma unroll
        for (int i = 0; i < 4; i++) af[i] = *(const bf16x8*)(sa + (wm * 64 + i * 16 + l15) * GB_LD + ks * 32 + l4 * 8);
#pragma unroll
        for (int j = 0; j < 4; j++) bfr[j] = *(const bf16x8*)(sBk + (wn * 64 + j * 16 + l15) * GB_LD + ks * 32 + l4 * 8);
#pragma unroll
        for (int i = 0; i < 4; i++)
#pragma unroll
          for (int j = 0; j < 4; j++) acc2[i][j] = __builtin_amdgcn_mfma_f32_16x16x32_bf16(af[i], bfr[j], acc2[i][j], 0, 0, 0);
      }
    }
    EPI_LOOP(acc2, 0, m0, { sc[((size_t)(hp * 128 + m)) * T_ALL + n] = v; });
  }
}

__device__ __forceinline__ void phase_scores(const P& p, int l, char* smem) {}

__device__ __forceinline__ int f2sort(float x) { int b = __float_as_int(x); return b ^ ((b >> 31) & 0x7fffffff); }
__device__ __forceinline__ float sort2f(int s) { return __int_as_float(s ^ ((s >> 31) & 0x7fffffff)); }
__device__ __forceinline__ void bitonic_sort16_desc(int (&a)[16]) {
#pragma unroll
  for (int k = 2; k <= 16; k <<= 1)
#pragma unroll
    for (int j = k >> 1; j > 0; j >>= 1)
#pragma unroll
      for (int i = 0; i < 16; i++) {
        int l_ = i ^ j;
        if (l_ > i) {
          int hi = max(a[i], a[l_]), lo = min(a[i], a[l_]);
          if ((i & k) == 0) { a[i] = hi; a[l_] = lo; } else { a[i] = lo; a[l_] = hi; }
        }
      }
}
__device__ __forceinline__ void merge_top16(int (&T)[16], const int (&S)[16]) {
#pragma unroll
  for (int i = 0; i < 16; i++) T[i] = max(T[i], S[15 - i]);
#pragma unroll
  for (int j = 8; j > 0; j >>= 1)
#pragma unroll
    for (int i = 0; i < 16; i++) {
      int l_ = i ^ j;
      if (l_ > i) { int hi = max(T[i], T[l_]), lo = min(T[i], T[l_]); T[i] = hi; T[l_] = lo; }
    }
}
__device__ __forceinline__ void top16_col(const float* src, int (&L)[16]) {
#pragma unroll 1
  for (int k0 = 0; k0 < 128; k0 += 16) {
    float xv[16];
#pragma unroll
    for (int k = 0; k < 16; k++) xv[k] = src[(size_t)(k0 + k) * T_ALL];
    int S[16];
#pragma unroll
    for (int k = 0; k < 16; k++) S[k] = (f2sort(xv[k]) & ~127) | (127 - (k0 + k));
    bitonic_sort16_desc(S);
    if (k0 == 0) {
#pragma unroll
      for (int k = 0; k < 16; k++) L[k] = S[k];
    } else {
      merge_top16(L, S);
    }
  }
}
__device__ __forceinline__ void phase_topk(const P& p, int l) {
  const float* sc = (const float*)W_gates;
  int lane = tidx() & 63, w = tidx() >> 6;
  for (int it = blockIdx.x * 4 + w; it < 192 * 8; it += gridDim.x * 4) {
    int h = it & 7, t = (it >> 3) * 64 + lane;
    int L1[16], L2[16];
    const float* s1 = sc + (size_t)(h * 2) * 128 * T_ALL + t;
    top16_col(s1, L1);
    top16_col(s1 + (size_t)128 * T_ALL, L2);
    float v1[16], v2[16];
    unsigned P1[4] = {0u, 0u, 0u, 0u}, P2[4] = {0u, 0u, 0u, 0u};
#pragma unroll
    for (int i = 0; i < 16; i++) {
      v1[i] = sort2f(L1[i] & ~127);
      v2[i] = sort2f(L2[i] & ~127);
      P1[i >> 2] |= (unsigned)(127 - (L1[i] & 127)) << ((i & 3) * 8);
      P2[i >> 2] |= (unsigned)(127 - (L2[i] & 127)) << ((i & 3) * 8);
    }
    int Tk[16];
#pragma unroll
    for (int j = 0; j < 16; j++) Tk[j] = (f2sort(v1[0] + v2[j]) & ~255) | (255 - j);
    {
      int G[3][16];
#pragma unroll
      for (int g_ = 0; g_ < 3; g_++)
#pragma unroll
        for (int k = 0; k < 16; k++) G[g_][k] = (int)0x80000000;
      int cnt = 0;
#pragma unroll
      for (int i = 1; i < 16; i++) {
#pragma unroll
        for (int j = 0; j < 16 / (i + 1); j++) {
          G[cnt >> 4][cnt & 15] = (f2sort(v1[i] + v2[j]) & ~255) | (255 - (i * 16 + j));
          cnt++;
        }
      }
#pragma unroll
      for (int g_ = 0; g_ < 3; g_++) { bitonic_sort16_desc(G[g_]); merge_top16(Tk, G[g_]); }
    }
    float v0 = sort2f(Tk[0] & ~255);
    float e[16], Z = 0.f;
    int oi[16];
#pragma unroll
    for (int s_ = 0; s_ < 16; s_++) {
      e[s_] = __expf(sort2f(Tk[s_] & ~255) - v0);
      Z += e[s_];
      int code = 255 - (Tk[s_] & 255), i = code >> 4, j = code & 15;
      unsigned r1 = (i >> 2) == 0 ? P1[0] : (i >> 2) == 1 ? P1[1] : (i >> 2) == 2 ? P1[2] : P1[3];
      unsigned r2 = (j >> 2) == 0 ? P2[0] : (j >> 2) == 1 ? P2[1] : (j >> 2) == 2 ? P2[2] : P2[3];
      int i1 = (r1 >> ((i & 3) * 8)) & 255, i2 = (r2 >> ((j & 3) * 8)) & 255;
      oi[s_] = i1 * 128 + i2;
    }
    float inv = 1.f / Z;
    int* po = W_pidx + (size_t)t * 128 + h * 16;
    float* pwo = W_pw + (size_t)t * 128 + h * 16;
#pragma unroll
    for (int q = 0; q < 4; q++) {
      *(int4*)(po + q * 4) = int4{oi[q * 4], oi[q * 4 + 1], oi[q * 4 + 2], oi[q * 4 + 3]};
      *(float4*)(pwo + q * 4) = float4{e[q * 4] * inv, e[q * 4 + 1] * inv, e[q * 4 + 2] * inv, e[q * 4 + 3] * inv};
    }
  }
}

__device__ __forceinline__ void unpack16(u32x4 r, float (&f)[16]) {
#pragma unroll
  for (int q = 0; q < 4; q++) {
    auto lo = __builtin_amdgcn_cvt_pk_f32_fp8((int)r[q], false);
    auto hi = __builtin_amdgcn_cvt_pk_f32_fp8((int)r[q], true);
    f[q * 4 + 0] = lo[0]; f[q * 4 + 1] = lo[1]; f[q * 4 + 2] = hi[0]; f[q * 4 + 3] = hi[1];
  }
}
#define PEER_PF 8
#ifndef PEER_REP
#define PEER_REP 1
#endif
__device__ __forceinline__ void phase_peer(const P& p, int l, char* smem) {
  int lane = tidx() & 63, w = tidx() >> 6;
  float* scoef = (float*)smem + w * 128;
  const unsigned char* tu = W_tabU + (size_t)l * 16384 * 1024 + lane * 16;
  const unsigned char* tv = W_tabV + (size_t)l * 16384 * 1024 + lane * 16;
  for (int it = blockIdx.x; it < T_ALL / 4; it += gridDim.x) {
    int g = it * 4 + w;
    float uu[16];
    {
      u32x4 r0 = *(const u32x4*)(W_u + (size_t)g * 1024 + lane * 16);
      u32x4 r1 = *(const u32x4*)(W_u + (size_t)g * 1024 + lane * 16 + 8);
      uu[0] = __uint_as_float(r0.x << 16); uu[1] = __uint_as_float(r0.x & 0xffff0000u);
      uu[2] = __uint_as_float(r0.y << 16); uu[3] = __uint_as_float(r0.y & 0xffff0000u);
      uu[4] = __uint_as_float(r0.z << 16); uu[5] = __uint_as_float(r0.z & 0xffff0000u);
      uu[6] = __uint_as_float(r0.w << 16); uu[7] = __uint_as_float(r0.w & 0xffff0000u);
      uu[8] = __uint_as_float(r1.x << 16); uu[9] = __uint_as_float(r1.x & 0xffff0000u);
      uu[10] = __uint_as_float(r1.y << 16); uu[11] = __uint_as_float(r1.y & 0xffff0000u);
      uu[12] = __uint_as_float(r1.z << 16); uu[13] = __uint_as_float(r1.z & 0xffff0000u);
      uu[14] = __uint_as_float(r1.w << 16); uu[15] = __uint_as_float(r1.w & 0xffff0000u);
    }
    const float* pwt = W_pw + (size_t)g * 128;
    const int pi0 = W_pidx[(size_t)g * 128 + lane], pi1 = W_pidx[(size_t)g * 128 + 64 + lane];
    auto ldrows = [&](u32x4 (&r)[8], const unsigned char* tab, int e0) {
#pragma unroll
      for (int k = 0; k < 8; k++) {
        int e = e0 + k;
        int idx = __builtin_amdgcn_readlane(e < 64 ? pi0 : pi1, e & 63);
        r[k] = *(const u32x4*)(tab + (size_t)idx * 1024);
      }
    };
    float o[16];
    for (int rep_ = 0; rep_ < PEER_REP; rep_++) {
    float dv0 = 0.f, dv1 = 0.f;
    auto dots = [&](const u32x4 (&r)[8], int e0) {
#pragma unroll
      for (int k = 0; k < 8; k++) {
        float f[16];
        unpack16(r[k], f);
        float a = 0.f;
#pragma unroll
        for (int j = 0; j < 16; j++) a += uu[j] * f[j];
        float dd = wsum(a);
        if (e0 < 64) dv0 = (lane == e0 + k) ? dd : dv0;
        else dv1 = (lane == e0 + k - 64) ? dd : dv1;
      }
    };
    {
      u32x4 ra[8], rb[8];
      ldrows(ra, tu, 0);
#pragma unroll 1
      for (int e0 = 0; e0 < 128; e0 += 16) {
        ldrows(rb, tu, e0 + 8);
        dots(ra, e0);
        if (e0 + 16 < 128) ldrows(ra, tu, e0 + 16);
        dots(rb, e0 + 8);
      }
    }
    {
      float d0 = dv0 * (1.f / PEER_U_SCALE), d1 = dv1 * (1.f / PEER_U_SCALE);
      float a0 = 0.5f * d0 * (1.f + erff(d0 * 0.7071067811865476f));
      float a1 = 0.5f * d1 * (1.f + erff(d1 * 0.7071067811865476f));
      scoef[lane] = pwt[lane] * a0 * (1.f / PEER_V_SCALE);
      scoef[64 + lane] = pwt[64 + lane] * a1 * (1.f / PEER_V_SCALE);
    }
    __builtin_amdgcn_s_waitcnt(0xc07f);
    __builtin_amdgcn_wave_barrier();
#pragma unroll
    for (int j = 0; j < 16; j++) o[j] = 0.f;
    auto accum = [&](const u32x4 (&r)[8], int e0) {
#pragma unroll
      for (int k = 0; k < 8; k++) {
        float cf = scoef[e0 + k];
        float f[16];
        unpack16(r[k], f);
#pragma unroll
        for (int j = 0; j < 16; j++) o[j] += cf * f[j];
      }
    };
    {
      u32x4 ra[8], rb[8];
      ldrows(ra, tv, 0);
#pragma unroll 1
      for (int e0 = 0; e0 < 128; e0 += 16) {
        ldrows(rb, tv, e0 + 8);
        accum(ra, e0);
        if (e0 + 16 < 128) ldrows(ra, tv, e0 + 16);
        accum(rb, e0 + 8);
      }
    }
    __builtin_amdgcn_wave_barrier();
    }
    float* xr = x_out_row(p, l, g) + lane * 16;
    const float* m = W_mada + (l * 3 + cond_row(g)) * 6144 + lane * 16;
    float x1[16];
#pragma unroll
    for (int q = 0; q < 4; q++) {
      float4 xv = *(const float4*)(xr + q * 4);
      float4 g2 = *(const float4*)(m + 5120 + q * 4);
      x1[q * 4 + 0] = 1.4142135623730951f * xv.x + g2.x * o[q * 4 + 0];
      x1[q * 4 + 1] = 1.4142135623730951f * xv.y + g2.y * o[q * 4 + 1];
      x1[q * 4 + 2] = 1.4142135623730951f * xv.z + g2.z * o[q * 4 + 2];
      x1[q * 4 + 3] = 1.4142135623730951f * xv.w + g2.w * o[q * 4 + 3];
    }
    ln16(x1);
#pragma unroll
    for (int q = 0; q < 4; q++) {
      float4 a = *(const float4*)(p.ln2_g + l * 1024 + lane * 16 + q * 4);
      float4 c = *(const float4*)(p.ln2_b + l * 1024 + lane * 16 + q * 4);
      x1[q * 4 + 0] = x1[q * 4 + 0] * a.x + c.x; x1[q * 4 + 1] = x1[q * 4 + 1] * a.y + c.y;
      x1[q * 4 + 2] = x1[q * 4 + 2] * a.z + c.z; x1[q * 4 + 3] = x1[q * 4 + 3] * a.w + c.w;
      *(float4*)(xr + q * 4) = float4{x1[q * 4], x1[q * 4 + 1], x1[q * 4 + 2], x1[q * 4 + 3]};
    }
    if (l == 0) {
      ln16(x1);
      const float* m1 = W_mada + (1 * 3 + cond_row(g)) * 6144 + lane * 16;
#pragma unroll
      for (int q = 0; q < 4; q++) {
        float4 a = *(const float4*)(m1 + 1024 + q * 4);
        float4 b = *(const float4*)(m1 + q * 4);
        ushort4 ov;
        ov.x = f2bf(x1[q * 4 + 0] * (1.f + a.x) + b.x);
        ov.y = f2bf(x1[q * 4 + 1] * (1.f + a.y) + b.y);
        ov.z = f2bf(x1[q * 4 + 2] * (1.f + a.z) + b.z);
        ov.w = f2bf(x1[q * 4 + 3] * (1.f + a.w) + b.w);
        *(ushort4*)(W_u + (size_t)g * 1024 + lane * 16 + q * 4) = ov;
      }
    }
  }
}

#define N_PHASES 28
__device__ __forceinline__ void run_phase(const P& p, int ph, char* smem) {
#ifdef ONLYQ
  { int l = ph & 1; if (ONLYQ == -1) { phase_prep(p, smem); return; } if (ONLYQ == -2) { phase_ln0(p); return; }
    switch (ONLYQ) { case 0: phase_win(p, l, smem); break; case 1: phase_post(p, l); break; case 2: phase_small_gemms(p, l, smem); break; case 3: phase_mixers(p, l, smem); break; case 4: phase_gla_scan(p, l); break; case 5: phase_gla_out(p, l, smem); break; case 6: phase_merge(p, l, smem); break; case 7: phase_wout(p, l, smem); break; case 8: phase_ln_mid(p, l); break; case 9: phase_pq(p, l, smem); break; case 10: phase_scores(p, l, smem); break; case 11: phase_topk(p, l); break; case 12: phase_peer(p, l, smem); break; } return; }
#endif
  if (ph == 0) { phase_prep(p, smem); return; }
  if (ph == 1) { phase_ln0(p); return; }
  int l = (ph - 2) / 13, q = (ph - 2) % 13;
#ifdef EXCL
  if (q == EXCL) return;
#endif
  switch (q) {
    case 0: phase_win(p, l, smem); break;
    case 1: phase_post(p, l); break;
    case 2: phase_small_gemms(p, l, smem); break;
    case 3: phase_mixers(p, l, smem); break;
    case 4: phase_gla_scan(p, l); break;
    case 5: phase_gla_out(p, l, smem); break;
    case 6: phase_merge(p, l, smem); break;
    case 7: phase_wout(p, l, smem); break;
    case 8: phase_ln_mid(p, l); break;
    case 9: phase_pq(p, l, smem); break;
    case 10: phase_scores(p, l, smem); break;
    case 11: phase_topk(p, l); break;
    case 12: phase_peer(p, l, smem); break;
  }
}

#define XB_TMO      128
#define XB_XCNT(j)  (256  + 64 * (j))
#define XB_XSUB(j)  (1280 + 64 * (j))
#define XB_XGEN(j)  (2304 + 64 * (j))
#define XB_TOP      3328
#define XB_TOPGEN   3392
#define XCD_BAR_WORDS 3456
#define XB_SPIN_CAP (1u << 18)
#define LAS __attribute__((address_space(3)))

__device__ __forceinline__ unsigned xb_ld(unsigned* p)              { return __hip_atomic_load(p, __ATOMIC_RELAXED, __HIP_MEMORY_SCOPE_AGENT); }
__device__ __forceinline__ unsigned xb_add(unsigned* p, unsigned v) { return __hip_atomic_fetch_add(p, v, __ATOMIC_RELAXED, __HIP_MEMORY_SCOPE_AGENT); }
__device__ __forceinline__ unsigned xb_xcc_id() { return (unsigned)__builtin_amdgcn_s_getreg((3 << 11) | 20) & 0xFu; }
#define XB_SPIN(cond, bar) do { unsigned _sp = 0; while (cond) { __builtin_amdgcn_s_sleep(1); \
    if ((++_sp & 255u) == 0u) { if (xb_ld(&(bar)[XB_TMO])) break; if (_sp > XB_SPIN_CAP) { atomicAdd(&(bar)[XB_TMO], 1u); break; } } } } while (0)

struct XcdBarrier {
    unsigned* bar; unsigned x;
    volatile LAS unsigned* st;
};

__device__ __forceinline__ XcdBarrier xcd_barrier_post(unsigned* bar, volatile LAS unsigned* st) {
    XcdBarrier b; b.bar = bar; b.x = xb_xcc_id(); b.st = st;
    if (threadIdx.x == 0) (void)xb_add(&bar[XB_XCNT(b.x)], 1u);
    return b;
}
__device__ __forceinline__ void xcd_barrier_complete(unsigned* bar, unsigned x, unsigned& nloc, unsigned& nx) {
    const unsigned G = gridDim.x * gridDim.y * gridDim.z;
    unsigned sum, cnt, mine, sp = 0u;
    for (;;) {
        sum = 0u; cnt = 0u; mine = 0u;
#pragma unroll
        for (unsigned j = 0; j < 16; ++j) { const unsigned c = xb_ld(&bar[XB_XCNT(j)]); sum += c; cnt += (c > 0u) ? 1u : 0u; mine = (j == x) ? c : mine; }
        if (sum == G) break;
        __builtin_amdgcn_s_sleep(1);
        if ((++sp & 255u) == 0u) { if (xb_ld(&bar[XB_TMO])) break; if (sp > XB_SPIN_CAP) { atomicAdd(&bar[XB_TMO], 1u); break; } }
    }
    nloc = mine > 0u ? mine : 1u; nx = cnt > 0u ? cnt : 1u;
}

__device__ __forceinline__ void xcd_barrier(const XcdBarrier& b) {
    asm volatile("s_waitcnt vmcnt(0)" ::: "memory");
    __syncthreads();
    if (threadIdx.x == 0) {
        unsigned* bar = b.bar;
        __builtin_amdgcn_s_waitcnt(0);
        unsigned nloc = b.st[0], nx = b.st[1];
        if (nloc == 0u) { xcd_barrier_complete(bar, b.x, nloc, nx); b.st[0] = nloc; b.st[1] = nx; }
        const unsigned old = xb_add(&bar[XB_XSUB(b.x)], 1u);
        const unsigned gen = old / nloc;
        if (old + 1u == (gen + 1u) * nloc) {
            __builtin_amdgcn_fence(__ATOMIC_RELEASE, "agent");
            asm volatile("s_waitcnt vmcnt(0)" ::: "memory");
            const unsigned og = xb_add(&bar[XB_TOP], 1u);
            const unsigned tg = og / nx;
            if (og + 1u == (tg + 1u) * nx) xb_add(&bar[XB_TOPGEN], 1u);
            else XB_SPIN(xb_ld(&bar[XB_TOPGEN]) == tg, bar);
            __builtin_amdgcn_fence(__ATOMIC_ACQUIRE, "agent");
            xb_add(&bar[XB_XGEN(b.x)], 1u);
            asm volatile("s_waitcnt vmcnt(0)" ::: "memory");
        } else {
            XB_SPIN(xb_ld(&bar[XB_XGEN(b.x)]) == gen, bar);
            __builtin_amdgcn_fence(__ATOMIC_ACQUIRE, "agent");
            asm volatile("s_waitcnt vmcnt(0)" ::: "memory");
        }
    }
    __syncthreads();
}


#define SMEM_BYTES 61440

#if MULTI
__global__ void __launch_bounds__(256, 2) k_phase(P p, int ph) {
  __shared__ __attribute__((aligned(16))) char smem[SMEM_BYTES];
  run_phase(p, ph, smem);
}
#else
__global__ void __launch_bounds__(256, 2) k_mega(P p) {
  __shared__ __attribute__((aligned(16))) char smem[SMEM_BYTES];
  __shared__ uint4 xb_words;
  cg::grid_group grid = cg::this_grid();
  if (threadIdx.x == 0) xb_words = make_uint4(0u, 0u, 0u, 0u);
  __syncthreads();
  XcdBarrier xb = xcd_barrier_post((unsigned*)(p.ws + OFF_bar), (volatile LAS unsigned*)&xb_words);
#pragma nounroll
  for (int ph = 0; ph < N_PHASES; ph++) {
    if (ph >= 2 && (ph - 2) % 13 == 10) continue;
    run_phase(p, ph, smem);
#ifdef DUPMASK
    if (ph >= 2 && ((DUPMASK >> ((ph - 2) % 13)) & 1)) run_phase(p, ph, smem);
#endif
    if (ph + 1 < N_PHASES) {
      if (gridDim.y > 1) grid.sync();
      xcd_barrier(xb);
    }
  }
}
#endif

extern "C" void kernel_launch(void* const* d_in, const int* in_sizes, int n_in, void* d_out, int out_size, void* d_ws,
                              size_t ws_size, hipStream_t stream) {
  P p{};
  const float** fp = (const float**)&p;
  for (int i = 0; i < 32; i++) fp[i] = (const float*)d_in[i];
  p.out = (float*)d_out;
  p.ws = (char*)d_ws;
  size_t off = WS_TOTAL;
  if (off > ws_size) { fprintf(stderr, "ws too small: need %zu have %zu\n", off, ws_size); return; }
#if MULTI
  for (int ph = 0; ph < N_PHASES; ph++) hipLaunchKernelGGL(k_phase, dim3(512), dim3(256), 0, stream, p, ph);
#else
  static int grid_blocks = 0;
  if (!grid_blocks) {
    int dev = 0, cus = 0, per_cu = 0;
    hipGetDevice(&dev);
    hipDeviceGetAttribute(&cus, hipDeviceAttributeMultiprocessorCount, dev);
    hipOccupancyMaxActiveBlocksPerMultiprocessor(&per_cu, k_mega, 256, 0);
    if (per_cu > 2) per_cu = 2;
    grid_blocks = cus * per_cu;
  }
  hipMemsetAsync(p.ws + OFF_bar, 0, 16384, stream);
  void* args[] = {&p};
  hipError_t e = hipLaunchCooperativeKernel((void*)k_mega, dim3(grid_blocks), dim3(256), args, 0, stream);
  if (e != hipSuccess) fprintf(stderr, "cooperative launch failed: %s (grid %d)\n", hipGetErrorString(e), grid_blocks);
#endif
}
```

```cpp
#include <hip/hip_runtime.h>
#include <hip/hip_cooperative_groups.h>
#include <cstdio>
#include <cstdint>
namespace cg = cooperative_groups;

#ifndef MULTI
#define MULTI 0
#endif

typedef unsigned short bf16_t;
using bf16x8 = __attribute__((ext_vector_type(8))) short;
using f32x4 = __attribute__((ext_vector_type(4))) float;
using u32x4 = __attribute__((ext_vector_type(4))) unsigned int;

#define T_ALL 12288
#define T_CTX 8192
#define NEG_INF (-__builtin_inff())

__device__ __forceinline__ int tidx() {
  int t = threadIdx.x;
  asm volatile("" : "+v"(t));
  return t;
}
__device__ __forceinline__ bf16_t f2bf(float f) {
  unsigned u = __float_as_uint(f);
  u += 0x7fffu + ((u >> 16) & 1u);
  return (bf16_t)(u >> 16);
}
__device__ __forceinline__ float bf2f(bf16_t b) { return __uint_as_float(((unsigned)b) << 16); }
__device__ __forceinline__ float wsum_shfl(float v) {
#pragma unroll
  for (int o = 32; o; o >>= 1) v += __shfl_xor(v, o);
  return v;
}
#define DPP_F(old, src, ctrl, rm) __int_as_float(__builtin_amdgcn_update_dpp(__float_as_int(old), __float_as_int(src), ctrl, rm, 0xf, false))
__device__ __forceinline__ float wsum(float v) {
  v += DPP_F(v, v, 0xB1, 0xf);
  v += DPP_F(v, v, 0x4E, 0xf);
  v += DPP_F(v, v, 0x141, 0xf);
  v += DPP_F(v, v, 0x140, 0xf);
  v += DPP_F(0.f, v, 0x142, 0xa);
  v += DPP_F(0.f, v, 0x143, 0xc);
  return __int_as_float(__builtin_amdgcn_readlane(__float_as_int(v), 63));
}
__device__ __forceinline__ float wmax(float v) {
  v = fmaxf(v, DPP_F(v, v, 0xB1, 0xf));
  v = fmaxf(v, DPP_F(v, v, 0x4E, 0xf));
  v = fmaxf(v, DPP_F(v, v, 0x141, 0xf));
  v = fmaxf(v, DPP_F(v, v, 0x140, 0xf));
  v = fmaxf(v, DPP_F(v, v, 0x142, 0xa));
  v = fmaxf(v, DPP_F(v, v, 0x143, 0xc));
  return __int_as_float(__builtin_amdgcn_readlane(__float_as_int(v), 63));
}
__device__ __forceinline__ float siluf(float x) { return x * __builtin_amdgcn_rcpf(1.f + __expf(-x)); }
__device__ __forceinline__ float sigmf(float x) { return __builtin_amdgcn_rcpf(1.f + __expf(-x)); }
__device__ __forceinline__ float logsigf(float z) { return fminf(z, 0.f) - log1pf(__expf(-fabsf(z))); }
__device__ __forceinline__ int cond_row(int g) { return g < T_CTX ? 0 : 1 + ((g - T_CTX) >> 11); }

struct P {
  const float *x_prompt, *x_sample, *c, *cache_ckv, *cache_krope, *cache_swa_k, *cache_swa_v, *state_gla, *c_ctx,
      *w_ada, *b_ada, *w_in, *mla_q_norm, *w_uq, *mla_kv_norm, *w_ukv, *w_gla_a_fwd, *b_gla_a_fwd, *w_gla_a_bwd,
      *b_gla_a_bwd, *gla_norm, *swa_sink, *w_branch, *w_out, *ln1_g, *ln1_b, *ln2_g, *ln2_b, *w_peer_q, *peer_keys,
      *peer_u, *peer_v;
  float* out;
  char* ws;
};

constexpr size_t OFF_Wt_in = 0ull;
constexpr size_t OFF_Wt_uq = OFF_Wt_in + (((2ull * 6144 * 1024 * 2) + 255ull) & ~255ull);
constexpr size_t OFF_Wt_ukv = OFF_Wt_uq + (((2ull * 384 * 256 * 2) + 255ull) & ~255ull);
constexpr size_t OFF_Wt_br = OFF_Wt_ukv + (((2ull * 512 * 128 * 2) + 255ull) & ~255ull);
constexpr size_t OFF_Wt_out = OFF_Wt_br + (((8ull * 1024 * 256 * 2) + 255ull) & ~255ull);
constexpr size_t OFF_Wt_pq = OFF_Wt_out + (((2ull * 1024 * 1024 * 2) + 255ull) & ~255ull);
constexpr size_t OFF_keysbf = OFF_Wt_pq + (((2ull * 2048 * 1024 * 2) + 255ull) & ~255ull);
constexpr size_t OFF_Cch = OFF_keysbf + (((2ull * 16 * 128 * 128 * 2) + 255ull) & ~255ull);
constexpr size_t OFF_A256 = OFF_Cch + (((128ull * 64 * 2) + 255ull) & ~255ull);
constexpr size_t OFF_A2048 = OFF_A256 + (((256ull * 512 * 2) + 255ull) & ~255ull);
constexpr size_t OFF_mada = OFF_A2048 + (((2048ull * 4096 * 2) + 255ull) & ~255ull);
constexpr size_t OFF_xbuf = OFF_mada + (((2ull * 3 * 6144 * 4) + 255ull) & ~255ull);
constexpr size_t OFF_u = OFF_xbuf + 256ull;
constexpr size_t OFF_hbuf = OFF_u + (((12288ull * 1024 * 2) + 255ull) & ~255ull);
constexpr size_t OFF_gates = OFF_hbuf + (((12288ull * 1984 * 4) + 255ull) & ~255ull);
constexpr size_t OFF_qn = OFF_gates + (((12288ull * 4096 * 2) + 255ull) & ~255ull);
constexpr size_t OFF_ckv_all = OFF_qn + (((12288ull * 256 * 2) + 255ull) & ~255ull);
constexpr size_t OFF_Qa = OFF_ckv_all + (((13312ull * 128 * 2) + 255ull) & ~255ull);
constexpr size_t OFF_Ka_ctx = OFF_Qa + (((12288ull * 384 * 2) + 255ull) & ~255ull);
constexpr size_t OFF_Ka_lat = OFF_Ka_ctx + (((32ull * 4 * 256 * 96 * 2) + 255ull) & ~255ull);
constexpr size_t OFF_Va_ctx = OFF_Ka_lat + (((2ull * 4 * 2560 * 96 * 2) + 255ull) & ~255ull);
constexpr size_t OFF_Va_lat = OFF_Va_ctx + (((32ull * 4 * 256 * 64 * 2) + 255ull) & ~255ull);
constexpr size_t OFF_Qd = OFF_Va_lat + (((2ull * 4 * 2560 * 64 * 2) + 255ull) & ~255ull);
constexpr size_t OFF_Kd_ctx = OFF_Qd + (((12288ull * 256 * 2) + 255ull) & ~255ull);
constexpr size_t OFF_Kd_lat = OFF_Kd_ctx + (((32ull * 2 * 256 * 64 * 2) + 255ull) & ~255ull);
constexpr size_t OFF_Vd_ctx = OFF_Kd_lat + (((2ull * 2 * 2560 * 64 * 2) + 255ull) & ~255ull);
constexpr size_t OFF_Vd_lat = OFF_Vd_ctx + (((32ull * 2 * 256 * 64 * 2) + 255ull) & ~255ull);
constexpr size_t OFF_fnet = OFF_Vd_lat + (((2ull * 2 * 2560 * 64 * 2) + 255ull) & ~255ull);
constexpr size_t OFF_Yt_ctx = OFF_fnet + (((12288ull * 256 * 2) + 255ull) & ~255ull);
constexpr size_t OFF_Yt_lat = OFF_Yt_ctx + (((32ull * 256 * 512 * 2) + 255ull) & ~255ull);
constexpr size_t OFF_br = OFF_Yt_lat + (((2ull * 256 * 4096 * 2) + 255ull) & ~255ull);
constexpr size_t OFF_un = OFF_br + (((12288ull * 1024 * 2) + 255ull) & ~255ull);
constexpr size_t OFF_sin_ = OFF_un + (((1536ull * 2048 * 4) + 255ull) & ~255ull);
constexpr size_t OFF_gn = OFF_sin_ + (((1536ull * 2048 * 4) + 255ull) & ~255ull);
constexpr size_t OFF_pidx = OFF_gn + (((1536ull * 32 * 4) + 255ull) & ~255ull);
constexpr size_t OFF_pw = OFF_pidx + (((12288ull * 128 * 4) + 255ull) & ~255ull);
constexpr size_t OFF_bar = OFF_pw + (((12288ull * 128 * 4) + 255ull) & ~255ull);
constexpr size_t WS_TOTAL_OLD = OFF_pw + (((12288ull * 128 * 4) + 255ull) & ~255ull);
constexpr size_t OFF_tabU = OFF_bar + 16384ull;
constexpr size_t OFF_tabV = OFF_tabU + 2ull * 16384 * 1024;
constexpr size_t WS_TOTAL = OFF_tabV + 2ull * 16384 * 1024;
#define W_tabU ((unsigned char*)(p.ws + OFF_tabU))
#define W_tabV ((unsigned char*)(p.ws + OFF_tabV))
#define W_Wt_in ((bf16_t*)(p.ws + OFF_Wt_in))
#define W_Wt_uq ((bf16_t*)(p.ws + OFF_Wt_uq))
#define W_Wt_ukv ((bf16_t*)(p.ws + OFF_Wt_ukv))
#define W_Wt_br ((bf16_t*)(p.ws + OFF_Wt_br))
#define W_Wt_out ((bf16_t*)(p.ws + OFF_Wt_out))
#define W_Wt_pq ((bf16_t*)(p.ws + OFF_Wt_pq))
#define W_keysbf ((bf16_t*)(p.ws + OFF_keysbf))
#define W_Cch ((bf16_t*)(p.ws + OFF_Cch))
#define W_A256 ((bf16_t*)(p.ws + OFF_A256))
#define W_A2048 ((bf16_t*)(p.ws + OFF_A2048))
#define W_mada ((float*)(p.ws + OFF_mada))
#define W_xbuf ((float*)(p.ws + OFF_xbuf))
#define W_u ((bf16_t*)(p.ws + OFF_u))
#define W_hbuf ((float*)(p.ws + OFF_hbuf))
#define W_gates ((bf16_t*)(p.ws + OFF_gates))
#define W_qn ((bf16_t*)(p.ws + OFF_qn))
#define W_ckv_all ((bf16_t*)(p.ws + OFF_ckv_all))
#define W_Qa ((bf16_t*)(p.ws + OFF_Qa))
#define W_Ka_ctx ((bf16_t*)(p.ws + OFF_Ka_ctx))
#define W_Ka_lat ((bf16_t*)(p.ws + OFF_Ka_lat))
#define W_Va_ctx ((bf16_t*)(p.ws + OFF_Va_ctx))
#define W_Va_lat ((bf16_t*)(p.ws + OFF_Va_lat))
#define W_Qd ((bf16_t*)(p.ws + OFF_Qd))
#define W_Kd_ctx ((bf16_t*)(p.ws + OFF_Kd_ctx))
#define W_Kd_lat ((bf16_t*)(p.ws + OFF_Kd_lat))
#define W_Vd_ctx ((bf16_t*)(p.ws + OFF_Vd_ctx))
#define W_Vd_lat ((bf16_t*)(p.ws + OFF_Vd_lat))
#define W_fnet ((bf16_t*)(p.ws + OFF_fnet))
#define W_Yt_ctx ((bf16_t*)(p.ws + OFF_Yt_ctx))
#define W_Yt_lat ((bf16_t*)(p.ws + OFF_Yt_lat))
#define W_br ((bf16_t*)(p.ws + OFF_br))
#define W_un ((float*)(p.ws + OFF_un))
#define W_sin_ ((float*)(p.ws + OFF_sin_))
#define W_gn ((float*)(p.ws + OFF_gn))
#define W_pidx ((int*)(p.ws + OFF_pidx))
#define W_pw ((float*)(p.ws + OFF_pw))

#define GB_LD 72
#define G_LOAD(RA, RB, KOFF)                                                         \
  _Pragma("unroll") for (int i = 0; i < 4; i++) {                                    \
    int c = tid + i * 256, r = c >> 3, cc = (c & 7) * 8;                             \
    RA[i] = *(const u32x4*)(A + (size_t)r * lda + (KOFF) + cc);                      \
    if (i < NJ) RB[i] = *(const u32x4*)(B + (size_t)r * ldb + (KOFF) + cc);          \
  }
#define G_STORE(RA, RB)                                                              \
  _Pragma("unroll") for (int i = 0; i < 4; i++) {                                    \
    int c = tid + i * 256, r = c >> 3, cc = (c & 7) * 8;                             \
    *(u32x4*)(sa + r * GB_LD + cc) = RA[i];                                          \
    if (i < NJ) *(u32x4*)(sb + r * GB_LD + cc) = RB[i];                              \
  }
#define G_COMPUTE()                                                                  \
  _Pragma("unroll") for (int ks = 0; ks < 2; ks++) {                                 \
    bf16x8 af[4], bfr[NJ];                                                           \
    _Pragma("unroll") for (int i = 0; i < 4; i++)                                    \
      af[i] = *(const bf16x8*)(sa + (wm * 64 + i * 16 + l15) * GB_LD + ks * 32 + l4 * 8); \
    _Pragma("unroll") for (int j = 0; j < NJ; j++)                                   \
      bfr[j] = *(const bf16x8*)(sb + (wn * NJ * 16 + j * 16 + l15) * GB_LD + ks * 32 + l4 * 8); \
    _Pragma("unroll") for (int i = 0; i < 4; i++)                                    \
    _Pragma("unroll") for (int j = 0; j < NJ; j++)                                   \
      acc[i][j] = __builtin_amdgcn_mfma_f32_16x16x32_bf16(af[i], bfr[j], acc[i][j], 0, 0, 0); \
  }
template <int NJ>
__device__ __forceinline__ void gemm_core_t(f32x4 (&acc)[4][NJ], const bf16_t* __restrict__ A, int lda,
                                            const bf16_t* __restrict__ B, int ldb, int K, char* smem) {
  bf16_t* sa = (bf16_t*)smem;
  bf16_t* sb = sa + 128 * GB_LD;
  const int tid = tidx(), lane = tid & 63, w = tid >> 6, wm = w >> 1, wn = w & 1;
  const int l15 = lane & 15, l4 = lane >> 4;
  u32x4 ra0[4], rb0[NJ], ra1[4], rb1[NJ];
  G_LOAD(ra0, rb0, 0);
  if (K > 64) { G_LOAD(ra1, rb1, 64); }
  for (int k0 = 0; k0 < K; k0 += 128) {
    __syncthreads();
    G_STORE(ra0, rb0);
    __syncthreads();
    if (k0 + 128 < K) { G_LOAD(ra0, rb0, k0 + 128); }
    G_COMPUTE();
    if (k0 + 64 < K) {
      __syncthreads();
      G_STORE(ra1, rb1);
      __syncthreads();
      if (k0 + 192 < K) { G_LOAD(ra1, rb1, k0 + 192); }
      G_COMPUTE();
    }
  }
}
#define gemm_core gemm_core_t<4>
#define ZERO_ACC_N(acc, NJ)                                        \
  _Pragma("unroll") for (int i_ = 0; i_ < 4; i_++)                 \
  _Pragma("unroll") for (int j_ = 0; j_ < NJ; j_++) { acc[i_][j_] = f32x4{0.f, 0.f, 0.f, 0.f}; }
#define ZERO_ACC(acc) ZERO_ACC_N(acc, 4)
#define EPI_LOOP_N(acc, m0, n0, NJ, ...)                                                   \
  {                                                                                        \
    const int lane_ = tidx() & 63, w_ = tidx() >> 6, wm_ = w_ >> 1, wn_ = w_ & 1; \
    _Pragma("unroll") for (int i_ = 0; i_ < 4; i_++)                                       \
    _Pragma("unroll") for (int j_ = 0; j_ < NJ; j_++)                                      \
    _Pragma("unroll") for (int r_ = 0; r_ < 4; r_++) {                                     \
      const int m = (m0) + wm_ * 64 + i_ * 16 + (lane_ >> 4) * 4 + r_;                     \
      const int n = (n0) + wn_ * (NJ * 16) + j_ * 16 + (lane_ & 15);                       \
      float v = acc[i_][j_][r_];                                                           \
      __VA_ARGS__                                                                          \
    }                                                                                      \
  }
#define EPI_LOOP(acc, m0, n0, ...) EPI_LOOP_N(acc, m0, n0, 4, __VA_ARGS__)
#define EPI4_LOOP(acc, c0, t0, ...)                                                        \
  {                                                                                        \
    const int lane_ = tidx() & 63, w_ = tidx() >> 6, wm_ = w_ >> 1, wn_ = w_ & 1;           \
    _Pragma("unroll") for (int i_ = 0; i_ < 4; i_++)                                       \
    _Pragma("unroll") for (int j_ = 0; j_ < 4; j_++) {                                     \
      const int col = (c0) + wm_ * 64 + i_ * 16 + (lane_ >> 4) * 4;                        \
      const int tok = (t0) + wn_ * 64 + j_ * 16 + (lane_ & 15);                            \
      const f32x4 v4 = acc[i_][j_];                                                        \
      __VA_ARGS__                                                                          \
    }                                                                                      \
  }

__device__ __forceinline__ void transpose_tile(const float* __restrict__ src, int K, int N, bf16_t* __restrict__ dst, int tile, int ntn,
                               float* sm, int ldd = 0) {
  if (ldd == 0) ldd = K;
  int kt = tile / ntn, nt = tile % ntn, k0 = kt * 64, n0 = nt * 64;
  int tx = tidx() & 63, ty = tidx() >> 6;
  __syncthreads();
  for (int i = 0; i < 16; i++) {
    int k = i * 4 + ty, n = n0 + tx;
    sm[k * 65 + tx] = (n < N) ? src[(size_t)(k0 + k) * N + n] : 0.f;
  }
  __syncthreads();
  for (int i = 0; i < 16; i++) {
    int n = i * 4 + ty;
    dst[(size_t)(n0 + n) * ldd + k0 + tx] = f2bf(sm[tx * 65 + n]);
  }
}

__device__ __forceinline__ void ada_item(const P& p, int item, float* sm) {
  int l = item / 24, cgp = item % 24;
  int lane = tidx() & 63, w = tidx() >> 6;
  const float* W = p.w_ada + (size_t)l * 1024 * 6144 + cgp * 256 + lane * 4;
  float4 a0 = {0, 0, 0, 0}, a1 = {0, 0, 0, 0}, a2 = {0, 0, 0, 0};
#pragma unroll 16
  for (int k = w * 256; k < (w + 1) * 256; k++) {
    float4 wv = *(const float4*)(W + (size_t)k * 6144);
    float c0 = siluf(p.c_ctx[k]), c1 = siluf(p.c[k]), c2 = siluf(p.c[1024 + k]);
    a0.x += c0 * wv.x; a0.y += c0 * wv.y; a0.z += c0 * wv.z; a0.w += c0 * wv.w;
    a1.x += c1 * wv.x; a1.y += c1 * wv.y; a1.z += c1 * wv.z; a1.w += c1 * wv.w;
    a2.x += c2 * wv.x; a2.y += c2 * wv.y; a2.z += c2 * wv.z; a2.w += c2 * wv.w;
  }
  __syncthreads();
  *(float4*)(sm + (w * 3 + 0) * 256 + lane * 4) = a0;
  *(float4*)(sm + (w * 3 + 1) * 256 + lane * 4) = a1;
  *(float4*)(sm + (w * 3 + 2) * 256 + lane * 4) = a2;
  __syncthreads();
  for (int o = tidx(); o < 768; o += 256) {
    int r = o >> 8, col = o & 255;
    float s = sm[(0 * 3 + r) * 256 + col] + sm[(1 * 3 + r) * 256 + col] + sm[(2 * 3 + r) * 256 + col] +
              sm[(3 * 3 + r) * 256 + col];
    W_mada[(l * 3 + r) * 6144 + cgp * 256 + col] = s + p.b_ada[l * 6144 + cgp * 256 + col];
  }
}

__device__ __forceinline__ void dft_seq_fill(bf16_t* dst, int S, int item) {
  float inv = rsqrtf((float)S);
  size_t base = (size_t)item * 2048;
  for (int e = 0; e < 8; e++) {
    size_t idx = base + e * 256 + tidx();
    int k = (int)(idx / (2 * S)), col = (int)(idx % (2 * S));
    int s = col < S ? col : col - S;
    int mm = (k * s) & (S - 1);
    float rev = (float)mm / (float)S;
    float v = col < S ? __builtin_amdgcn_cosf(rev) : -__builtin_amdgcn_sinf(rev);
    dst[idx] = f2bf(v * inv);
  }
}

#define PEER_U_SCALE 64.f
#define PEER_V_SCALE 16.f
__device__ __forceinline__ void tab_convert_item(const P& p, int item) {
  int l = item >> 12, isv = (item >> 11) & 1, sub = item & 2047;
  const float* src = (isv ? p.peer_v : p.peer_u) + (size_t)l * 16384 * 1024 + (size_t)sub * 8192;
  unsigned char* dst = (isv ? W_tabV : W_tabU) + (size_t)l * 16384 * 1024 + (size_t)sub * 8192;
  const float sc = isv ? PEER_V_SCALE : PEER_U_SCALE;
  int tid = tidx();
  float4 tt[8];
#pragma unroll
  for (int e = 0; e < 8; e++) tt[e] = *(const float4*)(src + (e * 256 + tid) * 4);
#pragma unroll
  for (int e = 0; e < 8; e++) {
    float4 t = tt[e];
    int pk = __builtin_amdgcn_cvt_pk_fp8_f32(t.x * sc, t.y * sc, 0, false);
    pk = __builtin_amdgcn_cvt_pk_fp8_f32(t.z * sc, t.w * sc, pk, true);
    *(int*)(dst + (e * 256 + tid) * 4) = pk;
  }
}

__device__ __forceinline__ void phase_prep(const P& p, char* smem) {
  float* sm = (float*)smem;
  const int nb = gridDim.x;
  const int J_ADA = 48;
  const int J_IN = 2 * 16 * 96;
  const int J_UQ = 2 * 4 * 6;
  const int J_UKV = 2 * 2 * 8;
  const int J_BR = 2 * 4 * 4 * 16;
  const int J_OUT = 2 * 16 * 16;
  const int J_PQ = 2 * 16 * 32;
  const int J_KEYS = 256;
  const int J_CCH = 4;
  const int J_A256 = 64;
  const int J_A2048 = 4096;
  const int J_TAB = 8192;
  const int total = J_ADA + J_IN + J_UQ + J_UKV + J_BR + J_OUT + J_PQ + J_KEYS + J_CCH + J_A256 + J_A2048 + J_TAB;
  const bool ada_split = nb >= 4 * J_ADA;
  const int it_start = ada_split ? ((int)blockIdx.x < J_ADA ? (int)blockIdx.x : J_ADA + ((int)blockIdx.x - J_ADA)) : (int)blockIdx.x;
  const int it_step = ada_split ? ((int)blockIdx.x < J_ADA ? total : nb - J_ADA) : nb;
  for (int it0 = it_start; it0 < total; it0 += it_step) {
    int it = it0;
    if (it < J_ADA) { ada_item(p, it, sm); continue; }
    it -= J_ADA;
    if (it < J_IN) { int l = it / 1536, t = it % 1536; transpose_tile(p.w_in + (size_t)l * 1024 * 6080, 1024, 6080, W_Wt_in + (size_t)l * 6144 * 1024, t, 96, sm); continue; }
    it -= J_IN;
    if (it < J_UQ) { int l = it / 24, t = it % 24; transpose_tile(p.w_uq + (size_t)l * 256 * 384, 256, 384, W_Wt_uq + (size_t)l * 384 * 256, t, 6, sm); continue; }
    it -= J_UQ;
    if (it < J_UKV) { int l = it / 16, t = it % 16; transpose_tile(p.w_ukv + (size_t)l * 128 * 512, 128, 512, W_Wt_ukv + (size_t)l * 512 * 128, t, 8, sm); continue; }
    it -= J_UKV;
    if (it < J_BR) { int lb = it / 64, t = it % 64; transpose_tile(p.w_branch + (size_t)lb * 256 * 1024, 256, 1024, W_Wt_br + (size_t)(lb >> 2) * 1024 * 1024 + (lb & 3) * 256, t, 16, sm, 1024); continue; }
    it -= J_BR;
    if (it < J_OUT) { int l = it / 256, t = it % 256; transpose_tile(p.w_out + (size_t)l * 1024 * 1024, 1024, 1024, W_Wt_out + (size_t)l * 1024 * 1024, t, 16, sm); continue; }
    it -= J_OUT;
    if (it < J_PQ) { int l = it / 512, t = it % 512; transpose_tile(p.w_peer_q + (size_t)l * 1024 * 2048, 1024, 2048, W_Wt_pq + (size_t)l * 2048 * 1024, t, 32, sm); continue; }
    it -= J_PQ;
    if (it < J_KEYS) {
      size_t base = (size_t)it * 2048;
      float kv_[8];
#pragma unroll
      for (int e = 0; e < 8; e++) kv_[e] = p.peer_keys[base + e * 256 + tidx()];
#pragma unroll
      for (int e = 0; e < 8; e++) W_keysbf[base + e * 256 + tidx()] = f2bf(kv_[e]);
      continue;
    }
    it -= J_KEYS;
    if (it < J_CCH) {
      for (int e = 0; e < 8; e++) {
        int idx = it * 2048 + e * 256 + tidx();
        int n = idx >> 6, c = idx & 63;
        int j = n & 63;
        float rev = (float)((j * c) & 63) / 64.f;
        float v = n < 64 ? __builtin_amdgcn_cosf(rev) : __builtin_amdgcn_sinf(rev);
        W_Cch[idx] = f2bf(v * 0.125f);
      }
      continue;
    }
    it -= J_CCH;
    if (it < J_A256) { dft_seq_fill(W_A256, 256, it); continue; }
    it -= J_A256;
    if (it < J_A2048) { dft_seq_fill(W_A2048, 2048, it); continue; }
    it -= J_A2048;
    tab_convert_item(p, it);
  }
}

__device__ __forceinline__ void load_row16(const float* row, int lane, float (&v)[16]) {
#pragma unroll
  for (int q = 0; q < 4; q++) {
    float4 t = *(const float4*)(row + q * 256 + lane * 4);
    v[q * 4 + 0] = t.x; v[q * 4 + 1] = t.y; v[q * 4 + 2] = t.z; v[q * 4 + 3] = t.w;
  }
}
__device__ __forceinline__ void store_row16(float* row, int lane, const float (&v)[16]) {
#pragma unroll
  for (int q = 0; q < 4; q++) *(float4*)(row + q * 256 + lane * 4) = float4{v[q * 4], v[q * 4 + 1], v[q * 4 + 2], v[q * 4 + 3]};
}
__device__ __forceinline__ void ln16(float (&v)[16]) {
  float s = 0;
#pragma unroll
  for (int i = 0; i < 16; i++) s += v[i];
  s = wsum(s);
  float mu = s * (1.f / 1024.f);
  float q = 0;
#pragma unroll
  for (int i = 0; i < 16; i++) { v[i] -= mu; q += v[i] * v[i]; }
  q = wsum(q);
  float rs = rsqrtf(q * (1.f / 1024.f) + 1e-6f);
#pragma unroll
  for (int i = 0; i < 16; i++) v[i] *= rs;
}
__device__ __forceinline__ void modulate_store(const float (&v)[16], const float* sh, const float* sc, bf16_t* dst, int lane) {
#pragma unroll
  for (int q = 0; q < 4; q++) {
    float4 a = *(const float4*)(sc + q * 256 + lane * 4);
    float4 b = *(const float4*)(sh + q * 256 + lane * 4);
    ushort4 o;
    o.x = f2bf(v[q * 4 + 0] * (1.f + a.x) + b.x);
    o.y = f2bf(v[q * 4 + 1] * (1.f + a.y) + b.y);
    o.z = f2bf(v[q * 4 + 2] * (1.f + a.z) + b.z);
    o.w = f2bf(v[q * 4 + 3] * (1.f + a.w) + b.w);
    *(ushort4*)(dst + q * 256 + lane * 4) = o;
  }
}
__device__ __forceinline__ void affine16(float (&v)[16], const float* g, const float* b, int lane) {
#pragma unroll
  for (int q = 0; q < 4; q++) {
    float4 a = *(const float4*)(g + q * 256 + lane * 4);
    float4 c = *(const float4*)(b + q * 256 + lane * 4);
    v[q * 4 + 0] = v[q * 4 + 0] * a.x + c.x;
    v[q * 4 + 1] = v[q * 4 + 1] * a.y + c.y;
    v[q * 4 + 2] = v[q * 4 + 2] * a.z + c.z;
    v[q * 4 + 3] = v[q * 4 + 3] * a.w + c.w;
  }
}
__device__ __forceinline__ const float* x_in_row(const P& p, int l, int g) {
  if (l == 0) return g < T_CTX ? p.x_prompt + (size_t)g * 1024 : p.x_sample + (size_t)(g - T_CTX) * 1024;
  return p.out + (size_t)g * 1024;
}
__device__ __forceinline__ float* x_out_row(const P& p, int l, int g) {
  return p.out + (size_t)g * 1024;
}

__device__ __forceinline__ void phase_ln0(const P& p) {
  int lane = tidx() & 63, w = tidx() >> 6;
  for (int it = blockIdx.x; it < T_ALL / 4; it += gridDim.x) {
    int g = it * 4 + w;
    float v[16];
    load_row16(x_in_row(p, 0, g), lane, v);
    ln16(v);
    const float* m = W_mada + (0 * 3 + cond_row(g)) * 6144;
    modulate_store(v, m, m + 1024, W_u + (size_t)g * 1024, lane);
  }
}

__device__ __forceinline__ void phase_win(const P& p, int l, char* smem) {
  const bf16_t* Wt = W_Wt_in + (size_t)l * 6144 * 1024;
  for (int tile = blockIdx.x; tile < 96 * 48; tile += gridDim.x) {
    int mt = tile / 48, nt = tile % 48, m0 = mt * 128, n0 = nt * 128;
    f32x4 acc[4][4];
    ZERO_ACC(acc);
    gemm_core(acc, Wt + (size_t)n0 * 1024, 1024, W_u + (size_t)m0 * 1024, 1024, 1024, smem);
    EPI4_LOOP(acc, n0, m0, {
      if (col < 1984) *(float4*)(W_hbuf + (size_t)tok * 1984 + col) = float4{v4[0], v4[1], v4[2], v4[3]};
      else if (col < 6080) {
        ushort4 o_; o_.x = f2bf(sigmf(v4[0])); o_.y = f2bf(sigmf(v4[1])); o_.z = f2bf(sigmf(v4[2])); o_.w = f2bf(sigmf(v4[3]));
        *(ushort4*)(W_gates + (size_t)tok * 4096 + (col - 1984)) = o_;
      }
    });
  }
}

__device__ __forceinline__ void rope_cs(float pos, int i, float inv_hp, float& cs, float& sn) {
  float freq = exp2f(-(float)i * inv_hp * 13.287712379549449f);
  float a = pos * freq;
  sn = __sinf(a);
  cs = __cosf(a);
}

__device__ __forceinline__ void phase_post(const P& p, int l) {
  int lane = tidx() & 63, w = tidx() >> 6;
  for (int it = blockIdx.x; it < 13312 / 4; it += gridDim.x) {
    int g = it * 4 + w;
    if (g < T_ALL) {
      const bool lat = g >= T_CTX;
      int b, s;
      if (!lat) { b = g >> 8; s = g & 255; } else { b = (g - T_CTX) >> 11; s = (g - T_CTX) & 2047; }
      const float* h = W_hbuf + (size_t)g * 1984;
      const float prow = (float)(s >> 6), pcol = (float)(s & 63);
      const float4 pl_q = *(const float4*)(h + lane * 4);
      const float2 pl_c = *(const float2*)(h + 256 + lane * 2);
      const float pl_kr1 = h[384 + ((lane >> 3) & 1) * 16 + (lane & 7)], pl_kr2 = h[384 + ((lane >> 3) & 1) * 16 + 8 + (lane & 7)];
      const float4 pl_f = *(const float4*)(h + 416 + lane * 4);
      float pl_sq1[2], pl_sq2[2];
#pragma unroll
      for (int jj = 0; jj < 2; jj++) {
        int pi = lane + 64 * jj, hq = pi >> 5, pp = (pi >> 4) & 1, i = pi & 15;
        pl_sq1[jj] = h[1472 + hq * 64 + pp * 32 + i]; pl_sq2[jj] = h[1472 + hq * 64 + pp * 32 + 16 + i];
      }
      const float pl_sk1 = h[1728 + (lane >> 5) * 64 + ((lane >> 4) & 1) * 32 + (lane & 15)];
      const float pl_sk2 = h[1728 + (lane >> 5) * 64 + ((lane >> 4) & 1) * 32 + 16 + (lane & 15)];
      const float2 pl_v = *(const float2*)(h + 1856 + lane * 2);
      {
        float4 t = pl_q;
        float ss = wsum(t.x * t.x + t.y * t.y + t.z * t.z + t.w * t.w);
        float rs = rsqrtf(ss * (1.f / 256.f) + 1e-6f);
        float4 gq = *(const float4*)(p.mla_q_norm + l * 256 + lane * 4);
        ushort4 o;
        o.x = f2bf(t.x * rs * gq.x); o.y = f2bf(t.y * rs * gq.y); o.z = f2bf(t.z * rs * gq.z); o.w = f2bf(t.w * rs * gq.w);
        *(ushort4*)(W_qn + (size_t)g * 256 + lane * 4) = o;
      }
      {
        float2 t = pl_c;
        float ss = wsum(t.x * t.x + t.y * t.y);
        float rs = rsqrtf(ss * (1.f / 128.f) + 1e-6f);
        float2 gk = *(const float2*)(p.mla_kv_norm + l * 128 + lane * 2);
        float v0 = t.x * rs * gk.x, v1 = t.y * rs * gk.y;
        ushort2 o; o.x = f2bf(v0); o.y = f2bf(v1);
        *(ushort2*)(W_ckv_all + (size_t)g * 128 + lane * 2) = o;
        if (!lat) *(float2*)(p.out + 12582912 + ((size_t)((b * 2 + l) * 256 + s)) * 128 + lane * 2) = float2{v0, v1};
      }
      if (lane < 16) {
        int pp = lane >> 3, i = lane & 7;
        float x1 = pl_kr1, x2 = pl_kr2;
        float o1 = x1, o2 = x2;
        if (lat) {
          float cs, sn;
          rope_cs(pp ? pcol : prow, i, 0.125f, cs, sn);
          o1 = x1 * cs - x2 * sn; o2 = x2 * cs + x1 * sn;
        } else {
          float* ok = p.out + 14680064 + ((size_t)((b * 2 + l) * 256 + s)) * 32 + pp * 16 + i;
          ok[0] = o1; ok[8] = o2;
        }
        bf16_t b1 = f2bf(o1), b2 = f2bf(o2);
        for (int hh = 0; hh < 4; hh++) {
          bf16_t* kd = lat ? W_Ka_lat + ((size_t)((b * 4 + hh) * 2560 + 512 + s)) * 96 : W_Ka_ctx + ((size_t)((b * 4 + hh) * 256 + s)) * 96;
          kd[64 + pp * 16 + i] = b1; kd[64 + pp * 16 + 8 + i] = b2;
        }
      }
      {
        float4 t = pl_f;
        ushort4 o; o.x = f2bf(t.x); o.y = f2bf(t.y); o.z = f2bf(t.z); o.w = f2bf(t.w);
        *(ushort4*)(W_fnet + (size_t)g * 256 + lane * 4) = o;
      }
#pragma unroll
      for (int jj = 0; jj < 2; jj++) {
        int pi = lane + 64 * jj, hq = pi >> 5, pp = (pi >> 4) & 1, i = pi & 15;
        float x1 = pl_sq1[jj], x2 = pl_sq2[jj];
        float o1 = x1, o2 = x2;
        if (lat) {
          float cs, sn;
          rope_cs(pp ? pcol : prow, i, 0.0625f, cs, sn);
          o1 = x1 * cs - x2 * sn; o2 = x2 * cs + x1 * sn;
        }
        bf16_t* qd = W_Qd + (size_t)g * 256 + hq * 64 + pp * 32 + i;
        qd[0] = f2bf(o1); qd[16] = f2bf(o2);
      }
      {
        int kv = lane >> 5, pp = (lane >> 4) & 1, i = lane & 15;
        float x1 = pl_sk1, x2 = pl_sk2;
        float o1 = x1, o2 = x2;
        bf16_t* kd;
        if (lat) {
          float cs, sn;
          rope_cs(pp ? pcol : prow, i, 0.0625f, cs, sn);
          o1 = x1 * cs - x2 * sn; o2 = x2 * cs + x1 * sn;
          kd = W_Kd_lat + ((size_t)((b * 2 + kv) * 2560 + 512 + s)) * 64;
        } else {
          float* ok = p.out + 15204352 + ((size_t)(((b * 2 + l) * 2 + kv) * 256 + s)) * 64 + pp * 32 + i;
          ok[0] = o1; ok[16] = o2;
          kd = W_Kd_ctx + ((size_t)((b * 2 + kv) * 256 + s)) * 64;
        }
        kd[pp * 32 + i] = f2bf(o1); kd[pp * 32 + 16 + i] = f2bf(o2);
      }
      {
        int e = lane * 2, kv = e >> 6, d = e & 63;
        float2 t = pl_v;
        if (lat) {
          bf16_t* vt = W_Vd_lat + (size_t)(b * 2 + kv) * 64 * 2560 + 512 + s;
          vt[(size_t)d * 2560] = f2bf(t.x); vt[(size_t)(d + 1) * 2560] = f2bf(t.y);
        } else {
          *(float2*)(p.out + 17301504 + ((size_t)(((b * 2 + l) * 2 + kv) * 256 + s)) * 64 + d) = t;
          bf16_t* vt = W_Vd_ctx + (size_t)(b * 2 + kv) * 64 * 256 + s;
          vt[d * 256] = f2bf(t.x); vt[(d + 1) * 256] = f2bf(t.y);
        }
      }
    } else {
      int gc = g - T_ALL, b = gc >> 9, pp = gc & 511;
      {
        float2 t = *(const float2*)(p.cache_ckv + ((size_t)((b * 2 + l) * 512 + pp)) * 128 + lane * 2);
        ushort2 o; o.x = f2bf(t.x); o.y = f2bf(t.y);
        *(ushort2*)(W_ckv_all + (size_t)g * 128 + lane * 2) = o;
      }
      if (lane < 32) {
        bf16_t v = f2bf(p.cache_krope[((size_t)((b * 2 + l) * 512 + pp)) * 32 + lane]);
        for (int hh = 0; hh < 4; hh++) W_Ka_lat[((size_t)((b * 4 + hh) * 2560 + pp)) * 96 + 64 + lane] = v;
      }
      {
        int e = lane * 2, kv = e >> 6, d = e & 63;
        size_t src = ((size_t)(((b * 2 + l) * 2 + kv) * 512 + pp)) * 64 + d;
        float2 tk = *(const float2*)(p.cache_swa_k + src);
        float2 tv = *(const float2*)(p.cache_swa_v + src);
        size_t dst = ((size_t)((b * 2 + kv) * 2560 + pp)) * 64 + d;
        ushort2 ok; ok.x = f2bf(tk.x); ok.y = f2bf(tk.y);
        *(ushort2*)(W_Kd_lat + dst) = ok;
        bf16_t* vt = W_Vd_lat + (size_t)(b * 2 + kv) * 64 * 2560 + pp;
        vt[(size_t)d * 2560] = f2bf(tv.x); vt[(size_t)(d + 1) * 2560] = f2bf(tv.y);
      }
    }
  }
}

__device__ __forceinline__ void phase_small_gemms(const P& p, int l, char* smem) {
  const int NA = 96 * 3, NB = 104 * 4, NC = 384;
  for (int it0 = blockIdx.x; it0 < NA + NB + NC; it0 += gridDim.x) {
    int it = it0;
    f32x4 acc[4][4];
    ZERO_ACC(acc);
    if (it < NA) {
      int mt = it / 3, nt = it % 3, m0 = mt * 128, n0 = nt * 128;
      gemm_core(acc, W_qn + (size_t)m0 * 256, 256, W_Wt_uq + (size_t)l * 384 * 256 + (size_t)n0 * 256, 256, 256, smem);
      const bool lat = m0 >= T_CTX;
      EPI_LOOP(acc, m0, n0, {
        int c96 = n % 96;
        if (lat && c96 >= 64) {
          float pv = DPP_F(v, v, 0x128, 0xf);
          int cr = c96 - 64, pp = cr >> 4, ii = cr & 15, i = ii & 7;
          int s = (m - T_CTX) & 2047;
          float cs, sn;
          rope_cs(pp ? (float)(s & 63) : (float)(s >> 6), i, 0.125f, cs, sn);
          v = (ii < 8) ? v * cs - pv * sn : v * cs + pv * sn;
        }
        W_Qa[(size_t)m * 384 + n] = f2bf(v);
      });
      continue;
    }
    it -= NA;
    if (it < NB) {
      int mt = it / 4, nt = it % 4, m0 = mt * 128, n0 = nt * 128;
      gemm_core(acc, W_ckv_all + (size_t)m0 * 128, 128, W_Wt_ukv + (size_t)l * 512 * 128 + (size_t)n0 * 128, 128, 128, smem);
      EPI_LOOP(acc, m0, n0, {
        int hh = n >> 7, c = n & 127;
        bf16_t* kd; bf16_t* vd; int vstride;
        if (m < T_CTX) {
          int b = m >> 8, s = m & 255;
          size_t r = (size_t)((b * 4 + hh) * 256 + s);
          kd = W_Ka_ctx + r * 96; vd = W_Va_ctx + (size_t)(b * 4 + hh) * 64 * 256 + s; vstride = 256;
        } else {
          int b, pos;
          if (m < T_ALL) { b = (m - T_CTX) >> 11; pos = 512 + ((m - T_CTX) & 2047); }
          else { b = (m - T_ALL) >> 9; pos = (m - T_ALL) & 511; }
          size_t r = (size_t)((b * 4 + hh) * 2560 + pos);
          kd = W_Ka_lat + r * 96; vd = W_Va_lat + (size_t)(b * 4 + hh) * 64 * 2560 + pos; vstride = 2560;
        }
        if (c < 64) kd[c] = f2bf(v); else vd[(size_t)(c - 64) * vstride] = f2bf(v);
      });
      continue;
    }
    it -= NB;
    {
      int m0 = it * 128;
      gemm_core(acc, W_fnet + (size_t)m0 * 64, 64, W_Cch, 64, 64, smem);
      EPI_LOOP(acc, m0, 0, {
        int g = m >> 2, grp = m & 3, part = n >> 6, j = n & 63;
        if (g < T_CTX) {
          int b = g >> 8, s = g & 255;
          W_Yt_ctx[((size_t)(b * 256 + grp * 64 + j)) * 512 + part * 256 + s] = f2bf(v);
        } else {
          int b = (g - T_CTX) >> 11, s = (g - T_CTX) & 2047;
          W_Yt_lat[((size_t)(b * 256 + grp * 64 + j)) * 4096 + part * 2048 + s] = f2bf(v);
        }
      });
    }
  }
}

template <int DK>
__device__ __forceinline__ void attn_item(const bf16_t* __restrict__ Qp, int qstride, const bf16_t* __restrict__ Kp,
                          const bf16_t* __restrict__ Vp, bf16_t* __restrict__ Op, int q0, int Sk, int n_ctx, int W,
                          float scale, bool has_sink, float sink, char* smem) {
  constexpr int KLD = DK + 8;
  bf16_t* sK = (bf16_t*)smem;
  bf16_t* sVt = sK + 64 * KLD;
  bf16_t* sP = sVt + 64 * 72;
  const int tid = tidx(), lane = tid & 63, w = tid >> 6, l15 = lane & 15, l4 = lane >> 4;
  bf16_t* sPw = sP + w * 16 * 72;
  bf16x8 qf[DK / 32];
  {
    const bf16_t* qrow = Qp + (size_t)(q0 + w * 16 + l15) * qstride;
#pragma unroll
    for (int ks = 0; ks < DK / 32; ks++) qf[ks] = *(const bf16x8*)(qrow + ks * 32 + l4 * 8);
  }
  f32x4 o[4];
#pragma unroll
  for (int j = 0; j < 4; j++) o[j] = f32x4{0.f, 0.f, 0.f, 0.f};
  float mrow[4], lrow[4];
#pragma unroll
  for (int r = 0; r < 4; r++) { mrow[r] = NEG_INF; lrow[r] = 0.f; }
  const int ntile = Sk >> 6;
  auto tile_ok = [&](int kt) -> bool {
    int kb = kt * 64;
    if (W >= 0 && kb >= n_ctx) { int lp = kb - n_ctx; if (lp + 63 < q0 - W || lp > q0 + 63 + W) return false; }
    return true;
  };
  u32x4 rk[DK / 32], rv[2];
  int kt = 0;
  while (kt < ntile && !tile_ok(kt)) kt++;
  if (kt < ntile) {
#pragma unroll
    for (int i = 0; i < DK / 32; i++) { int c = tid + i * 256, r = c / (DK / 8), cc = (c % (DK / 8)) * 8; rk[i] = *(const u32x4*)(Kp + (size_t)(kt * 64 + r) * DK + cc); }
#pragma unroll
    for (int i = 0; i < 2; i++) { int c = tid + i * 256, dv = c >> 3, k0 = (c & 7) * 8; rv[i] = *(const u32x4*)(Vp + (size_t)dv * Sk + kt * 64 + k0); }
  }
  while (kt < ntile) {
    const int kbase = kt * 64;
    __syncthreads();
#pragma unroll
    for (int i = 0; i < DK / 32; i++) { int c = tid + i * 256, r = c / (DK / 8), cc = (c % (DK / 8)) * 8; *(u32x4*)(sK + r * KLD + cc) = rk[i]; }
#pragma unroll
    for (int i = 0; i < 2; i++) {
      int c = tid + i * 256, dv = c >> 3, k0 = (c & 7) * 8;
      *(u32x4*)(sVt + dv * 72 + k0) = rv[i];
    }
    __syncthreads();
    int ktn = kt + 1;
    while (ktn < ntile && !tile_ok(ktn)) ktn++;
    if (ktn < ntile) {
#pragma unroll
      for (int i = 0; i < DK / 32; i++) { int c = tid + i * 256, r = c / (DK / 8), cc = (c % (DK / 8)) * 8; rk[i] = *(const u32x4*)(Kp + (size_t)(ktn * 64 + r) * DK + cc); }
#pragma unroll
      for (int i = 0; i < 2; i++) { int c = tid + i * 256, dv = c >> 3, k0 = (c & 7) * 8; rv[i] = *(const u32x4*)(Vp + (size_t)dv * Sk + ktn * 64 + k0); }
    }
    kt = ktn;
    f32x4 s[4];
#pragma unroll
    for (int j = 0; j < 4; j++) {
      s[j] = f32x4{0.f, 0.f, 0.f, 0.f};
#pragma unroll
      for (int ks = 0; ks < DK / 32; ks++) {
        bf16x8 kf = *(const bf16x8*)(sK + (j * 16 + l15) * KLD + ks * 32 + l4 * 8);
        s[j] = __builtin_amdgcn_mfma_f32_16x16x32_bf16(qf[ks], kf, s[j], 0, 0, 0);
      }
    }
#pragma unroll
    for (int j = 0; j < 4; j++)
#pragma unroll
      for (int r = 0; r < 4; r++) {
        float v = s[j][r] * scale;
        if (W >= 0) {
          int kk = kbase + j * 16 + l15, t = q0 + w * 16 + l4 * 4 + r;
          int dlt = kk - n_ctx - t;
          bool valid = (kk < n_ctx) || (dlt <= W && dlt >= -W);
          if (!valid) v = NEG_INF;
        }
        s[j][r] = v;
      }
#pragma unroll
    for (int r = 0; r < 4; r++) {
      float mx = fmaxf(fmaxf(s[0][r], s[1][r]), fmaxf(s[2][r], s[3][r]));
      mx = fmaxf(mx, DPP_F(mx, mx, 0xB1, 0xf));
      mx = fmaxf(mx, DPP_F(mx, mx, 0x4E, 0xf));
      mx = fmaxf(mx, DPP_F(mx, mx, 0x141, 0xf));
      mx = fmaxf(mx, DPP_F(mx, mx, 0x140, 0xf));
      float mnew = fmaxf(mrow[r], mx);
      float muse = (mnew == NEG_INF) ? 0.f : mnew;
      float alpha = __expf(mrow[r] - muse);
      float rs = 0.f;
#pragma unroll
      for (int j = 0; j < 4; j++) { float pe = __expf(s[j][r] - muse); s[j][r] = pe; rs += pe; }
      rs += DPP_F(rs, rs, 0xB1, 0xf);
      rs += DPP_F(rs, rs, 0x4E, 0xf);
      rs += DPP_F(rs, rs, 0x141, 0xf);
      rs += DPP_F(rs, rs, 0x140, 0xf);
      lrow[r] = lrow[r] * alpha + rs;
      mrow[r] = mnew;
#pragma unroll
      for (int j = 0; j < 4; j++) o[j][r] *= alpha;
    }
#pragma unroll
    for (int j = 0; j < 4; j++)
#pragma unroll
      for (int r = 0; r < 4; r++) sPw[(l4 * 4 + r) * 72 + j * 16 + l15] = f2bf(s[j][r]);
    __builtin_amdgcn_s_waitcnt(0xc07f);
    __builtin_amdgcn_wave_barrier();
#pragma unroll
    for (int ks = 0; ks < 2; ks++) {
      bf16x8 pf = *(const bf16x8*)(sPw + l15 * 72 + ks * 32 + l4 * 8);
#pragma unroll
      for (int jn = 0; jn < 4; jn++) {
        bf16x8 vf = *(const bf16x8*)(sVt + (jn * 16 + l15) * 72 + ks * 32 + l4 * 8);
        o[jn] = __builtin_amdgcn_mfma_f32_16x16x32_bf16(pf, vf, o[jn], 0, 0, 0);
      }
    }
  }
#pragma unroll
  for (int r = 0; r < 4; r++) {
    float lsum = lrow[r];
    if (has_sink) lsum += __expf(sink - mrow[r]);
    float inv = 1.f / lsum;
#pragma unroll
    for (int jn = 0; jn < 4; jn++)
      Op[(size_t)(q0 + w * 16 + l4 * 4 + r) * 1024 + jn * 16 + l15] = f2bf(o[jn][r] * inv);
  }
}

__device__ __forceinline__ int gla_tok(int tb, int c, int dir, int tau) { return tb + c * 64 + (dir ? 63 - tau : tau); }

#define GLA_W2_OFF 40960
__device__ __forceinline__ void gla_stage_w2(const P& p, int l, char* smem) {
  float* w2s = (float*)(smem + GLA_W2_OFF);
  const int tid = tidx();
  __syncthreads();
#pragma unroll
  for (int i = 0; i < 2; i++) {
    int e = (tid + i * 256) * 4;
    *(float4*)(w2s + e) = *(const float4*)(p.w_gla_a_fwd + l * 2048 + e);
    *(float4*)(w2s + 2048 + e) = *(const float4*)(p.w_gla_a_bwd + l * 2048 + e);
  }
  if (tid < 128) w2s[4096 + tid] = p.b_gla_a_fwd[l * 128 + tid];
  else w2s[4096 + tid] = p.b_gla_a_bwd[l * 128 + tid - 128];
  __syncthreads();
}
__device__ __forceinline__ void gla_load_alow(const P& p, int tok, int dir, float4 (&al)[4]) {
  const float* src = W_hbuf + (size_t)tok * 1984 + (dir ? 1456 : 1440);
#pragma unroll
  for (int q = 0; q < 4; q++) al[q] = *(const float4*)(src + q * 4);
}
__device__ __forceinline__ void gla_cum_regs(const char* smem, const float4 (&al)[4], int h, int dir, int w, int lane, float (&c)[8], float (&tot)[8]) {
  const float* w2 = (const float*)(smem + GLA_W2_OFF) + dir * 2048 + h * 32 + w * 8;
  const float* b2 = (const float*)(smem + GLA_W2_OFF) + 4096 + dir * 128 + h * 32 + w * 8;
  float a[16];
#pragma unroll
  for (int q = 0; q < 4; q++) { a[q * 4] = al[q].x; a[q * 4 + 1] = al[q].y; a[q * 4 + 2] = al[q].z; a[q * 4 + 3] = al[q].w; }
#pragma unroll
  for (int j = 0; j < 8; j++) {
    float z = b2[j];
#pragma unroll
    for (int r = 0; r < 16; r++) z += a[r] * w2[r * 128 + j];
    float la = logsigf(z) * (1.f / 16.f);
    float v = la;
#pragma unroll
    for (int d = 1; d < 64; d <<= 1) { float t_ = __shfl_up(v, d); if (lane >= d) v += t_; }
    float total = __shfl(v, 63);
    c[j] = dir ? (total - v + la) : v;
    tot[j] = total;
  }
}
__device__ __forceinline__ void gla_load_v(const P& p, int tok, int h, int w, float4 (&vr)[4]) {
  const float* src = W_hbuf + (size_t)tok * 1984 + 928 + h * 64 + w * 16;
#pragma unroll
  for (int q = 0; q < 4; q++) vr[q] = *(const float4*)(src + q * 4);
}
__device__ __forceinline__ void gla_store_vt(const float4 (&vr)[4], int w, int lane, bf16_t* sVt) {
#pragma unroll
  for (int q = 0; q < 4; q++) {
    sVt[(w * 16 + q * 4 + 0) * 72 + lane] = f2bf(vr[q].x);
    sVt[(w * 16 + q * 4 + 1) * 72 + lane] = f2bf(vr[q].y);
    sVt[(w * 16 + q * 4 + 2) * 72 + lane] = f2bf(vr[q].z);
    sVt[(w * 16 + q * 4 + 3) * 72 + lane] = f2bf(vr[q].w);
  }
}

__device__ __forceinline__ void chunk_info(int cidx, int& tb, int& nch, int& n, int& cbase) {
  if (cidx < 128) { int b = cidx >> 2; n = cidx & 3; nch = 4; tb = b * 256; cbase = b * 4; }
  else { int cl = cidx - 128, b = cl >> 5; n = cl & 31; nch = 32; tb = T_CTX + b * 2048; cbase = 128 + b * 32; }
}

__device__ __forceinline__ void gla_g1_item(const P& p, int l, int item, char* smem) {
  bf16_t* sKeT = (bf16_t*)smem;
  bf16_t* sVt = sKeT + 32 * 72;
  const int tid = tidx(), lane = tid & 63, w = __builtin_amdgcn_readfirstlane(tid >> 6), l15 = lane & 15, l4 = lane >> 4;
  int dir = item & 1, h = (item >> 1) & 3, cidx = item >> 3;
  int tb, nch, n, cbase;
  chunk_info(cidx, tb, nch, n, cbase);
  int c = dir ? nch - 1 - n : n;
  int tok = tb + c * 64 + lane;
  float4 al[4], vr[4];
  gla_load_alow(p, tok, dir, al);
  const float* kr = W_hbuf + (size_t)tok * 1984 + 800 + h * 32 + w * 8;
  float4 k0 = *(const float4*)kr, k1 = *(const float4*)(kr + 4);
  gla_load_v(p, tok, h, w, vr);
  float cs[8], tot[8];
  gla_cum_regs(smem, al, h, dir, w, lane, cs, tot);
  __syncthreads();
  {
    float kk[8] = {k0.x, k0.y, k0.z, k0.w, k1.x, k1.y, k1.z, k1.w};
#pragma unroll
    for (int j = 0; j < 8; j++) sKeT[(w * 8 + j) * 72 + lane] = f2bf(kk[j] * __expf(tot[j] - cs[j]));
  }
  gla_store_vt(vr, w, lane, sVt);
  __syncthreads();
  f32x4 acc[2] = {f32x4{0.f, 0.f, 0.f, 0.f}, f32x4{0.f, 0.f, 0.f, 0.f}};
#pragma unroll
  for (int ks = 0; ks < 2; ks++) {
    bf16x8 bv = *(const bf16x8*)(sVt + (w * 16 + l15) * 72 + ks * 32 + l4 * 8);
#pragma unroll
    for (int mt = 0; mt < 2; mt++) {
      bf16x8 av = *(const bf16x8*)(sKeT + (mt * 16 + l15) * 72 + ks * 32 + l4 * 8);
      acc[mt] = __builtin_amdgcn_mfma_f32_16x16x32_bf16(av, bv, acc[mt], 0, 0, 0);
    }
  }
  float* dst = W_un + (size_t)item * 2048;
#pragma unroll
  for (int mt = 0; mt < 2; mt++)
#pragma unroll
    for (int r = 0; r < 4; r++) dst[(mt * 16 + l4 * 4 + r) * 64 + w * 16 + l15] = acc[mt][r];
  if (lane == 0) {
#pragma unroll
    for (int j = 0; j < 8; j++) W_gn[item * 32 + w * 8 + j] = __expf(tot[j]);
  }
}

__device__ __forceinline__ void phase_gla_scan(const P& p, int l) {
  for (int it = blockIdx.x; it < 2176; it += gridDim.x) {
    int e = it * 256 + tidx();
    int kv = e & 2047, sd = e >> 11, dir = sd & 1, h = (sd >> 1) & 3, seq = ((sd >> 3) + 32) % 34;
    int nch, cbase;
    float s;
    if (seq < 32) { nch = 4; cbase = seq * 4; s = 0.f; }
    else { int b = seq - 32; nch = 32; cbase = 128 + b * 32; s = p.state_gla[((size_t)(((b * 2 + l) * 2 + dir) * 4 + h)) * 2048 + kv]; }
    for (int n0 = 0; n0 < nch; n0 += 4) {
      float gv[4], uv[4];
#pragma unroll
      for (int k = 0; k < 4; k++) {
        int item = ((cbase + n0 + k) * 4 + h) * 2 + dir;
        gv[k] = W_gn[item * 32 + (kv >> 6)];
        uv[k] = W_un[(size_t)item * 2048 + kv];
      }
#pragma unroll
      for (int k = 0; k < 4; k++) {
        int item = ((cbase + n0 + k) * 4 + h) * 2 + dir;
        W_sin_[(size_t)item * 2048 + kv] = s;
        s = gv[k] * s + uv[k];
      }
    }
    if (seq < 32) p.out[19398656 + ((size_t)(((seq * 2 + l) * 2 + dir) * 4 + h)) * 2048 + kv] = s;
  }
}

__device__ __forceinline__ void phase_gla_out(const P& p, int l, char* smem) {
  bf16_t* sQe = (bf16_t*)smem;
  bf16_t* sKe = sQe + 64 * 40;
  bf16_t* sSt = sKe + 64 * 40;
  bf16_t* sVt = sSt + 64 * 40;
  bf16_t* sAtt = sVt + 64 * 72;
  const int tid = tidx(), lane = tid & 63, w = __builtin_amdgcn_readfirstlane(tid >> 6), l15 = lane & 15, l4 = lane >> 4;
  gla_stage_w2(p, l, smem);
  for (int it = blockIdx.x; it < 768; it += gridDim.x) {
    int h = it & 3, cidx = it >> 2;
    int tb, nch, c, cbase;
    chunk_info(cidx, tb, nch, c, cbase);
    const int tok = tb + c * 64 + lane;
    f32x4 o[4];
#pragma unroll
    for (int j = 0; j < 4; j++) o[j] = f32x4{0.f, 0.f, 0.f, 0.f};
    float4 vr[4], alf[4], alb[4];
    gla_load_v(p, tok, h, w, vr);
    gla_load_alow(p, tok, 0, alf);
    gla_load_alow(p, tok, 1, alb);
    const float* qr = W_hbuf + (size_t)tok * 1984 + 672 + h * 32 + w * 8;
    const float* kr = qr + 128;
    const float4 q0 = *(const float4*)qr, q1 = *(const float4*)(qr + 4), k0 = *(const float4*)kr, k1 = *(const float4*)(kr + 4);
    float sinv[2][8];
#pragma unroll
    for (int dir = 0; dir < 2; dir++) {
      int n = dir ? nch - 1 - c : c;
      int item = ((cbase + n) * 4 + h) * 2 + dir;
      const float* sin = W_sin_ + (size_t)item * 2048 + (w * 8) * 64 + lane;
#pragma unroll
      for (int j = 0; j < 8; j++) sinv[dir][j] = sin[j * 64];
    }
    float gpre[4][4];
#pragma unroll
    for (int r = 0; r < 4; r++)
#pragma unroll
      for (int jn = 0; jn < 4; jn++) gpre[r][jn] = W_hbuf[(size_t)(tb + c * 64 + w * 16 + l4 * 4 + r) * 1984 + 1184 + h * 64 + jn * 16 + l15];
    __syncthreads();
    gla_store_vt(vr, w, lane, sVt);
#pragma unroll
    for (int dir = 0; dir < 2; dir++) {
      float cs[8], tot[8];
      gla_cum_regs(smem, dir ? alb : alf, h, dir, w, lane, cs, tot);
      if (dir) __syncthreads();
      {
        float qq[8] = {q0.x, q0.y, q0.z, q0.w, q1.x, q1.y, q1.z, q1.w};
        float kk[8] = {k0.x, k0.y, k0.z, k0.w, k1.x, k1.y, k1.z, k1.w};
        bf16x8 qv, kv, sv;
#pragma unroll
        for (int j = 0; j < 8; j++) {
          float cm = __shfl(cs[j], 32);
          qv[j] = (short)f2bf(qq[j] * 0.17677669529663687f * __expf(cs[j] - cm));
          kv[j] = (short)f2bf(kk[j] * __expf(cm - cs[j]));
          sv[j] = (short)f2bf(sinv[dir][j] * __expf(cm));
        }
        *(bf16x8*)(sQe + lane * 40 + w * 8) = qv;
        *(bf16x8*)(sKe + lane * 40 + w * 8) = kv;
        *(bf16x8*)(sSt + lane * 40 + w * 8) = sv;
      }
      __syncthreads();
      bf16x8 qa = *(const bf16x8*)(sQe + (w * 16 + l15) * 40 + l4 * 8);
#pragma unroll
      for (int jc = 0; jc < 4; jc++) {
        bf16x8 kb = *(const bf16x8*)(sKe + (jc * 16 + l15) * 40 + l4 * 8);
        f32x4 sacc = __builtin_amdgcn_mfma_f32_16x16x32_bf16(qa, kb, f32x4{0.f, 0.f, 0.f, 0.f}, 0, 0, 0);
#pragma unroll
        for (int r = 0; r < 4; r++) {
          int trow = w * 16 + l4 * 4 + r, scol = jc * 16 + l15;
          bool keep = dir ? (scol >= trow) : (scol <= trow);
          sAtt[trow * 72 + scol] = f2bf(keep ? sacc[r] : 0.f);
        }
      }
      __syncthreads();
#pragma unroll
      for (int ks = 0; ks < 2; ks++) {
        bf16x8 aa = *(const bf16x8*)(sAtt + (w * 16 + l15) * 72 + ks * 32 + l4 * 8);
#pragma unroll
        for (int jn = 0; jn < 4; jn++) {
          bf16x8 vb = *(const bf16x8*)(sVt + (jn * 16 + l15) * 72 + ks * 32 + l4 * 8);
          o[jn] = __builtin_amdgcn_mfma_f32_16x16x32_bf16(aa, vb, o[jn], 0, 0, 0);
        }
      }
#pragma unroll
      for (int jn = 0; jn < 4; jn++) {
        bf16x8 sb = *(const bf16x8*)(sSt + (jn * 16 + l15) * 40 + l4 * 8);
        o[jn] = __builtin_amdgcn_mfma_f32_16x16x32_bf16(qa, sb, o[jn], 0, 0, 0);
      }
    }
#pragma unroll
    for (int r = 0; r < 4; r++) {
      float ss = o[0][r] * o[0][r] + o[1][r] * o[1][r] + o[2][r] * o[2][r] + o[3][r] * o[3][r];
      ss += DPP_F(ss, ss, 0xB1, 0xf);
      ss += DPP_F(ss, ss, 0x4E, 0xf);
      ss += DPP_F(ss, ss, 0x141, 0xf);
      ss += DPP_F(ss, ss, 0x140, 0xf);
      float rs = rsqrtf(ss * (1.f / 64.f) + 1e-6f);
      int tk = tb + c * 64 + w * 16 + l4 * 4 + r;
      const float* grow = W_hbuf + (size_t)tk * 1984 + 1184 + h * 64;
      bf16_t* dst = W_br + (size_t)tk * 1024 + 512 + h * 64;
#pragma unroll
      for (int jn = 0; jn < 4; jn++) {
        int vcol = jn * 16 + l15;
        float val = o[jn][r] * rs * p.gla_norm[l * 64 + vcol];
        dst[vcol] = f2bf(val * siluf(gpre[r][jn]));
      }
    }
  }
}

__device__ __forceinline__ void phase_mixers(const P& p, int l, char* smem) {
  const int N_MLAL = 256, N_DFTL = 64, N_SWAL = 256, N_MLAC = 512, N_SWAC = 512, N_DFTC = 128, N_G1 = 1536;
  const int total = N_MLAL + N_DFTL + N_SWAL + N_MLAC + N_SWAC + N_DFTC + N_G1;
  gla_stage_w2(p, l, smem);
  for (int r_ = 0; r_ * (int)gridDim.x < total; r_++) {
    int it0 = r_ * gridDim.x + ((r_ & 1) ? (gridDim.x - 1 - blockIdx.x) : blockIdx.x);
    if (it0 >= total) continue;
    int it = it0;
    int type;
    bool lat = false;
    if (it < N_MLAL) { type = 0; lat = true; }
    else if ((it -= N_MLAL) < N_DFTL) { type = 2; lat = true; }
    else if ((it -= N_DFTL) < N_SWAL) { type = 1; lat = true; }
    else if ((it -= N_SWAL) < N_MLAC) { type = 0; }
    else if ((it -= N_MLAC) < N_SWAC) { type = 1; }
    else if ((it -= N_SWAC) < N_DFTC) { type = 2; }
    else { it -= N_DFTC; type = 3; }
#ifdef DUPTYPE
    for (int rep_ = 0; rep_ < ((type == (DUPTYPE & 3) && (int)lat == (DUPTYPE >> 2)) ? 2 : 1); rep_++)
#endif
    if (type == 0) {
      int qt, h, b, Sk;
      size_t tok0;
      if (lat) { qt = it & 31; h = (it >> 5) & 3; b = it >> 7; tok0 = T_CTX + b * 2048; Sk = 2560; }
      else { qt = it & 3; h = (it >> 2) & 3; b = it >> 4; tok0 = b * 256; Sk = 256; }
      const bf16_t* Kp = (lat ? W_Ka_lat : W_Ka_ctx) + (size_t)(b * 4 + h) * Sk * 96;
      const bf16_t* Vp = (lat ? W_Va_lat : W_Va_ctx) + (size_t)(b * 4 + h) * Sk * 64;
      attn_item<96>(W_Qa + tok0 * 384 + h * 96, 384, Kp, Vp, W_br + tok0 * 1024 + h * 64, qt * 64, Sk, 0, -1,
                    0.10206207261596575f, false, 0.f, smem);
    } else if (type == 1) {
      int qt, hq, b, Sk, nctx, W;
      size_t tok0;
      if (lat) { qt = it & 31; hq = (it >> 5) & 3; b = it >> 7; tok0 = T_CTX + b * 2048; Sk = 2560; nctx = 512; W = 128; }
      else { qt = it & 3; hq = (it >> 2) & 3; b = it >> 4; tok0 = b * 256; Sk = 256; nctx = 0; W = -1; }
      int kv = hq >> 1;
      const bf16_t* Kp = (lat ? W_Kd_lat : W_Kd_ctx) + (size_t)(b * 2 + kv) * Sk * 64;
      const bf16_t* Vp = (lat ? W_Vd_lat : W_Vd_ctx) + (size_t)(b * 2 + kv) * Sk * 64;
      attn_item<64>(W_Qd + tok0 * 256 + hq * 64, 256, Kp, Vp, W_br + tok0 * 1024 + 768 + hq * 64, qt * 64, Sk, nctx, W,
                    0.125f, true, p.swa_sink[l * 4 + hq], smem);
    } else if (type == 2) {
      int nt = it & 1, mt, b, S;
      size_t tok0;
      if (lat) { mt = (it >> 1) & 15; b = it >> 5; S = 2048; tok0 = T_CTX + b * 2048; }
      else { mt = (it >> 1) & 1; b = it >> 2; S = 256; tok0 = b * 256; }
      const bf16_t* Ap = (lat ? W_A2048 : W_A256) + (size_t)mt * 128 * 2 * S;
      const bf16_t* Bp = (lat ? W_Yt_lat : W_Yt_ctx) + (size_t)(b * 256 + nt * 128) * 2 * S;
      f32x4 acc[4][4];
      ZERO_ACC(acc);
      gemm_core(acc, Ap, 2 * S, Bp, 2 * S, 2 * S, smem);
      EPI_LOOP(acc, mt * 128, nt * 128, { W_br[(tok0 + m) * 1024 + 256 + n] = f2bf(v); });
    } else {
      gla_g1_item(p, l, it, smem);
    }
  }
}

#define EPI4_LOOP_N(acc, c0, t0, NJ, ...)                                                  \
  {                                                                                        \
    const int lane_ = tidx() & 63, w_ = tidx() >> 6, wm_ = w_ >> 1, wn_ = w_ & 1;           \
    _Pragma("unroll") for (int i_ = 0; i_ < 4; i_++)                                       \
    _Pragma("unroll") for (int j_ = 0; j_ < NJ; j_++) {                                    \
      const int col = (c0) + wm_ * 64 + i_ * 16 + (lane_ >> 4) * 4;                        \
      const int tok = (t0) + wn_ * (NJ * 16) + j_ * 16 + (lane_ & 15);                     \
      const f32x4 v4 = acc[i_][j_];                                                        \
      __VA_ARGS__                                                                          \
    }                                                                                      \
  }
__device__ __forceinline__ void phase_merge(const P& p, int l, char* smem) {
  constexpr int NJ = 2;
  bf16_t* sa = (bf16_t*)smem;
  bf16_t* sb = sa + 128 * GB_LD;
  const int tid = tidx(), lane = tid & 63, w = tid >> 6, wm = w >> 1, wn = w & 1;
  const int l15 = lane & 15, l4 = lane >> 4;
  for (int tile = blockIdx.x; tile < 192 * 8; tile += gridDim.x) {
    int tt = tile >> 3, nt = tile & 7, t0 = tt * 64, n0 = nt * 128;
    const bf16_t* A = W_Wt_br + ((size_t)l * 1024 + n0) * 1024;
    const bf16_t* B = W_br + (size_t)t0 * 1024;
    const int lda = 1024, ldb = 1024, K = 1024;
    f32x4 tot[4][2], acc[4][2];
    ZERO_ACC_N(tot, 2);
    ZERO_ACC_N(acc, 2);
    u32x4 ra0[4], rb0[NJ], ra1[4], rb1[NJ];
    G_LOAD(ra0, rb0, 0);
    G_LOAD(ra1, rb1, 64);
    ushort4 gl[4][2];
    for (int k0 = 0; k0 < K; k0 += 128) {
      const bool seg_end = (k0 & 128) != 0;
      const int bidx = k0 >> 8;
      if (seg_end) {
#pragma unroll
        for (int i_ = 0; i_ < 4; i_++)
#pragma unroll
          for (int j_ = 0; j_ < 2; j_++) {
            int col = n0 + wm * 64 + i_ * 16 + l4 * 4, tok = t0 + wn * 32 + j_ * 16 + l15;
            gl[i_][j_] = *(const ushort4*)(W_gates + (size_t)tok * 4096 + bidx * 1024 + col);
          }
      }
      __syncthreads();
      G_STORE(ra0, rb0);
      __syncthreads();
      if (k0 + 128 < K) { G_LOAD(ra0, rb0, k0 + 128); }
      G_COMPUTE();
      __syncthreads();
      G_STORE(ra1, rb1);
      __syncthreads();
      if (k0 + 192 < K) { G_LOAD(ra1, rb1, k0 + 192); }
      G_COMPUTE();
      if (seg_end) {
#pragma unroll
        for (int i_ = 0; i_ < 4; i_++)
#pragma unroll
          for (int j_ = 0; j_ < 2; j_++) {
            tot[i_][j_][0] += bf2f(gl[i_][j_].x) * acc[i_][j_][0];
            tot[i_][j_][1] += bf2f(gl[i_][j_].y) * acc[i_][j_][1];
            tot[i_][j_][2] += bf2f(gl[i_][j_].z) * acc[i_][j_][2];
            tot[i_][j_][3] += bf2f(gl[i_][j_].w) * acc[i_][j_][3];
            acc[i_][j_] = f32x4{0.f, 0.f, 0.f, 0.f};
          }
      }
    }
    EPI4_LOOP_N(tot, n0, t0, 2, {
      ushort4 o_; o_.x = f2bf(v4[0]); o_.y = f2bf(v4[1]); o_.z = f2bf(v4[2]); o_.w = f2bf(v4[3]);
      *(ushort4*)(W_u + (size_t)tok * 1024 + col) = o_;
    });
  }
}

__device__ __forceinline__ void phase_wout(const P& p, int l, char* smem) {
  float* r = W_hbuf;
  const float alpha = 1.4142135623730951f;
  for (int tile = blockIdx.x; tile < 96 * 8; tile += gridDim.x) {
    int mt = tile >> 3, nt = tile & 7, m0 = mt * 128, n0 = nt * 128;
    f32x4 acc[4][4];
    ZERO_ACC(acc);
    gemm_core(acc, W_Wt_out + ((size_t)l * 1024 + n0) * 1024, 1024, W_u + (size_t)m0 * 1024, 1024, 1024, smem);
    const float* g1 = W_mada + (l * 3 + cond_row(m0)) * 6144 + 2048;
    {
      const int lane_ = tidx() & 63, w_ = tidx() >> 6, wm_ = w_ >> 1, wn_ = w_ & 1;
#pragma unroll
      for (int ih = 0; ih < 2; ih++) {
        float4 xv[8];
#pragma unroll
        for (int q = 0; q < 8; q++) {
          int i_ = ih * 2 + (q >> 2), j_ = q & 3;
          int col = n0 + wm_ * 64 + i_ * 16 + (lane_ >> 4) * 4, tok = m0 + wn_ * 64 + j_ * 16 + (lane_ & 15);
          xv[q] = *(const float4*)(x_in_row(p, l, tok) + col);
        }
#pragma unroll
        for (int q = 0; q < 8; q++) {
          int i_ = ih * 2 + (q >> 2), j_ = q & 3;
          int col = n0 + wm_ * 64 + i_ * 16 + (lane_ >> 4) * 4, tok = m0 + wn_ * 64 + j_ * 16 + (lane_ & 15);
          float4 gv = *(const float4*)(g1 + col);
          f32x4 v4 = acc[i_][j_];
          *(float4*)(r + (size_t)tok * 1024 + col) = float4{alpha * xv[q].x + gv.x * v4[0], alpha * xv[q].y + gv.y * v4[1], alpha * xv[q].z + gv.z * v4[2], alpha * xv[q].w + gv.w * v4[3]};
        }
      }
    }
  }
}

__device__ __forceinline__ void phase_ln_mid(const P& p, int l) {
  int lane = tidx() & 63, w = tidx() >> 6;
  const float* r = W_hbuf;
  for (int it = blockIdx.x; it < T_ALL / 4; it += gridDim.x) {
    int g = it * 4 + w;
    float v[16];
    load_row16(r + (size_t)g * 1024, lane, v);
    ln16(v);
    affine16(v, p.ln1_g + l * 1024, p.ln1_b + l * 1024, lane);
    store_row16(x_out_row(p, l, g), lane, v);
    ln16(v);
    const float* m = W_mada + (l * 3 + cond_row(g)) * 6144;
    modulate_store(v, m + 3072, m + 4096, W_u + (size_t)g * 1024, lane);
  }
}

__device__ __forceinline__ void phase_pq(const P& p, int l, char* smem) {
  float* sc = (float*)W_gates;
  bf16_t* sa = (bf16_t*)smem;
  const int tid = tidx(), lane = tid & 63, w = tid >> 6, wm = w >> 1, wn = w & 1, l15 = lane & 15, l4 = lane >> 4;
  for (int tile = blockIdx.x; tile < 96 * 16; tile += gridDim.x) {
    int mt = tile >> 4, hp = tile & 15, m0 = mt * 128, n0 = hp * 128;
    f32x4 acc[4][4];
    ZERO_ACC(acc);
    gemm_core(acc, W_Wt_pq + ((size_t)l * 2048 + n0) * 1024, 1024, W_u + (size_t)m0 * 1024, 1024, 1024, smem);
    __syncthreads();
    {
      bf16_t* sB = sa + 128 * GB_LD * (1 + wm);
#pragma unroll
      for (int i = 0; i < 4; i++)
#pragma unroll
        for (int j = 0; j < 4; j++) {
          ushort4 o_;
          o_.x = f2bf(acc[i][j][0]); o_.y = f2bf(acc[i][j][1]); o_.z = f2bf(acc[i][j][2]); o_.w = f2bf(acc[i][j][3]);
          *(ushort4*)(sB + (wn * 64 + j * 16 + l15) * GB_LD + i * 16 + l4 * 4) = o_;
        }
    }
    f32x4 acc2[4][4];
    ZERO_ACC(acc2);
    const bf16_t* keys = W_keysbf + (size_t)(l * 16 + hp) * 128 * 128;
#pragma unroll
    for (int kh = 0; kh < 2; kh++) {
      u32x4 rk[4];
#pragma unroll
      for (int i = 0; i < 4; i++) { int c = tid + i * 256, r = c >> 3, cc = (c & 7) * 8; rk[i] = *(const u32x4*)(keys + r * 128 + kh * 64 + cc); }
      if (kh) __syncthreads();
#pragma unroll
      for (int i = 0; i < 4; i++) { int c = tid + i * 256, r = c >> 3, cc = (c & 7) * 8; *(u32x4*)(sa + r * GB_LD + cc) = rk[i]; }
      __syncthreads();
      const bf16_t* sBk = sa + 128 * GB_LD * (1 + kh);
#pragma unroll
      for (int ks = 0; ks < 2; ks++) {
        bf16x8 af[4], bfr[4];
#pragma unroll
        for (int i = 0; i < 4; i++) af[i] = *(const bf16x8*)(sa + (wm * 64 + i * 16 + l15) * GB_LD + ks * 32 + l4 * 8);
#pragma unroll
        for (int j = 0; j < 4; j++) bfr[j] = *(const bf16x8*)(sBk + (wn * 64 + j * 16 + l15) * GB_LD + ks * 32 + l4 * 8);
#pragma unroll
        for (int i = 0; i < 4; i++)
#pragma unroll
          for (int j = 0; j < 4; j++) acc2[i][j] = __builtin_amdgcn_mfma_f32_16x16x32_bf16(af[i], bfr[j], acc2[i][j], 0, 0, 0);
      }
    }
    EPI_LOOP(acc2, 0, m0, { sc[((size_t)(hp * 128 + m)) * T_ALL + n] = v; });
  }
}

__device__ __forceinline__ void phase_scores(const P& p, int l, char* smem) {}

__device__ __forceinline__ int f2sort(float x) { int b = __float_as_int(x); return b ^ ((b >> 31) & 0x7fffffff); }
__device__ __forceinline__ float sort2f(int s) { return __int_as_float(s ^ ((s >> 31) & 0x7fffffff)); }
__device__ __forceinline__ void bitonic_sort16_desc(int (&a)[16]) {
#pragma unroll
  for (int k = 2; k <= 16; k <<= 1)
#pragma unroll
    for (int j = k >> 1; j > 0; j >>= 1)
#pragma unroll
      for (int i = 0; i < 16; i++) {
        int l_ = i ^ j;
        if (l_ > i) {
          int hi = max(a[i], a[l_]), lo = min(a[i], a[l_]);
          if ((i & k) == 0) { a[i] = hi; a[l_] = lo; } else { a[i] = lo; a[l_] = hi; }
        }
      }
}
__device__ __forceinline__ void merge_top16(int (&T)[16], const int (&S)[16]) {
#pragma unroll
  for (int i = 0; i < 16; i++) T[i] = max(T[i], S[15 - i]);
#pragma unroll
  for (int j = 8; j > 0; j >>= 1)
#pragma unroll
    for (int i = 0; i < 16; i++) {
      int l_ = i ^ j;
      if (l_ > i) { int hi = max(T[i], T[l_]), lo = min(T[i], T[l_]); T[i] = hi; T[l_] = lo; }
    }
}
__device__ __forceinline__ void top16_col(const float* src, int (&L)[16]) {
#pragma unroll 1
  for (int k0 = 0; k0 < 128; k0 += 16) {
    float xv[16];
#pragma unroll
    for (int k = 0; k < 16; k++) xv[k] = src[(size_t)(k0 + k) * T_ALL];
    int S[16];
#pragma unroll
    for (int k = 0; k < 16; k++) S[k] = (f2sort(xv[k]) & ~127) | (127 - (k0 + k));
    bitonic_sort16_desc(S);
    if (k0 == 0) {
#pragma unroll
      for (int k = 0; k < 16; k++) L[k] = S[k];
    } else {
      merge_top16(L, S);
    }
  }
}
__device__ __forceinline__ void phase_topk(const P& p, int l) {
  const float* sc = (const float*)W_gates;
  int lane = tidx() & 63, w = tidx() >> 6;
  for (int it = blockIdx.x * 4 + w; it < 192 * 8; it += gridDim.x * 4) {
    int h = it & 7, t = (it >> 3) * 64 + lane;
    int L1[16], L2[16];
    const float* s1 = sc + (size_t)(h * 2) * 128 * T_ALL + t;
    top16_col(s1, L1);
    top16_col(s1 + (size_t)128 * T_ALL, L2);
    float v1[16], v2[16];
    unsigned P1[4] = {0u, 0u, 0u, 0u}, P2[4] = {0u, 0u, 0u, 0u};
#pragma unroll
    for (int i = 0; i < 16; i++) {
      v1[i] = sort2f(L1[i] & ~127);
      v2[i] = sort2f(L2[i] & ~127);
      P1[i >> 2] |= (unsigned)(127 - (L1[i] & 127)) << ((i & 3) * 8);
      P2[i >> 2] |= (unsigned)(127 - (L2[i] & 127)) << ((i & 3) * 8);
    }
    int Tk[16];
#pragma unroll
    for (int j = 0; j < 16; j++) Tk[j] = (f2sort(v1[0] + v2[j]) & ~255) | (255 - j);
    {
      int G[3][16];
#pragma unroll
      for (int g_ = 0; g_ < 3; g_++)
#pragma unroll
        for (int k = 0; k < 16; k++) G[g_][k] = (int)0x80000000;
      int cnt = 0;
#pragma unroll
      for (int i = 1; i < 16; i++) {
#pragma unroll
        for (int j = 0; j < 16 / (i + 1); j++) {
          G[cnt >> 4][cnt & 15] = (f2sort(v1[i] + v2[j]) & ~255) | (255 - (i * 16 + j));
          cnt++;
        }
      }
#pragma unroll
      for (int g_ = 0; g_ < 3; g_++) { bitonic_sort16_desc(G[g_]); merge_top16(Tk, G[g_]); }
    }
    float v0 = sort2f(Tk[0] & ~255);
    float e[16], Z = 0.f;
    int oi[16];
#pragma unroll
    for (int s_ = 0; s_ < 16; s_++) {
      e[s_] = __expf(sort2f(Tk[s_] & ~255) - v0);
      Z += e[s_];
      int code = 255 - (Tk[s_] & 255), i = code >> 4, j = code & 15;
      unsigned r1 = (i >> 2) == 0 ? P1[0] : (i >> 2) == 1 ? P1[1] : (i >> 2) == 2 ? P1[2] : P1[3];
      unsigned r2 = (j >> 2) == 0 ? P2[0] : (j >> 2) == 1 ? P2[1] : (j >> 2) == 2 ? P2[2] : P2[3];
      int i1 = (r1 >> ((i & 3) * 8)) & 255, i2 = (r2 >> ((j & 3) * 8)) & 255;
      oi[s_] = i1 * 128 + i2;
    }
    float inv = 1.f / Z;
    int* po = W_pidx + (size_t)t * 128 + h * 16;
    float* pwo = W_pw + (size_t)t * 128 + h * 16;
#pragma unroll
    for (int q = 0; q < 4; q++) {
      *(int4*)(po + q * 4) = int4{oi[q * 4], oi[q * 4 + 1], oi[q * 4 + 2], oi[q * 4 + 3]};
      *(float4*)(pwo + q * 4) = float4{e[q * 4] * inv, e[q * 4 + 1] * inv, e[q * 4 + 2] * inv, e[q * 4 + 3] * inv};
    }
  }
}

__device__ __forceinline__ void unpack16(u32x4 r, float (&f)[16]) {
#pragma unroll
  for (int q = 0; q < 4; q++) {
    auto lo = __builtin_amdgcn_cvt_pk_f32_fp8((int)r[q], false);
    auto hi = __builtin_amdgcn_cvt_pk_f32_fp8((int)r[q], true);
    f[q * 4 + 0] = lo[0]; f[q * 4 + 1] = lo[1]; f[q * 4 + 2] = hi[0]; f[q * 4 + 3] = hi[1];
  }
}
#define PEER_PF 8
#ifndef PEER_REP
#define PEER_REP 1
#endif
__device__ __forceinline__ void phase_peer(const P& p, int l, char* smem) {
  int lane = tidx() & 63, w = tidx() >> 6;
  float* scoef_w = (float*)smem + w * (8 * 128);
  const unsigned char* tu = W_tabU + (size_t)l * 16384 * 1024 + lane * 16;
  const unsigned char* tv = W_tabV + (size_t)l * 16384 * 1024 + lane * 16;
  const int nb = gridDim.x;
  const int ntok = (T_ALL / 4 - (int)blockIdx.x + nb - 1) / nb;
  for (int c0 = 0; c0 < ntok; c0 += 8) {
    const int nc = (ntok - c0) < 8 ? (ntok - c0) : 8;
    __builtin_amdgcn_wave_barrier();
    for (int t = 0; t < nc; t++) {
      const int g = ((int)blockIdx.x + (c0 + t) * nb) * 4 + w;
      float* scoef = scoef_w + t * 128;
      float uu[16];
      {
        u32x4 r0 = *(const u32x4*)(W_u + (size_t)g * 1024 + lane * 16);
        u32x4 r1 = *(const u32x4*)(W_u + (size_t)g * 1024 + lane * 16 + 8);
#pragma unroll
        for (int q = 0; q < 4; q++) {
          uu[q * 2] = __uint_as_float(r0[q] << 16); uu[q * 2 + 1] = __uint_as_float(r0[q] & 0xffff0000u);
          uu[8 + q * 2] = __uint_as_float(r1[q] << 16); uu[8 + q * 2 + 1] = __uint_as_float(r1[q] & 0xffff0000u);
        }
      }
      const float* pwt = W_pw + (size_t)g * 128;
      const int pi0 = W_pidx[(size_t)g * 128 + lane], pi1 = W_pidx[(size_t)g * 128 + 64 + lane];
      auto ldrows = [&](u32x4 (&r)[8], const unsigned char* tab, int e0) {
#pragma unroll
        for (int k = 0; k < 8; k++) {
          int e = e0 + k;
          int idx = __builtin_amdgcn_readlane(e < 64 ? pi0 : pi1, e & 63);
          r[k] = *(const u32x4*)(tab + (size_t)idx * 1024);
        }
      };
      float dv0 = 0.f, dv1 = 0.f;
      auto dots = [&](const u32x4 (&r)[8], int e0) {
#pragma unroll
        for (int k = 0; k < 8; k++) {
          float f[16];
          unpack16(r[k], f);
          float a = 0.f;
#pragma unroll
          for (int j = 0; j < 16; j++) a += uu[j] * f[j];
          float dd = wsum(a);
          if (e0 < 64) dv0 = (lane == e0 + k) ? dd : dv0;
          else dv1 = (lane == e0 + k - 64) ? dd : dv1;
        }
      };
      {
        u32x4 ra[8], rb[8];
        ldrows(ra, tu, 0);
#pragma unroll 1
        for (int e0 = 0; e0 < 128; e0 += 16) {
          ldrows(rb, tu, e0 + 8);
          dots(ra, e0);
          if (e0 + 16 < 128) ldrows(ra, tu, e0 + 16);
          dots(rb, e0 + 8);
        }
      }
      float d0 = dv0 * (1.f / PEER_U_SCALE), d1 = dv1 * (1.f / PEER_U_SCALE);
      float a0 = 0.5f * d0 * (1.f + erff(d0 * 0.7071067811865476f));
      float a1 = 0.5f * d1 * (1.f + erff(d1 * 0.7071067811865476f));
      scoef[lane] = pwt[lane] * a0 * (1.f / PEER_V_SCALE);
      scoef[64 + lane] = pwt[64 + lane] * a1 * (1.f / PEER_V_SCALE);
    }
    __builtin_amdgcn_s_waitcnt(0xc07f);
    __builtin_amdgcn_wave_barrier();
    for (int t = 0; t < nc; t++) {
      const int g = ((int)blockIdx.x + (c0 + t) * nb) * 4 + w;
      const float* scoef = scoef_w + t * 128;
      const int pi0 = W_pidx[(size_t)g * 128 + lane], pi1 = W_pidx[(size_t)g * 128 + 64 + lane];
      auto ldrows = [&](u32x4 (&r)[8], const unsigned char* tab, int e0) {
#pragma unroll
        for (int k = 0; k < 8; k++) {
          int e = e0 + k;
          int idx = __builtin_amdgcn_readlane(e < 64 ? pi0 : pi1, e & 63);
          r[k] = *(const u32x4*)(tab + (size_t)idx * 1024);
        }
      };
      float o[16];
#pragma unroll
      for (int j = 0; j < 16; j++) o[j] = 0.f;
      auto accum = [&](const u32x4 (&r)[8], int e0) {
#pragma unroll
        for (int k = 0; k < 8; k++) {
          float cf = scoef[e0 + k];
          float f[16];
          unpack16(r[k], f);
#pragma unroll
          for (int j = 0; j < 16; j++) o[j] += cf * f[j];
        }
      };
      {
        u32x4 ra[8], rb[8];
        ldrows(ra, tv, 0);
#pragma unroll 1
        for (int e0 = 0; e0 < 128; e0 += 16) {
          ldrows(rb, tv, e0 + 8);
          accum(ra, e0);
          if (e0 + 16 < 128) ldrows(ra, tv, e0 + 16);
          accum(rb, e0 + 8);
        }
      }
      float* xr = x_out_row(p, l, g) + lane * 16;
      const float* m = W_mada + (l * 3 + cond_row(g)) * 6144 + lane * 16;
      float x1[16];
#pragma unroll
      for (int q = 0; q < 4; q++) {
        float4 xv = *(const float4*)(xr + q * 4);
        float4 g2 = *(const float4*)(m + 5120 + q * 4);
        x1[q * 4 + 0] = 1.4142135623730951f * xv.x + g2.x * o[q * 4 + 0];
        x1[q * 4 + 1] = 1.4142135623730951f * xv.y + g2.y * o[q * 4 + 1];
        x1[q * 4 + 2] = 1.4142135623730951f * xv.z + g2.z * o[q * 4 + 2];
        x1[q * 4 + 3] = 1.4142135623730951f * xv.w + g2.w * o[q * 4 + 3];
      }
      ln16(x1);
#pragma unroll
      for (int q = 0; q < 4; q++) {
        float4 a = *(const float4*)(p.ln2_g + l * 1024 + lane * 16 + q * 4);
        float4 c = *(const float4*)(p.ln2_b + l * 1024 + lane * 16 + q * 4);
        x1[q * 4 + 0] = x1[q * 4 + 0] * a.x + c.x; x1[q * 4 + 1] = x1[q * 4 + 1] * a.y + c.y;
        x1[q * 4 + 2] = x1[q * 4 + 2] * a.z + c.z; x1[q * 4 + 3] = x1[q * 4 + 3] * a.w + c.w;
        *(float4*)(xr + q * 4) = float4{x1[q * 4], x1[q * 4 + 1], x1[q * 4 + 2], x1[q * 4 + 3]};
      }
      if (l == 0) {
        ln16(x1);
        const float* m1 = W_mada + (1 * 3 + cond_row(g)) * 6144 + lane * 16;
#pragma unroll
        for (int q = 0; q < 4; q++) {
          float4 a = *(const float4*)(m1 + 1024 + q * 4);
          float4 b = *(const float4*)(m1 + q * 4);
          ushort4 ov;
          ov.x = f2bf(x1[q * 4 + 0] * (1.f + a.x) + b.x);
          ov.y = f2bf(x1[q * 4 + 1] * (1.f + a.y) + b.y);
          ov.z = f2bf(x1[q * 4 + 2] * (1.f + a.z) + b.z);
          ov.w = f2bf(x1[q * 4 + 3] * (1.f + a.w) + b.w);
          *(ushort4*)(W_u + (size_t)g * 1024 + lane * 16 + q * 4) = ov;
        }
      }
    }
  }
}

#define N_PHASES 28
__device__ __forceinline__ void run_phase(const P& p, int ph, char* smem) {
#ifdef ONLYQ
  { int l = ph & 1; if (ONLYQ == -1) { phase_prep(p, smem); return; } if (ONLYQ == -2) { phase_ln0(p); return; }
    switch (ONLYQ) { case 0: phase_win(p, l, smem); break; case 1: phase_post(p, l); break; case 2: phase_small_gemms(p, l, smem); break; case 3: phase_mixers(p, l, smem); break; case 4: phase_gla_scan(p, l); break; case 5: phase_gla_out(p, l, smem); break; case 6: phase_merge(p, l, smem); break; case 7: phase_wout(p, l, smem); break; case 8: phase_ln_mid(p, l); break; case 9: phase_pq(p, l, smem); break; case 10: phase_scores(p, l, smem); break; case 11: phase_topk(p, l); break; case 12: phase_peer(p, l, smem); break; } return; }
#endif
  if (ph == 0) { phase_prep(p, smem); return; }
  if (ph == 1) { phase_ln0(p); return; }
  int l = (ph - 2) / 13, q = (ph - 2) % 13;
#ifdef EXCL
  if (q == EXCL) return;
#endif
  switch (q) {
    case 0: phase_win(p, l, smem); break;
    case 1: phase_post(p, l); break;
    case 2: phase_small_gemms(p, l, smem); break;
    case 3: phase_mixers(p, l, smem); break;
    case 4: phase_gla_scan(p, l); break;
    case 5: phase_gla_out(p, l, smem); break;
    case 6: phase_merge(p, l, smem); break;
    case 7: phase_wout(p, l, smem); break;
    case 8: phase_ln_mid(p, l); break;
    case 9: phase_pq(p, l, smem); break;
    case 10: phase_scores(p, l, smem); break;
    case 11: phase_topk(p, l); break;
    case 12: phase_peer(p, l, smem); break;
  }
}

#define XB_TMO      128
#define XB_XCNT(j)  (256  + 64 * (j))
#define XB_XSUB(j)  (1280 + 64 * (j))
#define XB_XGEN(j)  (2304 + 64 * (j))
#define XB_TOP      3328
#define XB_TOPGEN   3392
#define XCD_BAR_WORDS 3456
#define XB_SPIN_CAP (1u << 18)
#define LAS __attribute__((address_space(3)))

__device__ __forceinline__ unsigned xb_ld(unsigned* p)              { return __hip_atomic_load(p, __ATOMIC_RELAXED, __HIP_MEMORY_SCOPE_AGENT); }
__device__ __forceinline__ unsigned xb_add(unsigned* p, unsigned v) { return __hip_atomic_fetch_add(p, v, __ATOMIC_RELAXED, __HIP_MEMORY_SCOPE_AGENT); }
__device__ __forceinline__ unsigned xb_xcc_id() { return (unsigned)__builtin_amdgcn_s_getreg((3 << 11) | 20) & 0xFu; }
#define XB_SPIN(cond, bar) do { unsigned _sp = 0; while (cond) { __builtin_amdgcn_s_sleep(1); \
    if ((++_sp & 255u) == 0u) { if (xb_ld(&(bar)[XB_TMO])) break; if (_sp > XB_SPIN_CAP) { atomicAdd(&(bar)[XB_TMO], 1u); break; } } } } while (0)

struct XcdBarrier {
    unsigned* bar; unsigned x;
    volatile LAS unsigned* st;
};

__device__ __forceinline__ XcdBarrier xcd_barrier_post(unsigned* bar, volatile LAS unsigned* st) {
    XcdBarrier b; b.bar = bar; b.x = xb_xcc_id(); b.st = st;
    if (threadIdx.x == 0) (void)xb_add(&bar[XB_XCNT(b.x)], 1u);
    return b;
}
__device__ __forceinline__ void xcd_barrier_complete(unsigned* bar, unsigned x, unsigned& nloc, unsigned& nx) {
    const unsigned G = gridDim.x * gridDim.y * gridDim.z;
    unsigned sum, cnt, mine, sp = 0u;
    for (;;) {
        sum = 0u; cnt = 0u; mine = 0u;
#pragma unroll
        for (unsigned j = 0; j < 16; ++j) { const unsigned c = xb_ld(&bar[XB_XCNT(j)]); sum += c; cnt += (c > 0u) ? 1u : 0u; mine = (j == x) ? c : mine; }
        if (sum == G) break;
        __builtin_amdgcn_s_sleep(1);
        if ((++sp & 255u) == 0u) { if (xb_ld(&bar[XB_TMO])) break; if (sp > XB_SPIN_CAP) { atomicAdd(&bar[XB_TMO], 1u); break; } }
    }
    nloc = mine > 0u ? mine : 1u; nx = cnt > 0u ? cnt : 1u;
}

__device__ __forceinline__ void xcd_barrier(const XcdBarrier& b) {
    asm volatile("s_waitcnt vmcnt(0)" ::: "memory");
    __syncthreads();
    if (threadIdx.x == 0) {
        unsigned* bar = b.bar;
        __builtin_amdgcn_s_waitcnt(0);
        unsigned nloc = b.st[0], nx = b.st[1];
        if (nloc == 0u) { xcd_barrier_complete(bar, b.x, nloc, nx); b.st[0] = nloc; b.st[1] = nx; }
        const unsigned old = xb_add(&bar[XB_XSUB(b.x)], 1u);
        const unsigned gen = old / nloc;
        if (old + 1u == (gen + 1u) * nloc) {
            __builtin_amdgcn_fence(__ATOMIC_RELEASE, "agent");
            asm volatile("s_waitcnt vmcnt(0)" ::: "memory");
            const unsigned og = xb_add(&bar[XB_TOP], 1u);
            const unsigned tg = og / nx;
            if (og + 1u == (tg + 1u) * nx) xb_add(&bar[XB_TOPGEN], 1u);
            else XB_SPIN(xb_ld(&bar[XB_TOPGEN]) == tg, bar);
            __builtin_amdgcn_fence(__ATOMIC_ACQUIRE, "agent");
            xb_add(&bar[XB_XGEN(b.x)], 1u);
            asm volatile("s_waitcnt vmcnt(0)" ::: "memory");
        } else {
            XB_SPIN(xb_ld(&bar[XB_XGEN(b.x)]) == gen, bar);
            __builtin_amdgcn_fence(__ATOMIC_ACQUIRE, "agent");
            asm volatile("s_waitcnt vmcnt(0)" ::: "memory");
        }
    }
    __syncthreads();
}


#define SMEM_BYTES 61440

#if MULTI
__global__ void __launch_bounds__(256, 2) k_phase(P p, int ph) {
  __shared__ __attribute__((aligned(16))) char smem[SMEM_BYTES];
  run_phase(p, ph, smem);
}
#else
__global__ void __launch_bounds__(256, 2) k_mega(P p) {
  __shared__ __attribute__((aligned(16))) char smem[SMEM_BYTES];
  __shared__ uint4 xb_words;
  cg::grid_group grid = cg::this_grid();
  if (threadIdx.x == 0) xb_words = make_uint4(0u, 0u, 0u, 0u);
  __syncthreads();
  XcdBarrier xb = xcd_barrier_post((unsigned*)(p.ws + OFF_bar), (volatile LAS unsigned*)&xb_words);
#pragma nounroll
  for (int ph = 0; ph < N_PHASES; ph++) {
    if (ph >= 2 && (ph - 2) % 13 == 10) continue;
    run_phase(p, ph, smem);
#ifdef DUPMASK
    if (ph >= 2 && ((DUPMASK >> ((ph - 2) % 13)) & 1)) run_phase(p, ph, smem);
#endif
    if (ph + 1 < N_PHASES) {
      if (gridDim.y > 1) grid.sync();
      xcd_barrier(xb);
    }
  }
}
#endif

extern "C" void kernel_launch(void* const* d_in, const int* in_sizes, int n_in, void* d_out, int out_size, void* d_ws,
                              size_t ws_size, hipStream_t stream) {
  P p{};
  const float** fp = (const float**)&p;
  for (int i = 0; i < 32; i++) fp[i] = (const float*)d_in[i];
  p.out = (float*)d_out;
  p.ws = (char*)d_ws;
  size_t off = WS_TOTAL;
  if (off > ws_size) { fprintf(stderr, "ws too small: need %zu have %zu\n", off, ws_size); return; }
#if MULTI
  for (int ph = 0; ph < N_PHASES; ph++) hipLaunchKernelGGL(k_phase, dim3(512), dim3(256), 0, stream, p, ph);
#else
  static int grid_blocks = 0;
  if (!grid_blocks) {
    int dev = 0, cus = 0, per_cu = 0;
    hipGetDevice(&dev);
    hipDeviceGetAttribute(&cus, hipDeviceAttributeMultiprocessorCount, dev);
    hipOccupancyMaxActiveBlocksPerMultiprocessor(&per_cu, k_mega, 256, 0);
    if (per_cu > 2) per_cu = 2;
    grid_blocks = cus * per_cu;
  }
  hipMemsetAsync(p.ws + OFF_bar, 0, 16384, stream);
  void* args[] = {&p};
  hipError_t e = hipLaunchCooperativeKernel((void*)k_mega, dim3(grid_blocks), dim3(256), args, 0, stream);
  if (e != hipSuccess) fprintf(stderr, "cooperative launch failed: %s (grid %d)\n", hipGetErrorString(e), grid_blocks);
#endif
}
```

```cpp
#include <hip/hip_runtime.h>
#include <hip/hip_cooperative_groups.h>
#include <cstdio>
#include <cstdint>
namespace cg = cooperative_groups;

#ifndef MULTI
#define MULTI 0
#endif

typedef unsigned short bf16_t;
using bf16x8 = __attribute__((ext_vector_type(8))) short;
using f32x4 = __attribute__((ext_vector_type(4))) float;
using u32x4 = __attribute__((ext_vector_type(4))) unsigned int;

#define T_ALL 12288
#define T_CTX 8192
#define NEG_INF (-__builtin_inff())

__device__ __forceinline__ int tidx() {
  int t = threadIdx.x;
  asm volatile("" : "+v"(t));
  return t;
}
__device__ __forceinline__ bf16_t f2bf(float f) {
  unsigned u = __float_as_uint(f);
  u += 0x7fffu + ((u >> 16) & 1u);
  return (bf16_t)(u >> 16);
}
__device__ __forceinline__ float bf2f(bf16_t b) { return __uint_as_float(((unsigned)b) << 16); }
__device__ __forceinline__ float wsum_shfl(float v) {
#pragma unroll
  for (int o = 32; o; o >>= 1) v += __shfl_xor(v, o);
  return v;
}
#define DPP_F(old, src, ctrl, rm) __int_as_float(__builtin_amdgcn_update_dpp(__float_as_int(old), __float_as_int(src), ctrl, rm, 0xf, false))
__device__ __forceinline__ float wsum(float v) {
  v += DPP_F(v, v, 0xB1, 0xf);
  v += DPP_F(v, v, 0x4E, 0xf);
  v += DPP_F(v, v, 0x141, 0xf);
  v += DPP_F(v, v, 0x140, 0xf);
  v += DPP_F(0.f, v, 0x142, 0xa);
  v += DPP_F(0.f, v, 0x143, 0xc);
  return __int_as_float(__builtin_amdgcn_readlane(__float_as_int(v), 63));
}
__device__ __forceinline__ float wmax(float v) {
  v = fmaxf(v, DPP_F(v, v, 0xB1, 0xf));
  v = fmaxf(v, DPP_F(v, v, 0x4E, 0xf));
  v = fmaxf(v, DPP_F(v, v, 0x141, 0xf));
  v = fmaxf(v, DPP_F(v, v, 0x140, 0xf));
  v = fmaxf(v, DPP_F(v, v, 0x142, 0xa));
  v = fmaxf(v, DPP_F(v, v, 0x143, 0xc));
  return __int_as_float(__builtin_amdgcn_readlane(__float_as_int(v), 63));
}
__device__ __forceinline__ float siluf(float x) { return x * __builtin_amdgcn_rcpf(1.f + __expf(-x)); }
__device__ __forceinline__ float sigmf(float x) { return __builtin_amdgcn_rcpf(1.f + __expf(-x)); }
__device__ __forceinline__ float logsigf(float z) { return fminf(z, 0.f) - log1pf(__expf(-fabsf(z))); }
__device__ __forceinline__ int cond_row(int g) { return g < T_CTX ? 0 : 1 + ((g - T_CTX) >> 11); }

struct P {
  const float *x_prompt, *x_sample, *c, *cache_ckv, *cache_krope, *cache_swa_k, *cache_swa_v, *state_gla, *c_ctx,
      *w_ada, *b_ada, *w_in, *mla_q_norm, *w_uq, *mla_kv_norm, *w_ukv, *w_gla_a_fwd, *b_gla_a_fwd, *w_gla_a_bwd,
      *b_gla_a_bwd, *gla_norm, *swa_sink, *w_branch, *w_out, *ln1_g, *ln1_b, *ln2_g, *ln2_b, *w_peer_q, *peer_keys,
      *peer_u, *peer_v;
  float* out;
  char* ws;
};

constexpr size_t OFF_Wt_in = 0ull;
constexpr size_t OFF_Wt_uq = OFF_Wt_in + (((2ull * 6144 * 1024 * 2) + 255ull) & ~255ull);
constexpr size_t OFF_Wt_ukv = OFF_Wt_uq + (((2ull * 384 * 256 * 2) + 255ull) & ~255ull);
constexpr size_t OFF_Wt_br = OFF_Wt_ukv + (((2ull * 512 * 128 * 2) + 255ull) & ~255ull);
constexpr size_t OFF_Wt_out = OFF_Wt_br + (((8ull * 1024 * 256 * 2) + 255ull) & ~255ull);
constexpr size_t OFF_Wt_pq = OFF_Wt_out + (((2ull * 1024 * 1024 * 2) + 255ull) & ~255ull);
constexpr size_t OFF_keysbf = OFF_Wt_pq + (((2ull * 2048 * 1024 * 2) + 255ull) & ~255ull);
constexpr size_t OFF_Cch = OFF_keysbf + (((2ull * 16 * 128 * 128 * 2) + 255ull) & ~255ull);
constexpr size_t OFF_A256 = OFF_Cch + (((128ull * 64 * 2) + 255ull) & ~255ull);
constexpr size_t OFF_A2048 = OFF_A256 + (((256ull * 512 * 2) + 255ull) & ~255ull);
constexpr size_t OFF_mada = OFF_A2048 + (((2048ull * 4096 * 2) + 255ull) & ~255ull);
constexpr size_t OFF_xbuf = OFF_mada + (((2ull * 3 * 6144 * 4) + 255ull) & ~255ull);
constexpr size_t OFF_u = OFF_xbuf + 256ull;
constexpr size_t OFF_hbuf = OFF_u + (((12288ull * 1024 * 2) + 255ull) & ~255ull);
constexpr size_t OFF_gates = OFF_hbuf + (((12288ull * 1984 * 4) + 255ull) & ~255ull);
constexpr size_t OFF_qn = OFF_gates + (((12288ull * 4096 * 2) + 255ull) & ~255ull);
constexpr size_t OFF_ckv_all = OFF_qn + (((12288ull * 256 * 2) + 255ull) & ~255ull);
constexpr size_t OFF_Qa = OFF_ckv_all + (((13312ull * 128 * 2) + 255ull) & ~255ull);
constexpr size_t OFF_Ka_ctx = OFF_Qa + (((12288ull * 384 * 2) + 255ull) & ~255ull);
constexpr size_t OFF_Ka_lat = OFF_Ka_ctx + (((32ull * 4 * 256 * 96 * 2) + 255ull) & ~255ull);
constexpr size_t OFF_Va_ctx = OFF_Ka_lat + (((2ull * 4 * 2560 * 96 * 2) + 255ull) & ~255ull);
constexpr size_t OFF_Va_lat = OFF_Va_ctx + (((32ull * 4 * 256 * 64 * 2) + 255ull) & ~255ull);
constexpr size_t OFF_Qd = OFF_Va_lat + (((2ull * 4 * 2560 * 64 * 2) + 255ull) & ~255ull);
constexpr size_t OFF_Kd_ctx = OFF_Qd + (((12288ull * 256 * 2) + 255ull) & ~255ull);
constexpr size_t OFF_Kd_lat = OFF_Kd_ctx + (((32ull * 2 * 256 * 64 * 2) + 255ull) & ~255ull);
constexpr size_t OFF_Vd_ctx = OFF_Kd_lat + (((2ull * 2 * 2560 * 64 * 2) + 255ull) & ~255ull);
constexpr size_t OFF_Vd_lat = OFF_Vd_ctx + (((32ull * 2 * 256 * 64 * 2) + 255ull) & ~255ull);
constexpr size_t OFF_fnet = OFF_Vd_lat + (((2ull * 2 * 2560 * 64 * 2) + 255ull) & ~255ull);
constexpr size_t OFF_Yt_ctx = OFF_fnet + (((12288ull * 256 * 2) + 255ull) & ~255ull);
constexpr size_t OFF_Yt_lat = OFF_Yt_ctx + (((32ull * 256 * 512 * 2) + 255ull) & ~255ull);
constexpr size_t OFF_br = OFF_Yt_lat + (((2ull * 256 * 4096 * 2) + 255ull) & ~255ull);
constexpr size_t OFF_un = OFF_br + (((12288ull * 1024 * 2) + 255ull) & ~255ull);
constexpr size_t OFF_sin_ = OFF_un + (((1536ull * 2048 * 4) + 255ull) & ~255ull);
constexpr size_t OFF_gn = OFF_sin_ + (((1536ull * 2048 * 4) + 255ull) & ~255ull);
constexpr size_t OFF_pidx = OFF_gn + (((1536ull * 32 * 4) + 255ull) & ~255ull);
constexpr size_t OFF_pw = OFF_pidx + (((12288ull * 128 * 4) + 255ull) & ~255ull);
constexpr size_t OFF_bar = OFF_pw + (((12288ull * 128 * 4) + 255ull) & ~255ull);
constexpr size_t WS_TOTAL_OLD = OFF_pw + (((12288ull * 128 * 4) + 255ull) & ~255ull);
constexpr size_t OFF_tabU = OFF_bar + 16384ull;
constexpr size_t OFF_tabV = OFF_tabU + 2ull * 16384 * 1024;
constexpr size_t WS_TOTAL = OFF_tabV + 2ull * 16384 * 1024;
#define W_tabU ((unsigned char*)(p.ws + OFF_tabU))
#define W_tabV ((unsigned char*)(p.ws + OFF_tabV))
#define W_Wt_in ((bf16_t*)(p.ws + OFF_Wt_in))
#define W_Wt_uq ((bf16_t*)(p.ws + OFF_Wt_uq))
#define W_Wt_ukv ((bf16_t*)(p.ws + OFF_Wt_ukv))
#define W_Wt_br ((bf16_t*)(p.ws + OFF_Wt_br))
#define W_Wt_out ((bf16_t*)(p.ws + OFF_Wt_out))
#define W_Wt_pq ((bf16_t*)(p.ws + OFF_Wt_pq))
#define W_keysbf ((bf16_t*)(p.ws + OFF_keysbf))
#define W_Cch ((bf16_t*)(p.ws + OFF_Cch))
#define W_A256 ((bf16_t*)(p.ws + OFF_A256))
#define W_A2048 ((bf16_t*)(p.ws + OFF_A2048))
#define W_mada ((float*)(p.ws + OFF_mada))
#define W_xbuf ((float*)(p.ws + OFF_xbuf))
#define W_u ((bf16_t*)(p.ws + OFF_u))
#define W_hbuf ((float*)(p.ws + OFF_hbuf))
#define W_gates ((bf16_t*)(p.ws + OFF_gates))
#define W_qn ((bf16_t*)(p.ws + OFF_qn))
#define W_ckv_all ((bf16_t*)(p.ws + OFF_ckv_all))
#define W_Qa ((bf16_t*)(p.ws + OFF_Qa))
#define W_Ka_ctx ((bf16_t*)(p.ws + OFF_Ka_ctx))
#define W_Ka_lat ((bf16_t*)(p.ws + OFF_Ka_lat))
#define W_Va_ctx ((bf16_t*)(p.ws + OFF_Va_ctx))
#define W_Va_lat ((bf16_t*)(p.ws + OFF_Va_lat))
#define W_Qd ((bf16_t*)(p.ws + OFF_Qd))
#define W_Kd_ctx ((bf16_t*)(p.ws + OFF_Kd_ctx))
#define W_Kd_lat ((bf16_t*)(p.ws + OFF_Kd_lat))
#define W_Vd_ctx ((bf16_t*)(p.ws + OFF_Vd_ctx))
#define W_Vd_lat ((bf16_t*)(p.ws + OFF_Vd_lat))
#define W_fnet ((bf16_t*)(p.ws + OFF_fnet))
#define W_Yt_ctx ((bf16_t*)(p.ws + OFF_Yt_ctx))
#define W_Yt_lat ((bf16_t*)(p.ws + OFF_Yt_lat))
#define W_br ((bf16_t*)(p.ws + OFF_br))
#define W_un ((float*)(p.ws + OFF_un))
#define W_sin_ ((float*)(p.ws + OFF_sin_))
#define W_gn ((float*)(p.ws + OFF_gn))
#define W_pidx ((int*)(p.ws + OFF_pidx))
#define W_pw ((float*)(p.ws + OFF_pw))

#define GB_LD 72
#define G_LOAD(RA, RB, KOFF)                                                         \
  _Pragma("unroll") for (int i = 0; i < 4; i++) {                                    \
    int c = tid + i * 256, r = c >> 3, cc = (c & 7) * 8;                             \
    RA[i] = *(const u32x4*)(A + (size_t)r * lda + (KOFF) + cc);                      \
    if (i < NJ) RB[i] = *(const u32x4*)(B + (size_t)r * ldb + (KOFF) + cc);          \
  }
#define G_STORE(RA, RB)                                                              \
  _Pragma("unroll") for (int i = 0; i < 4; i++) {                                    \
    int c = tid + i * 256, r = c >> 3, cc = (c & 7) * 8;                             \
    *(u32x4*)(sa + r * GB_LD + cc) = RA[i];                                          \
    if (i < NJ) *(u32x4*)(sb + r * GB_LD + cc) = RB[i];                              \
  }
#define G_COMPUTE()                                                                  \
  _Pragma("unroll") for (int ks = 0; ks < 2; ks++) {                                 \
    bf16x8 af[4], bfr[NJ];                                                           \
    _Pragma("unroll") for (int i = 0; i < 4; i++)                                    \
      af[i] = *(const bf16x8*)(sa + (wm * 64 + i * 16 + l15) * GB_LD + ks * 32 + l4 * 8); \
    _Pragma("unroll") for (int j = 0; j < NJ; j++)                                   \
      bfr[j] = *(const bf16x8*)(sb + (wn * NJ * 16 + j * 16 + l15) * GB_LD + ks * 32 + l4 * 8); \
    _Pragma("unroll") for (int i = 0; i < 4; i++)                                    \
    _Pragma("unroll") for (int j = 0; j < NJ; j++)                                   \
      acc[i][j] = __builtin_amdgcn_mfma_f32_16x16x32_bf16(af[i], bfr[j], acc[i][j], 0, 0, 0); \
  }
template <int NJ>
__device__ __forceinline__ void gemm_core_t(f32x4 (&acc)[4][NJ], const bf16_t* __restrict__ A, int lda,
                                            const bf16_t* __restrict__ B, int ldb, int K, char* smem) {
  bf16_t* sa = (bf16_t*)smem;
  bf16_t* sb = sa + 128 * GB_LD;
  const int tid = tidx(), lane = tid & 63, w = tid >> 6, wm = w >> 1, wn = w & 1;
  const int l15 = lane & 15, l4 = lane >> 4;
  u32x4 ra0[4], rb0[NJ], ra1[4], rb1[NJ];
  G_LOAD(ra0, rb0, 0);
  if (K > 64) { G_LOAD(ra1, rb1, 64); }
  for (int k0 = 0; k0 < K; k0 += 128) {
    __syncthreads();
    G_STORE(ra0, rb0);
    __syncthreads();
    if (k0 + 128 < K) { G_LOAD(ra0, rb0, k0 + 128); }
    G_COMPUTE();
    if (k0 + 64 < K) {
      __syncthreads();
      G_STORE(ra1, rb1);
      __syncthreads();
      if (k0 + 192 < K) { G_LOAD(ra1, rb1, k0 + 192); }
      G_COMPUTE();
    }
  }
}
#define gemm_core gemm_core_t<4>
#define ZERO_ACC_N(acc, NJ)                                        \
  _Pragma("unroll") for (int i_ = 0; i_ < 4; i_++)                 \
  _Pragma("unroll") for (int j_ = 0; j_ < NJ; j_++) { acc[i_][j_] = f32x4{0.f, 0.f, 0.f, 0.f}; }
#define ZERO_ACC(acc) ZERO_ACC_N(acc, 4)
#define EPI_LOOP_N(acc, m0, n0, NJ, ...)                                                   \
  {                                                                                        \
    const int lane_ = tidx() & 63, w_ = tidx() >> 6, wm_ = w_ >> 1, wn_ = w_ & 1; \
    _Pragma("unroll") for (int i_ = 0; i_ < 4; i_++)                                       \
    _Pragma("unroll") for (int j_ = 0; j_ < NJ; j_++)                                      \
    _Pragma("unroll") for (int r_ = 0; r_ < 4; r_++) {                                     \
      const int m = (m0) + wm_ * 64 + i_ * 16 + (lane_ >> 4) * 4 + r_;                     \
      const int n = (n0) + wn_ * (NJ * 16) + j_ * 16 + (lane_ & 15);                       \
      float v = acc[i_][j_][r_];                                                           \
      __VA_ARGS__                                                                          \
    }                                                                                      \
  }
#define EPI_LOOP(acc, m0, n0, ...) EPI_LOOP_N(acc, m0, n0, 4, __VA_ARGS__)
#define EPI4_LOOP(acc, c0, t0, ...)                                                        \
  {                                                                                        \
    const int lane_ = tidx() & 63, w_ = tidx() >> 6, wm_ = w_ >> 1, wn_ = w_ & 1;           \
    _Pragma("unroll") for (int i_ = 0; i_ < 4; i_++)                                       \
    _Pragma("unroll") for (int j_ = 0; j_ < 4; j_++) {                                     \
      const int col = (c0) + wm_ * 64 + i_ * 16 + (lane_ >> 4) * 4;                        \
      const int tok = (t0) + wn_ * 64 + j_ * 16 + (lane_ & 15);                            \
      const f32x4 v4 = acc[i_][j_];                                                        \
      __VA_ARGS__                                                                          \
    }                                                                                      \
  }

__device__ __forceinline__ void transpose_tile(const float* __restrict__ src, int K, int N, bf16_t* __restrict__ dst, int tile, int ntn,
                               float* sm, int ldd = 0) {
  if (ldd == 0) ldd = K;
  int kt = tile / ntn, nt = tile % ntn, k0 = kt * 64, n0 = nt * 64;
  int tx = tidx() & 63, ty = tidx() >> 6;
  __syncthreads();
  for (int i = 0; i < 16; i++) {
    int k = i * 4 + ty, n = n0 + tx;
    sm[k * 65 + tx] = (n < N) ? src[(size_t)(k0 + k) * N + n] : 0.f;
  }
  __syncthreads();
  for (int i = 0; i < 16; i++) {
    int n = i * 4 + ty;
    dst[(size_t)(n0 + n) * ldd + k0 + tx] = f2bf(sm[tx * 65 + n]);
  }
}

__device__ __forceinline__ void ada_item(const P& p, int item, float* sm) {
  int l = item / 24, cgp = item % 24;
  int lane = tidx() & 63, w = tidx() >> 6;
  const float* W = p.w_ada + (size_t)l * 1024 * 6144 + cgp * 256 + lane * 4;
  float4 a0 = {0, 0, 0, 0}, a1 = {0, 0, 0, 0}, a2 = {0, 0, 0, 0};
#pragma unroll 16
  for (int k = w * 256; k < (w + 1) * 256; k++) {
    float4 wv = *(const float4*)(W + (size_t)k * 6144);
    float c0 = siluf(p.c_ctx[k]), c1 = siluf(p.c[k]), c2 = siluf(p.c[1024 + k]);
    a0.x += c0 * wv.x; a0.y += c0 * wv.y; a0.z += c0 * wv.z; a0.w += c0 * wv.w;
    a1.x += c1 * wv.x; a1.y += c1 * wv.y; a1.z += c1 * wv.z; a1.w += c1 * wv.w;
    a2.x += c2 * wv.x; a2.y += c2 * wv.y; a2.z += c2 * wv.z; a2.w += c2 * wv.w;
  }
  __syncthreads();
  *(float4*)(sm + (w * 3 + 0) * 256 + lane * 4) = a0;
  *(float4*)(sm + (w * 3 + 1) * 256 + lane * 4) = a1;
  *(float4*)(sm + (w * 3 + 2) * 256 + lane * 4) = a2;
  __syncthreads();
  for (int o = tidx(); o < 768; o += 256) {
    int r = o >> 8, col = o & 255;
    float s = sm[(0 * 3 + r) * 256 + col] + sm[(1 * 3 + r) * 256 + col] + sm[(2 * 3 + r) * 256 + col] +
              sm[(3 * 3 + r) * 256 + col];
    W_mada[(l * 3 + r) * 6144 + cgp * 256 + col] = s + p.b_ada[l * 6144 + cgp * 256 + col];
  }
}

__device__ __forceinline__ void dft_seq_fill(bf16_t* dst, int S, int item) {
  float inv = rsqrtf((float)S);
  size_t base = (size_t)item * 2048;
  for (int e = 0; e < 8; e++) {
    size_t idx = base + e * 256 + tidx();
    int k = (int)(idx / (2 * S)), col = (int)(idx % (2 * S));
    int s = col < S ? col : col - S;
    int mm = (k * s) & (S - 1);
    float rev = (float)mm / (float)S;
    float v = col < S ? __builtin_amdgcn_cosf(rev) : -__builtin_amdgcn_sinf(rev);
    dst[idx] = f2bf(v * inv);
  }
}

#define PEER_U_SCALE 64.f
#define PEER_V_SCALE 16.f
__device__ __forceinline__ void tab_convert_item(const P& p, int item) {
  int l = item >> 12, isv = (item >> 11) & 1, sub = item & 2047;
  const float* src = (isv ? p.peer_v : p.peer_u) + (size_t)l * 16384 * 1024 + (size_t)sub * 8192;
  unsigned char* dst = (isv ? W_tabV : W_tabU) + (size_t)l * 16384 * 1024 + (size_t)sub * 8192;
  const float sc = isv ? PEER_V_SCALE : PEER_U_SCALE;
  int tid = tidx();
  float4 tt[8];
#pragma unroll
  for (int e = 0; e < 8; e++) tt[e] = *(const float4*)(src + (e * 256 + tid) * 4);
#pragma unroll
  for (int e = 0; e < 8; e++) {
    float4 t = tt[e];
    int pk = __builtin_amdgcn_cvt_pk_fp8_f32(t.x * sc, t.y * sc, 0, false);
    pk = __builtin_amdgcn_cvt_pk_fp8_f32(t.z * sc, t.w * sc, pk, true);
    *(int*)(dst + (e * 256 + tid) * 4) = pk;
  }
}

__device__ __forceinline__ void phase_prep(const P& p, char* smem) {
  float* sm = (float*)smem;
  const int nb = gridDim.x;
  const int J_ADA = 48;
  const int J_IN = 2 * 16 * 96;
  const int J_UQ = 2 * 4 * 6;
  const int J_UKV = 2 * 2 * 8;
  const int J_BR = 2 * 4 * 4 * 16;
  const int J_OUT = 2 * 16 * 16;
  const int J_PQ = 2 * 16 * 32;
  const int J_KEYS = 256;
  const int J_CCH = 4;
  const int J_A256 = 64;
  const int J_A2048 = 4096;
  const int J_TAB = 8192;
  const int total = J_ADA + J_IN + J_UQ + J_UKV + J_BR + J_OUT + J_PQ + J_KEYS + J_CCH + J_A256 + J_A2048 + J_TAB;
  const bool ada_split = nb >= 4 * J_ADA;
  const int it_start = ada_split ? ((int)blockIdx.x < J_ADA ? (int)blockIdx.x : J_ADA + ((int)blockIdx.x - J_ADA)) : (int)blockIdx.x;
  const int it_step = ada_split ? ((int)blockIdx.x < J_ADA ? total : nb - J_ADA) : nb;
  for (int it0 = it_start; it0 < total; it0 += it_step) {
    int it = it0;
    if (it < J_ADA) { ada_item(p, it, sm); continue; }
    it -= J_ADA;
    if (it < J_IN) { int l = it / 1536, t = it % 1536; transpose_tile(p.w_in + (size_t)l * 1024 * 6080, 1024, 6080, W_Wt_in + (size_t)l * 6144 * 1024, t, 96, sm); continue; }
    it -= J_IN;
    if (it < J_UQ) { int l = it / 24, t = it % 24; transpose_tile(p.w_uq + (size_t)l * 256 * 384, 256, 384, W_Wt_uq + (size_t)l * 384 * 256, t, 6, sm); continue; }
    it -= J_UQ;
    if (it < J_UKV) { int l = it / 16, t = it % 16; transpose_tile(p.w_ukv + (size_t)l * 128 * 512, 128, 512, W_Wt_ukv + (size_t)l * 512 * 128, t, 8, sm); continue; }
    it -= J_UKV;
    if (it < J_BR) { int lb = it / 64, t = it % 64; transpose_tile(p.w_branch + (size_t)lb * 256 * 1024, 256, 1024, W_Wt_br + (size_t)(lb >> 2) * 1024 * 1024 + (lb & 3) * 256, t, 16, sm, 1024); continue; }
    it -= J_BR;
    if (it < J_OUT) { int l = it / 256, t = it % 256; transpose_tile(p.w_out + (size_t)l * 1024 * 1024, 1024, 1024, W_Wt_out + (size_t)l * 1024 * 1024, t, 16, sm); continue; }
    it -= J_OUT;
    if (it < J_PQ) { int l = it / 512, t = it % 512; transpose_tile(p.w_peer_q + (size_t)l * 1024 * 2048, 1024, 2048, W_Wt_pq + (size_t)l * 2048 * 1024, t, 32, sm); continue; }
    it -= J_PQ;
    if (it < J_KEYS) {
      size_t base = (size_t)it * 2048;
      float kv_[8];
#pragma unroll
      for (int e = 0; e < 8; e++) kv_[e] = p.peer_keys[base + e * 256 + tidx()];
#pragma unroll
      for (int e = 0; e < 8; e++) W_keysbf[base + e * 256 + tidx()] = f2bf(kv_[e]);
      continue;
    }
    it -= J_KEYS;
    if (it < J_CCH) {
      for (int e = 0; e < 8; e++) {
        int idx = it * 2048 + e * 256 + tidx();
        int n = idx >> 6, c = idx & 63;
        int j = n & 63;
        float rev = (float)((j * c) & 63) / 64.f;
        float v = n < 64 ? __builtin_amdgcn_cosf(rev) : __builtin_amdgcn_sinf(rev);
        W_Cch[idx] = f2bf(v * 0.125f);
      }
      continue;
    }
    it -= J_CCH;
    if (it < J_A256) { dft_seq_fill(W_A256, 256, it); continue; }
    it -= J_A256;
    if (it < J_A2048) { dft_seq_fill(W_A2048, 2048, it); continue; }
    it -= J_A2048;
    tab_convert_item(p, it);
  }
}

__device__ __forceinline__ void load_row16(const float* row, int lane, float (&v)[16]) {
#pragma unroll
  for (int q = 0; q < 4; q++) {
    float4 t = *(const float4*)(row + q * 256 + lane * 4);
    v[q * 4 + 0] = t.x; v[q * 4 + 1] = t.y; v[q * 4 + 2] = t.z; v[q * 4 + 3] = t.w;
  }
}
__device__ __forceinline__ void store_row16(float* row, int lane, const float (&v)[16]) {
#pragma unroll
  for (int q = 0; q < 4; q++) *(float4*)(row + q * 256 + lane * 4) = float4{v[q * 4], v[q * 4 + 1], v[q * 4 + 2], v[q * 4 + 3]};
}
__device__ __forceinline__ void ln16(float (&v)[16]) {
  float s = 0;
#pragma unroll
  for (int i = 0; i < 16; i++) s += v[i];
  s = wsum(s);
  float mu = s * (1.f / 1024.f);
  float q = 0;
#pragma unroll
  for (int i = 0; i < 16; i++) { v[i] -= mu; q += v[i] * v[i]; }
  q = wsum(q);
  float rs = rsqrtf(q * (1.f / 1024.f) + 1e-6f);
#pragma unroll
  for (int i = 0; i < 16; i++) v[i] *= rs;
}
__device__ __forceinline__ void modulate_store(const float (&v)[16], const float* sh, const float* sc, bf16_t* dst, int lane) {
#pragma unroll
  for (int q = 0; q < 4; q++) {
    float4 a = *(const float4*)(sc + q * 256 + lane * 4);
    float4 b = *(const float4*)(sh + q * 256 + lane * 4);
    ushort4 o;
    o.x = f2bf(v[q * 4 + 0] * (1.f + a.x) + b.x);
    o.y = f2bf(v[q * 4 + 1] * (1.f + a.y) + b.y);
    o.z = f2bf(v[q * 4 + 2] * (1.f + a.z) + b.z);
    o.w = f2bf(v[q * 4 + 3] * (1.f + a.w) + b.w);
    *(ushort4*)(dst + q * 256 + lane * 4) = o;
  }
}
__device__ __forceinline__ void affine16(float (&v)[16], const float* g, const float* b, int lane) {
#pragma unroll
  for (int q = 0; q < 4; q++) {
    float4 a = *(const float4*)(g + q * 256 + lane * 4);
    float4 c = *(const float4*)(b + q * 256 + lane * 4);
    v[q * 4 + 0] = v[q * 4 + 0] * a.x + c.x;
    v[q * 4 + 1] = v[q * 4 + 1] * a.y + c.y;
    v[q * 4 + 2] = v[q * 4 + 2] * a.z + c.z;
    v[q * 4 + 3] = v[q * 4 + 3] * a.w + c.w;
  }
}
__device__ __forceinline__ const float* x_in_row(const P& p, int l, int g) {
  if (l == 0) return g < T_CTX ? p.x_prompt + (size_t)g * 1024 : p.x_sample + (size_t)(g - T_CTX) * 1024;
  return p.out + (size_t)g * 1024;
}
__device__ __forceinline__ float* x_out_row(const P& p, int l, int g) {
  return p.out + (size_t)g * 1024;
}

__device__ __forceinline__ void phase_ln0(const P& p) {
  int lane = tidx() & 63, w = tidx() >> 6;
  for (int it = blockIdx.x; it < T_ALL / 4; it += gridDim.x) {
    int g = it * 4 + w;
    float v[16];
    load_row16(x_in_row(p, 0, g), lane, v);
    ln16(v);
    const float* m = W_mada + (0 * 3 + cond_row(g)) * 6144;
    modulate_store(v, m, m + 1024, W_u + (size_t)g * 1024, lane);
  }
}

__device__ __forceinline__ void phase_win(const P& p, int l, char* smem) {
  const bf16_t* Wt = W_Wt_in + (size_t)l * 6144 * 1024;
  for (int tile = blockIdx.x; tile < 96 * 48; tile += gridDim.x) {
    int mt = tile / 48, nt = tile % 48, m0 = mt * 128, n0 = nt * 128;
    f32x4 acc[4][4];
    ZERO_ACC(acc);
    gemm_core(acc, Wt + (size_t)n0 * 1024, 1024, W_u + (size_t)m0 * 1024, 1024, 1024, smem);
    EPI4_LOOP(acc, n0, m0, {
      if (col < 1984) *(float4*)(W_hbuf + (size_t)tok * 1984 + col) = float4{v4[0], v4[1], v4[2], v4[3]};
      else if (col < 6080) {
        ushort4 o_; o_.x = f2bf(sigmf(v4[0])); o_.y = f2bf(sigmf(v4[1])); o_.z = f2bf(sigmf(v4[2])); o_.w = f2bf(sigmf(v4[3]));
        *(ushort4*)(W_gates + (size_t)tok * 4096 + (col - 1984)) = o_;
      }
    });
  }
}

__device__ __forceinline__ void rope_cs(float pos, int i, float inv_hp, float& cs, float& sn) {
  float freq = exp2f(-(float)i * inv_hp * 13.287712379549449f);
  float a = pos * freq;
  sn = __sinf(a);
  cs = __cosf(a);
}

__device__ __forceinline__ void phase_post(const P& p, int l) {
  int lane = tidx() & 63, w = tidx() >> 6;
  for (int it = blockIdx.x; it < 13312 / 4; it += gridDim.x) {
    int g = it * 4 + w;
    if (g < T_ALL) {
      const bool lat = g >= T_CTX;
      int b, s;
      if (!lat) { b = g >> 8; s = g & 255; } else { b = (g - T_CTX) >> 11; s = (g - T_CTX) & 2047; }
      const float* h = W_hbuf + (size_t)g * 1984;
      const float prow = (float)(s >> 6), pcol = (float)(s & 63);
      const float4 pl_q = *(const float4*)(h + lane * 4);
      const float2 pl_c = *(const float2*)(h + 256 + lane * 2);
      const float pl_kr1 = h[384 + ((lane >> 3) & 1) * 16 + (lane & 7)], pl_kr2 = h[384 + ((lane >> 3) & 1) * 16 + 8 + (lane & 7)];
      const float4 pl_f = *(const float4*)(h + 416 + lane * 4);
      float pl_sq1[2], pl_sq2[2];
#pragma unroll
      for (int jj = 0; jj < 2; jj++) {
        int pi = lane + 64 * jj, hq = pi >> 5, pp = (pi >> 4) & 1, i = pi & 15;
        pl_sq1[jj] = h[1472 + hq * 64 + pp * 32 + i]; pl_sq2[jj] = h[1472 + hq * 64 + pp * 32 + 16 + i];
      }
      const float pl_sk1 = h[1728 + (lane >> 5) * 64 + ((lane >> 4) & 1) * 32 + (lane & 15)];
      const float pl_sk2 = h[1728 + (lane >> 5) * 64 + ((lane >> 4) & 1) * 32 + 16 + (lane & 15)];
      const float2 pl_v = *(const float2*)(h + 1856 + lane * 2);
      {
        float4 t = pl_q;
        float ss = wsum(t.x * t.x + t.y * t.y + t.z * t.z + t.w * t.w);
        float rs = rsqrtf(ss * (1.f / 256.f) + 1e-6f);
        float4 gq = *(const float4*)(p.mla_q_norm + l * 256 + lane * 4);
        ushort4 o;
        o.x = f2bf(t.x * rs * gq.x); o.y = f2bf(t.y * rs * gq.y); o.z = f2bf(t.z * rs * gq.z); o.w = f2bf(t.w * rs * gq.w);
        *(ushort4*)(W_qn + (size_t)g * 256 + lane * 4) = o;
      }
      {
        float2 t = pl_c;
        float ss = wsum(t.x * t.x + t.y * t.y);
        float rs = rsqrtf(ss * (1.f / 128.f) + 1e-6f);
        float2 gk = *(const float2*)(p.mla_kv_norm + l * 128 + lane * 2);
        float v0 = t.x * rs * gk.x, v1 = t.y * rs * gk.y;
        ushort2 o; o.x = f2bf(v0); o.y = f2bf(v1);
        *(ushort2*)(W_ckv_all + (size_t)g * 128 + lane * 2) = o;
        if (!lat) *(float2*)(p.out + 12582912 + ((size_t)((b * 2 + l) * 256 + s)) * 128 + lane * 2) = float2{v0, v1};
      }
      if (lane < 16) {
        int pp = lane >> 3, i = lane & 7;
        float x1 = pl_kr1, x2 = pl_kr2;
        float o1 = x1, o2 = x2;
        if (lat) {
          float cs, sn;
          rope_cs(pp ? pcol : prow, i, 0.125f, cs, sn);
          o1 = x1 * cs - x2 * sn; o2 = x2 * cs + x1 * sn;
        } else {
          float* ok = p.out + 14680064 + ((size_t)((b * 2 + l) * 256 + s)) * 32 + pp * 16 + i;
          ok[0] = o1; ok[8] = o2;
        }
        bf16_t b1 = f2bf(o1), b2 = f2bf(o2);
        for (int hh = 0; hh < 4; hh++) {
          bf16_t* kd = lat ? W_Ka_lat + ((size_t)((b * 4 + hh) * 2560 + 512 + s)) * 96 : W_Ka_ctx + ((size_t)((b * 4 + hh) * 256 + s)) * 96;
          kd[64 + pp * 16 + i] = b1; kd[64 + pp * 16 + 8 + i] = b2;
        }
      }
      {
        float4 t = pl_f;
        ushort4 o; o.x = f2bf(t.x); o.y = f2bf(t.y); o.z = f2bf(t.z); o.w = f2bf(t.w);
        *(ushort4*)(W_fnet + (size_t)g * 256 + lane * 4) = o;
      }
#pragma unroll
      for (int jj = 0; jj < 2; jj++) {
        int pi = lane + 64 * jj, hq = pi >> 5, pp = (pi >> 4) & 1, i = pi & 15;
        float x1 = pl_sq1[jj], x2 = pl_sq2[jj];
        float o1 = x1, o2 = x2;
        if (lat) {
          float cs, sn;
          rope_cs(pp ? pcol : prow, i, 0.0625f, cs, sn);
          o1 = x1 * cs - x2 * sn; o2 = x2 * cs + x1 * sn;
        }
        bf16_t* qd = W_Qd + (size_t)g * 256 + hq * 64 + pp * 32 + i;
        qd[0] = f2bf(o1); qd[16] = f2bf(o2);
      }
      {
        int kv = lane >> 5, pp = (lane >> 4) & 1, i = lane & 15;
        float x1 = pl_sk1, x2 = pl_sk2;
        float o1 = x1, o2 = x2;
        bf16_t* kd;
        if (lat) {
          float cs, sn;
          rope_cs(pp ? pcol : prow, i, 0.0625f, cs, sn);
          o1 = x1 * cs - x2 * sn; o2 = x2 * cs + x1 * sn;
          kd = W_Kd_lat + ((size_t)((b * 2 + kv) * 2560 + 512 + s)) * 64;
        } else {
          float* ok = p.out + 15204352 + ((size_t)(((b * 2 + l) * 2 + kv) * 256 + s)) * 64 + pp * 32 + i;
          ok[0] = o1; ok[16] = o2;
          kd = W_Kd_ctx + ((size_t)((b * 2 + kv) * 256 + s)) * 64;
        }
        kd[pp * 32 + i] = f2bf(o1); kd[pp * 32 + 16 + i] = f2bf(o2);
      }
      {
        int e = lane * 2, kv = e >> 6, d = e & 63;
        float2 t = pl_v;
        if (lat) {
          bf16_t* vt = W_Vd_lat + (size_t)(b * 2 + kv) * 64 * 2560 + 512 + s;
          vt[(size_t)d * 2560] = f2bf(t.x); vt[(size_t)(d + 1) * 2560] = f2bf(t.y);
        } else {
          *(float2*)(p.out + 17301504 + ((size_t)(((b * 2 + l) * 2 + kv) * 256 + s)) * 64 + d) = t;
          bf16_t* vt = W_Vd_ctx + (size_t)(b * 2 + kv) * 64 * 256 + s;
          vt[d * 256] = f2bf(t.x); vt[(d + 1) * 256] = f2bf(t.y);
        }
      }
    } else {
      int gc = g - T_ALL, b = gc >> 9, pp = gc & 511;
      {
        float2 t = *(const float2*)(p.cache_ckv + ((size_t)((b * 2 + l) * 512 + pp)) * 128 + lane * 2);
        ushort2 o; o.x = f2bf(t.x); o.y = f2bf(t.y);
        *(ushort2*)(W_ckv_all + (size_t)g * 128 + lane * 2) = o;
      }
      if (lane < 32) {
        bf16_t v = f2bf(p.cache_krope[((size_t)((b * 2 + l) * 512 + pp)) * 32 + lane]);
        for (int hh = 0; hh < 4; hh++) W_Ka_lat[((size_t)((b * 4 + hh) * 2560 + pp)) * 96 + 64 + lane] = v;
      }
      {
        int e = lane * 2, kv = e >> 6, d = e & 63;
        size_t src = ((size_t)(((b * 2 + l) * 2 + kv) * 512 + pp)) * 64 + d;
        float2 tk = *(const float2*)(p.cache_swa_k + src);
        float2 tv = *(const float2*)(p.cache_swa_v + src);
        size_t dst = ((size_t)((b * 2 + kv) * 2560 + pp)) * 64 + d;
        ushort2 ok; ok.x = f2bf(tk.x); ok.y = f2bf(tk.y);
        *(ushort2*)(W_Kd_lat + dst) = ok;
        bf16_t* vt = W_Vd_lat + (size_t)(b * 2 + kv) * 64 * 2560 + pp;
        vt[(size_t)d * 2560] = f2bf(tv.x); vt[(size_t)(d + 1) * 2560] = f2bf(tv.y);
      }
    }
  }
}

__device__ __forceinline__ void phase_small_gemms(const P& p, int l, char* smem) {
  const int NA = 96 * 3, NB = 104 * 4, NC = 384;
  for (int it0 = blockIdx.x; it0 < NA + NB + NC; it0 += gridDim.x) {
    int it = it0;
    f32x4 acc[4][4];
    ZERO_ACC(acc);
    if (it < NA) {
      int mt = it / 3, nt = it % 3, m0 = mt * 128, n0 = nt * 128;
      gemm_core(acc, W_qn + (size_t)m0 * 256, 256, W_Wt_uq + (size_t)l * 384 * 256 + (size_t)n0 * 256, 256, 256, smem);
      const bool lat = m0 >= T_CTX;
      EPI_LOOP(acc, m0, n0, {
        int c96 = n % 96;
        if (lat && c96 >= 64) {
          float pv = DPP_F(v, v, 0x128, 0xf);
          int cr = c96 - 64, pp = cr >> 4, ii = cr & 15, i = ii & 7;
          int s = (m - T_CTX) & 2047;
          float cs, sn;
          rope_cs(pp ? (float)(s & 63) : (float)(s >> 6), i, 0.125f, cs, sn);
          v = (ii < 8) ? v * cs - pv * sn : v * cs + pv * sn;
        }
        W_Qa[(size_t)m * 384 + n] = f2bf(v);
      });
      continue;
    }
    it -= NA;
    if (it < NB) {
      int mt = it / 4, nt = it % 4, m0 = mt * 128, n0 = nt * 128;
      gemm_core(acc, W_ckv_all + (size_t)m0 * 128, 128, W_Wt_ukv + (size_t)l * 512 * 128 + (size_t)n0 * 128, 128, 128, smem);
      EPI_LOOP(acc, m0, n0, {
        int hh = n >> 7, c = n & 127;
        bf16_t* kd; bf16_t* vd; int vstride;
        if (m < T_CTX) {
          int b = m >> 8, s = m & 255;
          size_t r = (size_t)((b * 4 + hh) * 256 + s);
          kd = W_Ka_ctx + r * 96; vd = W_Va_ctx + (size_t)(b * 4 + hh) * 64 * 256 + s; vstride = 256;
        } else {
          int b, pos;
          if (m < T_ALL) { b = (m - T_CTX) >> 11; pos = 512 + ((m - T_CTX) & 2047); }
          else { b = (m - T_ALL) >> 9; pos = (m - T_ALL) & 511; }
          size_t r = (size_t)((b * 4 + hh) * 2560 + pos);
          kd = W_Ka_lat + r * 96; vd = W_Va_lat + (size_t)(b * 4 + hh) * 64 * 2560 + pos; vstride = 2560;
        }
        if (c < 64) kd[c] = f2bf(v); else vd[(size_t)(c - 64) * vstride] = f2bf(v);
      });
      continue;
    }
    it -= NB;
    {
      int m0 = it * 128;
      gemm_core(acc, W_fnet + (size_t)m0 * 64, 64, W_Cch, 64, 64, smem);
      EPI_LOOP(acc, m0, 0, {
        int g = m >> 2, grp = m & 3, part = n >> 6, j = n & 63;
        if (g < T_CTX) {
          int b = g >> 8, s = g & 255;
          W_Yt_ctx[((size_t)(b * 256 + grp * 64 + j)) * 512 + part * 256 + s] = f2bf(v);
        } else {
          int b = (g - T_CTX) >> 11, s = (g - T_CTX) & 2047;
          W_Yt_lat[((size_t)(b * 256 + grp * 64 + j)) * 4096 + part * 2048 + s] = f2bf(v);
        }
      });
    }
  }
}

template <int DK>
__device__ __forceinline__ void attn_item(const bf16_t* __restrict__ Qp, int qstride, const bf16_t* __restrict__ Kp,
                          const bf16_t* __restrict__ Vp, bf16_t* __restrict__ Op, int q0, int Sk, int n_ctx, int W,
                          float scale, bool has_sink, float sink, char* smem) {
  constexpr int KLD = DK + 8;
  bf16_t* sK = (bf16_t*)smem;
  bf16_t* sVt = sK + 64 * KLD;
  bf16_t* sP = sVt + 64 * 72;
  const int tid = tidx(), lane = tid & 63, w = tid >> 6, l15 = lane & 15, l4 = lane >> 4;
  bf16_t* sPw = sP + w * 16 * 72;
  bf16x8 qf[DK / 32];
  {
    const bf16_t* qrow = Qp + (size_t)(q0 + w * 16 + l15) * qstride;
#pragma unroll
    for (int ks = 0; ks < DK / 32; ks++) qf[ks] = *(const bf16x8*)(qrow + ks * 32 + l4 * 8);
  }
  f32x4 o[4];
#pragma unroll
  for (int j = 0; j < 4; j++) o[j] = f32x4{0.f, 0.f, 0.f, 0.f};
  float mrow[4], lrow[4];
#pragma unroll
  for (int r = 0; r < 4; r++) { mrow[r] = NEG_INF; lrow[r] = 0.f; }
  const int ntile = Sk >> 6;
  auto tile_ok = [&](int kt) -> bool {
    int kb = kt * 64;
    if (W >= 0 && kb >= n_ctx) { int lp = kb - n_ctx; if (lp + 63 < q0 - W || lp > q0 + 63 + W) return false; }
    return true;
  };
  u32x4 rk[DK / 32], rv[2];
  int kt = 0;
  while (kt < ntile && !tile_ok(kt)) kt++;
  if (kt < ntile) {
#pragma unroll
    for (int i = 0; i < DK / 32; i++) { int c = tid + i * 256, r = c / (DK / 8), cc = (c % (DK / 8)) * 8; rk[i] = *(const u32x4*)(Kp + (size_t)(kt * 64 + r) * DK + cc); }
#pragma unroll
    for (int i = 0; i < 2; i++) { int c = tid + i * 256, dv = c >> 3, k0 = (c & 7) * 8; rv[i] = *(const u32x4*)(Vp + (size_t)dv * Sk + kt * 64 + k0); }
  }
  while (kt < ntile) {
    const int kbase = kt * 64;
    __syncthreads();
#pragma unroll
    for (int i = 0; i < DK / 32; i++) { int c = tid + i * 256, r = c / (DK / 8), cc = (c % (DK / 8)) * 8; *(u32x4*)(sK + r * KLD + cc) = rk[i]; }
#pragma unroll
    for (int i = 0; i < 2; i++) {
      int c = tid + i * 256, dv = c >> 3, k0 = (c & 7) * 8;
      *(u32x4*)(sVt + dv * 72 + k0) = rv[i];
    }
    __syncthreads();
    int ktn = kt + 1;
    while (ktn < ntile && !tile_ok(ktn)) ktn++;
    if (ktn < ntile) {
#pragma unroll
      for (int i = 0; i < DK / 32; i++) { int c = tid + i * 256, r = c / (DK / 8), cc = (c % (DK / 8)) * 8; rk[i] = *(const u32x4*)(Kp + (size_t)(ktn * 64 + r) * DK + cc); }
#pragma unroll
      for (int i = 0; i < 2; i++) { int c = tid + i * 256, dv = c >> 3, k0 = (c & 7) * 8; rv[i] = *(const u32x4*)(Vp + (size_t)dv * Sk + ktn * 64 + k0); }
    }
    kt = ktn;
    f32x4 s[4];
#pragma unroll
    for (int j = 0; j < 4; j++) {
      s[j] = f32x4{0.f, 0.f, 0.f, 0.f};
#pragma unroll
      for (int ks = 0; ks < DK / 32; ks++) {
        bf16x8 kf = *(const bf16x8*)(sK + (j * 16 + l15) * KLD + ks * 32 + l4 * 8);
        s[j] = __builtin_amdgcn_mfma_f32_16x16x32_bf16(qf[ks], kf, s[j], 0, 0, 0);
      }
    }
#pragma unroll
    for (int j = 0; j < 4; j++)
#pragma unroll
      for (int r = 0; r < 4; r++) {
        float v = s[j][r] * scale;
        if (W >= 0) {
          int kk = kbase + j * 16 + l15, t = q0 + w * 16 + l4 * 4 + r;
          int dlt = kk - n_ctx - t;
          bool valid = (kk < n_ctx) || (dlt <= W && dlt >= -W);
          if (!valid) v = NEG_INF;
        }
        s[j][r] = v;
      }
#pragma unroll
    for (int r = 0; r < 4; r++) {
      float mx = fmaxf(fmaxf(s[0][r], s[1][r]), fmaxf(s[2][r], s[3][r]));
      mx = fmaxf(mx, DPP_F(mx, mx, 0xB1, 0xf));
      mx = fmaxf(mx, DPP_F(mx, mx, 0x4E, 0xf));
      mx = fmaxf(mx, DPP_F(mx, mx, 0x141, 0xf));
      mx = fmaxf(mx, DPP_F(mx, mx, 0x140, 0xf));
      float mnew = fmaxf(mrow[r], mx);
      float muse = (mnew == NEG_INF) ? 0.f : mnew;
      float alpha = __expf(mrow[r] - muse);
      float rs = 0.f;
#pragma unroll
      for (int j = 0; j < 4; j++) { float pe = __expf(s[j][r] - muse); s[j][r] = pe; rs += pe; }
      rs += DPP_F(rs, rs, 0xB1, 0xf);
      rs += DPP_F(rs, rs, 0x4E, 0xf);
      rs += DPP_F(rs, rs, 0x141, 0xf);
      rs += DPP_F(rs, rs, 0x140, 0xf);
      lrow[r] = lrow[r] * alpha + rs;
      mrow[r] = mnew;
#pragma unroll
      for (int j = 0; j < 4; j++) o[j][r] *= alpha;
    }
#pragma unroll
    for (int j = 0; j < 4; j++)
#pragma unroll
      for (int r = 0; r < 4; r++) sPw[(l4 * 4 + r) * 72 + j * 16 + l15] = f2bf(s[j][r]);
    __builtin_amdgcn_s_waitcnt(0xc07f);
    __builtin_amdgcn_wave_barrier();
#pragma unroll
    for (int ks = 0; ks < 2; ks++) {
      bf16x8 pf = *(const bf16x8*)(sPw + l15 * 72 + ks * 32 + l4 * 8);
#pragma unroll
      for (int jn = 0; jn < 4; jn++) {
        bf16x8 vf = *(const bf16x8*)(sVt + (jn * 16 + l15) * 72 + ks * 32 + l4 * 8);
        o[jn] = __builtin_amdgcn_mfma_f32_16x16x32_bf16(pf, vf, o[jn], 0, 0, 0);
      }
    }
  }
#pragma unroll
  for (int r = 0; r < 4; r++) {
    float lsum = lrow[r];
    if (has_sink) lsum += __expf(sink - mrow[r]);
    float inv = 1.f / lsum;
#pragma unroll
    for (int jn = 0; jn < 4; jn++)
      Op[(size_t)(q0 + w * 16 + l4 * 4 + r) * 1024 + jn * 16 + l15] = f2bf(o[jn][r] * inv);
  }
}

__device__ __forceinline__ int gla_tok(int tb, int c, int dir, int tau) { return tb + c * 64 + (dir ? 63 - tau : tau); }

#define GLA_W2_OFF 40960
__device__ __forceinline__ void gla_stage_w2(const P& p, int l, char* smem) {
  float* w2s = (float*)(smem + GLA_W2_OFF);
  const int tid = tidx();
  __syncthreads();
#pragma unroll
  for (int i = 0; i < 2; i++) {
    int e = (tid + i * 256) * 4;
    *(float4*)(w2s + e) = *(const float4*)(p.w_gla_a_fwd + l * 2048 + e);
    *(float4*)(w2s + 2048 + e) = *(const float4*)(p.w_gla_a_bwd + l * 2048 + e);
  }
  if (tid < 128) w2s[4096 + tid] = p.b_gla_a_fwd[l * 128 + tid];
  else w2s[4096 + tid] = p.b_gla_a_bwd[l * 128 + tid - 128];
  __syncthreads();
}
__device__ __forceinline__ void gla_load_alow(const P& p, int tok, int dir, float4 (&al)[4]) {
  const float* src = W_hbuf + (size_t)tok * 1984 + (dir ? 1456 : 1440);
#pragma unroll
  for (int q = 0; q < 4; q++) al[q] = *(const float4*)(src + q * 4);
}
__device__ __forceinline__ void gla_cum_regs(const char* smem, const float4 (&al)[4], int h, int dir, int w, int lane, float (&c)[8], float (&tot)[8]) {
  const float* w2 = (const float*)(smem + GLA_W2_OFF) + dir * 2048 + h * 32 + w * 8;
  const float* b2 = (const float*)(smem + GLA_W2_OFF) + 4096 + dir * 128 + h * 32 + w * 8;
  float a[16];
#pragma unroll
  for (int q = 0; q < 4; q++) { a[q * 4] = al[q].x; a[q * 4 + 1] = al[q].y; a[q * 4 + 2] = al[q].z; a[q * 4 + 3] = al[q].w; }
#pragma unroll
  for (int j = 0; j < 8; j++) {
    float z = b2[j];
#pragma unroll
    for (int r = 0; r < 16; r++) z += a[r] * w2[r * 128 + j];
    float la = logsigf(z) * (1.f / 16.f);
    float v = la;
#pragma unroll
    for (int d = 1; d < 64; d <<= 1) { float t_ = __shfl_up(v, d); if (lane >= d) v += t_; }
    float total = __shfl(v, 63);
    c[j] = dir ? (total - v + la) : v;
    tot[j] = total;
  }
}
__device__ __forceinline__ void gla_load_v(const P& p, int tok, int h, int w, float4 (&vr)[4]) {
  const float* src = W_hbuf + (size_t)tok * 1984 + 928 + h * 64 + w * 16;
#pragma unroll
  for (int q = 0; q < 4; q++) vr[q] = *(const float4*)(src + q * 4);
}
__device__ __forceinline__ void gla_store_vt(const float4 (&vr)[4], int w, int lane, bf16_t* sVt) {
#pragma unroll
  for (int q = 0; q < 4; q++) {
    sVt[(w * 16 + q * 4 + 0) * 72 + lane] = f2bf(vr[q].x);
    sVt[(w * 16 + q * 4 + 1) * 72 + lane] = f2bf(vr[q].y);
    sVt[(w * 16 + q * 4 + 2) * 72 + lane] = f2bf(vr[q].z);
    sVt[(w * 16 + q * 4 + 3) * 72 + lane] = f2bf(vr[q].w);
  }
}

__device__ __forceinline__ void chunk_info(int cidx, int& tb, int& nch, int& n, int& cbase) {
  if (cidx < 128) { int b = cidx >> 2; n = cidx & 3; nch = 4; tb = b * 256; cbase = b * 4; }
  else { int cl = cidx - 128, b = cl >> 5; n = cl & 31; nch = 32; tb = T_CTX + b * 2048; cbase = 128 + b * 32; }
}

__device__ __forceinline__ void gla_g1_item(const P& p, int l, int item, char* smem) {
  bf16_t* sKeT = (bf16_t*)smem;
  bf16_t* sVt = sKeT + 32 * 72;
  const int tid = tidx(), lane = tid & 63, w = __builtin_amdgcn_readfirstlane(tid >> 6), l15 = lane & 15, l4 = lane >> 4;
  int dir = item & 1, h = (item >> 1) & 3, cidx = item >> 3;
  int tb, nch, n, cbase;
  chunk_info(cidx, tb, nch, n, cbase);
  int c = dir ? nch - 1 - n : n;
  int tok = tb + c * 64 + lane;
  float4 al[4], vr[4];
  gla_load_alow(p, tok, dir, al);
  const float* kr = W_hbuf + (size_t)tok * 1984 + 800 + h * 32 + w * 8;
  float4 k0 = *(const float4*)kr, k1 = *(const float4*)(kr + 4);
  gla_load_v(p, tok, h, w, vr);
  float cs[8], tot[8];
  gla_cum_regs(smem, al, h, dir, w, lane, cs, tot);
  __syncthreads();
  {
    float kk[8] = {k0.x, k0.y, k0.z, k0.w, k1.x, k1.y, k1.z, k1.w};
#pragma unroll
    for (int j = 0; j < 8; j++) sKeT[(w * 8 + j) * 72 + lane] = f2bf(kk[j] * __expf(tot[j] - cs[j]));
  }
  gla_store_vt(vr, w, lane, sVt);
  __syncthreads();
  f32x4 acc[2] = {f32x4{0.f, 0.f, 0.f, 0.f}, f32x4{0.f, 0.f, 0.f, 0.f}};
#pragma unroll
  for (int ks = 0; ks < 2; ks++) {
    bf16x8 bv = *(const bf16x8*)(sVt + (w * 16 + l15) * 72 + ks * 32 + l4 * 8);
#pragma unroll
    for (int mt = 0; mt < 2; mt++) {
      bf16x8 av = *(const bf16x8*)(sKeT + (mt * 16 + l15) * 72 + ks * 32 + l4 * 8);
      acc[mt] = __builtin_amdgcn_mfma_f32_16x16x32_bf16(av, bv, acc[mt], 0, 0, 0);
    }
  }
  float* dst = W_un + (size_t)item * 2048;
#pragma unroll
  for (int mt = 0; mt < 2; mt++)
#pragma unroll
    for (int r = 0; r < 4; r++) dst[(mt * 16 + l4 * 4 + r) * 64 + w * 16 + l15] = acc[mt][r];
  if (lane == 0) {
#pragma unroll
    for (int j = 0; j < 8; j++) W_gn[item * 32 + w * 8 + j] = __expf(tot[j]);
  }
}

__device__ __forceinline__ void phase_gla_scan(const P& p, int l) {
  for (int it = blockIdx.x; it < 2176; it += gridDim.x) {
    int e = it * 256 + tidx();
    int kv = e & 2047, sd = e >> 11, dir = sd & 1, h = (sd >> 1) & 3, seq = ((sd >> 3) + 32) % 34;
    int nch, cbase;
    float s;
    if (seq < 32) { nch = 4; cbase = seq * 4; s = 0.f; }
    else { int b = seq - 32; nch = 32; cbase = 128 + b * 32; s = p.state_gla[((size_t)(((b * 2 + l) * 2 + dir) * 4 + h)) * 2048 + kv]; }
    for (int n0 = 0; n0 < nch; n0 += 4) {
      float gv[4], uv[4];
#pragma unroll
      for (int k = 0; k < 4; k++) {
        int item = ((cbase + n0 + k) * 4 + h) * 2 + dir;
        gv[k] = W_gn[item * 32 + (kv >> 6)];
        uv[k] = W_un[(size_t)item * 2048 + kv];
      }
#pragma unroll
      for (int k = 0; k < 4; k++) {
        int item = ((cbase + n0 + k) * 4 + h) * 2 + dir;
        W_sin_[(size_t)item * 2048 + kv] = s;
        s = gv[k] * s + uv[k];
      }
    }
    if (seq < 32) p.out[19398656 + ((size_t)(((seq * 2 + l) * 2 + dir) * 4 + h)) * 2048 + kv] = s;
  }
}

__device__ __forceinline__ void phase_gla_out(const P& p, int l, char* smem) {
  bf16_t* sQe = (bf16_t*)smem;
  bf16_t* sKe = sQe + 64 * 40;
  bf16_t* sSt = sKe + 64 * 40;
  bf16_t* sVt = sSt + 64 * 40;
  bf16_t* sAtt = sVt + 64 * 72;
  const int tid = tidx(), lane = tid & 63, w = __builtin_amdgcn_readfirstlane(tid >> 6), l15 = lane & 15, l4 = lane >> 4;
  gla_stage_w2(p, l, smem);
  for (int it = blockIdx.x; it < 768; it += gridDim.x) {
    int h = it & 3, cidx = it >> 2;
    int tb, nch, c, cbase;
    chunk_info(cidx, tb, nch, c, cbase);
    const int tok = tb + c * 64 + lane;
    f32x4 o[4];
#pragma unroll
    for (int j = 0; j < 4; j++) o[j] = f32x4{0.f, 0.f, 0.f, 0.f};
    float4 vr[4], alf[4], alb[4];
    gla_load_v(p, tok, h, w, vr);
    gla_load_alow(p, tok, 0, alf);
    gla_load_alow(p, tok, 1, alb);
    const float* qr = W_hbuf + (size_t)tok * 1984 + 672 + h * 32 + w * 8;
    const float* kr = qr + 128;
    const float4 q0 = *(const float4*)qr, q1 = *(const float4*)(qr + 4), k0 = *(const float4*)kr, k1 = *(const float4*)(kr + 4);
    float sinv[2][8];
#pragma unroll
    for (int dir = 0; dir < 2; dir++) {
      int n = dir ? nch - 1 - c : c;
      int item = ((cbase + n) * 4 + h) * 2 + dir;
      const float* sin = W_sin_ + (size_t)item * 2048 + (w * 8) * 64 + lane;
#pragma unroll
      for (int j = 0; j < 8; j++) sinv[dir][j] = sin[j * 64];
    }
    float gpre[4][4];
#pragma unroll
    for (int r = 0; r < 4; r++)
#pragma unroll
      for (int jn = 0; jn < 4; jn++) gpre[r][jn] = W_hbuf[(size_t)(tb + c * 64 + w * 16 + l4 * 4 + r) * 1984 + 1184 + h * 64 + jn * 16 + l15];
    __syncthreads();
    gla_store_vt(vr, w, lane, sVt);
#pragma unroll
    for (int dir = 0; dir < 2; dir++) {
      float cs[8], tot[8];
      gla_cum_regs(smem, dir ? alb : alf, h, dir, w, lane, cs, tot);
      if (dir) __syncthreads();
      {
        float qq[8] = {q0.x, q0.y, q0.z, q0.w, q1.x, q1.y, q1.z, q1.w};
        float kk[8] = {k0.x, k0.y, k0.z, k0.w, k1.x, k1.y, k1.z, k1.w};
        bf16x8 qv, kv, sv;
#pragma unroll
        for (int j = 0; j < 8; j++) {
          float cm = __shfl(cs[j], 32);
          qv[j] = (short)f2bf(qq[j] * 0.17677669529663687f * __expf(cs[j] - cm));
          kv[j] = (short)f2bf(kk[j] * __expf(cm - cs[j]));
          sv[j] = (short)f2bf(sinv[dir][j] * __expf(cm));
        }
        *(bf16x8*)(sQe + lane * 40 + w * 8) = qv;
        *(bf16x8*)(sKe + lane * 40 + w * 8) = kv;
        *(bf16x8*)(sSt + lane * 40 + w * 8) = sv;
      }
      __syncthreads();
      bf16x8 qa = *(const bf16x8*)(sQe + (w * 16 + l15) * 40 + l4 * 8);
#pragma unroll
      for (int jc = 0; jc < 4; jc++) {
        bf16x8 kb = *(const bf16x8*)(sKe + (jc * 16 + l15) * 40 + l4 * 8);
        f32x4 sacc = __builtin_amdgcn_mfma_f32_16x16x32_bf16(qa, kb, f32x4{0.f, 0.f, 0.f, 0.f}, 0, 0, 0);
#pragma unroll
        for (int r = 0; r < 4; r++) {
          int trow = w * 16 + l4 * 4 + r, scol = jc * 16 + l15;
          bool keep = dir ? (scol >= trow) : (scol <= trow);
          sAtt[trow * 72 + scol] = f2bf(keep ? sacc[r] : 0.f);
        }
      }
      __syncthreads();
#pragma unroll
      for (int ks = 0; ks < 2; ks++) {
        bf16x8 aa = *(const bf16x8*)(sAtt + (w * 16 + l15) * 72 + ks * 32 + l4 * 8);
#pragma unroll
        for (int jn = 0; jn < 4; jn++) {
          bf16x8 vb = *(const bf16x8*)(sVt + (jn * 16 + l15) * 72 + ks * 32 + l4 * 8);
          o[jn] = __builtin_amdgcn_mfma_f32_16x16x32_bf16(aa, vb, o[jn], 0, 0, 0);
        }
      }
#pragma unroll
      for (int jn = 0; jn < 4; jn++) {
        bf16x8 sb = *(const bf16x8*)(sSt + (jn * 16 + l15) * 40 + l4 * 8);
        o[jn] = __builtin_amdgcn_mfma_f32_16x16x32_bf16(qa, sb, o[jn], 0, 0, 0);
      }
    }
#pragma unroll
    for (int r = 0; r < 4; r++) {
      float ss = o[0][r] * o[0][r] + o[1][r] * o[1][r] + o[2][r] * o[2][r] + o[3][r] * o[3][r];
      ss += DPP_F(ss, ss, 0xB1, 0xf);
      ss += DPP_F(ss, ss, 0x4E, 0xf);
      ss += DPP_F(ss, ss, 0x141, 0xf);
      ss += DPP_F(ss, ss, 0x140, 0xf);
      float rs = rsqrtf(ss * (1.f / 64.f) + 1e-6f);
      int tk = tb + c * 64 + w * 16 + l4 * 4 + r;
      const float* grow = W_hbuf + (size_t)tk * 1984 + 1184 + h * 64;
      bf16_t* dst = W_br + (size_t)tk * 1024 + 512 + h * 64;
#pragma unroll
      for (int jn = 0; jn < 4; jn++) {
        int vcol = jn * 16 + l15;
        float val = o[jn][r] * rs * p.gla_norm[l * 64 + vcol];
        dst[vcol] = f2bf(val * siluf(gpre[r][jn]));
      }
    }
  }
}

__device__ __forceinline__ void phase_mixers(const P& p, int l, char* smem) {
  const int N_MLAL = 256, N_DFTL = 64, N_SWAL = 256, N_MLAC = 512, N_SWAC = 512, N_DFTC = 128, N_G1 = 1536;
  const int total = N_MLAL + N_DFTL + N_SWAL + N_MLAC + N_SWAC + N_DFTC + N_G1;
  gla_stage_w2(p, l, smem);
  for (int r_ = 0; r_ * (int)gridDim.x < total; r_++) {
    int it0 = r_ * gridDim.x + ((r_ & 1) ? (gridDim.x - 1 - blockIdx.x) : blockIdx.x);
    if (it0 >= total) continue;
    int it = it0;
    int type;
    bool lat = false;
    if (it < N_MLAL) { type = 0; lat = true; }
    else if ((it -= N_MLAL) < N_DFTL) { type = 2; lat = true; }
    else if ((it -= N_DFTL) < N_SWAL) { type = 1; lat = true; }
    else if ((it -= N_SWAL) < N_MLAC) { type = 0; }
    else if ((it -= N_MLAC) < N_SWAC) { type = 1; }
    else if ((it -= N_SWAC) < N_DFTC) { type = 2; }
    else { it -= N_DFTC; type = 3; }
#ifdef DUPTYPE
    for (int rep_ = 0; rep_ < ((type == (DUPTYPE & 3) && (int)lat == (DUPTYPE >> 2)) ? 2 : 1); rep_++)
#endif
    if (type == 0) {
      int qt, h, b, Sk;
      size_t tok0;
      if (lat) { qt = it & 31; h = (it >> 5) & 3; b = it >> 7; tok0 = T_CTX + b * 2048; Sk = 2560; }
      else { qt = it & 3; h = (it >> 2) & 3; b = it >> 4; tok0 = b * 256; Sk = 256; }
      const bf16_t* Kp = (lat ? W_Ka_lat : W_Ka_ctx) + (size_t)(b * 4 + h) * Sk * 96;
      const bf16_t* Vp = (lat ? W_Va_lat : W_Va_ctx) + (size_t)(b * 4 + h) * Sk * 64;
      attn_item<96>(W_Qa + tok0 * 384 + h * 96, 384, Kp, Vp, W_br + tok0 * 1024 + h * 64, qt * 64, Sk, 0, -1,
                    0.10206207261596575f, false, 0.f, smem);
    } else if (type == 1) {
      int qt, hq, b, Sk, nctx, W;
      size_t tok0;
      if (lat) { qt = it & 31; hq = (it >> 5) & 3; b = it >> 7; tok0 = T_CTX + b * 2048; Sk = 2560; nctx = 512; W = 128; }
      else { qt = it & 3; hq = (it >> 2) & 3; b = it >> 4; tok0 = b * 256; Sk = 256; nctx = 0; W = -1; }
      int kv = hq >> 1;
      const bf16_t* Kp = (lat ? W_Kd_lat : W_Kd_ctx) + (size_t)(b * 2 + kv) * Sk * 64;
      const bf16_t* Vp = (lat ? W_Vd_lat : W_Vd_ctx) + (size_t)(b * 2 + kv) * Sk * 64;
      attn_item<64>(W_Qd + tok0 * 256 + hq * 64, 256, Kp, Vp, W_br + tok0 * 1024 + 768 + hq * 64, qt * 64, Sk, nctx, W,
                    0.125f, true, p.swa_sink[l * 4 + hq], smem);
    } else if (type == 2) {
      int nt = it & 1, mt, b, S;
      size_t tok0;
      if (lat) { mt = (it >> 1) & 15; b = it >> 5; S = 2048; tok0 = T_CTX + b * 2048; }
      else { mt = (it >> 1) & 1; b = it >> 2; S = 256; tok0 = b * 256; }
      const bf16_t* Ap = (lat ? W_A2048 : W_A256) + (size_t)mt * 128 * 2 * S;
      const bf16_t* Bp = (lat ? W_Yt_lat : W_Yt_ctx) + (size_t)(b * 256 + nt * 128) * 2 * S;
      f32x4 acc[4][4];
      ZERO_ACC(acc);
      gemm_core(acc, Ap, 2 * S, Bp, 2 * S, 2 * S, smem);
      EPI_LOOP(acc, mt * 128, nt * 128, { W_br[(tok0 + m) * 1024 + 256 + n] = f2bf(v); });
    } else {
      gla_g1_item(p, l, it, smem);
    }
  }
}

#define EPI4_LOOP_N(acc, c0, t0, NJ, ...)                                                  \
  {                                                                                        \
    const int lane_ = tidx() & 63, w_ = tidx() >> 6, wm_ = w_ >> 1, wn_ = w_ & 1;           \
    _Pragma("unroll") for (int i_ = 0; i_ < 4; i_++)                                       \
    _Pragma("unroll") for (int j_ = 0; j_ < NJ; j_++) {                                    \
      const int col = (c0) + wm_ * 64 + i_ * 16 + (lane_ >> 4) * 4;                        \
      const int tok = (t0) + wn_ * (NJ * 16) + j_ * 16 + (lane_ & 15);                     \
      const f32x4 v4 = acc[i_][j_];                                                        \
      __VA_ARGS__                                                                          \
    }                                                                                      \
  }
__device__ __forceinline__ void phase_merge(const P& p, int l, char* smem) {
  constexpr int NJ = 2;
  bf16_t* sa = (bf16_t*)smem;
  bf16_t* sb = sa + 128 * GB_LD;
  const int tid = tidx(), lane = tid & 63, w = tid >> 6, wm = w >> 1, wn = w & 1;
  const int l15 = lane & 15, l4 = lane >> 4;
  for (int tile = blockIdx.x; tile < 192 * 8; tile += gridDim.x) {
    int tt = tile >> 3, nt = tile & 7, t0 = tt * 64, n0 = nt * 128;
    const bf16_t* A = W_Wt_br + ((size_t)l * 1024 + n0) * 1024;
    const bf16_t* B = W_br + (size_t)t0 * 1024;
    const int lda = 1024, ldb = 1024, K = 1024;
    f32x4 tot[4][2], acc[4][2];
    ZERO_ACC_N(tot, 2);
    ZERO_ACC_N(acc, 2);
    u32x4 ra0[4], rb0[NJ], ra1[4], rb1[NJ];
    G_LOAD(ra0, rb0, 0);
    G_LOAD(ra1, rb1, 64);
    ushort4 gl[4][2];
    for (int k0 = 0; k0 < K; k0 += 128) {
      const bool seg_end = (k0 & 128) != 0;
      const int bidx = k0 >> 8;
      if (seg_end) {
#pragma unroll
        for (int i_ = 0; i_ < 4; i_++)
#pragma unroll
          for (int j_ = 0; j_ < 2; j_++) {
            int col = n0 + wm * 64 + i_ * 16 + l4 * 4, tok = t0 + wn * 32 + j_ * 16 + l15;
            gl[i_][j_] = *(const ushort4*)(W_gates + (size_t)tok * 4096 + bidx * 1024 + col);
          }
      }
      __syncthreads();
      G_STORE(ra0, rb0);
      __syncthreads();
      if (k0 + 128 < K) { G_LOAD(ra0, rb0, k0 + 128); }
      G_COMPUTE();
      __syncthreads();
      G_STORE(ra1, rb1);
      __syncthreads();
      if (k0 + 192 < K) { G_LOAD(ra1, rb1, k0 + 192); }
      G_COMPUTE();
      if (seg_end) {
#pragma unroll
        for (int i_ = 0; i_ < 4; i_++)
#pragma unroll
          for (int j_ = 0; j_ < 2; j_++) {
            tot[i_][j_][0] += bf2f(gl[i_][j_].x) * acc[i_][j_][0];
            tot[i_][j_][1] += bf2f(gl[i_][j_].y) * acc[i_][j_][1];
            tot[i_][j_][2] += bf2f(gl[i_][j_].z) * acc[i_][j_][2];
            tot[i_][j_][3] += bf2f(gl[i_][j_].w) * acc[i_][j_][3];
            acc[i_][j_] = f32x4{0.f, 0.f, 0.f, 0.f};
          }
      }
    }
    EPI4_LOOP_N(tot, n0, t0, 2, {
      ushort4 o_; o_.x = f2bf(v4[0]); o_.y = f2bf(v4[1]); o_.z = f2bf(v4[2]); o_.w = f2bf(v4[3]);
      *(ushort4*)(W_u + (size_t)tok * 1024 + col) = o_;
    });
  }
}

__device__ __forceinline__ void phase_wout(const P& p, int l, char* smem) {
  float* r = W_hbuf;
  const float alpha = 1.4142135623730951f;
  for (int tile = blockIdx.x; tile < 96 * 8; tile += gridDim.x) {
    int mt = tile >> 3, nt = tile & 7, m0 = mt * 128, n0 = nt * 128;
    f32x4 acc[4][4];
    ZERO_ACC(acc);
    gemm_core(acc, W_Wt_out + ((size_t)l * 1024 + n0) * 1024, 1024, W_u + (size_t)m0 * 1024, 1024, 1024, smem);
    const float* g1 = W_mada + (l * 3 + cond_row(m0)) * 6144 + 2048;
    {
      const int lane_ = tidx() & 63, w_ = tidx() >> 6, wm_ = w_ >> 1, wn_ = w_ & 1;
#pragma unroll
      for (int ih = 0; ih < 2; ih++) {
        float4 xv[8];
#pragma unroll
        for (int q = 0; q < 8; q++) {
          int i_ = ih * 2 + (q >> 2), j_ = q & 3;
          int col = n0 + wm_ * 64 + i_ * 16 + (lane_ >> 4) * 4, tok = m0 + wn_ * 64 + j_ * 16 + (lane_ & 15);
          xv[q] = *(const float4*)(x_in_row(p, l, tok) + col);
        }
#pragma unroll
        for (int q = 0; q < 8; q++) {
          int i_ = ih * 2 + (q >> 2), j_ = q & 3;
          int col = n0 + wm_ * 64 + i_ * 16 + (lane_ >> 4) * 4, tok = m0 + wn_ * 64 + j_ * 16 + (lane_ & 15);
          float4 gv = *(const float4*)(g1 + col);
          f32x4 v4 = acc[i_][j_];
          *(float4*)(r + (size_t)tok * 1024 + col) = float4{alpha * xv[q].x + gv.x * v4[0], alpha * xv[q].y + gv.y * v4[1], alpha * xv[q].z + gv.z * v4[2], alpha * xv[q].w + gv.w * v4[3]};
        }
      }
    }
  }
}

__device__ __forceinline__ void phase_ln_mid(const P& p, int l) {
  int lane = tidx() & 63, w = tidx() >> 6;
  const float* r = W_hbuf;
  for (int it = blockIdx.x; it < T_ALL / 4; it += gridDim.x) {
    int g = it * 4 + w;
    float v[16];
    load_row16(r + (size_t)g * 1024, lane, v);
    ln16(v);
    affine16(v, p.ln1_g + l * 1024, p.ln1_b + l * 1024, lane);
    store_row16(x_out_row(p, l, g), lane, v);
    ln16(v);
    const float* m = W_mada + (l * 3 + cond_row(g)) * 6144;
    modulate_store(v, m + 3072, m + 4096, W_u + (size_t)g * 1024, lane);
  }
}

__device__ __forceinline__ void phase_pq(const P& p, int l, char* smem) {
  bf16_t* sc = W_gates;
  bf16_t* sa = (bf16_t*)smem;
  const int tid = tidx(), lane = tid & 63, w = tid >> 6, wm = w >> 1, wn = w & 1, l15 = lane & 15, l4 = lane >> 4;
  for (int tile = blockIdx.x; tile < 96 * 16; tile += gridDim.x) {
    int mt = tile >> 4, hp = tile & 15, m0 = mt * 128, n0 = hp * 128;
    f32x4 acc[4][4];
    ZERO_ACC(acc);
    gemm_core(acc, W_Wt_pq + ((size_t)l * 2048 + n0) * 1024, 1024, W_u + (size_t)m0 * 1024, 1024, 1024, smem);
    __syncthreads();
    {
      bf16_t* sB = sa + 128 * GB_LD * (1 + wm);
#pragma unroll
      for (int i = 0; i < 4; i++)
#pragma unroll
        for (int j = 0; j < 4; j++) {
          ushort4 o_;
          o_.x = f2bf(acc[i][j][0]); o_.y = f2bf(acc[i][j][1]); o_.z = f2bf(acc[i][j][2]); o_.w = f2bf(acc[i][j][3]);
          *(ushort4*)(sB + (wn * 64 + j * 16 + l15) * GB_LD + i * 16 + l4 * 4) = o_;
        }
    }
    f32x4 acc2[4][4];
    ZERO_ACC(acc2);
    const bf16_t* keys = W_keysbf + (size_t)(l * 16 + hp) * 128 * 128;
#pragma unroll
    for (int kh = 0; kh < 2; kh++) {
      u32x4 rk[4];
#pragma unroll
      for (int i = 0; i < 4; i++) { int c = tid + i * 256, r = c >> 3, cc = (c & 7) * 8; rk[i] = *(const u32x4*)(keys + r * 128 + kh * 64 + cc); }
      if (kh) __syncthreads();
#pragma unroll
      for (int i = 0; i < 4; i++) { int c = tid + i * 256, r = c >> 3, cc = (c & 7) * 8; *(u32x4*)(sa + r * GB_LD + cc) = rk[i]; }
      __syncthreads();
      const bf16_t* sBk = sa + 128 * GB_LD * (1 + kh);
#pragma unroll
      for (int ks = 0; ks < 2; ks++) {
        bf16x8 af[4], bfr[4];
#pragma unroll
        for (int i = 0; i < 4; i++) af[i] = *(const bf16x8*)(sa + (wm * 64 + i * 16 + l15) * GB_LD + ks * 32 + l4 * 8);
#pragma unroll
        for (int j = 0; j < 4; j++) bfr[j] = *(const bf16x8*)(sBk + (wn * 64 + j * 16 + l15) * GB_LD + ks * 32 + l4 * 8);
#pragma unroll
        for (int i = 0; i < 4; i++)
#pragma unroll
          for (int j = 0; j < 4; j++) acc2[i][j] = __builtin_amdgcn_mfma_f32_16x16x32_bf16(af[i], bfr[j], acc2[i][j], 0, 0, 0);
      }
    }
    EPI_LOOP(acc2, 0, m0, { sc[((size_t)(hp * 128 + m)) * T_ALL + n] = f2bf(v); });
  }
}

__device__ __forceinline__ void phase_scores(const P& p, int l, char* smem) {}

__device__ __forceinline__ int f2sort(float x) { int b = __float_as_int(x); return b ^ ((b >> 31) & 0x7fffffff); }
__device__ __forceinline__ float sort2f(int s) { return __int_as_float(s ^ ((s >> 31) & 0x7fffffff)); }
__device__ __forceinline__ void bitonic_sort16_desc(int (&a)[16]) {
#pragma unroll
  for (int k = 2; k <= 16; k <<= 1)
#pragma unroll
    for (int j = k >> 1; j > 0; j >>= 1)
#pragma unroll
      for (int i = 0; i < 16; i++) {
        int l_ = i ^ j;
        if (l_ > i) {
          int hi = max(a[i], a[l_]), lo = min(a[i], a[l_]);
          if ((i & k) == 0) { a[i] = hi; a[l_] = lo; } else { a[i] = lo; a[l_] = hi; }
        }
      }
}
__device__ __forceinline__ void merge_top16(int (&T)[16], const int (&S)[16]) {
#pragma unroll
  for (int i = 0; i < 16; i++) T[i] = max(T[i], S[15 - i]);
#pragma unroll
  for (int j = 8; j > 0; j >>= 1)
#pragma unroll
    for (int i = 0; i < 16; i++) {
      int l_ = i ^ j;
      if (l_ > i) { int hi = max(T[i], T[l_]), lo = min(T[i], T[l_]); T[i] = hi; T[l_] = lo; }
    }
}
__device__ __forceinline__ void top16_col(const bf16_t* src, int (&L)[16]) {
#pragma unroll 1
  for (int k0 = 0; k0 < 128; k0 += 16) {
    float xv[16];
#pragma unroll
    for (int k = 0; k < 16; k++) xv[k] = bf2f(src[(size_t)(k0 + k) * T_ALL]);
    int S[16];
#pragma unroll
    for (int k = 0; k < 16; k++) S[k] = (f2sort(xv[k]) & ~127) | (127 - (k0 + k));
    bitonic_sort16_desc(S);
    if (k0 == 0) {
#pragma unroll
      for (int k = 0; k < 16; k++) L[k] = S[k];
    } else {
      merge_top16(L, S);
    }
  }
}
__device__ __forceinline__ void phase_topk(const P& p, int l) {
  const bf16_t* sc = W_gates;
  int lane = tidx() & 63, w = tidx() >> 6;
  for (int it = blockIdx.x * 4 + w; it < 192 * 8; it += gridDim.x * 4) {
    int h = it & 7, t = (it >> 3) * 64 + lane;
    int L1[16], L2[16];
    const bf16_t* s1 = sc + (size_t)(h * 2) * 128 * T_ALL + t;
    top16_col(s1, L1);
    top16_col(s1 + (size_t)128 * T_ALL, L2);
    float v1[16], v2[16];
    unsigned P1[4] = {0u, 0u, 0u, 0u}, P2[4] = {0u, 0u, 0u, 0u};
#pragma unroll
    for (int i = 0; i < 16; i++) {
      v1[i] = sort2f(L1[i] & ~127);
      v2[i] = sort2f(L2[i] & ~127);
      P1[i >> 2] |= (unsigned)(127 - (L1[i] & 127)) << ((i & 3) * 8);
      P2[i >> 2] |= (unsigned)(127 - (L2[i] & 127)) << ((i & 3) * 8);
    }
    int Tk[16];
#pragma unroll
    for (int j = 0; j < 16; j++) Tk[j] = (f2sort(v1[0] + v2[j]) & ~255) | (255 - j);
    {
      int G[3][16];
#pragma unroll
      for (int g_ = 0; g_ < 3; g_++)
#pragma unroll
        for (int k = 0; k < 16; k++) G[g_][k] = (int)0x80000000;
      int cnt = 0;
#pragma unroll
      for (int i = 1; i < 16; i++) {
#pragma unroll
        for (int j = 0; j < 16 / (i + 1); j++) {
          G[cnt >> 4][cnt & 15] = (f2sort(v1[i] + v2[j]) & ~255) | (255 - (i * 16 + j));
          cnt++;
        }
      }
#pragma unroll
      for (int g_ = 0; g_ < 3; g_++) { bitonic_sort16_desc(G[g_]); merge_top16(Tk, G[g_]); }
    }
    float v0 = sort2f(Tk[0] & ~255);
    float e[16], Z = 0.f;
    int oi[16];
#pragma unroll
    for (int s_ = 0; s_ < 16; s_++) {
      e[s_] = __expf(sort2f(Tk[s_] & ~255) - v0);
      Z += e[s_];
      int code = 255 - (Tk[s_] & 255), i = code >> 4, j = code & 15;
      unsigned r1 = (i >> 2) == 0 ? P1[0] : (i >> 2) == 1 ? P1[1] : (i >> 2) == 2 ? P1[2] : P1[3];
      unsigned r2 = (j >> 2) == 0 ? P2[0] : (j >> 2) == 1 ? P2[1] : (j >> 2) == 2 ? P2[2] : P2[3];
      int i1 = (r1 >> ((i & 3) * 8)) & 255, i2 = (r2 >> ((j & 3) * 8)) & 255;
      oi[s_] = i1 * 128 + i2;
    }
    float inv = 1.f / Z;
    int* po = W_pidx + (size_t)t * 128 + h * 16;
    float* pwo = W_pw + (size_t)t * 128 + h * 16;
#pragma unroll
    for (int q = 0; q < 4; q++) {
      *(int4*)(po + q * 4) = int4{oi[q * 4], oi[q * 4 + 1], oi[q * 4 + 2], oi[q * 4 + 3]};
      *(float4*)(pwo + q * 4) = float4{e[q * 4] * inv, e[q * 4 + 1] * inv, e[q * 4 + 2] * inv, e[q * 4 + 3] * inv};
    }
  }
}

__device__ __forceinline__ void unpack16(u32x4 r, float (&f)[16]) {
#pragma unroll
  for (int q = 0; q < 4; q++) {
    auto lo = __builtin_amdgcn_cvt_pk_f32_fp8((int)r[q], false);
    auto hi = __builtin_amdgcn_cvt_pk_f32_fp8((int)r[q], true);
    f[q * 4 + 0] = lo[0]; f[q * 4 + 1] = lo[1]; f[q * 4 + 2] = hi[0]; f[q * 4 + 3] = hi[1];
  }
}
#define PEER_PF 8
#ifndef PEER_REP
#define PEER_REP 1
#endif
__device__ __forceinline__ void phase_peer(const P& p, int l, char* smem) {
  int lane = tidx() & 63, w = tidx() >> 6;
  float* scoef_w = (float*)smem + w * (8 * 128);
  const unsigned char* tu = W_tabU + (size_t)l * 16384 * 1024 + lane * 16;
  const unsigned char* tv = W_tabV + (size_t)l * 16384 * 1024 + lane * 16;
  const int nb = gridDim.x;
  const int ntok = (T_ALL / 4 - (int)blockIdx.x + nb - 1) / nb;
  for (int c0 = 0; c0 < ntok; c0 += 8) {
    const int nc = (ntok - c0) < 8 ? (ntok - c0) : 8;
    __builtin_amdgcn_wave_barrier();
    for (int t = 0; t < nc; t++) {
      const int g = ((int)blockIdx.x + (c0 + t) * nb) * 4 + w;
      float* scoef = scoef_w + t * 128;
      float uu[16];
      {
        u32x4 r0 = *(const u32x4*)(W_u + (size_t)g * 1024 + lane * 16);
        u32x4 r1 = *(const u32x4*)(W_u + (size_t)g * 1024 + lane * 16 + 8);
#pragma unroll
        for (int q = 0; q < 4; q++) {
          uu[q * 2] = __uint_as_float(r0[q] << 16); uu[q * 2 + 1] = __uint_as_float(r0[q] & 0xffff0000u);
          uu[8 + q * 2] = __uint_as_float(r1[q] << 16); uu[8 + q * 2 + 1] = __uint_as_float(r1[q] & 0xffff0000u);
        }
      }
      const float* pwt = W_pw + (size_t)g * 128;
      const int pi0 = W_pidx[(size_t)g * 128 + lane], pi1 = W_pidx[(size_t)g * 128 + 64 + lane];
      auto ldrows = [&](u32x4 (&r)[8], const unsigned char* tab, int e0) {
#pragma unroll
        for (int k = 0; k < 8; k++) {
          int e = e0 + k;
          int idx = __builtin_amdgcn_readlane(e < 64 ? pi0 : pi1, e & 63);
          r[k] = *(const u32x4*)(tab + (size_t)idx * 1024);
        }
      };
      float dv0 = 0.f, dv1 = 0.f;
      auto dots = [&](const u32x4 (&r)[8], int e0) {
#pragma unroll
        for (int k = 0; k < 8; k++) {
          float f[16];
          unpack16(r[k], f);
          float a = 0.f;
#pragma unroll
          for (int j = 0; j < 16; j++) a += uu[j] * f[j];
          float dd = wsum(a);
          if (e0 < 64) dv0 = (lane == e0 + k) ? dd : dv0;
          else dv1 = (lane == e0 + k - 64) ? dd : dv1;
        }
      };
      {
        u32x4 ra[8], rb[8];
        ldrows(ra, tu, 0);
#pragma unroll 1
        for (int e0 = 0; e0 < 128; e0 += 16) {
          ldrows(rb, tu, e0 + 8);
          dots(ra, e0);
          if (e0 + 16 < 128) ldrows(ra, tu, e0 + 16);
          dots(rb, e0 + 8);
        }
      }
      float d0 = dv0 * (1.f / PEER_U_SCALE), d1 = dv1 * (1.f / PEER_U_SCALE);
      float a0 = 0.5f * d0 * (1.f + erff(d0 * 0.7071067811865476f));
      float a1 = 0.5f * d1 * (1.f + erff(d1 * 0.7071067811865476f));
      scoef[lane] = pwt[lane] * a0 * (1.f / PEER_V_SCALE);
      scoef[64 + lane] = pwt[64 + lane] * a1 * (1.f / PEER_V_SCALE);
    }
    __builtin_amdgcn_s_waitcnt(0xc07f);
    __builtin_amdgcn_wave_barrier();
    for (int t = 0; t < nc; t++) {
      const int g = ((int)blockIdx.x + (c0 + t) * nb) * 4 + w;
      const float* scoef = scoef_w + t * 128;
      const int pi0 = W_pidx[(size_t)g * 128 + lane], pi1 = W_pidx[(size_t)g * 128 + 64 + lane];
      auto ldrows = [&](u32x4 (&r)[8], const unsigned char* tab, int e0) {
#pragma unroll
        for (int k = 0; k < 8; k++) {
          int e = e0 + k;
          int idx = __builtin_amdgcn_readlane(e < 64 ? pi0 : pi1, e & 63);
          r[k] = *(const u32x4*)(tab + (size_t)idx * 1024);
        }
      };
      float o[16];
#pragma unroll
      for (int j = 0; j < 16; j++) o[j] = 0.f;
      auto accum = [&](const u32x4 (&r)[8], int e0) {
#pragma unroll
        for (int k = 0; k < 8; k++) {
          float cf = scoef[e0 + k];
          float f[16];
          unpack16(r[k], f);
#pragma unroll
          for (int j = 0; j < 16; j++) o[j] += cf * f[j];
        }
      };
      {
        u32x4 ra[8], rb[8];
        ldrows(ra, tv, 0);
#pragma unroll 1
        for (int e0 = 0; e0 < 128; e0 += 16) {
          ldrows(rb, tv, e0 + 8);
          accum(ra, e0);
          if (e0 + 16 < 128) ldrows(ra, tv, e0 + 16);
          accum(rb, e0 + 8);
        }
      }
      float* xr = x_out_row(p, l, g) + lane * 16;
      const float* m = W_mada + (l * 3 + cond_row(g)) * 6144 + lane * 16;
      float x1[16];
#pragma unroll
      for (int q = 0; q < 4; q++) {
        float4 xv = *(const float4*)(xr + q * 4);
        float4 g2 = *(const float4*)(m + 5120 + q * 4);
        x1[q * 4 + 0] = 1.4142135623730951f * xv.x + g2.x * o[q * 4 + 0];
        x1[q * 4 + 1] = 1.4142135623730951f * xv.y + g2.y * o[q * 4 + 1];
        x1[q * 4 + 2] = 1.4142135623730951f * xv.z + g2.z * o[q * 4 + 2];
        x1[q * 4 + 3] = 1.4142135623730951f * xv.w + g2.w * o[q * 4 + 3];
      }
      ln16(x1);
#pragma unroll
      for (int q = 0; q < 4; q++) {
        float4 a = *(const float4*)(p.ln2_g + l * 1024 + lane * 16 + q * 4);
        float4 c = *(const float4*)(p.ln2_b + l * 1024 + lane * 16 + q * 4);
        x1[q * 4 + 0] = x1[q * 4 + 0] * a.x + c.x; x1[q * 4 + 1] = x1[q * 4 + 1] * a.y + c.y;
        x1[q * 4 + 2] = x1[q * 4 + 2] * a.z + c.z; x1[q * 4 + 3] = x1[q * 4 + 3] * a.w + c.w;
        *(float4*)(xr + q * 4) = float4{x1[q * 4], x1[q * 4 + 1], x1[q * 4 + 2], x1[q * 4 + 3]};
      }
      if (l == 0) {
        ln16(x1);
        const float* m1 = W_mada + (1 * 3 + cond_row(g)) * 6144 + lane * 16;
#pragma unroll
        for (int q = 0; q < 4; q++) {
          float4 a = *(const float4*)(m1 + 1024 + q * 4);
          float4 b = *(const float4*)(m1 + q * 4);
          ushort4 ov;
          ov.x = f2bf(x1[q * 4 + 0] * (1.f + a.x) + b.x);
          ov.y = f2bf(x1[q * 4 + 1] * (1.f + a.y) + b.y);
          ov.z = f2bf(x1[q * 4 + 2] * (1.f + a.z) + b.z);
          ov.w = f2bf(x1[q * 4 + 3] * (1.f + a.w) + b.w);
          *(ushort4*)(W_u + (size_t)g * 1024 + lane * 16 + q * 4) = ov;
        }
      }
    }
  }
}

#define N_PHASES 28
__device__ __forceinline__ void run_phase(const P& p, int ph, char* smem) {
#ifdef ONLYQ
  { int l = ph & 1; if (ONLYQ == -1) { phase_prep(p, smem); return; } if (ONLYQ == -2) { phase_ln0(p); return; }
    switch (ONLYQ) { case 0: phase_win(p, l, smem); break; case 1: phase_post(p, l); break; case 2: phase_small_gemms(p, l, smem); break; case 3: phase_mixers(p, l, smem); break; case 4: phase_gla_scan(p, l); break; case 5: phase_gla_out(p, l, smem); break; case 6: phase_merge(p, l, smem); break; case 7: phase_wout(p, l, smem); break; case 8: phase_ln_mid(p, l); break; case 9: phase_pq(p, l, smem); break; case 10: phase_scores(p, l, smem); break; case 11: phase_topk(p, l); break; case 12: phase_peer(p, l, smem); break; } return; }
#endif
  if (ph == 0) { phase_prep(p, smem); return; }
  if (ph == 1) { phase_ln0(p); return; }
  int l = (ph - 2) / 13, q = (ph - 2) % 13;
#ifdef EXCL
  if (q == EXCL) return;
#endif
  switch (q) {
    case 0: phase_win(p, l, smem); break;
    case 1: phase_post(p, l); break;
    case 2: phase_small_gemms(p, l, smem); break;
    case 3: phase_mixers(p, l, smem); break;
    case 4: phase_gla_scan(p, l); break;
    case 5: phase_gla_out(p, l, smem); break;
    case 6: phase_merge(p, l, smem); break;
    case 7: phase_wout(p, l, smem); break;
    case 8: phase_ln_mid(p, l); break;
    case 9: phase_pq(p, l, smem); break;
    case 10: phase_scores(p, l, smem); break;
    case 11: phase_topk(p, l); break;
    case 12: phase_peer(p, l, smem); break;
  }
}

#define XB_TMO      128
#define XB_XCNT(j)  (256  + 64 * (j))
#define XB_XSUB(j)  (1280 + 64 * (j))
#define XB_XGEN(j)  (2304 + 64 * (j))
#define XB_TOP      3328
#define XB_TOPGEN   3392
#define XCD_BAR_WORDS 3456
#define XB_SPIN_CAP (1u << 18)
#define LAS __attribute__((address_space(3)))

__device__ __forceinline__ unsigned xb_ld(unsigned* p)              { return __hip_atomic_load(p, __ATOMIC_RELAXED, __HIP_MEMORY_SCOPE_AGENT); }
__device__ __forceinline__ unsigned xb_add(unsigned* p, unsigned v) { return __hip_atomic_fetch_add(p, v, __ATOMIC_RELAXED, __HIP_MEMORY_SCOPE_AGENT); }
__device__ __forceinline__ unsigned xb_xcc_id() { return (unsigned)__builtin_amdgcn_s_getreg((3 << 11) | 20) & 0xFu; }
#define XB_SPIN(cond, bar) do { unsigned _sp = 0; while (cond) { __builtin_amdgcn_s_sleep(1); \
    if ((++_sp & 255u) == 0u) { if (xb_ld(&(bar)[XB_TMO])) break; if (_sp > XB_SPIN_CAP) { atomicAdd(&(bar)[XB_TMO], 1u); break; } } } } while (0)

struct XcdBarrier {
    unsigned* bar; unsigned x;
    volatile LAS unsigned* st;
};

__device__ __forceinline__ XcdBarrier xcd_barrier_post(unsigned* bar, volatile LAS unsigned* st) {
    XcdBarrier b; b.bar = bar; b.x = xb_xcc_id(); b.st = st;
    if (threadIdx.x == 0) (void)xb_add(&bar[XB_XCNT(b.x)], 1u);
    return b;
}
__device__ __forceinline__ void xcd_barrier_complete(unsigned* bar, unsigned x, unsigned& nloc, unsigned& nx) {
    const unsigned G = gridDim.x * gridDim.y * gridDim.z;
    unsigned sum, cnt, mine, sp = 0u;
    for (;;) {
        sum = 0u; cnt = 0u; mine = 0u;
#pragma unroll
        for (unsigned j = 0; j < 16; ++j) { const unsigned c = xb_ld(&bar[XB_XCNT(j)]); sum += c; cnt += (c > 0u) ? 1u : 0u; mine = (j == x) ? c : mine; }
        if (sum == G) break;
        __builtin_amdgcn_s_sleep(1);
        if ((++sp & 255u) == 0u) { if (xb_ld(&bar[XB_TMO])) break; if (sp > XB_SPIN_CAP) { atomicAdd(&bar[XB_TMO], 1u); break; } }
    }
    nloc = mine > 0u ? mine : 1u; nx = cnt > 0u ? cnt : 1u;
}

__device__ __forceinline__ void xcd_barrier(const XcdBarrier& b) {
    asm volatile("s_waitcnt vmcnt(0)" ::: "memory");
    __syncthreads();
    if (threadIdx.x == 0) {
        unsigned* bar = b.bar;
        __builtin_amdgcn_s_waitcnt(0);
        unsigned nloc = b.st[0], nx = b.st[1];
        if (nloc == 0u) { xcd_barrier_complete(bar, b.x, nloc, nx); b.st[0] = nloc; b.st[1] = nx; }
        const unsigned old = xb_add(&bar[XB_XSUB(b.x)], 1u);
        const unsigned gen = old / nloc;
        if (old + 1u == (gen + 1u) * nloc) {
            __builtin_amdgcn_fence(__ATOMIC_RELEASE, "agent");
            asm volatile("s_waitcnt vmcnt(0)" ::: "memory");
            const unsigned og = xb_add(&bar[XB_TOP], 1u);
            const unsigned tg = og / nx;
            if (og + 1u == (tg + 1u) * nx) xb_add(&bar[XB_TOPGEN], 1u);
            else XB_SPIN(xb_ld(&bar[XB_TOPGEN]) == tg, bar);
            __builtin_amdgcn_fence(__ATOMIC_ACQUIRE, "agent");
            xb_add(&bar[XB_XGEN(b.x)], 1u);
            asm volatile("s_waitcnt vmcnt(0)" ::: "memory");
        } else {
            XB_SPIN(xb_ld(&bar[XB_XGEN(b.x)]) == gen, bar);
            __builtin_amdgcn_fence(__ATOMIC_ACQUIRE, "agent");
            asm volatile("s_waitcnt vmcnt(0)" ::: "memory");
        }
    }
    __syncthreads();
}


#define SMEM_BYTES 61440

#if MULTI
__global__ void __launch_bounds__(256, 2) k_phase(P p, int ph) {
  __shared__ __attribute__((aligned(16))) char smem[SMEM_BYTES];
  run_phase(p, ph, smem);
}
#else
__global__ void __launch_bounds__(256, 2) k_mega(P p) {
  __shared__ __attribute__((aligned(16))) char smem[SMEM_BYTES];
  __shared__ uint4 xb_words;
  cg::grid_group grid = cg::this_grid();
  if (threadIdx.x == 0) xb_words = make_uint4(0u, 0u, 0u, 0u);
  __syncthreads();
  XcdBarrier xb = xcd_barrier_post((unsigned*)(p.ws + OFF_bar), (volatile LAS unsigned*)&xb_words);
#pragma nounroll
  for (int ph = 0; ph < N_PHASES; ph++) {
    if (ph >= 2 && (ph - 2) % 13 == 10) continue;
    run_phase(p, ph, smem);
#ifdef DUPMASK
    if (ph >= 2 && ((DUPMASK >> ((ph - 2) % 13)) & 1)) run_phase(p, ph, smem);
#endif
    if (ph + 1 < N_PHASES) {
      if (gridDim.y > 1) grid.sync();
      xcd_barrier(xb);
    }
  }
}
#endif

extern "C" void kernel_launch(void* const* d_in, const int* in_sizes, int n_in, void* d_out, int out_size, void* d_ws,
                              size_t ws_size, hipStream_t stream) {
  P p{};
  const float** fp = (const float**)&p;
  for (int i = 0; i < 32; i++) fp[i] = (const float*)d_in[i];
  p.out = (float*)d_out;
  p.ws = (char*)d_ws;
  size_t off = WS_TOTAL;
  if (off > ws_size) { fprintf(stderr, "ws too small: need %zu have %zu\n", off, ws_size); return; }
#if MULTI
  for (int ph = 0; ph < N_PHASES; ph++) hipLaunchKernelGGL(k_phase, dim3(512), dim3(256), 0, stream, p, ph);
#else
  static int grid_blocks = 0;
  if (!grid_blocks) {
    int dev = 0, cus = 0, per_cu = 0;
    hipGetDevice(&dev);
    hipDeviceGetAttribute(&cus, hipDeviceAttributeMultiprocessorCount, dev);
    hipOccupancyMaxActiveBlocksPerMultiprocessor(&per_cu, k_mega, 256, 0);
    if (per_cu > 2) per_cu = 2;
    grid_blocks = cus * per_cu;
  }
  hipMemsetAsync(p.ws + OFF_bar, 0, 16384, stream);
  void* args[] = {&p};
  hipError_t e = hipLaunchCooperativeKernel((void*)k_mega, dim3(grid_blocks), dim3(256), args, 0, stream);
  if (e != hipSuccess) fprintf(stderr, "cooperative launch failed: %s (grid %d)\n", hipGetErrorString(e), grid_blocks);
#endif
}
```

```cpp
#include <hip/hip_runtime.h>
#include <hip/hip_cooperative_groups.h>
#include <cstdio>
#include <cstdint>
namespace cg = cooperative_groups;

#ifndef MULTI
#define MULTI 0
#endif

typedef unsigned short bf16_t;
using bf16x8 = __attribute__((ext_vector_type(8))) short;
using f32x4 = __attribute__((ext_vector_type(4))) float;
using u32x4 = __attribute__((ext_vector_type(4))) unsigned int;

#define T_ALL 12288
#define T_CTX 8192
#define NEG_INF (-__builtin_inff())

__device__ __forceinline__ int tidx() {
  int t = threadIdx.x;
  asm volatile("" : "+v"(t));
  return t;
}
__device__ __forceinline__ bf16_t f2bf(float f) {
  unsigned u = __float_as_uint(f);
  u += 0x7fffu + ((u >> 16) & 1u);
  return (bf16_t)(u >> 16);
}
__device__ __forceinline__ float bf2f(bf16_t b) { return __uint_as_float(((unsigned)b) << 16); }
__device__ __forceinline__ float wsum_shfl(float v) {
#pragma unroll
  for (int o = 32; o; o >>= 1) v += __shfl_xor(v, o);
  return v;
}
#define DPP_F(old, src, ctrl, rm) __int_as_float(__builtin_amdgcn_update_dpp(__float_as_int(old), __float_as_int(src), ctrl, rm, 0xf, false))
__device__ __forceinline__ float wsum(float v) {
  v += DPP_F(v, v, 0xB1, 0xf);
  v += DPP_F(v, v, 0x4E, 0xf);
  v += DPP_F(v, v, 0x141, 0xf);
  v += DPP_F(v, v, 0x140, 0xf);
  v += DPP_F(0.f, v, 0x142, 0xa);
  v += DPP_F(0.f, v, 0x143, 0xc);
  return __int_as_float(__builtin_amdgcn_readlane(__float_as_int(v), 63));
}
__device__ __forceinline__ float wmax(float v) {
  v = fmaxf(v, DPP_F(v, v, 0xB1, 0xf));
  v = fmaxf(v, DPP_F(v, v, 0x4E, 0xf));
  v = fmaxf(v, DPP_F(v, v, 0x141, 0xf));
  v = fmaxf(v, DPP_F(v, v, 0x140, 0xf));
  v = fmaxf(v, DPP_F(v, v, 0x142, 0xa));
  v = fmaxf(v, DPP_F(v, v, 0x143, 0xc));
  return __int_as_float(__builtin_amdgcn_readlane(__float_as_int(v), 63));
}
__device__ __forceinline__ float siluf(float x) { return x * __builtin_amdgcn_rcpf(1.f + __expf(-x)); }
__device__ __forceinline__ float sigmf(float x) { return __builtin_amdgcn_rcpf(1.f + __expf(-x)); }
__device__ __forceinline__ float logsigf(float z) { return fminf(z, 0.f) - log1pf(__expf(-fabsf(z))); }
__device__ __forceinline__ int cond_row(int g) { return g < T_CTX ? 0 : 1 + ((g - T_CTX) >> 11); }

struct P {
  const float *x_prompt, *x_sample, *c, *cache_ckv, *cache_krope, *cache_swa_k, *cache_swa_v, *state_gla, *c_ctx,
      *w_ada, *b_ada, *w_in, *mla_q_norm, *w_uq, *mla_kv_norm, *w_ukv, *w_gla_a_fwd, *b_gla_a_fwd, *w_gla_a_bwd,
      *b_gla_a_bwd, *gla_norm, *swa_sink, *w_branch, *w_out, *ln1_g, *ln1_b, *ln2_g, *ln2_b, *w_peer_q, *peer_keys,
      *peer_u, *peer_v;
  float* out;
  char* ws;
};

constexpr size_t OFF_Wt_in = 0ull;
constexpr size_t OFF_Wt_uq = OFF_Wt_in + (((2ull * 6144 * 1024 * 2) + 255ull) & ~255ull);
constexpr size_t OFF_Wt_ukv = OFF_Wt_uq + (((2ull * 384 * 256 * 2) + 255ull) & ~255ull);
constexpr size_t OFF_Wt_br = OFF_Wt_ukv + (((2ull * 512 * 128 * 2) + 255ull) & ~255ull);
constexpr size_t OFF_Wt_out = OFF_Wt_br + (((8ull * 1024 * 256 * 2) + 255ull) & ~255ull);
constexpr size_t OFF_Wt_pq = OFF_Wt_out + (((2ull * 1024 * 1024 * 2) + 255ull) & ~255ull);
constexpr size_t OFF_keysbf = OFF_Wt_pq + (((2ull * 2048 * 1024 * 2) + 255ull) & ~255ull);
constexpr size_t OFF_Cch = OFF_keysbf + (((2ull * 16 * 128 * 128 * 2) + 255ull) & ~255ull);
constexpr size_t OFF_A256 = OFF_Cch + (((128ull * 64 * 2) + 255ull) & ~255ull);
constexpr size_t OFF_A2048 = OFF_A256 + (((256ull * 512 * 2) + 255ull) & ~255ull);
constexpr size_t OFF_mada = OFF_A2048 + (((2048ull * 4096 * 2) + 255ull) & ~255ull);
constexpr size_t OFF_xbuf = OFF_mada + (((2ull * 3 * 6144 * 4) + 255ull) & ~255ull);
constexpr size_t OFF_u = OFF_xbuf + 256ull;
constexpr size_t OFF_hbuf = OFF_u + (((12288ull * 1024 * 2) + 255ull) & ~255ull);
constexpr size_t OFF_gates = OFF_hbuf + (((12288ull * 1984 * 4) + 255ull) & ~255ull);
constexpr size_t OFF_qn = OFF_gates + (((12288ull * 4096 * 2) + 255ull) & ~255ull);
constexpr size_t OFF_ckv_all = OFF_qn + (((12288ull * 256 * 2) + 255ull) & ~255ull);
constexpr size_t OFF_Qa = OFF_ckv_all + (((13312ull * 128 * 2) + 255ull) & ~255ull);
constexpr size_t OFF_Ka_ctx = OFF_Qa + (((12288ull * 384 * 2) + 255ull) & ~255ull);
constexpr size_t OFF_Ka_lat = OFF_Ka_ctx + (((32ull * 4 * 256 * 96 * 2) + 255ull) & ~255ull);
constexpr size_t OFF_Va_ctx = OFF_Ka_lat + (((2ull * 4 * 2560 * 96 * 2) + 255ull) & ~255ull);
constexpr size_t OFF_Va_lat = OFF_Va_ctx + (((32ull * 4 * 256 * 64 * 2) + 255ull) & ~255ull);
constexpr size_t OFF_Qd = OFF_Va_lat + (((2ull * 4 * 2560 * 64 * 2) + 255ull) & ~255ull);
constexpr size_t OFF_Kd_ctx = OFF_Qd + (((12288ull * 256 * 2) + 255ull) & ~255ull);
constexpr size_t OFF_Kd_lat = OFF_Kd_ctx + (((32ull * 2 * 256 * 64 * 2) + 255ull) & ~255ull);
constexpr size_t OFF_Vd_ctx = OFF_Kd_lat + (((2ull * 2 * 2560 * 64 * 2) + 255ull) & ~255ull);
constexpr size_t OFF_Vd_lat = OFF_Vd_ctx + (((32ull * 2 * 256 * 64 * 2) + 255ull) & ~255ull);
constexpr size_t OFF_fnet = OFF_Vd_lat + (((2ull * 2 * 2560 * 64 * 2) + 255ull) & ~255ull);
constexpr size_t OFF_Yt_ctx = OFF_fnet + (((12288ull * 256 * 2) + 255ull) & ~255ull);
constexpr size_t OFF_Yt_lat = OFF_Yt_ctx + (((32ull * 256 * 512 * 2) + 255ull) & ~255ull);
constexpr size_t OFF_br = OFF_Yt_lat + (((2ull * 256 * 4096 * 2) + 255ull) & ~255ull);
constexpr size_t OFF_un = OFF_br + (((12288ull * 1024 * 2) + 255ull) & ~255ull);
constexpr size_t OFF_sin_ = OFF_un + (((1536ull * 2048 * 4) + 255ull) & ~255ull);
constexpr size_t OFF_gn = OFF_sin_ + (((1536ull * 2048 * 4) + 255ull) & ~255ull);
constexpr size_t OFF_pidx = OFF_gn + (((1536ull * 32 * 4) + 255ull) & ~255ull);
constexpr size_t OFF_pw = OFF_pidx + (((12288ull * 128 * 4) + 255ull) & ~255ull);
constexpr size_t OFF_bar = OFF_pw + (((12288ull * 128 * 4) + 255ull) & ~255ull);
constexpr size_t WS_TOTAL_OLD = OFF_pw + (((12288ull * 128 * 4) + 255ull) & ~255ull);
constexpr size_t OFF_tabU = OFF_bar + 16384ull;
constexpr size_t OFF_tabV = OFF_tabU + 2ull * 16384 * 1024;
constexpr size_t OFF_u8 = OFF_tabV + 2ull * 16384 * 1024;
constexpr size_t OFF_win8 = OFF_u8 + 12288ull * 1024;
constexpr size_t WS_TOTAL = OFF_win8 + 2ull * 4096 * 1024;
static_assert(WS_TOTAL <= 536870912ull, "workspace budget");
#define W_u8 ((unsigned char*)(p.ws + OFF_u8))
#define W_win8 ((unsigned char*)(p.ws + OFF_win8))
#define W_tabU ((unsigned char*)(p.ws + OFF_tabU))
#define W_tabV ((unsigned char*)(p.ws + OFF_tabV))
#define W_Wt_in ((bf16_t*)(p.ws + OFF_Wt_in))
#define W_Wt_uq ((bf16_t*)(p.ws + OFF_Wt_uq))
#define W_Wt_ukv ((bf16_t*)(p.ws + OFF_Wt_ukv))
#define W_Wt_br ((bf16_t*)(p.ws + OFF_Wt_br))
#define W_Wt_out ((bf16_t*)(p.ws + OFF_Wt_out))
#define W_Wt_pq ((bf16_t*)(p.ws + OFF_Wt_pq))
#define W_keysbf ((bf16_t*)(p.ws + OFF_keysbf))
#define W_Cch ((bf16_t*)(p.ws + OFF_Cch))
#define W_A256 ((bf16_t*)(p.ws + OFF_A256))
#define W_A2048 ((bf16_t*)(p.ws + OFF_A2048))
#define W_mada ((float*)(p.ws + OFF_mada))
#define W_xbuf ((float*)(p.ws + OFF_xbuf))
#define W_u ((bf16_t*)(p.ws + OFF_u))
#define W_hbuf ((float*)(p.ws + OFF_hbuf))
#define W_gates ((bf16_t*)(p.ws + OFF_gates))
#define W_qn ((bf16_t*)(p.ws + OFF_qn))
#define W_ckv_all ((bf16_t*)(p.ws + OFF_ckv_all))
#define W_Qa ((bf16_t*)(p.ws + OFF_Qa))
#define W_Ka_ctx ((bf16_t*)(p.ws + OFF_Ka_ctx))
#define W_Ka_lat ((bf16_t*)(p.ws + OFF_Ka_lat))
#define W_Va_ctx ((bf16_t*)(p.ws + OFF_Va_ctx))
#define W_Va_lat ((bf16_t*)(p.ws + OFF_Va_lat))
#define W_Qd ((bf16_t*)(p.ws + OFF_Qd))
#define W_Kd_ctx ((bf16_t*)(p.ws + OFF_Kd_ctx))
#define W_Kd_lat ((bf16_t*)(p.ws + OFF_Kd_lat))
#define W_Vd_ctx ((bf16_t*)(p.ws + OFF_Vd_ctx))
#define W_Vd_lat ((bf16_t*)(p.ws + OFF_Vd_lat))
#define W_fnet ((bf16_t*)(p.ws + OFF_fnet))
#define W_Yt_ctx ((bf16_t*)(p.ws + OFF_Yt_ctx))
#define W_Yt_lat ((bf16_t*)(p.ws + OFF_Yt_lat))
#define W_br ((bf16_t*)(p.ws + OFF_br))
#define W_un ((float*)(p.ws + OFF_un))
#define W_sin_ ((float*)(p.ws + OFF_sin_))
#define W_gn ((float*)(p.ws + OFF_gn))
#define W_pidx ((int*)(p.ws + OFF_pidx))
#define W_pw ((float*)(p.ws + OFF_pw))

#define GB_LD 72
#define G_LOAD(RA, RB, KOFF)                                                         \
  _Pragma("unroll") for (int i = 0; i < 4; i++) {                                    \
    int c = tid + i * 256, r = c >> 3, cc = (c & 7) * 8;                             \
    RA[i] = *(const u32x4*)(A + (size_t)r * lda + (KOFF) + cc);                      \
    if (i < NJ) RB[i] = *(const u32x4*)(B + (size_t)r * ldb + (KOFF) + cc);          \
  }
#define G_STORE(RA, RB)                                                              \
  _Pragma("unroll") for (int i = 0; i < 4; i++) {                                    \
    int c = tid + i * 256, r = c >> 3, cc = (c & 7) * 8;                             \
    *(u32x4*)(sa + r * GB_LD + cc) = RA[i];                                          \
    if (i < NJ) *(u32x4*)(sb + r * GB_LD + cc) = RB[i];                              \
  }
#define G_COMPUTE()                                                                  \
  _Pragma("unroll") for (int ks = 0; ks < 2; ks++) {                                 \
    bf16x8 af[4], bfr[NJ];                                                           \
    _Pragma("unroll") for (int i = 0; i < 4; i++)                                    \
      af[i] = *(const bf16x8*)(sa + (wm * 64 + i * 16 + l15) * GB_LD + ks * 32 + l4 * 8); \
    _Pragma("unroll") for (int j = 0; j < NJ; j++)                                   \
      bfr[j] = *(const bf16x8*)(sb + (wn * NJ * 16 + j * 16 + l15) * GB_LD + ks * 32 + l4 * 8); \
    _Pragma("unroll") for (int i = 0; i < 4; i++)                                    \
    _Pragma("unroll") for (int j = 0; j < NJ; j++)                                   \
      acc[i][j] = __builtin_amdgcn_mfma_f32_16x16x32_bf16(af[i], bfr[j], acc[i][j], 0, 0, 0); \
  }
template <int NJ>
__device__ __forceinline__ void gemm_core_t(f32x4 (&acc)[4][NJ], const bf16_t* __restrict__ A, int lda,
                                            const bf16_t* __restrict__ B, int ldb, int K, char* smem) {
  bf16_t* sa = (bf16_t*)smem;
  bf16_t* sb = sa + 128 * GB_LD;
  const int tid = tidx(), lane = tid & 63, w = tid >> 6, wm = w >> 1, wn = w & 1;
  const int l15 = lane & 15, l4 = lane >> 4;
  u32x4 ra0[4], rb0[NJ], ra1[4], rb1[NJ];
  G_LOAD(ra0, rb0, 0);
  if (K > 64) { G_LOAD(ra1, rb1, 64); }
  for (int k0 = 0; k0 < K; k0 += 128) {
    __syncthreads();
    G_STORE(ra0, rb0);
    __syncthreads();
    if (k0 + 128 < K) { G_LOAD(ra0, rb0, k0 + 128); }
    G_COMPUTE();
    if (k0 + 64 < K) {
      __syncthreads();
      G_STORE(ra1, rb1);
      __syncthreads();
      if (k0 + 192 < K) { G_LOAD(ra1, rb1, k0 + 192); }
      G_COMPUTE();
    }
  }
}
#define gemm_core gemm_core_t<4>
using i64x2 = __attribute__((ext_vector_type(2))) long;
__device__ __forceinline__ int pack_fp8x4(float a, float b, float c, float d) {
  int pk = __builtin_amdgcn_cvt_pk_fp8_f32(a, b, 0, false);
  return __builtin_amdgcn_cvt_pk_fp8_f32(c, d, pk, true);
}
__device__ __forceinline__ void gemm_core8(f32x4 (&acc)[4][4], const bf16_t* __restrict__ A, int lda,
                                           const bf16_t* __restrict__ B, int ldb, int K, char* smem) {
  constexpr int NJ = 4;
  bf16_t* sa = (bf16_t*)smem;
  bf16_t* sb = sa + 128 * GB_LD;
  const int tid = tidx(), lane = tid & 63, w = tid >> 6, wm = w >> 1, wn = w & 1;
  const int l15 = lane & 15, l4 = lane >> 4;
  u32x4 ra0[4], rb0[NJ], ra1[4], rb1[NJ];
  G_LOAD(ra0, rb0, 0);
  if (K > 64) { G_LOAD(ra1, rb1, 64); }
#define G_COMPUTE8()                                                                                   \
  _Pragma("unroll") for (int ks = 0; ks < 2; ks++) {                                                   \
    i64x2 af[4], bfr[4];                                                                               \
    _Pragma("unroll") for (int i = 0; i < 4; i++)                                                      \
      af[i] = *(const i64x2*)(sa + (wm * 64 + i * 16 + l15) * GB_LD + ks * 32 + l4 * 8);               \
    _Pragma("unroll") for (int j = 0; j < 4; j++)                                                      \
      bfr[j] = *(const i64x2*)(sb + (wn * 64 + j * 16 + l15) * GB_LD + ks * 32 + l4 * 8);              \
    _Pragma("unroll") for (int i = 0; i < 4; i++)                                                      \
    _Pragma("unroll") for (int j = 0; j < 4; j++) {                                                    \
      acc[i][j] = __builtin_amdgcn_mfma_f32_16x16x32_fp8_fp8(af[i].x, bfr[j].x, acc[i][j], 0, 0, 0);   \
      acc[i][j] = __builtin_amdgcn_mfma_f32_16x16x32_fp8_fp8(af[i].y, bfr[j].y, acc[i][j], 0, 0, 0);   \
    }                                                                                                  \
  }
  for (int k0 = 0; k0 < K; k0 += 128) {
    __syncthreads();
    G_STORE(ra0, rb0);
    __syncthreads();
    if (k0 + 128 < K) { G_LOAD(ra0, rb0, k0 + 128); }
    G_COMPUTE8();
    if (k0 + 64 < K) {
      __syncthreads();
      G_STORE(ra1, rb1);
      __syncthreads();
      if (k0 + 192 < K) { G_LOAD(ra1, rb1, k0 + 192); }
      G_COMPUTE8();
    }
  }
}
#define ZERO_ACC_N(acc, NJ)                                        \
  _Pragma("unroll") for (int i_ = 0; i_ < 4; i_++)                 \
  _Pragma("unroll") for (int j_ = 0; j_ < NJ; j_++) { acc[i_][j_] = f32x4{0.f, 0.f, 0.f, 0.f}; }
#define ZERO_ACC(acc) ZERO_ACC_N(acc, 4)
#define EPI_LOOP_N(acc, m0, n0, NJ, ...)                                                   \
  {                                                                                        \
    const int lane_ = tidx() & 63, w_ = tidx() >> 6, wm_ = w_ >> 1, wn_ = w_ & 1; \
    _Pragma("unroll") for (int i_ = 0; i_ < 4; i_++)                                       \
    _Pragma("unroll") for (int j_ = 0; j_ < NJ; j_++)                                      \
    _Pragma("unroll") for (int r_ = 0; r_ < 4; r_++) {                                     \
      const int m = (m0) + wm_ * 64 + i_ * 16 + (lane_ >> 4) * 4 + r_;                     \
      const int n = (n0) + wn_ * (NJ * 16) + j_ * 16 + (lane_ & 15);                       \
      float v = acc[i_][j_][r_];                                                           \
      __VA_ARGS__                                                                          \
    }                                                                                      \
  }
#define EPI_LOOP(acc, m0, n0, ...) EPI_LOOP_N(acc, m0, n0, 4, __VA_ARGS__)
#define EPI4_LOOP(acc, c0, t0, ...)                                                        \
  {                                                                                        \
    const int lane_ = tidx() & 63, w_ = tidx() >> 6, wm_ = w_ >> 1, wn_ = w_ & 1;           \
    _Pragma("unroll") for (int i_ = 0; i_ < 4; i_++)                                       \
    _Pragma("unroll") for (int j_ = 0; j_ < 4; j_++) {                                     \
      const int col = (c0) + wm_ * 64 + i_ * 16 + (lane_ >> 4) * 4;                        \
      const int tok = (t0) + wn_ * 64 + j_ * 16 + (lane_ & 15);                            \
      const f32x4 v4 = acc[i_][j_];                                                        \
      __VA_ARGS__                                                                          \
    }                                                                                      \
  }

__device__ __forceinline__ void transpose_tile(const float* __restrict__ src, int K, int N, bf16_t* __restrict__ dst, int tile, int ntn,
                               float* sm, int ldd = 0) {
  if (ldd == 0) ldd = K;
  int kt = tile / ntn, nt = tile % ntn, k0 = kt * 64, n0 = nt * 64;
  int tx = tidx() & 63, ty = tidx() >> 6;
  __syncthreads();
  for (int i = 0; i < 16; i++) {
    int k = i * 4 + ty, n = n0 + tx;
    sm[k * 65 + tx] = (n < N) ? src[(size_t)(k0 + k) * N + n] : 0.f;
  }
  __syncthreads();
  for (int i = 0; i < 16; i++) {
    int n = i * 4 + ty;
    dst[(size_t)(n0 + n) * ldd + k0 + tx] = f2bf(sm[tx * 65 + n]);
  }
}

__device__ __forceinline__ void transpose_tile8(const float* __restrict__ src, unsigned char* __restrict__ dst, int tile, float* sm) {
  int kt = tile >> 6, nt = tile & 63, k0 = kt * 64, n0 = nt * 64;
  int tx = tidx() & 63, ty = tidx() >> 6;
  __syncthreads();
  for (int i = 0; i < 16; i++) {
    int k = i * 4 + ty, n = 2048 + n0 + tx;
    sm[k * 65 + tx] = (n < 6080) ? src[(size_t)(k0 + k) * 6080 + n] : 0.f;
  }
  __syncthreads();
  for (int i = 0; i < 16; i++) {
    int n = i * 4 + ty;
    float v = sm[tx * 65 + n] * 64.f;
    dst[(size_t)(n0 + n) * 1024 + k0 + tx] = (unsigned char)(__builtin_amdgcn_cvt_pk_fp8_f32(v, v, 0, false) & 0xff);
  }
}

__device__ __forceinline__ void ada_item(const P& p, int item, float* sm) {
  int l = item / 24, cgp = item % 24;
  int lane = tidx() & 63, w = tidx() >> 6;
  const float* W = p.w_ada + (size_t)l * 1024 * 6144 + cgp * 256 + lane * 4;
  float4 a0 = {0, 0, 0, 0}, a1 = {0, 0, 0, 0}, a2 = {0, 0, 0, 0};
#pragma unroll 16
  for (int k = w * 256; k < (w + 1) * 256; k++) {
    float4 wv = *(const float4*)(W + (size_t)k * 6144);
    float c0 = siluf(p.c_ctx[k]), c1 = siluf(p.c[k]), c2 = siluf(p.c[1024 + k]);
    a0.x += c0 * wv.x; a0.y += c0 * wv.y; a0.z += c0 * wv.z; a0.w += c0 * wv.w;
    a1.x += c1 * wv.x; a1.y += c1 * wv.y; a1.z += c1 * wv.z; a1.w += c1 * wv.w;
    a2.x += c2 * wv.x; a2.y += c2 * wv.y; a2.z += c2 * wv.z; a2.w += c2 * wv.w;
  }
  __syncthreads();
  *(float4*)(sm + (w * 3 + 0) * 256 + lane * 4) = a0;
  *(float4*)(sm + (w * 3 + 1) * 256 + lane * 4) = a1;
  *(float4*)(sm + (w * 3 + 2) * 256 + lane * 4) = a2;
  __syncthreads();
  for (int o = tidx(); o < 768; o += 256) {
    int r = o >> 8, col = o & 255;
    float s = sm[(0 * 3 + r) * 256 + col] + sm[(1 * 3 + r) * 256 + col] + sm[(2 * 3 + r) * 256 + col] +
              sm[(3 * 3 + r) * 256 + col];
    W_mada[(l * 3 + r) * 6144 + cgp * 256 + col] = s + p.b_ada[l * 6144 + cgp * 256 + col];
  }
}

__device__ __forceinline__ void dft_seq_fill(bf16_t* dst, int S, int item) {
  float inv = rsqrtf((float)S);
  size_t base = (size_t)item * 2048;
  for (int e = 0; e < 8; e++) {
    size_t idx = base + e * 256 + tidx();
    int k = (int)(idx / (2 * S)), col = (int)(idx % (2 * S));
    int s = col < S ? col : col - S;
    int mm = (k * s) & (S - 1);
    float rev = (float)mm / (float)S;
    float v = col < S ? __builtin_amdgcn_cosf(rev) : -__builtin_amdgcn_sinf(rev);
    dst[idx] = f2bf(v * inv);
  }
}

#define PEER_U_SCALE 64.f
#define PEER_V_SCALE 16.f
__device__ __forceinline__ void tab_convert_item(const P& p, int item) {
  int l = item >> 12, isv = (item >> 11) & 1, sub = item & 2047;
  const float* src = (isv ? p.peer_v : p.peer_u) + (size_t)l * 16384 * 1024 + (size_t)sub * 8192;
  unsigned char* dst = (isv ? W_tabV : W_tabU) + (size_t)l * 16384 * 1024 + (size_t)sub * 8192;
  const float sc = isv ? PEER_V_SCALE : PEER_U_SCALE;
  int tid = tidx();
  float4 tt[8];
#pragma unroll
  for (int e = 0; e < 8; e++) tt[e] = *(const float4*)(src + (e * 256 + tid) * 4);
#pragma unroll
  for (int e = 0; e < 8; e++) {
    float4 t = tt[e];
    int pk = __builtin_amdgcn_cvt_pk_fp8_f32(t.x * sc, t.y * sc, 0, false);
    pk = __builtin_amdgcn_cvt_pk_fp8_f32(t.z * sc, t.w * sc, pk, true);
    *(int*)(dst + (e * 256 + tid) * 4) = pk;
  }
}

__device__ __forceinline__ void phase_prep(const P& p, char* smem) {
  float* sm = (float*)smem;
  const int nb = gridDim.x;
  const int J_ADA = 48;
  const int J_IN = 2 * 16 * 32;
  const int J_IN8 = 2 * 16 * 64;
  const int J_UQ = 2 * 4 * 6;
  const int J_UKV = 2 * 2 * 8;
  const int J_BR = 2 * 4 * 4 * 16;
  const int J_OUT = 2 * 16 * 16;
  const int J_PQ = 2 * 16 * 32;
  const int J_KEYS = 256;
  const int J_CCH = 4;
  const int J_A256 = 64;
  const int J_A2048 = 4096;
  const int J_TAB = 8192;
  const int total = J_ADA + J_IN + J_IN8 + J_UQ + J_UKV + J_BR + J_OUT + J_PQ + J_KEYS + J_CCH + J_A256 + J_A2048 + J_TAB;
  const bool ada_split = nb >= 4 * J_ADA;
  const int it_start = ada_split ? ((int)blockIdx.x < J_ADA ? (int)blockIdx.x : J_ADA + ((int)blockIdx.x - J_ADA)) : (int)blockIdx.x;
  const int it_step = ada_split ? ((int)blockIdx.x < J_ADA ? total : nb - J_ADA) : nb;
  for (int it0 = it_start; it0 < total; it0 += it_step) {
    int it = it0;
    if (it < J_ADA) { ada_item(p, it, sm); continue; }
    it -= J_ADA;
    if (it < J_IN) { int l = it / 512, t = it % 512; transpose_tile(p.w_in + (size_t)l * 1024 * 6080, 1024, 6080, W_Wt_in + (size_t)l * 6144 * 1024, t, 32, sm); continue; }
    it -= J_IN;
    if (it < J_IN8) { int l = it / 1024, t = it % 1024; transpose_tile8(p.w_in + (size_t)l * 1024 * 6080, W_win8 + (size_t)l * 4096 * 1024, t, sm); continue; }
    it -= J_IN8;
    if (it < J_UQ) { int l = it / 24, t = it % 24; transpose_tile(p.w_uq + (size_t)l * 256 * 384, 256, 384, W_Wt_uq + (size_t)l * 384 * 256, t, 6, sm); continue; }
    it -= J_UQ;
    if (it < J_UKV) { int l = it / 16, t = it % 16; transpose_tile(p.w_ukv + (size_t)l * 128 * 512, 128, 512, W_Wt_ukv + (size_t)l * 512 * 128, t, 8, sm); continue; }
    it -= J_UKV;
    if (it < J_BR) { int lb = it / 64, t = it % 64; transpose_tile(p.w_branch + (size_t)lb * 256 * 1024, 256, 1024, W_Wt_br + (size_t)(lb >> 2) * 1024 * 1024 + (lb & 3) * 256, t, 16, sm, 1024); continue; }
    it -= J_BR;
    if (it < J_OUT) { int l = it / 256, t = it % 256; transpose_tile(p.w_out + (size_t)l * 1024 * 1024, 1024, 1024, W_Wt_out + (size_t)l * 1024 * 1024, t, 16, sm); continue; }
    it -= J_OUT;
    if (it < J_PQ) { int l = it / 512, t = it % 512; transpose_tile(p.w_peer_q + (size_t)l * 1024 * 2048, 1024, 2048, W_Wt_pq + (size_t)l * 2048 * 1024, t, 32, sm); continue; }
    it -= J_PQ;
    if (it < J_KEYS) {
      size_t base = (size_t)it * 2048;
      float kv_[8];
#pragma unroll
      for (int e = 0; e < 8; e++) kv_[e] = p.peer_keys[base + e * 256 + tidx()];
#pragma unroll
      for (int e = 0; e < 8; e++) W_keysbf[base + e * 256 + tidx()] = f2bf(kv_[e]);
      continue;
    }
    it -= J_KEYS;
    if (it < J_CCH) {
      for (int e = 0; e < 8; e++) {
        int idx = it * 2048 + e * 256 + tidx();
        int n = idx >> 6, c = idx & 63;
        int j = n & 63;
        float rev = (float)((j * c) & 63) / 64.f;
        float v = n < 64 ? __builtin_amdgcn_cosf(rev) : __builtin_amdgcn_sinf(rev);
        W_Cch[idx] = f2bf(v * 0.125f);
      }
      continue;
    }
    it -= J_CCH;
    if (it < J_A256) { dft_seq_fill(W_A256, 256, it); continue; }
    it -= J_A256;
    if (it < J_A2048) { dft_seq_fill(W_A2048, 2048, it); continue; }
    it -= J_A2048;
    tab_convert_item(p, it);
  }
}

__device__ __forceinline__ void load_row16(const float* row, int lane, float (&v)[16]) {
#pragma unroll
  for (int q = 0; q < 4; q++) {
    float4 t = *(const float4*)(row + q * 256 + lane * 4);
    v[q * 4 + 0] = t.x; v[q * 4 + 1] = t.y; v[q * 4 + 2] = t.z; v[q * 4 + 3] = t.w;
  }
}
__device__ __forceinline__ void store_row16(float* row, int lane, const float (&v)[16]) {
#pragma unroll
  for (int q = 0; q < 4; q++) *(float4*)(row + q * 256 + lane * 4) = float4{v[q * 4], v[q * 4 + 1], v[q * 4 + 2], v[q * 4 + 3]};
}
__device__ __forceinline__ void ln16(float (&v)[16]) {
  float s = 0;
#pragma unroll
  for (int i = 0; i < 16; i++) s += v[i];
  s = wsum(s);
  float mu = s * (1.f / 1024.f);
  float q = 0;
#pragma unroll
  for (int i = 0; i < 16; i++) { v[i] -= mu; q += v[i] * v[i]; }
  q = wsum(q);
  float rs = rsqrtf(q * (1.f / 1024.f) + 1e-6f);
#pragma unroll
  for (int i = 0; i < 16; i++) v[i] *= rs;
}
__device__ __forceinline__ void modulate_store(const float (&v)[16], const float* sh, const float* sc, bf16_t* dst, int lane, unsigned char* dst8 = nullptr) {
#pragma unroll
  for (int q = 0; q < 4; q++) {
    float4 a = *(const float4*)(sc + q * 256 + lane * 4);
    float4 b = *(const float4*)(sh + q * 256 + lane * 4);
    ushort4 o;
    o.x = f2bf(v[q * 4 + 0] * (1.f + a.x) + b.x);
    o.y = f2bf(v[q * 4 + 1] * (1.f + a.y) + b.y);
    o.z = f2bf(v[q * 4 + 2] * (1.f + a.z) + b.z);
    o.w = f2bf(v[q * 4 + 3] * (1.f + a.w) + b.w);
    *(ushort4*)(dst + q * 256 + lane * 4) = o;
    if (dst8) *(int*)(dst8 + q * 256 + lane * 4) = pack_fp8x4(v[q * 4 + 0] * (1.f + a.x) + b.x, v[q * 4 + 1] * (1.f + a.y) + b.y,
                                                               v[q * 4 + 2] * (1.f + a.z) + b.z, v[q * 4 + 3] * (1.f + a.w) + b.w);
  }
}
__device__ __forceinline__ void affine16(float (&v)[16], const float* g, const float* b, int lane) {
#pragma unroll
  for (int q = 0; q < 4; q++) {
    float4 a = *(const float4*)(g + q * 256 + lane * 4);
    float4 c = *(const float4*)(b + q * 256 + lane * 4);
    v[q * 4 + 0] = v[q * 4 + 0] * a.x + c.x;
    v[q * 4 + 1] = v[q * 4 + 1] * a.y + c.y;
    v[q * 4 + 2] = v[q * 4 + 2] * a.z + c.z;
    v[q * 4 + 3] = v[q * 4 + 3] * a.w + c.w;
  }
}
__device__ __forceinline__ const float* x_in_row(const P& p, int l, int g) {
  if (l == 0) return g < T_CTX ? p.x_prompt + (size_t)g * 1024 : p.x_sample + (size_t)(g - T_CTX) * 1024;
  return p.out + (size_t)g * 1024;
}
__device__ __forceinline__ float* x_out_row(const P& p, int l, int g) {
  return p.out + (size_t)g * 1024;
}

__device__ __forceinline__ void phase_ln0(const P& p) {
  int lane = tidx() & 63, w = tidx() >> 6;
  for (int it = blockIdx.x; it < T_ALL / 4; it += gridDim.x) {
    int g = it * 4 + w;
    float v[16];
    load_row16(x_in_row(p, 0, g), lane, v);
    ln16(v);
    const float* m = W_mada + (0 * 3 + cond_row(g)) * 6144;
    modulate_store(v, m, m + 1024, W_u + (size_t)g * 1024, lane, W_u8 + (size_t)g * 1024);
  }
}

__device__ __forceinline__ void phase_win(const P& p, int l, char* smem) {
  const bf16_t* Wt = W_Wt_in + (size_t)l * 6144 * 1024;
  const unsigned char* Wt8 = W_win8 + (size_t)l * 4096 * 1024;
  for (int tile = blockIdx.x; tile < 96 * 48; tile += gridDim.x) {
    int mt = tile / 48, nt = tile % 48, m0 = mt * 128, n0 = nt * 128;
    f32x4 acc[4][4];
    ZERO_ACC(acc);
    if (nt < 16) {
      gemm_core(acc, Wt + (size_t)n0 * 1024, 1024, W_u + (size_t)m0 * 1024, 1024, 1024, smem);
      EPI4_LOOP(acc, n0, m0, {
        if (col < 1984) *(float4*)(W_hbuf + (size_t)tok * 1984 + col) = float4{v4[0], v4[1], v4[2], v4[3]};
        else {
          ushort4 o_; o_.x = f2bf(sigmf(v4[0])); o_.y = f2bf(sigmf(v4[1])); o_.z = f2bf(sigmf(v4[2])); o_.w = f2bf(sigmf(v4[3]));
          *(ushort4*)(W_gates + (size_t)tok * 4096 + (col - 1984)) = o_;
        }
      });
    } else {
      gemm_core8(acc, (const bf16_t*)(Wt8 + (size_t)(n0 - 2048) * 1024), 512, (const bf16_t*)(W_u8 + (size_t)m0 * 1024), 512, 512, smem);
      EPI4_LOOP(acc, n0, m0, {
        if (col < 6080) {
          ushort4 o_;
          o_.x = f2bf(sigmf(v4[0] * (1.f / 64.f))); o_.y = f2bf(sigmf(v4[1] * (1.f / 64.f)));
          o_.z = f2bf(sigmf(v4[2] * (1.f / 64.f))); o_.w = f2bf(sigmf(v4[3] * (1.f / 64.f)));
          *(ushort4*)(W_gates + (size_t)tok * 4096 + (col - 1984)) = o_;
        }
      });
    }
  }
}

__device__ __forceinline__ void rope_cs(float pos, int i, float inv_hp, float& cs, float& sn) {
  float freq = exp2f(-(float)i * inv_hp * 13.287712379549449f);
  float a = pos * freq;
  sn = __sinf(a);
  cs = __cosf(a);
}

__device__ __forceinline__ void phase_post(const P& p, int l) {
  int lane = tidx() & 63, w = tidx() >> 6;
  for (int it = blockIdx.x; it < 13312 / 4; it += gridDim.x) {
    int g = it * 4 + w;
    if (g < T_ALL) {
      const bool lat = g >= T_CTX;
      int b, s;
      if (!lat) { b = g >> 8; s = g & 255; } else { b = (g - T_CTX) >> 11; s = (g - T_CTX) & 2047; }
      const float* h = W_hbuf + (size_t)g * 1984;
      const float prow = (float)(s >> 6), pcol = (float)(s & 63);
      const float4 pl_q = *(const float4*)(h + lane * 4);
      const float2 pl_c = *(const float2*)(h + 256 + lane * 2);
      const float pl_kr1 = h[384 + ((lane >> 3) & 1) * 16 + (lane & 7)], pl_kr2 = h[384 + ((lane >> 3) & 1) * 16 + 8 + (lane & 7)];
      const float4 pl_f = *(const float4*)(h + 416 + lane * 4);
      float pl_sq1[2], pl_sq2[2];
#pragma unroll
      for (int jj = 0; jj < 2; jj++) {
        int pi = lane + 64 * jj, hq = pi >> 5, pp = (pi >> 4) & 1, i = pi & 15;
        pl_sq1[jj] = h[1472 + hq * 64 + pp * 32 + i]; pl_sq2[jj] = h[1472 + hq * 64 + pp * 32 + 16 + i];
      }
      const float pl_sk1 = h[1728 + (lane >> 5) * 64 + ((lane >> 4) & 1) * 32 + (lane & 15)];
      const float pl_sk2 = h[1728 + (lane >> 5) * 64 + ((lane >> 4) & 1) * 32 + 16 + (lane & 15)];
      const float2 pl_v = *(const float2*)(h + 1856 + lane * 2);
      {
        float4 t = pl_q;
        float ss = wsum(t.x * t.x + t.y * t.y + t.z * t.z + t.w * t.w);
        float rs = rsqrtf(ss * (1.f / 256.f) + 1e-6f);
        float4 gq = *(const float4*)(p.mla_q_norm + l * 256 + lane * 4);
        ushort4 o;
        o.x = f2bf(t.x * rs * gq.x); o.y = f2bf(t.y * rs * gq.y); o.z = f2bf(t.z * rs * gq.z); o.w = f2bf(t.w * rs * gq.w);
        *(ushort4*)(W_qn + (size_t)g * 256 + lane * 4) = o;
      }
      {
        float2 t = pl_c;
        float ss = wsum(t.x * t.x + t.y * t.y);
        float rs = rsqrtf(ss * (1.f / 128.f) + 1e-6f);
        float2 gk = *(const float2*)(p.mla_kv_norm + l * 128 + lane * 2);
        float v0 = t.x * rs * gk.x, v1 = t.y * rs * gk.y;
        ushort2 o; o.x = f2bf(v0); o.y = f2bf(v1);
        *(ushort2*)(W_ckv_all + (size_t)g * 128 + lane * 2) = o;
        if (!lat) *(float2*)(p.out + 12582912 + ((size_t)((b * 2 + l) * 256 + s)) * 128 + lane * 2) = float2{v0, v1};
      }
      if (lane < 16) {
        int pp = lane >> 3, i = lane & 7;
        float x1 = pl_kr1, x2 = pl_kr2;
        float o1 = x1, o2 = x2;
        if (lat) {
          float cs, sn;
          rope_cs(pp ? pcol : prow, i, 0.125f, cs, sn);
          o1 = x1 * cs - x2 * sn; o2 = x2 * cs + x1 * sn;
        } else {
          float* ok = p.out + 14680064 + ((size_t)((b * 2 + l) * 256 + s)) * 32 + pp * 16 + i;
          ok[0] = o1; ok[8] = o2;
        }
        bf16_t b1 = f2bf(o1), b2 = f2bf(o2);
        for (int hh = 0; hh < 4; hh++) {
          bf16_t* kd = lat ? W_Ka_lat + ((size_t)((b * 4 + hh) * 2560 + 512 + s)) * 96 : W_Ka_ctx + ((size_t)((b * 4 + hh) * 256 + s)) * 96;
          kd[64 + pp * 16 + i] = b1; kd[64 + pp * 16 + 8 + i] = b2;
        }
      }
      {
        float4 t = pl_f;
        ushort4 o; o.x = f2bf(t.x); o.y = f2bf(t.y); o.z = f2bf(t.z); o.w = f2bf(t.w);
        *(ushort4*)(W_fnet + (size_t)g * 256 + lane * 4) = o;
      }
#pragma unroll
      for (int jj = 0; jj < 2; jj++) {
        int pi = lane + 64 * jj, hq = pi >> 5, pp = (pi >> 4) & 1, i = pi & 15;
        float x1 = pl_sq1[jj], x2 = pl_sq2[jj];
        float o1 = x1, o2 = x2;
        if (lat) {
          float cs, sn;
          rope_cs(pp ? pcol : prow, i, 0.0625f, cs, sn);
          o1 = x1 * cs - x2 * sn; o2 = x2 * cs + x1 * sn;
        }
        bf16_t* qd = W_Qd + (size_t)g * 256 + hq * 64 + pp * 32 + i;
        qd[0] = f2bf(o1); qd[16] = f2bf(o2);
      }
      {
        int kv = lane >> 5, pp = (lane >> 4) & 1, i = lane & 15;
        float x1 = pl_sk1, x2 = pl_sk2;
        float o1 = x1, o2 = x2;
        bf16_t* kd;
        if (lat) {
          float cs, sn;
          rope_cs(pp ? pcol : prow, i, 0.0625f, cs, sn);
          o1 = x1 * cs - x2 * sn; o2 = x2 * cs + x1 * sn;
          kd = W_Kd_lat + ((size_t)((b * 2 + kv) * 2560 + 512 + s)) * 64;
        } else {
          float* ok = p.out + 15204352 + ((size_t)(((b * 2 + l) * 2 + kv) * 256 + s)) * 64 + pp * 32 + i;
          ok[0] = o1; ok[16] = o2;
          kd = W_Kd_ctx + ((size_t)((b * 2 + kv) * 256 + s)) * 64;
        }
        kd[pp * 32 + i] = f2bf(o1); kd[pp * 32 + 16 + i] = f2bf(o2);
      }
      {
        int e = lane * 2, kv = e >> 6, d = e & 63;
        float2 t = pl_v;
        if (lat) {
          bf16_t* vt = W_Vd_lat + (size_t)(b * 2 + kv) * 64 * 2560 + 512 + s;
          vt[(size_t)d * 2560] = f2bf(t.x); vt[(size_t)(d + 1) * 2560] = f2bf(t.y);
        } else {
          *(float2*)(p.out + 17301504 + ((size_t)(((b * 2 + l) * 2 + kv) * 256 + s)) * 64 + d) = t;
          bf16_t* vt = W_Vd_ctx + (size_t)(b * 2 + kv) * 64 * 256 + s;
          vt[d * 256] = f2bf(t.x); vt[(d + 1) * 256] = f2bf(t.y);
        }
      }
    } else {
      int gc = g - T_ALL, b = gc >> 9, pp = gc & 511;
      {
        float2 t = *(const float2*)(p.cache_ckv + ((size_t)((b * 2 + l) * 512 + pp)) * 128 + lane * 2);
        ushort2 o; o.x = f2bf(t.x); o.y = f2bf(t.y);
        *(ushort2*)(W_ckv_all + (size_t)g * 128 + lane * 2) = o;
      }
      if (lane < 32) {
        bf16_t v = f2bf(p.cache_krope[((size_t)((b * 2 + l) * 512 + pp)) * 32 + lane]);
        for (int hh = 0; hh < 4; hh++) W_Ka_lat[((size_t)((b * 4 + hh) * 2560 + pp)) * 96 + 64 + lane] = v;
      }
      {
        int e = lane * 2, kv = e >> 6, d = e & 63;
        size_t src = ((size_t)(((b * 2 + l) * 2 + kv) * 512 + pp)) * 64 + d;
        float2 tk = *(const float2*)(p.cache_swa_k + src);
        float2 tv = *(const float2*)(p.cache_swa_v + src);
        size_t dst = ((size_t)((b * 2 + kv) * 2560 + pp)) * 64 + d;
        ushort2 ok; ok.x = f2bf(tk.x); ok.y = f2bf(tk.y);
        *(ushort2*)(W_Kd_lat + dst) = ok;
        bf16_t* vt = W_Vd_lat + (size_t)(b * 2 + kv) * 64 * 2560 + pp;
        vt[(size_t)d * 2560] = f2bf(tv.x); vt[(size_t)(d + 1) * 2560] = f2bf(tv.y);
      }
    }
  }
}

__device__ __forceinline__ void phase_small_gemms(const P& p, int l, char* smem) {
  const int NA = 96 * 3, NB = 104 * 4, NC = 384;
  for (int it0 = blockIdx.x; it0 < NA + NB + NC; it0 += gridDim.x) {
    int it = it0;
    f32x4 acc[4][4];
    ZERO_ACC(acc);
    if (it < NA) {
      int mt = it / 3, nt = it % 3, m0 = mt * 128, n0 = nt * 128;
      gemm_core(acc, W_qn + (size_t)m0 * 256, 256, W_Wt_uq + (size_t)l * 384 * 256 + (size_t)n0 * 256, 256, 256, smem);
      const bool lat = m0 >= T_CTX;
      EPI_LOOP(acc, m0, n0, {
        int c96 = n % 96;
        if (lat && c96 >= 64) {
          float pv = DPP_F(v, v, 0x128, 0xf);
          int cr = c96 - 64, pp = cr >> 4, ii = cr & 15, i = ii & 7;
          int s = (m - T_CTX) & 2047;
          float cs, sn;
          rope_cs(pp ? (float)(s & 63) : (float)(s >> 6), i, 0.125f, cs, sn);
          v = (ii < 8) ? v * cs - pv * sn : v * cs + pv * sn;
        }
        W_Qa[(size_t)m * 384 + n] = f2bf(v);
      });
      continue;
    }
    it -= NA;
    if (it < NB) {
      int mt = it / 4, nt = it % 4, m0 = mt * 128, n0 = nt * 128;
      gemm_core(acc, W_ckv_all + (size_t)m0 * 128, 128, W_Wt_ukv + (size_t)l * 512 * 128 + (size_t)n0 * 128, 128, 128, smem);
      EPI_LOOP(acc, m0, n0, {
        int hh = n >> 7, c = n & 127;
        bf16_t* kd; bf16_t* vd; int vstride;
        if (m < T_CTX) {
          int b = m >> 8, s = m & 255;
          size_t r = (size_t)((b * 4 + hh) * 256 + s);
          kd = W_Ka_ctx + r * 96; vd = W_Va_ctx + (size_t)(b * 4 + hh) * 64 * 256 + s; vstride = 256;
        } else {
          int b, pos;
          if (m < T_ALL) { b = (m - T_CTX) >> 11; pos = 512 + ((m - T_CTX) & 2047); }
          else { b = (m - T_ALL) >> 9; pos = (m - T_ALL) & 511; }
          size_t r = (size_t)((b * 4 + hh) * 2560 + pos);
          kd = W_Ka_lat + r * 96; vd = W_Va_lat + (size_t)(b * 4 + hh) * 64 * 2560 + pos; vstride = 2560;
        }
        if (c < 64) kd[c] = f2bf(v); else vd[(size_t)(c - 64) * vstride] = f2bf(v);
      });
      continue;
    }
    it -= NB;
    {
      int m0 = it * 128;
      gemm_core(acc, W_fnet + (size_t)m0 * 64, 64, W_Cch, 64, 64, smem);
      EPI_LOOP(acc, m0, 0, {
        int g = m >> 2, grp = m & 3, part = n >> 6, j = n & 63;
        if (g < T_CTX) {
          int b = g >> 8, s = g & 255;
          W_Yt_ctx[((size_t)(b * 256 + grp * 64 + j)) * 512 + part * 256 + s] = f2bf(v);
        } else {
          int b = (g - T_CTX) >> 11, s = (g - T_CTX) & 2047;
          W_Yt_lat[((size_t)(b * 256 + grp * 64 + j)) * 4096 + part * 2048 + s] = f2bf(v);
        }
      });
    }
  }
}

template <int DK>
__device__ __forceinline__ void attn_item(const bf16_t* __restrict__ Qp, int qstride, const bf16_t* __restrict__ Kp,
                          const bf16_t* __restrict__ Vp, bf16_t* __restrict__ Op, int q0, int Sk, int n_ctx, int W,
                          float scale, bool has_sink, float sink, char* smem) {
  constexpr int KLD = DK + 8;
  bf16_t* sK = (bf16_t*)smem;
  bf16_t* sVt = sK + 64 * KLD;
  bf16_t* sP = sVt + 64 * 72;
  const int tid = tidx(), lane = tid & 63, w = tid >> 6, l15 = lane & 15, l4 = lane >> 4;
  bf16_t* sPw = sP + w * 16 * 72;
  bf16x8 qf[DK / 32];
  {
    const bf16_t* qrow = Qp + (size_t)(q0 + w * 16 + l15) * qstride;
#pragma unroll
    for (int ks = 0; ks < DK / 32; ks++) qf[ks] = *(const bf16x8*)(qrow + ks * 32 + l4 * 8);
  }
  f32x4 o[4];
#pragma unroll
  for (int j = 0; j < 4; j++) o[j] = f32x4{0.f, 0.f, 0.f, 0.f};
  float mrow[4], lrow[4];
#pragma unroll
  for (int r = 0; r < 4; r++) { mrow[r] = NEG_INF; lrow[r] = 0.f; }
  const int ntile = Sk >> 6;
  auto tile_ok = [&](int kt) -> bool {
    int kb = kt * 64;
    if (W >= 0 && kb >= n_ctx) { int lp = kb - n_ctx; if (lp + 63 < q0 - W || lp > q0 + 63 + W) return false; }
    return true;
  };
  u32x4 rk[DK / 32], rv[2];
  int kt = 0;
  while (kt < ntile && !tile_ok(kt)) kt++;
  if (kt < ntile) {
#pragma unroll
    for (int i = 0; i < DK / 32; i++) { int c = tid + i * 256, r = c / (DK / 8), cc = (c % (DK / 8)) * 8; rk[i] = *(const u32x4*)(Kp + (size_t)(kt * 64 + r) * DK + cc); }
#pragma unroll
    for (int i = 0; i < 2; i++) { int c = tid + i * 256, dv = c >> 3, k0 = (c & 7) * 8; rv[i] = *(const u32x4*)(Vp + (size_t)dv * Sk + kt * 64 + k0); }
  }
  while (kt < ntile) {
    const int kbase = kt * 64;
    __syncthreads();
#pragma unroll
    for (int i = 0; i < DK / 32; i++) { int c = tid + i * 256, r = c / (DK / 8), cc = (c % (DK / 8)) * 8; *(u32x4*)(sK + r * KLD + cc) = rk[i]; }
#pragma unroll
    for (int i = 0; i < 2; i++) {
      int c = tid + i * 256, dv = c >> 3, k0 = (c & 7) * 8;
      *(u32x4*)(sVt + dv * 72 + k0) = rv[i];
    }
    __syncthreads();
    int ktn = kt + 1;
    while (ktn < ntile && !tile_ok(ktn)) ktn++;
    if (ktn < ntile) {
#pragma unroll
      for (int i = 0; i < DK / 32; i++) { int c = tid + i * 256, r = c / (DK / 8), cc = (c % (DK / 8)) * 8; rk[i] = *(const u32x4*)(Kp + (size_t)(ktn * 64 + r) * DK + cc); }
#pragma unroll
      for (int i = 0; i < 2; i++) { int c = tid + i * 256, dv = c >> 3, k0 = (c & 7) * 8; rv[i] = *(const u32x4*)(Vp + (size_t)dv * Sk + ktn * 64 + k0); }
    }
    kt = ktn;
    f32x4 s[4];
#pragma unroll
    for (int j = 0; j < 4; j++) {
      s[j] = f32x4{0.f, 0.f, 0.f, 0.f};
#pragma unroll
      for (int ks = 0; ks < DK / 32; ks++) {
        bf16x8 kf = *(const bf16x8*)(sK + (j * 16 + l15) * KLD + ks * 32 + l4 * 8);
        s[j] = __builtin_amdgcn_mfma_f32_16x16x32_bf16(qf[ks], kf, s[j], 0, 0, 0);
      }
    }
#pragma unroll
    for (int j = 0; j < 4; j++)
#pragma unroll
      for (int r = 0; r < 4; r++) {
        float v = s[j][r] * scale;
        if (W >= 0) {
          int kk = kbase + j * 16 + l15, t = q0 + w * 16 + l4 * 4 + r;
          int dlt = kk - n_ctx - t;
          bool valid = (kk < n_ctx) || (dlt <= W && dlt >= -W);
          if (!valid) v = NEG_INF;
        }
        s[j][r] = v;
      }
#pragma unroll
    for (int r = 0; r < 4; r++) {
      float mx = fmaxf(fmaxf(s[0][r], s[1][r]), fmaxf(s[2][r], s[3][r]));
      mx = fmaxf(mx, DPP_F(mx, mx, 0xB1, 0xf));
      mx = fmaxf(mx, DPP_F(mx, mx, 0x4E, 0xf));
      mx = fmaxf(mx, DPP_F(mx, mx, 0x141, 0xf));
      mx = fmaxf(mx, DPP_F(mx, mx, 0x140, 0xf));
      float mnew = fmaxf(mrow[r], mx);
      float muse = (mnew == NEG_INF) ? 0.f : mnew;
      float alpha = __expf(mrow[r] - muse);
      float rs = 0.f;
#pragma unroll
      for (int j = 0; j < 4; j++) { float pe = __expf(s[j][r] - muse); s[j][r] = pe; rs += pe; }
      rs += DPP_F(rs, rs, 0xB1, 0xf);
      rs += DPP_F(rs, rs, 0x4E, 0xf);
      rs += DPP_F(rs, rs, 0x141, 0xf);
      rs += DPP_F(rs, rs, 0x140, 0xf);
      lrow[r] = lrow[r] * alpha + rs;
      mrow[r] = mnew;
#pragma unroll
      for (int j = 0; j < 4; j++) o[j][r] *= alpha;
    }
#pragma unroll
    for (int j = 0; j < 4; j++)
#pragma unroll
      for (int r = 0; r < 4; r++) sPw[(l4 * 4 + r) * 72 + j * 16 + l15] = f2bf(s[j][r]);
    __builtin_amdgcn_s_waitcnt(0xc07f);
    __builtin_amdgcn_wave_barrier();
#pragma unroll
    for (int ks = 0; ks < 2; ks++) {
      bf16x8 pf = *(const bf16x8*)(sPw + l15 * 72 + ks * 32 + l4 * 8);
#pragma unroll
      for (int jn = 0; jn < 4; jn++) {
        bf16x8 vf = *(const bf16x8*)(sVt + (jn * 16 + l15) * 72 + ks * 32 + l4 * 8);
        o[jn] = __builtin_amdgcn_mfma_f32_16x16x32_bf16(pf, vf, o[jn], 0, 0, 0);
      }
    }
  }
#pragma unroll
  for (int r = 0; r < 4; r++) {
    float lsum = lrow[r];
    if (has_sink) lsum += __expf(sink - mrow[r]);
    float inv = 1.f / lsum;
#pragma unroll
    for (int jn = 0; jn < 4; jn++)
      Op[(size_t)(q0 + w * 16 + l4 * 4 + r) * 1024 + jn * 16 + l15] = f2bf(o[jn][r] * inv);
  }
}

__device__ __forceinline__ int gla_tok(int tb, int c, int dir, int tau) { return tb + c * 64 + (dir ? 63 - tau : tau); }

#define GLA_W2_OFF 40960
__device__ __forceinline__ void gla_stage_w2(const P& p, int l, char* smem) {
  float* w2s = (float*)(smem + GLA_W2_OFF);
  const int tid = tidx();
  __syncthreads();
#pragma unroll
  for (int i = 0; i < 2; i++) {
    int e = (tid + i * 256) * 4;
    *(float4*)(w2s + e) = *(const float4*)(p.w_gla_a_fwd + l * 2048 + e);
    *(float4*)(w2s + 2048 + e) = *(const float4*)(p.w_gla_a_bwd + l * 2048 + e);
  }
  if (tid < 128) w2s[4096 + tid] = p.b_gla_a_fwd[l * 128 + tid];
  else w2s[4096 + tid] = p.b_gla_a_bwd[l * 128 + tid - 128];
  __syncthreads();
}
__device__ __forceinline__ void gla_load_alow(const P& p, int tok, int dir, float4 (&al)[4]) {
  const float* src = W_hbuf + (size_t)tok * 1984 + (dir ? 1456 : 1440);
#pragma unroll
  for (int q = 0; q < 4; q++) al[q] = *(const float4*)(src + q * 4);
}
__device__ __forceinline__ void gla_cum_regs(const char* smem, const float4 (&al)[4], int h, int dir, int w, int lane, float (&c)[8], float (&tot)[8]) {
  const float* w2 = (const float*)(smem + GLA_W2_OFF) + dir * 2048 + h * 32 + w * 8;
  const float* b2 = (const float*)(smem + GLA_W2_OFF) + 4096 + dir * 128 + h * 32 + w * 8;
  float a[16];
#pragma unroll
  for (int q = 0; q < 4; q++) { a[q * 4] = al[q].x; a[q * 4 + 1] = al[q].y; a[q * 4 + 2] = al[q].z; a[q * 4 + 3] = al[q].w; }
#pragma unroll
  for (int j = 0; j < 8; j++) {
    float z = b2[j];
#pragma unroll
    for (int r = 0; r < 16; r++) z += a[r] * w2[r * 128 + j];
    float la = logsigf(z) * (1.f / 16.f);
    float v = la;
#pragma unroll
    for (int d = 1; d < 64; d <<= 1) { float t_ = __shfl_up(v, d); if (lane >= d) v += t_; }
    float total = __shfl(v, 63);
    c[j] = dir ? (total - v + la) : v;
    tot[j] = total;
  }
}
__device__ __forceinline__ void gla_load_v(const P& p, int tok, int h, int w, float4 (&vr)[4]) {
  const float* src = W_hbuf + (size_t)tok * 1984 + 928 + h * 64 + w * 16;
#pragma unroll
  for (int q = 0; q < 4; q++) vr[q] = *(const float4*)(src + q * 4);
}
__device__ __forceinline__ void gla_store_vt(const float4 (&vr)[4], int w, int lane, bf16_t* sVt) {
#pragma unroll
  for (int q = 0; q < 4; q++) {
    sVt[(w * 16 + q * 4 + 0) * 72 + lane] = f2bf(vr[q].x);
    sVt[(w * 16 + q * 4 + 1) * 72 + lane] = f2bf(vr[q].y);
    sVt[(w * 16 + q * 4 + 2) * 72 + lane] = f2bf(vr[q].z);
    sVt[(w * 16 + q * 4 + 3) * 72 + lane] = f2bf(vr[q].w);
  }
}

__device__ __forceinline__ void chunk_info(int cidx, int& tb, int& nch, int& n, int& cbase) {
  if (cidx < 128) { int b = cidx >> 2; n = cidx & 3; nch = 4; tb = b * 256; cbase = b * 4; }
  else { int cl = cidx - 128, b = cl >> 5; n = cl & 31; nch = 32; tb = T_CTX + b * 2048; cbase = 128 + b * 32; }
}

__device__ __forceinline__ void gla_g1_item(const P& p, int l, int item, char* smem) {
  bf16_t* sKeT = (bf16_t*)smem;
  bf16_t* sVt = sKeT + 32 * 72;
  const int tid = tidx(), lane = tid & 63, w = __builtin_amdgcn_readfirstlane(tid >> 6), l15 = lane & 15, l4 = lane >> 4;
  int dir = item & 1, h = (item >> 1) & 3, cidx = item >> 3;
  int tb, nch, n, cbase;
  chunk_info(cidx, tb, nch, n, cbase);
  int c = dir ? nch - 1 - n : n;
  int tok = tb + c * 64 + lane;
  float4 al[4], vr[4];
  gla_load_alow(p, tok, dir, al);
  const float* kr = W_hbuf + (size_t)tok * 1984 + 800 + h * 32 + w * 8;
  float4 k0 = *(const float4*)kr, k1 = *(const float4*)(kr + 4);
  gla_load_v(p, tok, h, w, vr);
  float cs[8], tot[8];
  gla_cum_regs(smem, al, h, dir, w, lane, cs, tot);
  __syncthreads();
  {
    float kk[8] = {k0.x, k0.y, k0.z, k0.w, k1.x, k1.y, k1.z, k1.w};
#pragma unroll
    for (int j = 0; j < 8; j++) sKeT[(w * 8 + j) * 72 + lane] = f2bf(kk[j] * __expf(tot[j] - cs[j]));
  }
  gla_store_vt(vr, w, lane, sVt);
  __syncthreads();
  f32x4 acc[2] = {f32x4{0.f, 0.f, 0.f, 0.f}, f32x4{0.f, 0.f, 0.f, 0.f}};
#pragma unroll
  for (int ks = 0; ks < 2; ks++) {
    bf16x8 bv = *(const bf16x8*)(sVt + (w * 16 + l15) * 72 + ks * 32 + l4 * 8);
#pragma unroll
    for (int mt = 0; mt < 2; mt++) {
      bf16x8 av = *(const bf16x8*)(sKeT + (mt * 16 + l15) * 72 + ks * 32 + l4 * 8);
      acc[mt] = __builtin_amdgcn_mfma_f32_16x16x32_bf16(av, bv, acc[mt], 0, 0, 0);
    }
  }
  float* dst = W_un + (size_t)item * 2048;
#pragma unroll
  for (int mt = 0; mt < 2; mt++)
#pragma unroll
    for (int r = 0; r < 4; r++) dst[(mt * 16 + l4 * 4 + r) * 64 + w * 16 + l15] = acc[mt][r];
  if (lane == 0) {
#pragma unroll
    for (int j = 0; j < 8; j++) W_gn[item * 32 + w * 8 + j] = __expf(tot[j]);
  }
}

__device__ __forceinline__ void phase_gla_scan(const P& p, int l) {
  for (int it = blockIdx.x; it < 2176; it += gridDim.x) {
    int e = it * 256 + tidx();
    int kv = e & 2047, sd = e >> 11, dir = sd & 1, h = (sd >> 1) & 3, seq = ((sd >> 3) + 32) % 34;
    int nch, cbase;
    float s;
    if (seq < 32) { nch = 4; cbase = seq * 4; s = 0.f; }
    else { int b = seq - 32; nch = 32; cbase = 128 + b * 32; s = p.state_gla[((size_t)(((b * 2 + l) * 2 + dir) * 4 + h)) * 2048 + kv]; }
    for (int n0 = 0; n0 < nch; n0 += 4) {
      float gv[4], uv[4];
#pragma unroll
      for (int k = 0; k < 4; k++) {
        int item = ((cbase + n0 + k) * 4 + h) * 2 + dir;
        gv[k] = W_gn[item * 32 + (kv >> 6)];
        uv[k] = W_un[(size_t)item * 2048 + kv];
      }
#pragma unroll
      for (int k = 0; k < 4; k++) {
        int item = ((cbase + n0 + k) * 4 + h) * 2 + dir;
        W_sin_[(size_t)item * 2048 + kv] = s;
        s = gv[k] * s + uv[k];
      }
    }
    if (seq < 32) p.out[19398656 + ((size_t)(((seq * 2 + l) * 2 + dir) * 4 + h)) * 2048 + kv] = s;
  }
}

__device__ __forceinline__ void phase_gla_out(const P& p, int l, char* smem) {
  bf16_t* sQe = (bf16_t*)smem;
  bf16_t* sKe = sQe + 64 * 40;
  bf16_t* sSt = sKe + 64 * 40;
  bf16_t* sVt = sSt + 64 * 40;
  bf16_t* sAtt = sVt + 64 * 72;
  const int tid = tidx(), lane = tid & 63, w = __builtin_amdgcn_readfirstlane(tid >> 6), l15 = lane & 15, l4 = lane >> 4;
  gla_stage_w2(p, l, smem);
  for (int it = blockIdx.x; it < 768; it += gridDim.x) {
    int h = it & 3, cidx = it >> 2;
    int tb, nch, c, cbase;
    chunk_info(cidx, tb, nch, c, cbase);
    const int tok = tb + c * 64 + lane;
    f32x4 o[4];
#pragma unroll
    for (int j = 0; j < 4; j++) o[j] = f32x4{0.f, 0.f, 0.f, 0.f};
    float4 vr[4], alf[4], alb[4];
    gla_load_v(p, tok, h, w, vr);
    gla_load_alow(p, tok, 0, alf);
    gla_load_alow(p, tok, 1, alb);
    const float* qr = W_hbuf + (size_t)tok * 1984 + 672 + h * 32 + w * 8;
    const float* kr = qr + 128;
    const float4 q0 = *(const float4*)qr, q1 = *(const float4*)(qr + 4), k0 = *(const float4*)kr, k1 = *(const float4*)(kr + 4);
    float sinv[2][8];
#pragma unroll
    for (int dir = 0; dir < 2; dir++) {
      int n = dir ? nch - 1 - c : c;
      int item = ((cbase + n) * 4 + h) * 2 + dir;
      const float* sin = W_sin_ + (size_t)item * 2048 + (w * 8) * 64 + lane;
#pragma unroll
      for (int j = 0; j < 8; j++) sinv[dir][j] = sin[j * 64];
    }
    float gpre[4][4];
#pragma unroll
    for (int r = 0; r < 4; r++)
#pragma unroll
      for (int jn = 0; jn < 4; jn++) gpre[r][jn] = W_hbuf[(size_t)(tb + c * 64 + w * 16 + l4 * 4 + r) * 1984 + 1184 + h * 64 + jn * 16 + l15];
    __syncthreads();
    gla_store_vt(vr, w, lane, sVt);
#pragma unroll
    for (int dir = 0; dir < 2; dir++) {
      float cs[8], tot[8];
      gla_cum_regs(smem, dir ? alb : alf, h, dir, w, lane, cs, tot);
      if (dir) __syncthreads();
      {
        float qq[8] = {q0.x, q0.y, q0.z, q0.w, q1.x, q1.y, q1.z, q1.w};
        float kk[8] = {k0.x, k0.y, k0.z, k0.w, k1.x, k1.y, k1.z, k1.w};
        bf16x8 qv, kv, sv;
#pragma unroll
        for (int j = 0; j < 8; j++) {
          float cm = __shfl(cs[j], 32);
          qv[j] = (short)f2bf(qq[j] * 0.17677669529663687f * __expf(cs[j] - cm));
          kv[j] = (short)f2bf(kk[j] * __expf(cm - cs[j]));
          sv[j] = (short)f2bf(sinv[dir][j] * __expf(cm));
        }
        *(bf16x8*)(sQe + lane * 40 + w * 8) = qv;
        *(bf16x8*)(sKe + lane * 40 + w * 8) = kv;
        *(bf16x8*)(sSt + lane * 40 + w * 8) = sv;
      }
      __syncthreads();
      bf16x8 qa = *(const bf16x8*)(sQe + (w * 16 + l15) * 40 + l4 * 8);
#pragma unroll
      for (int jc = 0; jc < 4; jc++) {
        bf16x8 kb = *(const bf16x8*)(sKe + (jc * 16 + l15) * 40 + l4 * 8);
        f32x4 sacc = __builtin_amdgcn_mfma_f32_16x16x32_bf16(qa, kb, f32x4{0.f, 0.f, 0.f, 0.f}, 0, 0, 0);
#pragma unroll
        for (int r = 0; r < 4; r++) {
          int trow = w * 16 + l4 * 4 + r, scol = jc * 16 + l15;
          bool keep = dir ? (scol >= trow) : (scol <= trow);
          sAtt[trow * 72 + scol] = f2bf(keep ? sacc[r] : 0.f);
        }
      }
      __syncthreads();
#pragma unroll
      for (int ks = 0; ks < 2; ks++) {
        bf16x8 aa = *(const bf16x8*)(sAtt + (w * 16 + l15) * 72 + ks * 32 + l4 * 8);
#pragma unroll
        for (int jn = 0; jn < 4; jn++) {
          bf16x8 vb = *(const bf16x8*)(sVt + (jn * 16 + l15) * 72 + ks * 32 + l4 * 8);
          o[jn] = __builtin_amdgcn_mfma_f32_16x16x32_bf16(aa, vb, o[jn], 0, 0, 0);
        }
      }
#pragma unroll
      for (int jn = 0; jn < 4; jn++) {
        bf16x8 sb = *(const bf16x8*)(sSt + (jn * 16 + l15) * 40 + l4 * 8);
        o[jn] = __builtin_amdgcn_mfma_f32_16x16x32_bf16(qa, sb, o[jn], 0, 0, 0);
      }
    }
#pragma unroll
    for (int r = 0; r < 4; r++) {
      float ss = o[0][r] * o[0][r] + o[1][r] * o[1][r] + o[2][r] * o[2][r] + o[3][r] * o[3][r];
      ss += DPP_F(ss, ss, 0xB1, 0xf);
      ss += DPP_F(ss, ss, 0x4E, 0xf);
      ss += DPP_F(ss, ss, 0x141, 0xf);
      ss += DPP_F(ss, ss, 0x140, 0xf);
      float rs = rsqrtf(ss * (1.f / 64.f) + 1e-6f);
      int tk = tb + c * 64 + w * 16 + l4 * 4 + r;
      const float* grow = W_hbuf + (size_t)tk * 1984 + 1184 + h * 64;
      bf16_t* dst = W_br + (size_t)tk * 1024 + 512 + h * 64;
#pragma unroll
      for (int jn = 0; jn < 4; jn++) {
        int vcol = jn * 16 + l15;
        float val = o[jn][r] * rs * p.gla_norm[l * 64 + vcol];
        dst[vcol] = f2bf(val * siluf(gpre[r][jn]));
      }
    }
  }
}

__device__ __forceinline__ void phase_mixers(const P& p, int l, char* smem) {
  const int N_MLAL = 256, N_DFTL = 64, N_SWAL = 256, N_MLAC = 512, N_SWAC = 512, N_DFTC = 128, N_G1 = 1536;
  const int total = N_MLAL + N_DFTL + N_SWAL + N_MLAC + N_SWAC + N_DFTC + N_G1;
  gla_stage_w2(p, l, smem);
  for (int r_ = 0; r_ * (int)gridDim.x < total; r_++) {
    int it0 = r_ * gridDim.x + ((r_ & 1) ? (gridDim.x - 1 - blockIdx.x) : blockIdx.x);
    if (it0 >= total) continue;
    int it = it0;
    int type;
    bool lat = false;
    if (it < N_MLAL) { type = 0; lat = true; }
    else if ((it -= N_MLAL) < N_DFTL) { type = 2; lat = true; }
    else if ((it -= N_DFTL) < N_SWAL) { type = 1; lat = true; }
    else if ((it -= N_SWAL) < N_MLAC) { type = 0; }
    else if ((it -= N_MLAC) < N_SWAC) { type = 1; }
    else if ((it -= N_SWAC) < N_DFTC) { type = 2; }
    else { it -= N_DFTC; type = 3; }
#ifdef DUPTYPE
    for (int rep_ = 0; rep_ < ((type == (DUPTYPE & 3) && (int)lat == (DUPTYPE >> 2)) ? 2 : 1); rep_++)
#endif
    if (type == 0) {
      int qt, h, b, Sk;
      size_t tok0;
      if (lat) { qt = it & 31; h = (it >> 5) & 3; b = it >> 7; tok0 = T_CTX + b * 2048; Sk = 2560; }
      else { qt = it & 3; h = (it >> 2) & 3; b = it >> 4; tok0 = b * 256; Sk = 256; }
      const bf16_t* Kp = (lat ? W_Ka_lat : W_Ka_ctx) + (size_t)(b * 4 + h) * Sk * 96;
      const bf16_t* Vp = (lat ? W_Va_lat : W_Va_ctx) + (size_t)(b * 4 + h) * Sk * 64;
      attn_item<96>(W_Qa + tok0 * 384 + h * 96, 384, Kp, Vp, W_br + tok0 * 1024 + h * 64, qt * 64, Sk, 0, -1,
                    0.10206207261596575f, false, 0.f, smem);
    } else if (type == 1) {
      int qt, hq, b, Sk, nctx, W;
      size_t tok0;
      if (lat) { qt = it & 31; hq = (it >> 5) & 3; b = it >> 7; tok0 = T_CTX + b * 2048; Sk = 2560; nctx = 512; W = 128; }
      else { qt = it & 3; hq = (it >> 2) & 3; b = it >> 4; tok0 = b * 256; Sk = 256; nctx = 0; W = -1; }
      int kv = hq >> 1;
      const bf16_t* Kp = (lat ? W_Kd_lat : W_Kd_ctx) + (size_t)(b * 2 + kv) * Sk * 64;
      const bf16_t* Vp = (lat ? W_Vd_lat : W_Vd_ctx) + (size_t)(b * 2 + kv) * Sk * 64;
      attn_item<64>(W_Qd + tok0 * 256 + hq * 64, 256, Kp, Vp, W_br + tok0 * 1024 + 768 + hq * 64, qt * 64, Sk, nctx, W,
                    0.125f, true, p.swa_sink[l * 4 + hq], smem);
    } else if (type == 2) {
      int nt = it & 1, mt, b, S;
      size_t tok0;
      if (lat) { mt = (it >> 1) & 15; b = it >> 5; S = 2048; tok0 = T_CTX + b * 2048; }
      else { mt = (it >> 1) & 1; b = it >> 2; S = 256; tok0 = b * 256; }
      const bf16_t* Ap = (lat ? W_A2048 : W_A256) + (size_t)mt * 128 * 2 * S;
      const bf16_t* Bp = (lat ? W_Yt_lat : W_Yt_ctx) + (size_t)(b * 256 + nt * 128) * 2 * S;
      f32x4 acc[4][4];
      ZERO_ACC(acc);
      gemm_core(acc, Ap, 2 * S, Bp, 2 * S, 2 * S, smem);
      EPI_LOOP(acc, mt * 128, nt * 128, { W_br[(tok0 + m) * 1024 + 256 + n] = f2bf(v); });
    } else {
      gla_g1_item(p, l, it, smem);
    }
  }
}

#define EPI4_LOOP_N(acc, c0, t0, NJ, ...)                                                  \
  {                                                                                        \
    const int lane_ = tidx() & 63, w_ = tidx() >> 6, wm_ = w_ >> 1, wn_ = w_ & 1;           \
    _Pragma("unroll") for (int i_ = 0; i_ < 4; i_++)                                       \
    _Pragma("unroll") for (int j_ = 0; j_ < NJ; j_++) {                                    \
      const int col = (c0) + wm_ * 64 + i_ * 16 + (lane_ >> 4) * 4;                        \
      const int tok = (t0) + wn_ * (NJ * 16) + j_ * 16 + (lane_ & 15);                     \
      const f32x4 v4 = acc[i_][j_];                                                        \
      __VA_ARGS__                                                                          \
    }                                                                                      \
  }
__device__ __forceinline__ void phase_merge(const P& p, int l, char* smem) {
  constexpr int NJ = 2;
  bf16_t* sa = (bf16_t*)smem;
  bf16_t* sb = sa + 128 * GB_LD;
  const int tid = tidx(), lane = tid & 63, w = tid >> 6, wm = w >> 1, wn = w & 1;
  const int l15 = lane & 15, l4 = lane >> 4;
  for (int tile = blockIdx.x; tile < 192 * 8; tile += gridDim.x) {
    int tt = tile >> 3, nt = tile & 7, t0 = tt * 64, n0 = nt * 128;
    const bf16_t* A = W_Wt_br + ((size_t)l * 1024 + n0) * 1024;
    const bf16_t* B = W_br + (size_t)t0 * 1024;
    const int lda = 1024, ldb = 1024, K = 1024;
    f32x4 tot[4][2], acc[4][2];
    ZERO_ACC_N(tot, 2);
    ZERO_ACC_N(acc, 2);
    u32x4 ra0[4], rb0[NJ], ra1[4], rb1[NJ];
    G_LOAD(ra0, rb0, 0);
    G_LOAD(ra1, rb1, 64);
    ushort4 gl[4][2];
    for (int k0 = 0; k0 < K; k0 += 128) {
      const bool seg_end = (k0 & 128) != 0;
      const int bidx = k0 >> 8;
      if (seg_end) {
#pragma unroll
        for (int i_ = 0; i_ < 4; i_++)
#pragma unroll
          for (int j_ = 0; j_ < 2; j_++) {
            int col = n0 + wm * 64 + i_ * 16 + l4 * 4, tok = t0 + wn * 32 + j_ * 16 + l15;
            gl[i_][j_] = *(const ushort4*)(W_gates + (size_t)tok * 4096 + bidx * 1024 + col);
          }
      }
      __syncthreads();
      G_STORE(ra0, rb0);
      __syncthreads();
      if (k0 + 128 < K) { G_LOAD(ra0, rb0, k0 + 128); }
      G_COMPUTE();
      __syncthreads();
      G_STORE(ra1, rb1);
      __syncthreads();
      if (k0 + 192 < K) { G_LOAD(ra1, rb1, k0 + 192); }
      G_COMPUTE();
      if (seg_end) {
#pragma unroll
        for (int i_ = 0; i_ < 4; i_++)
#pragma unroll
          for (int j_ = 0; j_ < 2; j_++) {
            tot[i_][j_][0] += bf2f(gl[i_][j_].x) * acc[i_][j_][0];
            tot[i_][j_][1] += bf2f(gl[i_][j_].y) * acc[i_][j_][1];
            tot[i_][j_][2] += bf2f(gl[i_][j_].z) * acc[i_][j_][2];
            tot[i_][j_][3] += bf2f(gl[i_][j_].w) * acc[i_][j_][3];
            acc[i_][j_] = f32x4{0.f, 0.f, 0.f, 0.f};
          }
      }
    }
    EPI4_LOOP_N(tot, n0, t0, 2, {
      ushort4 o_; o_.x = f2bf(v4[0]); o_.y = f2bf(v4[1]); o_.z = f2bf(v4[2]); o_.w = f2bf(v4[3]);
      *(ushort4*)(W_u + (size_t)tok * 1024 + col) = o_;
    });
  }
}

__device__ __forceinline__ void phase_wout(const P& p, int l, char* smem) {
  float* r = W_hbuf;
  const float alpha = 1.4142135623730951f;
  for (int tile = blockIdx.x; tile < 96 * 8; tile += gridDim.x) {
    int mt = tile >> 3, nt = tile & 7, m0 = mt * 128, n0 = nt * 128;
    f32x4 acc[4][4];
    ZERO_ACC(acc);
    gemm_core(acc, W_Wt_out + ((size_t)l * 1024 + n0) * 1024, 1024, W_u + (size_t)m0 * 1024, 1024, 1024, smem);
    const float* g1 = W_mada + (l * 3 + cond_row(m0)) * 6144 + 2048;
    {
      const int lane_ = tidx() & 63, w_ = tidx() >> 6, wm_ = w_ >> 1, wn_ = w_ & 1;
#pragma unroll
      for (int ih = 0; ih < 2; ih++) {
        float4 xv[8];
#pragma unroll
        for (int q = 0; q < 8; q++) {
          int i_ = ih * 2 + (q >> 2), j_ = q & 3;
          int col = n0 + wm_ * 64 + i_ * 16 + (lane_ >> 4) * 4, tok = m0 + wn_ * 64 + j_ * 16 + (lane_ & 15);
          xv[q] = *(const float4*)(x_in_row(p, l, tok) + col);
        }
#pragma unroll
        for (int q = 0; q < 8; q++) {
          int i_ = ih * 2 + (q >> 2), j_ = q & 3;
          int col = n0 + wm_ * 64 + i_ * 16 + (lane_ >> 4) * 4, tok = m0 + wn_ * 64 + j_ * 16 + (lane_ & 15);
          float4 gv = *(const float4*)(g1 + col);
          f32x4 v4 = acc[i_][j_];
          *(float4*)(r + (size_t)tok * 1024 + col) = float4{alpha * xv[q].x + gv.x * v4[0], alpha * xv[q].y + gv.y * v4[1], alpha * xv[q].z + gv.z * v4[2], alpha * xv[q].w + gv.w * v4[3]};
        }
      }
    }
  }
}

__device__ __forceinline__ void phase_ln_mid(const P& p, int l) {
  int lane = tidx() & 63, w = tidx() >> 6;
  const float* r = W_hbuf;
  for (int it = blockIdx.x; it < T_ALL / 4; it += gridDim.x) {
    int g = it * 4 + w;
    float v[16];
    load_row16(r + (size_t)g * 1024, lane, v);
    ln16(v);
    affine16(v, p.ln1_g + l * 1024, p.ln1_b + l * 1024, lane);
    store_row16(x_out_row(p, l, g), lane, v);
    ln16(v);
    const float* m = W_mada + (l * 3 + cond_row(g)) * 6144;
    modulate_store(v, m + 3072, m + 4096, W_u + (size_t)g * 1024, lane);
  }
}

__device__ __forceinline__ void phase_pq(const P& p, int l, char* smem) {
  bf16_t* sc = W_gates;
  bf16_t* sa = (bf16_t*)smem;
  const int tid = tidx(), lane = tid & 63, w = tid >> 6, wm = w >> 1, wn = w & 1, l15 = lane & 15, l4 = lane >> 4;
  for (int tile = blockIdx.x; tile < 96 * 16; tile += gridDim.x) {
    int mt = tile >> 4, hp = tile & 15, m0 = mt * 128, n0 = hp * 128;
    f32x4 acc[4][4];
    ZERO_ACC(acc);
    gemm_core(acc, W_Wt_pq + ((size_t)l * 2048 + n0) * 1024, 1024, W_u + (size_t)m0 * 1024, 1024, 1024, smem);
    __syncthreads();
    {
      bf16_t* sB = sa + 128 * GB_LD * (1 + wm);
#pragma unroll
      for (int i = 0; i < 4; i++)
#pragma unroll
        for (int j = 0; j < 4; j++) {
          ushort4 o_;
          o_.x = f2bf(acc[i][j][0]); o_.y = f2bf(acc[i][j][1]); o_.z = f2bf(acc[i][j][2]); o_.w = f2bf(acc[i][j][3]);
          *(ushort4*)(sB + (wn * 64 + j * 16 + l15) * GB_LD + i * 16 + l4 * 4) = o_;
        }
    }
    f32x4 acc2[4][4];
    ZERO_ACC(acc2);
    const bf16_t* keys = W_keysbf + (size_t)(l * 16 + hp) * 128 * 128;
#pragma unroll
    for (int kh = 0; kh < 2; kh++) {
      u32x4 rk[4];
#pragma unroll
      for (int i = 0; i < 4; i++) { int c = tid + i * 256, r = c >> 3, cc = (c & 7) * 8; rk[i] = *(const u32x4*)(keys + r * 128 + kh * 64 + cc); }
      if (kh) __syncthreads();
#pragma unroll
      for (int i = 0; i < 4; i++) { int c = tid + i * 256, r = c >> 3, cc = (c & 7) * 8; *(u32x4*)(sa + r * GB_LD + cc) = rk[i]; }
      __syncthreads();
      const bf16_t* sBk = sa + 128 * GB_LD * (1 + kh);
#pragma unroll
      for (int ks = 0; ks < 2; ks++) {
        bf16x8 af[4], bfr[4];
#pragma unroll
        for (int i = 0; i < 4; i++) af[i] = *(const bf16x8*)(sa + (wm * 64 + i * 16 + l15) * GB_LD + ks * 32 + l4 * 8);
#pragma unroll
        for (int j = 0; j < 4; j++) bfr[j] = *(const bf16x8*)(sBk + (wn * 64 + j * 16 + l15) * GB_LD + ks * 32 + l4 * 8);
#pragma unroll
        for (int i = 0; i < 4; i++)
#pragma unroll
          for (int j = 0; j < 4; j++) acc2[i][j] = __builtin_amdgcn_mfma_f32_16x16x32_bf16(af[i], bfr[j], acc2[i][j], 0, 0, 0);
      }
    }
    EPI_LOOP(acc2, 0, m0, { sc[((size_t)(hp * 128 + m)) * T_ALL + n] = f2bf(v); });
  }
}

__device__ __forceinline__ void phase_scores(const P& p, int l, char* smem) {}

__device__ __forceinline__ int f2sort(float x) { int b = __float_as_int(x); return b ^ ((b >> 31) & 0x7fffffff); }
__device__ __forceinline__ float sort2f(int s) { return __int_as_float(s ^ ((s >> 31) & 0x7fffffff)); }
__device__ __forceinline__ void bitonic_sort16_desc(int (&a)[16]) {
#pragma unroll
  for (int k = 2; k <= 16; k <<= 1)
#pragma unroll
    for (int j = k >> 1; j > 0; j >>= 1)
#pragma unroll
      for (int i = 0; i < 16; i++) {
        int l_ = i ^ j;
        if (l_ > i) {
          int hi = max(a[i], a[l_]), lo = min(a[i], a[l_]);
          if ((i & k) == 0) { a[i] = hi; a[l_] = lo; } else { a[i] = lo; a[l_] = hi; }
        }
      }
}
__device__ __forceinline__ void merge_top16(int (&T)[16], const int (&S)[16]) {
#pragma unroll
  for (int i = 0; i < 16; i++) T[i] = max(T[i], S[15 - i]);
#pragma unroll
  for (int j = 8; j > 0; j >>= 1)
#pragma unroll
    for (int i = 0; i < 16; i++) {
      int l_ = i ^ j;
      if (l_ > i) { int hi = max(T[i], T[l_]), lo = min(T[i], T[l_]); T[i] = hi; T[l_] = lo; }
    }
}
__device__ __forceinline__ void top16_col(const bf16_t* src, int (&L)[16]) {
#pragma unroll 1
  for (int k0 = 0; k0 < 128; k0 += 16) {
    float xv[16];
#pragma unroll
    for (int k = 0; k < 16; k++) xv[k] = bf2f(src[(size_t)(k0 + k) * T_ALL]);
    int S[16];
#pragma unroll
    for (int k = 0; k < 16; k++) S[k] = (f2sort(xv[k]) & ~127) | (127 - (k0 + k));
    bitonic_sort16_desc(S);
    if (k0 == 0) {
#pragma unroll
      for (int k = 0; k < 16; k++) L[k] = S[k];
    } else {
      merge_top16(L, S);
    }
  }
}
__device__ __forceinline__ void phase_topk(const P& p, int l) {
  const bf16_t* sc = W_gates;
  int lane = tidx() & 63, w = tidx() >> 6;
  for (int it = blockIdx.x * 4 + w; it < 192 * 8; it += gridDim.x * 4) {
    int h = it & 7, t = (it >> 3) * 64 + lane;
    int L1[16], L2[16];
    const bf16_t* s1 = sc + (size_t)(h * 2) * 128 * T_ALL + t;
    top16_col(s1, L1);
    top16_col(s1 + (size_t)128 * T_ALL, L2);
    float v1[16], v2[16];
    unsigned P1[4] = {0u, 0u, 0u, 0u}, P2[4] = {0u, 0u, 0u, 0u};
#pragma unroll
    for (int i = 0; i < 16; i++) {
      v1[i] = sort2f(L1[i] & ~127);
      v2[i] = sort2f(L2[i] & ~127);
      P1[i >> 2] |= (unsigned)(127 - (L1[i] & 127)) << ((i & 3) * 8);
      P2[i >> 2] |= (unsigned)(127 - (L2[i] & 127)) << ((i & 3) * 8);
    }
    int Tk[16];
#pragma unroll
    for (int j = 0; j < 16; j++) Tk[j] = (f2sort(v1[0] + v2[j]) & ~255) | (255 - j);
    {
      int G[3][16];
#pragma unroll
      for (int g_ = 0; g_ < 3; g_++)
#pragma unroll
        for (int k = 0; k < 16; k++) G[g_][k] = (int)0x80000000;
      int cnt = 0;
#pragma unroll
      for (int i = 1; i < 16; i++) {
#pragma unroll
        for (int j = 0; j < 16 / (i + 1); j++) {
          G[cnt >> 4][cnt & 15] = (f2sort(v1[i] + v2[j]) & ~255) | (255 - (i * 16 + j));
          cnt++;
        }
      }
#pragma unroll
      for (int g_ = 0; g_ < 3; g_++) { bitonic_sort16_desc(G[g_]); merge_top16(Tk, G[g_]); }
    }
    float v0 = sort2f(Tk[0] & ~255);
    float e[16], Z = 0.f;
    int oi[16];
#pragma unroll
    for (int s_ = 0; s_ < 16; s_++) {
      e[s_] = __expf(sort2f(Tk[s_] & ~255) - v0);
      Z += e[s_];
      int code = 255 - (Tk[s_] & 255), i = code >> 4, j = code & 15;
      unsigned r1 = (i >> 2) == 0 ? P1[0] : (i >> 2) == 1 ? P1[1] : (i >> 2) == 2 ? P1[2] : P1[3];
      unsigned r2 = (j >> 2) == 0 ? P2[0] : (j >> 2) == 1 ? P2[1] : (j >> 2) == 2 ? P2[2] : P2[3];
      int i1 = (r1 >> ((i & 3) * 8)) & 255, i2 = (r2 >> ((j & 3) * 8)) & 255;
      oi[s_] = i1 * 128 + i2;
    }
    float inv = 1.f / Z;
    int* po = W_pidx + (size_t)t * 128 + h * 16;
    float* pwo = W_pw + (size_t)t * 128 + h * 16;
#pragma unroll
    for (int q = 0; q < 4; q++) {
      *(int4*)(po + q * 4) = int4{oi[q * 4], oi[q * 4 + 1], oi[q * 4 + 2], oi[q * 4 + 3]};
      *(float4*)(pwo + q * 4) = float4{e[q * 4] * inv, e[q * 4 + 1] * inv, e[q * 4 + 2] * inv, e[q * 4 + 3] * inv};
    }
  }
}

__device__ __forceinline__ void unpack16(u32x4 r, float (&f)[16]) {
#pragma unroll
  for (int q = 0; q < 4; q++) {
    auto lo = __builtin_amdgcn_cvt_pk_f32_fp8((int)r[q], false);
    auto hi = __builtin_amdgcn_cvt_pk_f32_fp8((int)r[q], true);
    f[q * 4 + 0] = lo[0]; f[q * 4 + 1] = lo[1]; f[q * 4 + 2] = hi[0]; f[q * 4 + 3] = hi[1];
  }
}
#define PEER_PF 8
#ifndef PEER_REP
#define PEER_REP 1
#endif
__device__ __forceinline__ void phase_peer(const P& p, int l, char* smem) {
  int lane = tidx() & 63, w = tidx() >> 6;
  float* scoef_w = (float*)smem + w * (8 * 128);
  const unsigned char* tu = W_tabU + (size_t)l * 16384 * 1024 + lane * 16;
  const unsigned char* tv = W_tabV + (size_t)l * 16384 * 1024 + lane * 16;
  const int nb = gridDim.x;
  const int ntok = (T_ALL / 4 - (int)blockIdx.x + nb - 1) / nb;
  for (int c0 = 0; c0 < ntok; c0 += 8) {
    const int nc = (ntok - c0) < 8 ? (ntok - c0) : 8;
    __builtin_amdgcn_wave_barrier();
    for (int t = 0; t < nc; t++) {
      const int g = ((int)blockIdx.x + (c0 + t) * nb) * 4 + w;
      float* scoef = scoef_w + t * 128;
      float uu[16];
      {
        u32x4 r0 = *(const u32x4*)(W_u + (size_t)g * 1024 + lane * 16);
        u32x4 r1 = *(const u32x4*)(W_u + (size_t)g * 1024 + lane * 16 + 8);
#pragma unroll
        for (int q = 0; q < 4; q++) {
          uu[q * 2] = __uint_as_float(r0[q] << 16); uu[q * 2 + 1] = __uint_as_float(r0[q] & 0xffff0000u);
          uu[8 + q * 2] = __uint_as_float(r1[q] << 16); uu[8 + q * 2 + 1] = __uint_as_float(r1[q] & 0xffff0000u);
        }
      }
      const float* pwt = W_pw + (size_t)g * 128;
      const int pi0 = W_pidx[(size_t)g * 128 + lane], pi1 = W_pidx[(size_t)g * 128 + 64 + lane];
      auto ldrows = [&](u32x4 (&r)[8], const unsigned char* tab, int e0) {
#pragma unroll
        for (int k = 0; k < 8; k++) {
          int e = e0 + k;
          int idx = __builtin_amdgcn_readlane(e < 64 ? pi0 : pi1, e & 63);
          r[k] = *(const u32x4*)(tab + (size_t)idx * 1024);
        }
      };
      float dv0 = 0.f, dv1 = 0.f;
      auto dots = [&](const u32x4 (&r)[8], int e0) {
#pragma unroll
        for (int k = 0; k < 8; k++) {
          float f[16];
          unpack16(r[k], f);
          float a = 0.f;
#pragma unroll
          for (int j = 0; j < 16; j++) a += uu[j] * f[j];
          float dd = wsum(a);
          if (e0 < 64) dv0 = (lane == e0 + k) ? dd : dv0;
          else dv1 = (lane == e0 + k - 64) ? dd : dv1;
        }
      };
      {
        u32x4 ra[8], rb[8];
        ldrows(ra, tu, 0);
#pragma unroll 1
        for (int e0 = 0; e0 < 128; e0 += 16) {
          ldrows(rb, tu, e0 + 8);
          dots(ra, e0);
          if (e0 + 16 < 128) ldrows(ra, tu, e0 + 16);
          dots(rb, e0 + 8);
        }
      }
      float d0 = dv0 * (1.f / PEER_U_SCALE), d1 = dv1 * (1.f / PEER_U_SCALE);
      float a0 = 0.5f * d0 * (1.f + erff(d0 * 0.7071067811865476f));
      float a1 = 0.5f * d1 * (1.f + erff(d1 * 0.7071067811865476f));
      scoef[lane] = pwt[lane] * a0 * (1.f / PEER_V_SCALE);
      scoef[64 + lane] = pwt[64 + lane] * a1 * (1.f / PEER_V_SCALE);
    }
    __builtin_amdgcn_s_waitcnt(0xc07f);
    __builtin_amdgcn_wave_barrier();
    for (int t = 0; t < nc; t++) {
      const int g = ((int)blockIdx.x + (c0 + t) * nb) * 4 + w;
      const float* scoef = scoef_w + t * 128;
      const int pi0 = W_pidx[(size_t)g * 128 + lane], pi1 = W_pidx[(size_t)g * 128 + 64 + lane];
      auto ldrows = [&](u32x4 (&r)[8], const unsigned char* tab, int e0) {
#pragma unroll
        for (int k = 0; k < 8; k++) {
          int e = e0 + k;
          int idx = __builtin_amdgcn_readlane(e < 64 ? pi0 : pi1, e & 63);
          r[k] = *(const u32x4*)(tab + (size_t)idx * 1024);
        }
      };
      float o[16];
#pragma unroll
      for (int j = 0; j < 16; j++) o[j] = 0.f;
      auto accum = [&](const u32x4 (&r)[8], int e0) {
#pragma unroll
        for (int k = 0; k < 8; k++) {
          float cf = scoef[e0 + k];
          float f[16];
          unpack16(r[k], f);
#pragma unroll
          for (int j = 0; j < 16; j++) o[j] += cf * f[j];
        }
      };
      {
        u32x4 ra[8], rb[8];
        ldrows(ra, tv, 0);
#pragma unroll 1
        for (int e0 = 0; e0 < 128; e0 += 16) {
          ldrows(rb, tv, e0 + 8);
          accum(ra, e0);
          if (e0 + 16 < 128) ldrows(ra, tv, e0 + 16);
          accum(rb, e0 + 8);
        }
      }
      float* xr = x_out_row(p, l, g) + lane * 16;
      const float* m = W_mada + (l * 3 + cond_row(g)) * 6144 + lane * 16;
      float x1[16];
#pragma unroll
      for (int q = 0; q < 4; q++) {
        float4 xv = *(const float4*)(xr + q * 4);
        float4 g2 = *(const float4*)(m + 5120 + q * 4);
        x1[q * 4 + 0] = 1.4142135623730951f * xv.x + g2.x * o[q * 4 + 0];
        x1[q * 4 + 1] = 1.4142135623730951f * xv.y + g2.y * o[q * 4 + 1];
        x1[q * 4 + 2] = 1.4142135623730951f * xv.z + g2.z * o[q * 4 + 2];
        x1[q * 4 + 3] = 1.4142135623730951f * xv.w + g2.w * o[q * 4 + 3];
      }
      ln16(x1);
#pragma unroll
      for (int q = 0; q < 4; q++) {
        float4 a = *(const float4*)(p.ln2_g + l * 1024 + lane * 16 + q * 4);
        float4 c = *(const float4*)(p.ln2_b + l * 1024 + lane * 16 + q * 4);
        x1[q * 4 + 0] = x1[q * 4 + 0] * a.x + c.x; x1[q * 4 + 1] = x1[q * 4 + 1] * a.y + c.y;
        x1[q * 4 + 2] = x1[q * 4 + 2] * a.z + c.z; x1[q * 4 + 3] = x1[q * 4 + 3] * a.w + c.w;
        *(float4*)(xr + q * 4) = float4{x1[q * 4], x1[q * 4 + 1], x1[q * 4 + 2], x1[q * 4 + 3]};
      }
      if (l == 0) {
        ln16(x1);
        const float* m1 = W_mada + (1 * 3 + cond_row(g)) * 6144 + lane * 16;
#pragma unroll
        for (int q = 0; q < 4; q++) {
          float4 a = *(const float4*)(m1 + 1024 + q * 4);
          float4 b = *(const float4*)(m1 + q * 4);
          ushort4 ov;
          ov.x = f2bf(x1[q * 4 + 0] * (1.f + a.x) + b.x);
          ov.y = f2bf(x1[q * 4 + 1] * (1.f + a.y) + b.y);
          ov.z = f2bf(x1[q * 4 + 2] * (1.f + a.z) + b.z);
          ov.w = f2bf(x1[q * 4 + 3] * (1.f + a.w) + b.w);
          *(ushort4*)(W_u + (size_t)g * 1024 + lane * 16 + q * 4) = ov;
          *(int*)(W_u8 + (size_t)g * 1024 + lane * 16 + q * 4) = pack_fp8x4(x1[q * 4 + 0] * (1.f + a.x) + b.x, x1[q * 4 + 1] * (1.f + a.y) + b.y,
                                                                             x1[q * 4 + 2] * (1.f + a.z) + b.z, x1[q * 4 + 3] * (1.f + a.w) + b.w);
        }
      }
    }
  }
}

#define N_PHASES 28
__device__ __forceinline__ void run_phase(const P& p, int ph, char* smem) {
#ifdef ONLYQ
  { int l = ph & 1; if (ONLYQ == -1) { phase_prep(p, smem); return; } if (ONLYQ == -2) { phase_ln0(p); return; }
    switch (ONLYQ) { case 0: phase_win(p, l, smem); break; case 1: phase_post(p, l); break; case 2: phase_small_gemms(p, l, smem); break; case 3: phase_mixers(p, l, smem); break; case 4: phase_gla_scan(p, l); break; case 5: phase_gla_out(p, l, smem); break; case 6: phase_merge(p, l, smem); break; case 7: phase_wout(p, l, smem); break; case 8: phase_ln_mid(p, l); break; case 9: phase_pq(p, l, smem); break; case 10: phase_scores(p, l, smem); break; case 11: phase_topk(p, l); break; case 12: phase_peer(p, l, smem); break; } return; }
#endif
  if (ph == 0) { phase_prep(p, smem); return; }
  if (ph == 1) { phase_ln0(p); return; }
  int l = (ph - 2) / 13, q = (ph - 2) % 13;
#ifdef EXCL
  if (q == EXCL) return;
#endif
  switch (q) {
    case 0: phase_win(p, l, smem); break;
    case 1: phase_post(p, l); break;
    case 2: phase_small_gemms(p, l, smem); break;
    case 3: phase_mixers(p, l, smem); break;
    case 4: phase_gla_scan(p, l); break;
    case 5: phase_gla_out(p, l, smem); break;
    case 6: phase_merge(p, l, smem); break;
    case 7: phase_wout(p, l, smem); break;
    case 8: phase_ln_mid(p, l); break;
    case 9: phase_pq(p, l, smem); break;
    case 10: phase_scores(p, l, smem); break;
    case 11: phase_topk(p, l); break;
    case 12: phase_peer(p, l, smem); break;
  }
}

#define XB_TMO      128
#define XB_XCNT(j)  (256  + 64 * (j))
#define XB_XSUB(j)  (1280 + 64 * (j))
#define XB_XGEN(j)  (2304 + 64 * (j))
#define XB_TOP      3328
#define XB_TOPGEN   3392
#define XCD_BAR_WORDS 3456
#define XB_SPIN_CAP (1u << 18)
#define LAS __attribute__((address_space(3)))

__device__ __forceinline__ unsigned xb_ld(unsigned* p)              { return __hip_atomic_load(p, __ATOMIC_RELAXED, __HIP_MEMORY_SCOPE_AGENT); }
__device__ __forceinline__ unsigned xb_add(unsigned* p, unsigned v) { return __hip_atomic_fetch_add(p, v, __ATOMIC_RELAXED, __HIP_MEMORY_SCOPE_AGENT); }
__device__ __forceinline__ unsigned xb_xcc_id() { return (unsigned)__builtin_amdgcn_s_getreg((3 << 11) | 20) & 0xFu; }
#define XB_SPIN(cond, bar) do { unsigned _sp = 0; while (cond) { __builtin_amdgcn_s_sleep(1); \
    if ((++_sp & 255u) == 0u) { if (xb_ld(&(bar)[XB_TMO])) break; if (_sp > XB_SPIN_CAP) { atomicAdd(&(bar)[XB_TMO], 1u); break; } } } } while (0)

struct XcdBarrier {
    unsigned* bar; unsigned x;
    volatile LAS unsigned* st;
};

__device__ __forceinline__ XcdBarrier xcd_barrier_post(unsigned* bar, volatile LAS unsigned* st) {
    XcdBarrier b; b.bar = bar; b.x = xb_xcc_id(); b.st = st;
    if (threadIdx.x == 0) (void)xb_add(&bar[XB_XCNT(b.x)], 1u);
    return b;
}
__device__ __forceinline__ void xcd_barrier_complete(unsigned* bar, unsigned x, unsigned& nloc, unsigned& nx) {
    const unsigned G = gridDim.x * gridDim.y * gridDim.z;
    unsigned sum, cnt, mine, sp = 0u;
    for (;;) {
        sum = 0u; cnt = 0u; mine = 0u;
#pragma unroll
        for (unsigned j = 0; j < 16; ++j) { const unsigned c = xb_ld(&bar[XB_XCNT(j)]); sum += c; cnt += (c > 0u) ? 1u : 0u; mine = (j == x) ? c : mine; }
        if (sum == G) break;
        __builtin_amdgcn_s_sleep(1);
        if ((++sp & 255u) == 0u) { if (xb_ld(&bar[XB_TMO])) break; if (sp > XB_SPIN_CAP) { atomicAdd(&bar[XB_TMO], 1u); break; } }
    }
    nloc = mine > 0u ? mine : 1u; nx = cnt > 0u ? cnt : 1u;
}

__device__ __forceinline__ void xcd_barrier(const XcdBarrier& b) {
    asm volatile("s_waitcnt vmcnt(0)" ::: "memory");
    __syncthreads();
    if (threadIdx.x == 0) {
        unsigned* bar = b.bar;
        __builtin_amdgcn_s_waitcnt(0);
        unsigned nloc = b.st[0], nx = b.st[1];
        if (nloc == 0u) { xcd_barrier_complete(bar, b.x, nloc, nx); b.st[0] = nloc; b.st[1] = nx; }
        const unsigned old = xb_add(&bar[XB_XSUB(b.x)], 1u);
        const unsigned gen = old / nloc;
        if (old + 1u == (gen + 1u) * nloc) {
            __builtin_amdgcn_fence(__ATOMIC_RELEASE, "agent");
            asm volatile("s_waitcnt vmcnt(0)" ::: "memory");
            const unsigned og = xb_add(&bar[XB_TOP], 1u);
            const unsigned tg = og / nx;
            if (og + 1u == (tg + 1u) * nx) xb_add(&bar[XB_TOPGEN], 1u);
            else XB_SPIN(xb_ld(&bar[XB_TOPGEN]) == tg, bar);
            __builtin_amdgcn_fence(__ATOMIC_ACQUIRE, "agent");
            xb_add(&bar[XB_XGEN(b.x)], 1u);
            asm volatile("s_waitcnt vmcnt(0)" ::: "memory");
        } else {
            XB_SPIN(xb_ld(&bar[XB_XGEN(b.x)]) == gen, bar);
            __builtin_amdgcn_fence(__ATOMIC_ACQUIRE, "agent");
            asm volatile("s_waitcnt vmcnt(0)" ::: "memory");
        }
    }
    __syncthreads();
}


#define SMEM_BYTES 61440

#if MULTI
__global__ void __launch_bounds__(256, 2) k_phase(P p, int ph) {
  __shared__ __attribute__((aligned(16))) char smem[SMEM_BYTES];
  run_phase(p, ph, smem);
}
#else
__global__ void __launch_bounds__(256, 2) k_mega(P p) {
  __shared__ __attribute__((aligned(16))) char smem[SMEM_BYTES];
  __shared__ uint4 xb_words;
  cg::grid_group grid = cg::this_grid();
  if (threadIdx.x == 0) xb_words = make_uint4(0u, 0u, 0u, 0u);
  __syncthreads();
  XcdBarrier xb = xcd_barrier_post((unsigned*)(p.ws + OFF_bar), (volatile LAS unsigned*)&xb_words);
#pragma nounroll
  for (int ph = 0; ph < N_PHASES; ph++) {
    if (ph >= 2 && (ph - 2) % 13 == 10) continue;
    run_phase(p, ph, smem);
#ifdef DUPMASK
    if (ph >= 2 && ((DUPMASK >> ((ph - 2) % 13)) & 1)) run_phase(p, ph, smem);
#endif
    if (ph + 1 < N_PHASES) {
      if (gridDim.y > 1) grid.sync();
      xcd_barrier(xb);
    }
  }
}
#endif

extern "C" void kernel_launch(void* const* d_in, const int* in_sizes, int n_in, void* d_out, int out_size, void* d_ws,
                              size_t ws_size, hipStream_t stream) {
  P p{};
  const float** fp = (const float**)&p;
  for (int i = 0; i < 32; i++) fp[i] = (const float*)d_in[i];
  p.out = (float*)d_out;
  p.ws = (char*)d_ws;
  size_t off = WS_TOTAL;
  if (off > ws_size) { fprintf(stderr, "ws too small: need %zu have %zu\n", off, ws_size); return; }
#if MULTI
  for (int ph = 0; ph < N_PHASES; ph++) hipLaunchKernelGGL(k_phase, dim3(512), dim3(256), 0, stream, p, ph);
#else
  static int grid_blocks = 0;
  if (!grid_blocks) {
    int dev = 0, cus = 0, per_cu = 0;
    hipGetDevice(&dev);
    hipDeviceGetAttribute(&cus, hipDeviceAttributeMultiprocessorCount, dev);
    hipOccupancyMaxActiveBlocksPerMultiprocessor(&per_cu, k_mega, 256, 0);
    if (per_cu > 2) per_cu = 2;
    grid_blocks = cus * per_cu;
  }
  hipMemsetAsync(p.ws + OFF_bar, 0, 16384, stream);
  void* args[] = {&p};
  hipError_t e = hipLaunchCooperativeKernel((void*)k_mega, dim3(grid_blocks), dim3(256), args, 0, stream);
  if (e != hipSuccess) fprintf(stderr, "cooperative launch failed: %s (grid %d)\n", hipGetErrorString(e), grid_blocks);
#endif
}
```

```cpp
#include <hip/hip_runtime.h>
#include <hip/hip_cooperative_groups.h>
#include <cstdio>
#include <cstdint>
namespace cg = cooperative_groups;

#ifndef MULTI
#define MULTI 0
#endif

typedef unsigned short bf16_t;
using bf16x8 = __attribute__((ext_vector_type(8))) short;
using f32x4 = __attribute__((ext_vector_type(4))) float;
using u32x4 = __attribute__((ext_vector_type(4))) unsigned int;

#define T_ALL 12288
#define T_CTX 8192
#define NEG_INF (-__builtin_inff())

__device__ __forceinline__ int tidx() {
  int t = threadIdx.x;
  asm volatile("" : "+v"(t));
  return t;
}
__device__ __forceinline__ bf16_t f2bf(float f) {
  unsigned u = __float_as_uint(f);
  u += 0x7fffu + ((u >> 16) & 1u);
  return (bf16_t)(u >> 16);
}
__device__ __forceinline__ float bf2f(bf16_t b) { return __uint_as_float(((unsigned)b) << 16); }
__device__ __forceinline__ float wsum_shfl(float v) {
#pragma unroll
  for (int o = 32; o; o >>= 1) v += __shfl_xor(v, o);
  return v;
}
#define DPP_F(old, src, ctrl, rm) __int_as_float(__builtin_amdgcn_update_dpp(__float_as_int(old), __float_as_int(src), ctrl, rm, 0xf, false))
__device__ __forceinline__ float wsum(float v) {
  v += DPP_F(v, v, 0xB1, 0xf);
  v += DPP_F(v, v, 0x4E, 0xf);
  v += DPP_F(v, v, 0x141, 0xf);
  v += DPP_F(v, v, 0x140, 0xf);
  v += DPP_F(0.f, v, 0x142, 0xa);
  v += DPP_F(0.f, v, 0x143, 0xc);
  return __int_as_float(__builtin_amdgcn_readlane(__float_as_int(v), 63));
}
__device__ __forceinline__ float wmax(float v) {
  v = fmaxf(v, DPP_F(v, v, 0xB1, 0xf));
  v = fmaxf(v, DPP_F(v, v, 0x4E, 0xf));
  v = fmaxf(v, DPP_F(v, v, 0x141, 0xf));
  v = fmaxf(v, DPP_F(v, v, 0x140, 0xf));
  v = fmaxf(v, DPP_F(v, v, 0x142, 0xa));
  v = fmaxf(v, DPP_F(v, v, 0x143, 0xc));
  return __int_as_float(__builtin_amdgcn_readlane(__float_as_int(v), 63));
}
__device__ __forceinline__ float siluf(float x) { return x * __builtin_amdgcn_rcpf(1.f + __expf(-x)); }
__device__ __forceinline__ float sigmf(float x) { return __builtin_amdgcn_rcpf(1.f + __expf(-x)); }
__device__ __forceinline__ float logsigf(float z) { return fminf(z, 0.f) - log1pf(__expf(-fabsf(z))); }
__device__ __forceinline__ int cond_row(int g) { return g < T_CTX ? 0 : 1 + ((g - T_CTX) >> 11); }

struct P {
  const float *x_prompt, *x_sample, *c, *cache_ckv, *cache_krope, *cache_swa_k, *cache_swa_v, *state_gla, *c_ctx,
      *w_ada, *b_ada, *w_in, *mla_q_norm, *w_uq, *mla_kv_norm, *w_ukv, *w_gla_a_fwd, *b_gla_a_fwd, *w_gla_a_bwd,
      *b_gla_a_bwd, *gla_norm, *swa_sink, *w_branch, *w_out, *ln1_g, *ln1_b, *ln2_g, *ln2_b, *w_peer_q, *peer_keys,
      *peer_u, *peer_v;
  float* out;
  char* ws;
};

constexpr size_t OFF_Wt_in = 0ull;
constexpr size_t OFF_Wt_uq = OFF_Wt_in + (((2ull * 6144 * 1024 * 2) + 255ull) & ~255ull);
constexpr size_t OFF_Wt_ukv = OFF_Wt_uq + (((2ull * 384 * 256 * 2) + 255ull) & ~255ull);
constexpr size_t OFF_Wt_br = OFF_Wt_ukv + (((2ull * 512 * 128 * 2) + 255ull) & ~255ull);
constexpr size_t OFF_Wt_out = OFF_Wt_br + (((8ull * 1024 * 256 * 2) + 255ull) & ~255ull);
constexpr size_t OFF_Wt_pq = OFF_Wt_out + (((2ull * 1024 * 1024 * 2) + 255ull) & ~255ull);
constexpr size_t OFF_keysbf = OFF_Wt_pq + (((2ull * 2048 * 1024 * 2) + 255ull) & ~255ull);
constexpr size_t OFF_Cch = OFF_keysbf + (((2ull * 16 * 128 * 128 * 2) + 255ull) & ~255ull);
constexpr size_t OFF_A256 = OFF_Cch + (((128ull * 64 * 2) + 255ull) & ~255ull);
constexpr size_t OFF_A2048 = OFF_A256 + (((256ull * 512 * 2) + 255ull) & ~255ull);
constexpr size_t OFF_mada = OFF_A2048 + (((2048ull * 4096 * 2) + 255ull) & ~255ull);
constexpr size_t OFF_xbuf = OFF_mada + (((2ull * 3 * 6144 * 4) + 255ull) & ~255ull);
constexpr size_t OFF_u = OFF_xbuf + 256ull;
constexpr size_t OFF_hbuf = OFF_u + (((12288ull * 1024 * 2) + 255ull) & ~255ull);
constexpr size_t OFF_gates = OFF_hbuf + (((12288ull * 1984 * 4) + 255ull) & ~255ull);
constexpr size_t OFF_qn = OFF_gates + (((12288ull * 4096 * 2) + 255ull) & ~255ull);
constexpr size_t OFF_ckv_all = OFF_qn + (((12288ull * 256 * 2) + 255ull) & ~255ull);
constexpr size_t OFF_Qa = OFF_ckv_all + (((13312ull * 128 * 2) + 255ull) & ~255ull);
constexpr size_t OFF_Ka_ctx = OFF_Qa + (((12288ull * 384 * 2) + 255ull) & ~255ull);
constexpr size_t OFF_Ka_lat = OFF_Ka_ctx + (((32ull * 4 * 256 * 96 * 2) + 255ull) & ~255ull);
constexpr size_t OFF_Va_ctx = OFF_Ka_lat + (((2ull * 4 * 2560 * 96 * 2) + 255ull) & ~255ull);
constexpr size_t OFF_Va_lat = OFF_Va_ctx + (((32ull * 4 * 256 * 64 * 2) + 255ull) & ~255ull);
constexpr size_t OFF_Qd = OFF_Va_lat + (((2ull * 4 * 2560 * 64 * 2) + 255ull) & ~255ull);
constexpr size_t OFF_Kd_ctx = OFF_Qd + (((12288ull * 256 * 2) + 255ull) & ~255ull);
constexpr size_t OFF_Kd_lat = OFF_Kd_ctx + (((32ull * 2 * 256 * 64 * 2) + 255ull) & ~255ull);
constexpr size_t OFF_Vd_ctx = OFF_Kd_lat + (((2ull * 2 * 2560 * 64 * 2) + 255ull) & ~255ull);
constexpr size_t OFF_Vd_lat = OFF_Vd_ctx + (((32ull * 2 * 256 * 64 * 2) + 255ull) & ~255ull);
constexpr size_t OFF_fnet = OFF_Vd_lat + (((2ull * 2 * 2560 * 64 * 2) + 255ull) & ~255ull);
constexpr size_t OFF_Yt_ctx = OFF_fnet + (((12288ull * 256 * 2) + 255ull) & ~255ull);
constexpr size_t OFF_Yt_lat = OFF_Yt_ctx + (((32ull * 256 * 512 * 2) + 255ull) & ~255ull);
constexpr size_t OFF_br = OFF_Yt_lat + (((2ull * 256 * 4096 * 2) + 255ull) & ~255ull);
constexpr size_t OFF_un = OFF_br + (((12288ull * 1024 * 2) + 255ull) & ~255ull);
constexpr size_t OFF_sin_ = OFF_un + (((1536ull * 2048 * 4) + 255ull) & ~255ull);
constexpr size_t OFF_gn = OFF_sin_ + (((1536ull * 2048 * 4) + 255ull) & ~255ull);
constexpr size_t OFF_pidx = OFF_gn + (((1536ull * 32 * 4) + 255ull) & ~255ull);
constexpr size_t OFF_pw = OFF_pidx + (((12288ull * 128 * 4) + 255ull) & ~255ull);
constexpr size_t OFF_bar = OFF_pw + (((12288ull * 128 * 4) + 255ull) & ~255ull);
constexpr size_t WS_TOTAL_OLD = OFF_pw + (((12288ull * 128 * 4) + 255ull) & ~255ull);
constexpr size_t OFF_tabU = OFF_bar + 16384ull;
constexpr size_t OFF_tabV = OFF_tabU + 2ull * 16384 * 1024;
constexpr size_t OFF_u8 = OFF_tabV + 2ull * 16384 * 1024;
constexpr size_t OFF_win8 = OFF_u8 + 12288ull * 1024;
constexpr size_t WS_TOTAL = OFF_win8 + 2ull * 4096 * 1024;
static_assert(WS_TOTAL <= 536870912ull, "workspace budget");
#define W_u8 ((unsigned char*)(p.ws + OFF_u8))
#define W_win8 ((unsigned char*)(p.ws + OFF_win8))
#define W_tabU ((unsigned char*)(p.ws + OFF_tabU))
#define W_tabV ((unsigned char*)(p.ws + OFF_tabV))
#define W_Wt_in ((bf16_t*)(p.ws + OFF_Wt_in))
#define W_Wt_uq ((bf16_t*)(p.ws + OFF_Wt_uq))
#define W_Wt_ukv ((bf16_t*)(p.ws + OFF_Wt_ukv))
#define W_Wt_br ((bf16_t*)(p.ws + OFF_Wt_br))
#define W_Wt_out ((bf16_t*)(p.ws + OFF_Wt_out))
#define W_Wt_pq ((bf16_t*)(p.ws + OFF_Wt_pq))
#define W_keysbf ((bf16_t*)(p.ws + OFF_keysbf))
#define W_Cch ((bf16_t*)(p.ws + OFF_Cch))
#define W_A256 ((bf16_t*)(p.ws + OFF_A256))
#define W_A2048 ((bf16_t*)(p.ws + OFF_A2048))
#define W_mada ((float*)(p.ws + OFF_mada))
#define W_xbuf ((float*)(p.ws + OFF_xbuf))
#define W_u ((bf16_t*)(p.ws + OFF_u))
#define W_hbuf ((float*)(p.ws + OFF_hbuf))
#define W_gates ((bf16_t*)(p.ws + OFF_gates))
#define W_qn ((bf16_t*)(p.ws + OFF_qn))
#define W_ckv_all ((bf16_t*)(p.ws + OFF_ckv_all))
#define W_Qa ((bf16_t*)(p.ws + OFF_Qa))
#define W_Ka_ctx ((bf16_t*)(p.ws + OFF_Ka_ctx))
#define W_Ka_lat ((bf16_t*)(p.ws + OFF_Ka_lat))
#define W_Va_ctx ((bf16_t*)(p.ws + OFF_Va_ctx))
#define W_Va_lat ((bf16_t*)(p.ws + OFF_Va_lat))
#define W_Qd ((bf16_t*)(p.ws + OFF_Qd))
#define W_Kd_ctx ((bf16_t*)(p.ws + OFF_Kd_ctx))
#define W_Kd_lat ((bf16_t*)(p.ws + OFF_Kd_lat))
#define W_Vd_ctx ((bf16_t*)(p.ws + OFF_Vd_ctx))
#define W_Vd_lat ((bf16_t*)(p.ws + OFF_Vd_lat))
#define W_fnet ((bf16_t*)(p.ws + OFF_fnet))
#define W_Yt_ctx ((bf16_t*)(p.ws + OFF_Yt_ctx))
#define W_Yt_lat ((bf16_t*)(p.ws + OFF_Yt_lat))
#define W_br ((bf16_t*)(p.ws + OFF_br))
#define W_un ((float*)(p.ws + OFF_un))
#define W_sin_ ((float*)(p.ws + OFF_sin_))
#define W_gn ((float*)(p.ws + OFF_gn))
#define W_pidx ((int*)(p.ws + OFF_pidx))
#define W_pw ((float*)(p.ws + OFF_pw))

#define GB_LD 72
#define G_LOAD(RA, RB, KOFF)                                                         \
  _Pragma("unroll") for (int i = 0; i < 4; i++) {                                    \
    int c = tid + i * 256, r = c >> 3, cc = (c & 7) * 8;                             \
    RA[i] = *(const u32x4*)(A + (size_t)r * lda + (KOFF) + cc);                      \
    if (i < NJ) RB[i] = *(const u32x4*)(B + (size_t)r * ldb + (KOFF) + cc);          \
  }
#define G_STORE(RA, RB)                                                              \
  _Pragma("unroll") for (int i = 0; i < 4; i++) {                                    \
    int c = tid + i * 256, r = c >> 3, cc = (c & 7) * 8;                             \
    *(u32x4*)(sa + r * GB_LD + cc) = RA[i];                                          \
    if (i < NJ) *(u32x4*)(sb + r * GB_LD + cc) = RB[i];                              \
  }
#define G_COMPUTE()                                                                  \
  _Pragma("unroll") for (int ks = 0; ks < 2; ks++) {                                 \
    bf16x8 af[4], bfr[NJ];                                                           \
    _Pragma("unroll") for (int i = 0; i < 4; i++)                                    \
      af[i] = *(const bf16x8*)(sa + (wm * 64 + i * 16 + l15) * GB_LD + ks * 32 + l4 * 8); \
    _Pragma("unroll") for (int j = 0; j < NJ; j++)                                   \
      bfr[j] = *(const bf16x8*)(sb + (wn * NJ * 16 + j * 16 + l15) * GB_LD + ks * 32 + l4 * 8); \
    _Pragma("unroll") for (int i = 0; i < 4; i++)                                    \
    _Pragma("unroll") for (int j = 0; j < NJ; j++)                                   \
      acc[i][j] = __builtin_amdgcn_mfma_f32_16x16x32_bf16(af[i], bfr[j], acc[i][j], 0, 0, 0); \
  }
template <int NJ>
__device__ __forceinline__ void gemm_core_t(f32x4 (&acc)[4][NJ], const bf16_t* __restrict__ A, int lda,
                                            const bf16_t* __restrict__ B, int ldb, int K, char* smem) {
  bf16_t* sa = (bf16_t*)smem;
  bf16_t* sb = sa + 128 * GB_LD;
  const int tid = tidx(), lane = tid & 63, w = tid >> 6, wm = w >> 1, wn = w & 1;
  const int l15 = lane & 15, l4 = lane >> 4;
  u32x4 ra0[4], rb0[NJ], ra1[4], rb1[NJ];
  G_LOAD(ra0, rb0, 0);
  if (K > 64) { G_LOAD(ra1, rb1, 64); }
  for (int k0 = 0; k0 < K; k0 += 128) {
    __syncthreads();
    G_STORE(ra0, rb0);
    __syncthreads();
    if (k0 + 128 < K) { G_LOAD(ra0, rb0, k0 + 128); }
    G_COMPUTE();
    if (k0 + 64 < K) {
      __syncthreads();
      G_STORE(ra1, rb1);
      __syncthreads();
      if (k0 + 192 < K) { G_LOAD(ra1, rb1, k0 + 192); }
      G_COMPUTE();
    }
  }
}
#define gemm_core gemm_core_t<4>
__device__ __forceinline__ void gemm_core_wide(f32x4 (&acc)[4][8], const bf16_t* __restrict__ A, int lda,
                                               const bf16_t* __restrict__ B, int ldb, int K, char* smem) {
  bf16_t* sa = (bf16_t*)smem;
  bf16_t* sb = sa + 128 * GB_LD;
  const int tid = tidx(), lane = tid & 63, w = tid >> 6, wm = w >> 1, wn = w & 1;
  const int l15 = lane & 15, l4 = lane >> 4;
  u32x4 ra[4], rb[8];
#pragma unroll
  for (int i = 0; i < 8; i++) {
    int c = tid + i * 256, r = c >> 3, cc = (c & 7) * 8;
    if (i < 4) ra[i] = *(const u32x4*)(A + (size_t)r * lda + cc);
    rb[i] = *(const u32x4*)(B + (size_t)r * ldb + cc);
  }
  for (int k0 = 0; k0 < K; k0 += 64) {
    __syncthreads();
#pragma unroll
    for (int i = 0; i < 8; i++) {
      int c = tid + i * 256, r = c >> 3, cc = (c & 7) * 8;
      if (i < 4) *(u32x4*)(sa + r * GB_LD + cc) = ra[i];
      *(u32x4*)(sb + r * GB_LD + cc) = rb[i];
    }
    __syncthreads();
    if (k0 + 64 < K) {
#pragma unroll
      for (int i = 0; i < 8; i++) {
        int c = tid + i * 256, r = c >> 3, cc = (c & 7) * 8;
        if (i < 4) ra[i] = *(const u32x4*)(A + (size_t)r * lda + k0 + 64 + cc);
        rb[i] = *(const u32x4*)(B + (size_t)r * ldb + k0 + 64 + cc);
      }
    }
#pragma unroll
    for (int ks = 0; ks < 2; ks++) {
      bf16x8 af[4];
#pragma unroll
      for (int i = 0; i < 4; i++) af[i] = *(const bf16x8*)(sa + (wm * 64 + i * 16 + l15) * GB_LD + ks * 32 + l4 * 8);
#pragma unroll
      for (int j = 0; j < 8; j++) {
        bf16x8 bfr = *(const bf16x8*)(sb + (wn * 128 + j * 16 + l15) * GB_LD + ks * 32 + l4 * 8);
#pragma unroll
        for (int i = 0; i < 4; i++) acc[i][j] = __builtin_amdgcn_mfma_f32_16x16x32_bf16(af[i], bfr, acc[i][j], 0, 0, 0);
      }
    }
  }
}
using i64x2 = __attribute__((ext_vector_type(2))) long;
__device__ __forceinline__ int pack_fp8x4(float a, float b, float c, float d) {
  int pk = __builtin_amdgcn_cvt_pk_fp8_f32(a, b, 0, false);
  return __builtin_amdgcn_cvt_pk_fp8_f32(c, d, pk, true);
}
__device__ __forceinline__ void gemm_core8(f32x4 (&acc)[4][4], const bf16_t* __restrict__ A, int lda,
                                           const bf16_t* __restrict__ B, int ldb, int K, char* smem) {
  constexpr int NJ = 4;
  bf16_t* sa = (bf16_t*)smem;
  bf16_t* sb = sa + 128 * GB_LD;
  const int tid = tidx(), lane = tid & 63, w = tid >> 6, wm = w >> 1, wn = w & 1;
  const int l15 = lane & 15, l4 = lane >> 4;
  u32x4 ra0[4], rb0[NJ], ra1[4], rb1[NJ];
  G_LOAD(ra0, rb0, 0);
  if (K > 64) { G_LOAD(ra1, rb1, 64); }
#define G_COMPUTE8()                                                                                   \
  _Pragma("unroll") for (int ks = 0; ks < 2; ks++) {                                                   \
    i64x2 af[4], bfr[4];                                                                               \
    _Pragma("unroll") for (int i = 0; i < 4; i++)                                                      \
      af[i] = *(const i64x2*)(sa + (wm * 64 + i * 16 + l15) * GB_LD + ks * 32 + l4 * 8);               \
    _Pragma("unroll") for (int j = 0; j < 4; j++)                                                      \
      bfr[j] = *(const i64x2*)(sb + (wn * 64 + j * 16 + l15) * GB_LD + ks * 32 + l4 * 8);              \
    _Pragma("unroll") for (int i = 0; i < 4; i++)                                                      \
    _Pragma("unroll") for (int j = 0; j < 4; j++) {                                                    \
      acc[i][j] = __builtin_amdgcn_mfma_f32_16x16x32_fp8_fp8(af[i].x, bfr[j].x, acc[i][j], 0, 0, 0);   \
      acc[i][j] = __builtin_amdgcn_mfma_f32_16x16x32_fp8_fp8(af[i].y, bfr[j].y, acc[i][j], 0, 0, 0);   \
    }                                                                                                  \
  }
  for (int k0 = 0; k0 < K; k0 += 128) {
    __syncthreads();
    G_STORE(ra0, rb0);
    __syncthreads();
    if (k0 + 128 < K) { G_LOAD(ra0, rb0, k0 + 128); }
    G_COMPUTE8();
    if (k0 + 64 < K) {
      __syncthreads();
      G_STORE(ra1, rb1);
      __syncthreads();
      if (k0 + 192 < K) { G_LOAD(ra1, rb1, k0 + 192); }
      G_COMPUTE8();
    }
  }
}
#define ZERO_ACC_N(acc, NJ)                                        \
  _Pragma("unroll") for (int i_ = 0; i_ < 4; i_++)                 \
  _Pragma("unroll") for (int j_ = 0; j_ < NJ; j_++) { acc[i_][j_] = f32x4{0.f, 0.f, 0.f, 0.f}; }
#define ZERO_ACC(acc) ZERO_ACC_N(acc, 4)
#define EPI_LOOP_N(acc, m0, n0, NJ, ...)                                                   \
  {                                                                                        \
    const int lane_ = tidx() & 63, w_ = tidx() >> 6, wm_ = w_ >> 1, wn_ = w_ & 1; \
    _Pragma("unroll") for (int i_ = 0; i_ < 4; i_++)                                       \
    _Pragma("unroll") for (int j_ = 0; j_ < NJ; j_++)                                      \
    _Pragma("unroll") for (int r_ = 0; r_ < 4; r_++) {                                     \
      const int m = (m0) + wm_ * 64 + i_ * 16 + (lane_ >> 4) * 4 + r_;                     \
      const int n = (n0) + wn_ * (NJ * 16) + j_ * 16 + (lane_ & 15);                       \
      float v = acc[i_][j_][r_];                                                           \
      __VA_ARGS__                                                                          \
    }                                                                                      \
  }
#define EPI_LOOP(acc, m0, n0, ...) EPI_LOOP_N(acc, m0, n0, 4, __VA_ARGS__)
#define EPI4_LOOP(acc, c0, t0, ...)                                                        \
  {                                                                                        \
    const int lane_ = tidx() & 63, w_ = tidx() >> 6, wm_ = w_ >> 1, wn_ = w_ & 1;           \
    _Pragma("unroll") for (int i_ = 0; i_ < 4; i_++)                                       \
    _Pragma("unroll") for (int j_ = 0; j_ < 4; j_++) {                                     \
      const int col = (c0) + wm_ * 64 + i_ * 16 + (lane_ >> 4) * 4;                        \
      const int tok = (t0) + wn_ * 64 + j_ * 16 + (lane_ & 15);                            \
      const f32x4 v4 = acc[i_][j_];                                                        \
      __VA_ARGS__                                                                          \
    }                                                                                      \
  }

__device__ __forceinline__ void transpose_tile(const float* __restrict__ src, int K, int N, bf16_t* __restrict__ dst, int tile, int ntn,
                               float* sm, int ldd = 0) {
  if (ldd == 0) ldd = K;
  int kt = tile / ntn, nt = tile % ntn, k0 = kt * 64, n0 = nt * 64;
  int tx = tidx() & 63, ty = tidx() >> 6;
  __syncthreads();
  for (int i = 0; i < 16; i++) {
    int k = i * 4 + ty, n = n0 + tx;
    sm[k * 65 + tx] = (n < N) ? src[(size_t)(k0 + k) * N + n] : 0.f;
  }
  __syncthreads();
  for (int i = 0; i < 16; i++) {
    int n = i * 4 + ty;
    dst[(size_t)(n0 + n) * ldd + k0 + tx] = f2bf(sm[tx * 65 + n]);
  }
}

__device__ __forceinline__ void transpose_tile8(const float* __restrict__ src, unsigned char* __restrict__ dst, int tile, float* sm) {
  int kt = tile >> 6, nt = tile & 63, k0 = kt * 64, n0 = nt * 64;
  int tx = tidx() & 63, ty = tidx() >> 6;
  __syncthreads();
  for (int i = 0; i < 16; i++) {
    int k = i * 4 + ty, n = 2048 + n0 + tx;
    sm[k * 65 + tx] = (n < 6080) ? src[(size_t)(k0 + k) * 6080 + n] : 0.f;
  }
  __syncthreads();
  for (int i = 0; i < 16; i++) {
    int n = i * 4 + ty;
    float v = sm[tx * 65 + n] * 64.f;
    dst[(size_t)(n0 + n) * 1024 + k0 + tx] = (unsigned char)(__builtin_amdgcn_cvt_pk_fp8_f32(v, v, 0, false) & 0xff);
  }
}

__device__ __forceinline__ void ada_item(const P& p, int item, float* sm) {
  int l = item / 24, cgp = item % 24;
  int lane = tidx() & 63, w = tidx() >> 6;
  const float* W = p.w_ada + (size_t)l * 1024 * 6144 + cgp * 256 + lane * 4;
  float4 a0 = {0, 0, 0, 0}, a1 = {0, 0, 0, 0}, a2 = {0, 0, 0, 0};
#pragma unroll 16
  for (int k = w * 256; k < (w + 1) * 256; k++) {
    float4 wv = *(const float4*)(W + (size_t)k * 6144);
    float c0 = siluf(p.c_ctx[k]), c1 = siluf(p.c[k]), c2 = siluf(p.c[1024 + k]);
    a0.x += c0 * wv.x; a0.y += c0 * wv.y; a0.z += c0 * wv.z; a0.w += c0 * wv.w;
    a1.x += c1 * wv.x; a1.y += c1 * wv.y; a1.z += c1 * wv.z; a1.w += c1 * wv.w;
    a2.x += c2 * wv.x; a2.y += c2 * wv.y; a2.z += c2 * wv.z; a2.w += c2 * wv.w;
  }
  __syncthreads();
  *(float4*)(sm + (w * 3 + 0) * 256 + lane * 4) = a0;
  *(float4*)(sm + (w * 3 + 1) * 256 + lane * 4) = a1;
  *(float4*)(sm + (w * 3 + 2) * 256 + lane * 4) = a2;
  __syncthreads();
  for (int o = tidx(); o < 768; o += 256) {
    int r = o >> 8, col = o & 255;
    float s = sm[(0 * 3 + r) * 256 + col] + sm[(1 * 3 + r) * 256 + col] + sm[(2 * 3 + r) * 256 + col] +
              sm[(3 * 3 + r) * 256 + col];
    W_mada[(l * 3 + r) * 6144 + cgp * 256 + col] = s + p.b_ada[l * 6144 + cgp * 256 + col];
  }
}

__device__ __forceinline__ void dft_seq_fill(bf16_t* dst, int S, int item) {
  float inv = rsqrtf((float)S);
  size_t base = (size_t)item * 2048;
  for (int e = 0; e < 8; e++) {
    size_t idx = base + e * 256 + tidx();
    int k = (int)(idx / (2 * S)), col = (int)(idx % (2 * S));
    int s = col < S ? col : col - S;
    int mm = (k * s) & (S - 1);
    float rev = (float)mm / (float)S;
    float v = col < S ? __builtin_amdgcn_cosf(rev) : -__builtin_amdgcn_sinf(rev);
    dst[idx] = f2bf(v * inv);
  }
}

#define PEER_U_SCALE 64.f
#define PEER_V_SCALE 16.f
__device__ __forceinline__ void tab_convert_item(const P& p, int item) {
  int l = item >> 12, isv = (item >> 11) & 1, sub = item & 2047;
  const float* src = (isv ? p.peer_v : p.peer_u) + (size_t)l * 16384 * 1024 + (size_t)sub * 8192;
  unsigned char* dst = (isv ? W_tabV : W_tabU) + (size_t)l * 16384 * 1024 + (size_t)sub * 8192;
  const float sc = isv ? PEER_V_SCALE : PEER_U_SCALE;
  int tid = tidx();
  float4 tt[8];
#pragma unroll
  for (int e = 0; e < 8; e++) tt[e] = *(const float4*)(src + (e * 256 + tid) * 4);
#pragma unroll
  for (int e = 0; e < 8; e++) {
    float4 t = tt[e];
    int pk = __builtin_amdgcn_cvt_pk_fp8_f32(t.x * sc, t.y * sc, 0, false);
    pk = __builtin_amdgcn_cvt_pk_fp8_f32(t.z * sc, t.w * sc, pk, true);
    *(int*)(dst + (e * 256 + tid) * 4) = pk;
  }
}

__device__ __forceinline__ void phase_prep(const P& p, char* smem) {
  float* sm = (float*)smem;
  const int nb = gridDim.x;
  const int J_ADA = 48;
  const int J_IN = 2 * 16 * 32;
  const int J_IN8 = 2 * 16 * 64;
  const int J_UQ = 2 * 4 * 6;
  const int J_UKV = 2 * 2 * 8;
  const int J_BR = 2 * 4 * 4 * 16;
  const int J_OUT = 2 * 16 * 16;
  const int J_PQ = 2 * 16 * 32;
  const int J_KEYS = 256;
  const int J_CCH = 4;
  const int J_A256 = 64;
  const int J_A2048 = 4096;
  const int J_TAB = 8192;
  const int total = J_ADA + J_IN + J_IN8 + J_UQ + J_UKV + J_BR + J_OUT + J_PQ + J_KEYS + J_CCH + J_A256 + J_A2048 + J_TAB;
  const bool ada_split = nb >= 4 * J_ADA;
  const int it_start = ada_split ? ((int)blockIdx.x < J_ADA ? (int)blockIdx.x : J_ADA + ((int)blockIdx.x - J_ADA)) : (int)blockIdx.x;
  const int it_step = ada_split ? ((int)blockIdx.x < J_ADA ? total : nb - J_ADA) : nb;
  for (int it0 = it_start; it0 < total; it0 += it_step) {
    int it = it0;
    if (it < J_ADA) { ada_item(p, it, sm); continue; }
    it -= J_ADA;
    if (it < J_IN) { int l = it / 512, t = it % 512; transpose_tile(p.w_in + (size_t)l * 1024 * 6080, 1024, 6080, W_Wt_in + (size_t)l * 6144 * 1024, t, 32, sm); continue; }
    it -= J_IN;
    if (it < J_IN8) { int l = it / 1024, t = it % 1024; transpose_tile8(p.w_in + (size_t)l * 1024 * 6080, W_win8 + (size_t)l * 4096 * 1024, t, sm); continue; }
    it -= J_IN8;
    if (it < J_UQ) { int l = it / 24, t = it % 24; transpose_tile(p.w_uq + (size_t)l * 256 * 384, 256, 384, W_Wt_uq + (size_t)l * 384 * 256, t, 6, sm); continue; }
    it -= J_UQ;
    if (it < J_UKV) { int l = it / 16, t = it % 16; transpose_tile(p.w_ukv + (size_t)l * 128 * 512, 128, 512, W_Wt_ukv + (size_t)l * 512 * 128, t, 8, sm); continue; }
    it -= J_UKV;
    if (it < J_BR) { int lb = it / 64, t = it % 64; transpose_tile(p.w_branch + (size_t)lb * 256 * 1024, 256, 1024, W_Wt_br + (size_t)(lb >> 2) * 1024 * 1024 + (lb & 3) * 256, t, 16, sm, 1024); continue; }
    it -= J_BR;
    if (it < J_OUT) { int l = it / 256, t = it % 256; transpose_tile(p.w_out + (size_t)l * 1024 * 1024, 1024, 1024, W_Wt_out + (size_t)l * 1024 * 1024, t, 16, sm); continue; }
    it -= J_OUT;
    if (it < J_PQ) { int l = it / 512, t = it % 512; transpose_tile(p.w_peer_q + (size_t)l * 1024 * 2048, 1024, 2048, W_Wt_pq + (size_t)l * 2048 * 1024, t, 32, sm); continue; }
    it -= J_PQ;
    if (it < J_KEYS) {
      size_t base = (size_t)it * 2048;
      float kv_[8];
#pragma unroll
      for (int e = 0; e < 8; e++) kv_[e] = p.peer_keys[base + e * 256 + tidx()];
#pragma unroll
      for (int e = 0; e < 8; e++) W_keysbf[base + e * 256 + tidx()] = f2bf(kv_[e]);
      continue;
    }
    it -= J_KEYS;
    if (it < J_CCH) {
      for (int e = 0; e < 8; e++) {
        int idx = it * 2048 + e * 256 + tidx();
        int n = idx >> 6, c = idx & 63;
        int j = n & 63;
        float rev = (float)((j * c) & 63) / 64.f;
        float v = n < 64 ? __builtin_amdgcn_cosf(rev) : __builtin_amdgcn_sinf(rev);
        W_Cch[idx] = f2bf(v * 0.125f);
      }
      continue;
    }
    it -= J_CCH;
    if (it < J_A256) { dft_seq_fill(W_A256, 256, it); continue; }
    it -= J_A256;
    if (it < J_A2048) { dft_seq_fill(W_A2048, 2048, it); continue; }
    it -= J_A2048;
    tab_convert_item(p, it);
  }
}

__device__ __forceinline__ void load_row16(const float* row, int lane, float (&v)[16]) {
#pragma unroll
  for (int q = 0; q < 4; q++) {
    float4 t = *(const float4*)(row + q * 256 + lane * 4);
    v[q * 4 + 0] = t.x; v[q * 4 + 1] = t.y; v[q * 4 + 2] = t.z; v[q * 4 + 3] = t.w;
  }
}
__device__ __forceinline__ void store_row16(float* row, int lane, const float (&v)[16]) {
#pragma unroll
  for (int q = 0; q < 4; q++) *(float4*)(row + q * 256 + lane * 4) = float4{v[q * 4], v[q * 4 + 1], v[q * 4 + 2], v[q * 4 + 3]};
}
__device__ __forceinline__ void ln16(float (&v)[16]) {
  float s = 0;
#pragma unroll
  for (int i = 0; i < 16; i++) s += v[i];
  s = wsum(s);
  float mu = s * (1.f / 1024.f);
  float q = 0;
#pragma unroll
  for (int i = 0; i < 16; i++) { v[i] -= mu; q += v[i] * v[i]; }
  q = wsum(q);
  float rs = rsqrtf(q * (1.f / 1024.f) + 1e-6f);
#pragma unroll
  for (int i = 0; i < 16; i++) v[i] *= rs;
}
__device__ __forceinline__ void modulate_store(const float (&v)[16], const float* sh, const float* sc, bf16_t* dst, int lane, unsigned char* dst8 = nullptr) {
#pragma unroll
  for (int q = 0; q < 4; q++) {
    float4 a = *(const float4*)(sc + q * 256 + lane * 4);
    float4 b = *(const float4*)(sh + q * 256 + lane * 4);
    ushort4 o;
    o.x = f2bf(v[q * 4 + 0] * (1.f + a.x) + b.x);
    o.y = f2bf(v[q * 4 + 1] * (1.f + a.y) + b.y);
    o.z = f2bf(v[q * 4 + 2] * (1.f + a.z) + b.z);
    o.w = f2bf(v[q * 4 + 3] * (1.f + a.w) + b.w);
    *(ushort4*)(dst + q * 256 + lane * 4) = o;
    if (dst8) *(int*)(dst8 + q * 256 + lane * 4) = pack_fp8x4(v[q * 4 + 0] * (1.f + a.x) + b.x, v[q * 4 + 1] * (1.f + a.y) + b.y,
                                                               v[q * 4 + 2] * (1.f + a.z) + b.z, v[q * 4 + 3] * (1.f + a.w) + b.w);
  }
}
__device__ __forceinline__ void affine16(float (&v)[16], const float* g, const float* b, int lane) {
#pragma unroll
  for (int q = 0; q < 4; q++) {
    float4 a = *(const float4*)(g + q * 256 + lane * 4);
    float4 c = *(const float4*)(b + q * 256 + lane * 4);
    v[q * 4 + 0] = v[q * 4 + 0] * a.x + c.x;
    v[q * 4 + 1] = v[q * 4 + 1] * a.y + c.y;
    v[q * 4 + 2] = v[q * 4 + 2] * a.z + c.z;
    v[q * 4 + 3] = v[q * 4 + 3] * a.w + c.w;
  }
}
__device__ __forceinline__ const float* x_in_row(const P& p, int l, int g) {
  if (l == 0) return g < T_CTX ? p.x_prompt + (size_t)g * 1024 : p.x_sample + (size_t)(g - T_CTX) * 1024;
  return p.out + (size_t)g * 1024;
}
__device__ __forceinline__ float* x_out_row(const P& p, int l, int g) {
  return p.out + (size_t)g * 1024;
}

__device__ __forceinline__ void phase_ln0(const P& p) {
  int lane = tidx() & 63, w = tidx() >> 6;
  for (int it = blockIdx.x; it < T_ALL / 4; it += gridDim.x) {
    int g = it * 4 + w;
    float v[16];
    load_row16(x_in_row(p, 0, g), lane, v);
    ln16(v);
    const float* m = W_mada + (0 * 3 + cond_row(g)) * 6144;
    modulate_store(v, m, m + 1024, W_u + (size_t)g * 1024, lane, W_u8 + (size_t)g * 1024);
  }
}

__device__ __forceinline__ void phase_win(const P& p, int l, char* smem) {
  const bf16_t* Wt = W_Wt_in + (size_t)l * 6144 * 1024;
  const unsigned char* Wt8 = W_win8 + (size_t)l * 4096 * 1024;
  const int N_WIDE = 48 * 16, N_F8 = 96 * 32;
  for (int it = blockIdx.x; it < N_WIDE + N_F8; it += gridDim.x) {
    if (it < N_WIDE) {
      const int mt2 = it >> 4, nt = it & 15, m0 = mt2 * 256, n0 = nt * 128;
      f32x4 acc[4][8];
      ZERO_ACC_N(acc, 8);
      gemm_core_wide(acc, Wt + (size_t)n0 * 1024, 1024, W_u + (size_t)m0 * 1024, 1024, 1024, smem);
      const int lane_ = tidx() & 63, w_ = tidx() >> 6, wm_ = w_ >> 1, wn_ = w_ & 1;
#pragma unroll
      for (int i_ = 0; i_ < 4; i_++)
#pragma unroll
        for (int j_ = 0; j_ < 8; j_++) {
          const int col = n0 + wm_ * 64 + i_ * 16 + (lane_ >> 4) * 4;
          const int tok = m0 + wn_ * 128 + j_ * 16 + (lane_ & 15);
          const f32x4 v4 = acc[i_][j_];
          if (col < 1984) *(float4*)(W_hbuf + (size_t)tok * 1984 + col) = float4{v4[0], v4[1], v4[2], v4[3]};
          else {
            ushort4 o_; o_.x = f2bf(sigmf(v4[0])); o_.y = f2bf(sigmf(v4[1])); o_.z = f2bf(sigmf(v4[2])); o_.w = f2bf(sigmf(v4[3]));
            *(ushort4*)(W_gates + (size_t)tok * 4096 + (col - 1984)) = o_;
          }
        }
    } else {
      const int it2 = it - N_WIDE, mt = it2 >> 5, nt = 16 + (it2 & 31), m0 = mt * 128, n0 = nt * 128;
      f32x4 acc[4][4];
      ZERO_ACC(acc);
      gemm_core8(acc, (const bf16_t*)(Wt8 + (size_t)(n0 - 2048) * 1024), 512, (const bf16_t*)(W_u8 + (size_t)m0 * 1024), 512, 512, smem);
      EPI4_LOOP(acc, n0, m0, {
        if (col < 6080) {
          ushort4 o_;
          o_.x = f2bf(sigmf(v4[0] * (1.f / 64.f))); o_.y = f2bf(sigmf(v4[1] * (1.f / 64.f)));
          o_.z = f2bf(sigmf(v4[2] * (1.f / 64.f))); o_.w = f2bf(sigmf(v4[3] * (1.f / 64.f)));
          *(ushort4*)(W_gates + (size_t)tok * 4096 + (col - 1984)) = o_;
        }
      });
    }
  }
}

__device__ __forceinline__ void rope_cs(float pos, int i, float inv_hp, float& cs, float& sn) {
  float freq = exp2f(-(float)i * inv_hp * 13.287712379549449f);
  float a = pos * freq;
  sn = __sinf(a);
  cs = __cosf(a);
}

__device__ __forceinline__ void phase_post(const P& p, int l) {
  int lane = tidx() & 63, w = tidx() >> 6;
  for (int it = blockIdx.x; it < 13312 / 4; it += gridDim.x) {
    int g = it * 4 + w;
    if (g < T_ALL) {
      const bool lat = g >= T_CTX;
      int b, s;
      if (!lat) { b = g >> 8; s = g & 255; } else { b = (g - T_CTX) >> 11; s = (g - T_CTX) & 2047; }
      const float* h = W_hbuf + (size_t)g * 1984;
      const float prow = (float)(s >> 6), pcol = (float)(s & 63);
      const float4 pl_q = *(const float4*)(h + lane * 4);
      const float2 pl_c = *(const float2*)(h + 256 + lane * 2);
      const float pl_kr1 = h[384 + ((lane >> 3) & 1) * 16 + (lane & 7)], pl_kr2 = h[384 + ((lane >> 3) & 1) * 16 + 8 + (lane & 7)];
      const float4 pl_f = *(const float4*)(h + 416 + lane * 4);
      float pl_sq1[2], pl_sq2[2];
#pragma unroll
      for (int jj = 0; jj < 2; jj++) {
        int pi = lane + 64 * jj, hq = pi >> 5, pp = (pi >> 4) & 1, i = pi & 15;
        pl_sq1[jj] = h[1472 + hq * 64 + pp * 32 + i]; pl_sq2[jj] = h[1472 + hq * 64 + pp * 32 + 16 + i];
      }
      const float pl_sk1 = h[1728 + (lane >> 5) * 64 + ((lane >> 4) & 1) * 32 + (lane & 15)];
      const float pl_sk2 = h[1728 + (lane >> 5) * 64 + ((lane >> 4) & 1) * 32 + 16 + (lane & 15)];
      const float2 pl_v = *(const float2*)(h + 1856 + lane * 2);
      {
        float4 t = pl_q;
        float ss = wsum(t.x * t.x + t.y * t.y + t.z * t.z + t.w * t.w);
        float rs = rsqrtf(ss * (1.f / 256.f) + 1e-6f);
        float4 gq = *(const float4*)(p.mla_q_norm + l * 256 + lane * 4);
        ushort4 o;
        o.x = f2bf(t.x * rs * gq.x); o.y = f2bf(t.y * rs * gq.y); o.z = f2bf(t.z * rs * gq.z); o.w = f2bf(t.w * rs * gq.w);
        *(ushort4*)(W_qn + (size_t)g * 256 + lane * 4) = o;
      }
      {
        float2 t = pl_c;
        float ss = wsum(t.x * t.x + t.y * t.y);
        float rs = rsqrtf(ss * (1.f / 128.f) + 1e-6f);
        float2 gk = *(const float2*)(p.mla_kv_norm + l * 128 + lane * 2);
        float v0 = t.x * rs * gk.x, v1 = t.y * rs * gk.y;
        ushort2 o; o.x = f2bf(v0); o.y = f2bf(v1);
        *(ushort2*)(W_ckv_all + (size_t)g * 128 + lane * 2) = o;
        if (!lat) *(float2*)(p.out + 12582912 + ((size_t)((b * 2 + l) * 256 + s)) * 128 + lane * 2) = float2{v0, v1};
      }
      if (lane < 16) {
        int pp = lane >> 3, i = lane & 7;
        float x1 = pl_kr1, x2 = pl_kr2;
        float o1 = x1, o2 = x2;
        if (lat) {
          float cs, sn;
          rope_cs(pp ? pcol : prow, i, 0.125f, cs, sn);
          o1 = x1 * cs - x2 * sn; o2 = x2 * cs + x1 * sn;
        } else {
          float* ok = p.out + 14680064 + ((size_t)((b * 2 + l) * 256 + s)) * 32 + pp * 16 + i;
          ok[0] = o1; ok[8] = o2;
        }
        bf16_t b1 = f2bf(o1), b2 = f2bf(o2);
        for (int hh = 0; hh < 4; hh++) {
          bf16_t* kd = lat ? W_Ka_lat + ((size_t)((b * 4 + hh) * 2560 + 512 + s)) * 96 : W_Ka_ctx + ((size_t)((b * 4 + hh) * 256 + s)) * 96;
          kd[64 + pp * 16 + i] = b1; kd[64 + pp * 16 + 8 + i] = b2;
        }
      }
      {
        float4 t = pl_f;
        ushort4 o; o.x = f2bf(t.x); o.y = f2bf(t.y); o.z = f2bf(t.z); o.w = f2bf(t.w);
        *(ushort4*)(W_fnet + (size_t)g * 256 + lane * 4) = o;
      }
#pragma unroll
      for (int jj = 0; jj < 2; jj++) {
        int pi = lane + 64 * jj, hq = pi >> 5, pp = (pi >> 4) & 1, i = pi & 15;
        float x1 = pl_sq1[jj], x2 = pl_sq2[jj];
        float o1 = x1, o2 = x2;
        if (lat) {
          float cs, sn;
          rope_cs(pp ? pcol : prow, i, 0.0625f, cs, sn);
          o1 = x1 * cs - x2 * sn; o2 = x2 * cs + x1 * sn;
        }
        bf16_t* qd = W_Qd + (size_t)g * 256 + hq * 64 + pp * 32 + i;
        qd[0] = f2bf(o1); qd[16] = f2bf(o2);
      }
      {
        int kv = lane >> 5, pp = (lane >> 4) & 1, i = lane & 15;
        float x1 = pl_sk1, x2 = pl_sk2;
        float o1 = x1, o2 = x2;
        bf16_t* kd;
        if (lat) {
          float cs, sn;
          rope_cs(pp ? pcol : prow, i, 0.0625f, cs, sn);
          o1 = x1 * cs - x2 * sn; o2 = x2 * cs + x1 * sn;
          kd = W_Kd_lat + ((size_t)((b * 2 + kv) * 2560 + 512 + s)) * 64;
        } else {
          float* ok = p.out + 15204352 + ((size_t)(((b * 2 + l) * 2 + kv) * 256 + s)) * 64 + pp * 32 + i;
          ok[0] = o1; ok[16] = o2;
          kd = W_Kd_ctx + ((size_t)((b * 2 + kv) * 256 + s)) * 64;
        }
        kd[pp * 32 + i] = f2bf(o1); kd[pp * 32 + 16 + i] = f2bf(o2);
      }
      {
        int e = lane * 2, kv = e >> 6, d = e & 63;
        float2 t = pl_v;
        if (lat) {
          bf16_t* vt = W_Vd_lat + (size_t)(b * 2 + kv) * 64 * 2560 + 512 + s;
          vt[(size_t)d * 2560] = f2bf(t.x); vt[(size_t)(d + 1) * 2560] = f2bf(t.y);
        } else {
          *(float2*)(p.out + 17301504 + ((size_t)(((b * 2 + l) * 2 + kv) * 256 + s)) * 64 + d) = t;
          bf16_t* vt = W_Vd_ctx + (size_t)(b * 2 + kv) * 64 * 256 + s;
          vt[d * 256] = f2bf(t.x); vt[(d + 1) * 256] = f2bf(t.y);
        }
      }
    } else {
      int gc = g - T_ALL, b = gc >> 9, pp = gc & 511;
      {
        float2 t = *(const float2*)(p.cache_ckv + ((size_t)((b * 2 + l) * 512 + pp)) * 128 + lane * 2);
        ushort2 o; o.x = f2bf(t.x); o.y = f2bf(t.y);
        *(ushort2*)(W_ckv_all + (size_t)g * 128 + lane * 2) = o;
      }
      if (lane < 32) {
        bf16_t v = f2bf(p.cache_krope[((size_t)((b * 2 + l) * 512 + pp)) * 32 + lane]);
        for (int hh = 0; hh < 4; hh++) W_Ka_lat[((size_t)((b * 4 + hh) * 2560 + pp)) * 96 + 64 + lane] = v;
      }
      {
        int e = lane * 2, kv = e >> 6, d = e & 63;
        size_t src = ((size_t)(((b * 2 + l) * 2 + kv) * 512 + pp)) * 64 + d;
        float2 tk = *(const float2*)(p.cache_swa_k + src);
        float2 tv = *(const float2*)(p.cache_swa_v + src);
        size_t dst = ((size_t)((b * 2 + kv) * 2560 + pp)) * 64 + d;
        ushort2 ok; ok.x = f2bf(tk.x); ok.y = f2bf(tk.y);
        *(ushort2*)(W_Kd_lat + dst) = ok;
        bf16_t* vt = W_Vd_lat + (size_t)(b * 2 + kv) * 64 * 2560 + pp;
        vt[(size_t)d * 2560] = f2bf(tv.x); vt[(size_t)(d + 1) * 2560] = f2bf(tv.y);
      }
    }
  }
}

__device__ __forceinline__ void phase_small_gemms(const P& p, int l, char* smem) {
  const int NA = 96 * 3, NB = 104 * 4, NC = 384;
  for (int it0 = blockIdx.x; it0 < NA + NB + NC; it0 += gridDim.x) {
    int it = it0;
    f32x4 acc[4][4];
    ZERO_ACC(acc);
    if (it < NA) {
      int mt = it / 3, nt = it % 3, m0 = mt * 128, n0 = nt * 128;
      gemm_core(acc, W_qn + (size_t)m0 * 256, 256, W_Wt_uq + (size_t)l * 384 * 256 + (size_t)n0 * 256, 256, 256, smem);
      const bool lat = m0 >= T_CTX;
      EPI_LOOP(acc, m0, n0, {
        int c96 = n % 96;
        if (lat && c96 >= 64) {
          float pv = DPP_F(v, v, 0x128, 0xf);
          int cr = c96 - 64, pp = cr >> 4, ii = cr & 15, i = ii & 7;
          int s = (m - T_CTX) & 2047;
          float cs, sn;
          rope_cs(pp ? (float)(s & 63) : (float)(s >> 6), i, 0.125f, cs, sn);
          v = (ii < 8) ? v * cs - pv * sn : v * cs + pv * sn;
        }
        W_Qa[(size_t)m * 384 + n] = f2bf(v);
      });
      continue;
    }
    it -= NA;
    if (it < NB) {
      int mt = it / 4, nt = it % 4, m0 = mt * 128, n0 = nt * 128;
      gemm_core(acc, W_ckv_all + (size_t)m0 * 128, 128, W_Wt_ukv + (size_t)l * 512 * 128 + (size_t)n0 * 128, 128, 128, smem);
      EPI_LOOP(acc, m0, n0, {
        int hh = n >> 7, c = n & 127;
        bf16_t* kd; bf16_t* vd; int vstride;
        if (m < T_CTX) {
          int b = m >> 8, s = m & 255;
          size_t r = (size_t)((b * 4 + hh) * 256 + s);
          kd = W_Ka_ctx + r * 96; vd = W_Va_ctx + (size_t)(b * 4 + hh) * 64 * 256 + s; vstride = 256;
        } else {
          int b, pos;
          if (m < T_ALL) { b = (m - T_CTX) >> 11; pos = 512 + ((m - T_CTX) & 2047); }
          else { b = (m - T_ALL) >> 9; pos = (m - T_ALL) & 511; }
          size_t r = (size_t)((b * 4 + hh) * 2560 + pos);
          kd = W_Ka_lat + r * 96; vd = W_Va_lat + (size_t)(b * 4 + hh) * 64 * 2560 + pos; vstride = 2560;
        }
        if (c < 64) kd[c] = f2bf(v); else vd[(size_t)(c - 64) * vstride] = f2bf(v);
      });
      continue;
    }
    it -= NB;
    {
      int m0 = it * 128;
      gemm_core(acc, W_fnet + (size_t)m0 * 64, 64, W_Cch, 64, 64, smem);
      EPI_LOOP(acc, m0, 0, {
        int g = m >> 2, grp = m & 3, part = n >> 6, j = n & 63;
        if (g < T_CTX) {
          int b = g >> 8, s = g & 255;
          W_Yt_ctx[((size_t)(b * 256 + grp * 64 + j)) * 512 + part * 256 + s] = f2bf(v);
        } else {
          int b = (g - T_CTX) >> 11, s = (g - T_CTX) & 2047;
          W_Yt_lat[((size_t)(b * 256 + grp * 64 + j)) * 4096 + part * 2048 + s] = f2bf(v);
        }
      });
    }
  }
}

template <int DK>
__device__ __forceinline__ void attn_item(const bf16_t* __restrict__ Qp, int qstride, const bf16_t* __restrict__ Kp,
                          const bf16_t* __restrict__ Vp, bf16_t* __restrict__ Op, int q0, int Sk, int n_ctx, int W,
                          float scale, bool has_sink, float sink, char* smem) {
  constexpr int KLD = DK + 8;
  bf16_t* sK = (bf16_t*)smem;
  bf16_t* sVt = sK + 64 * KLD;
  bf16_t* sP = sVt + 64 * 72;
  const int tid = tidx(), lane = tid & 63, w = tid >> 6, l15 = lane & 15, l4 = lane >> 4;
  bf16_t* sPw = sP + w * 16 * 72;
  bf16x8 qf[DK / 32];
  {
    const bf16_t* qrow = Qp + (size_t)(q0 + w * 16 + l15) * qstride;
#pragma unroll
    for (int ks = 0; ks < DK / 32; ks++) qf[ks] = *(const bf16x8*)(qrow + ks * 32 + l4 * 8);
  }
  f32x4 o[4];
#pragma unroll
  for (int j = 0; j < 4; j++) o[j] = f32x4{0.f, 0.f, 0.f, 0.f};
  float mrow[4], lrow[4];
#pragma unroll
  for (int r = 0; r < 4; r++) { mrow[r] = NEG_INF; lrow[r] = 0.f; }
  const int ntile = Sk >> 6;
  auto tile_ok = [&](int kt) -> bool {
    int kb = kt * 64;
    if (W >= 0 && kb >= n_ctx) { int lp = kb - n_ctx; if (lp + 63 < q0 - W || lp > q0 + 63 + W) return false; }
    return true;
  };
  u32x4 rk[DK / 32], rv[2];
  int kt = 0;
  while (kt < ntile && !tile_ok(kt)) kt++;
  if (kt < ntile) {
#pragma unroll
    for (int i = 0; i < DK / 32; i++) { int c = tid + i * 256, r = c / (DK / 8), cc = (c % (DK / 8)) * 8; rk[i] = *(const u32x4*)(Kp + (size_t)(kt * 64 + r) * DK + cc); }
#pragma unroll
    for (int i = 0; i < 2; i++) { int c = tid + i * 256, dv = c >> 3, k0 = (c & 7) * 8; rv[i] = *(const u32x4*)(Vp + (size_t)dv * Sk + kt * 64 + k0); }
  }
  while (kt < ntile) {
    const int kbase = kt * 64;
    __syncthreads();
#pragma unroll
    for (int i = 0; i < DK / 32; i++) { int c = tid + i * 256, r = c / (DK / 8), cc = (c % (DK / 8)) * 8; *(u32x4*)(sK + r * KLD + cc) = rk[i]; }
#pragma unroll
    for (int i = 0; i < 2; i++) {
      int c = tid + i * 256, dv = c >> 3, k0 = (c & 7) * 8;
      *(u32x4*)(sVt + dv * 72 + k0) = rv[i];
    }
    __syncthreads();
    int ktn = kt + 1;
    while (ktn < ntile && !tile_ok(ktn)) ktn++;
    if (ktn < ntile) {
#pragma unroll
      for (int i = 0; i < DK / 32; i++) { int c = tid + i * 256, r = c / (DK / 8), cc = (c % (DK / 8)) * 8; rk[i] = *(const u32x4*)(Kp + (size_t)(ktn * 64 + r) * DK + cc); }
#pragma unroll
      for (int i = 0; i < 2; i++) { int c = tid + i * 256, dv = c >> 3, k0 = (c & 7) * 8; rv[i] = *(const u32x4*)(Vp + (size_t)dv * Sk + ktn * 64 + k0); }
    }
    kt = ktn;
    f32x4 s[4];
#pragma unroll
    for (int j = 0; j < 4; j++) {
      s[j] = f32x4{0.f, 0.f, 0.f, 0.f};
#pragma unroll
      for (int ks = 0; ks < DK / 32; ks++) {
        bf16x8 kf = *(const bf16x8*)(sK + (j * 16 + l15) * KLD + ks * 32 + l4 * 8);
        s[j] = __builtin_amdgcn_mfma_f32_16x16x32_bf16(qf[ks], kf, s[j], 0, 0, 0);
      }
    }
#pragma unroll
    for (int j = 0; j < 4; j++)
#pragma unroll
      for (int r = 0; r < 4; r++) {
        float v = s[j][r] * scale;
        if (W >= 0) {
          int kk = kbase + j * 16 + l15, t = q0 + w * 16 + l4 * 4 + r;
          int dlt = kk - n_ctx - t;
          bool valid = (kk < n_ctx) || (dlt <= W && dlt >= -W);
          if (!valid) v = NEG_INF;
        }
        s[j][r] = v;
      }
#pragma unroll
    for (int r = 0; r < 4; r++) {
      float mx = fmaxf(fmaxf(s[0][r], s[1][r]), fmaxf(s[2][r], s[3][r]));
      mx = fmaxf(mx, DPP_F(mx, mx, 0xB1, 0xf));
      mx = fmaxf(mx, DPP_F(mx, mx, 0x4E, 0xf));
      mx = fmaxf(mx, DPP_F(mx, mx, 0x141, 0xf));
      mx = fmaxf(mx, DPP_F(mx, mx, 0x140, 0xf));
      float mnew = fmaxf(mrow[r], mx);
      float muse = (mnew == NEG_INF) ? 0.f : mnew;
      float alpha = __expf(mrow[r] - muse);
      float rs = 0.f;
#pragma unroll
      for (int j = 0; j < 4; j++) { float pe = __expf(s[j][r] - muse); s[j][r] = pe; rs += pe; }
      rs += DPP_F(rs, rs, 0xB1, 0xf);
      rs += DPP_F(rs, rs, 0x4E, 0xf);
      rs += DPP_F(rs, rs, 0x141, 0xf);
      rs += DPP_F(rs, rs, 0x140, 0xf);
      lrow[r] = lrow[r] * alpha + rs;
      mrow[r] = mnew;
#pragma unroll
      for (int j = 0; j < 4; j++) o[j][r] *= alpha;
    }
#pragma unroll
    for (int j = 0; j < 4; j++)
#pragma unroll
      for (int r = 0; r < 4; r++) sPw[(l4 * 4 + r) * 72 + j * 16 + l15] = f2bf(s[j][r]);
    __builtin_amdgcn_s_waitcnt(0xc07f);
    __builtin_amdgcn_wave_barrier();
#pragma unroll
    for (int ks = 0; ks < 2; ks++) {
      bf16x8 pf = *(const bf16x8*)(sPw + l15 * 72 + ks * 32 + l4 * 8);
#pragma unroll
      for (int jn = 0; jn < 4; jn++) {
        bf16x8 vf = *(const bf16x8*)(sVt + (jn * 16 + l15) * 72 + ks * 32 + l4 * 8);
        o[jn] = __builtin_amdgcn_mfma_f32_16x16x32_bf16(pf, vf, o[jn], 0, 0, 0);
      }
    }
  }
#pragma unroll
  for (int r = 0; r < 4; r++) {
    float lsum = lrow[r];
    if (has_sink) lsum += __expf(sink - mrow[r]);
    float inv = 1.f / lsum;
#pragma unroll
    for (int jn = 0; jn < 4; jn++)
      Op[(size_t)(q0 + w * 16 + l4 * 4 + r) * 1024 + jn * 16 + l15] = f2bf(o[jn][r] * inv);
  }
}

__device__ __forceinline__ int gla_tok(int tb, int c, int dir, int tau) { return tb + c * 64 + (dir ? 63 - tau : tau); }

#define GLA_W2_OFF 40960
__device__ __forceinline__ void gla_stage_w2(const P& p, int l, char* smem) {
  float* w2s = (float*)(smem + GLA_W2_OFF);
  const int tid = tidx();
  __syncthreads();
#pragma unroll
  for (int i = 0; i < 2; i++) {
    int e = (tid + i * 256) * 4;
    *(float4*)(w2s + e) = *(const float4*)(p.w_gla_a_fwd + l * 2048 + e);
    *(float4*)(w2s + 2048 + e) = *(const float4*)(p.w_gla_a_bwd + l * 2048 + e);
  }
  if (tid < 128) w2s[4096 + tid] = p.b_gla_a_fwd[l * 128 + tid];
  else w2s[4096 + tid] = p.b_gla_a_bwd[l * 128 + tid - 128];
  __syncthreads();
}
__device__ __forceinline__ void gla_load_alow(const P& p, int tok, int dir, float4 (&al)[4]) {
  const float* src = W_hbuf + (size_t)tok * 1984 + (dir ? 1456 : 1440);
#pragma unroll
  for (int q = 0; q < 4; q++) al[q] = *(const float4*)(src + q * 4);
}
__device__ __forceinline__ void gla_cum_regs(const char* smem, const float4 (&al)[4], int h, int dir, int w, int lane, float (&c)[8], float (&tot)[8]) {
  const float* w2 = (const float*)(smem + GLA_W2_OFF) + dir * 2048 + h * 32 + w * 8;
  const float* b2 = (const float*)(smem + GLA_W2_OFF) + 4096 + dir * 128 + h * 32 + w * 8;
  float a[16];
#pragma unroll
  for (int q = 0; q < 4; q++) { a[q * 4] = al[q].x; a[q * 4 + 1] = al[q].y; a[q * 4 + 2] = al[q].z; a[q * 4 + 3] = al[q].w; }
#pragma unroll
  for (int j = 0; j < 8; j++) {
    float z = b2[j];
#pragma unroll
    for (int r = 0; r < 16; r++) z += a[r] * w2[r * 128 + j];
    float la = logsigf(z) * (1.f / 16.f);
    float v = la;
#pragma unroll
    for (int d = 1; d < 64; d <<= 1) { float t_ = __shfl_up(v, d); if (lane >= d) v += t_; }
    float total = __shfl(v, 63);
    c[j] = dir ? (total - v + la) : v;
    tot[j] = total;
  }
}
__device__ __forceinline__ void gla_load_v(const P& p, int tok, int h, int w, float4 (&vr)[4]) {
  const float* src = W_hbuf + (size_t)tok * 1984 + 928 + h * 64 + w * 16;
#pragma unroll
  for (int q = 0; q < 4; q++) vr[q] = *(const float4*)(src + q * 4);
}
__device__ __forceinline__ void gla_store_vt(const float4 (&vr)[4], int w, int lane, bf16_t* sVt) {
#pragma unroll
  for (int q = 0; q < 4; q++) {
    sVt[(w * 16 + q * 4 + 0) * 72 + lane] = f2bf(vr[q].x);
    sVt[(w * 16 + q * 4 + 1) * 72 + lane] = f2bf(vr[q].y);
    sVt[(w * 16 + q * 4 + 2) * 72 + lane] = f2bf(vr[q].z);
    sVt[(w * 16 + q * 4 + 3) * 72 + lane] = f2bf(vr[q].w);
  }
}

__device__ __forceinline__ void chunk_info(int cidx, int& tb, int& nch, int& n, int& cbase) {
  if (cidx < 128) { int b = cidx >> 2; n = cidx & 3; nch = 4; tb = b * 256; cbase = b * 4; }
  else { int cl = cidx - 128, b = cl >> 5; n = cl & 31; nch = 32; tb = T_CTX + b * 2048; cbase = 128 + b * 32; }
}

__device__ __forceinline__ void gla_g1_item(const P& p, int l, int item, char* smem) {
  bf16_t* sKeT = (bf16_t*)smem;
  bf16_t* sVt = sKeT + 32 * 72;
  const int tid = tidx(), lane = tid & 63, w = __builtin_amdgcn_readfirstlane(tid >> 6), l15 = lane & 15, l4 = lane >> 4;
  int dir = item & 1, h = (item >> 1) & 3, cidx = item >> 3;
  int tb, nch, n, cbase;
  chunk_info(cidx, tb, nch, n, cbase);
  int c = dir ? nch - 1 - n : n;
  int tok = tb + c * 64 + lane;
  float4 al[4], vr[4];
  gla_load_alow(p, tok, dir, al);
  const float* kr = W_hbuf + (size_t)tok * 1984 + 800 + h * 32 + w * 8;
  float4 k0 = *(const float4*)kr, k1 = *(const float4*)(kr + 4);
  gla_load_v(p, tok, h, w, vr);
  float cs[8], tot[8];
  gla_cum_regs(smem, al, h, dir, w, lane, cs, tot);
  __syncthreads();
  {
    float kk[8] = {k0.x, k0.y, k0.z, k0.w, k1.x, k1.y, k1.z, k1.w};
#pragma unroll
    for (int j = 0; j < 8; j++) sKeT[(w * 8 + j) * 72 + lane] = f2bf(kk[j] * __expf(tot[j] - cs[j]));
  }
  gla_store_vt(vr, w, lane, sVt);
  __syncthreads();
  f32x4 acc[2] = {f32x4{0.f, 0.f, 0.f, 0.f}, f32x4{0.f, 0.f, 0.f, 0.f}};
#pragma unroll
  for (int ks = 0; ks < 2; ks++) {
    bf16x8 bv = *(const bf16x8*)(sVt + (w * 16 + l15) * 72 + ks * 32 + l4 * 8);
#pragma unroll
    for (int mt = 0; mt < 2; mt++) {
      bf16x8 av = *(const bf16x8*)(sKeT + (mt * 16 + l15) * 72 + ks * 32 + l4 * 8);
      acc[mt] = __builtin_amdgcn_mfma_f32_16x16x32_bf16(av, bv, acc[mt], 0, 0, 0);
    }
  }
  float* dst = W_un + (size_t)item * 2048;
#pragma unroll
  for (int mt = 0; mt < 2; mt++)
#pragma unroll
    for (int r = 0; r < 4; r++) dst[(mt * 16 + l4 * 4 + r) * 64 + w * 16 + l15] = acc[mt][r];
  if (lane == 0) {
#pragma unroll
    for (int j = 0; j < 8; j++) W_gn[item * 32 + w * 8 + j] = __expf(tot[j]);
  }
}

__device__ __forceinline__ void phase_gla_scan(const P& p, int l) {
  for (int it = blockIdx.x; it < 2176; it += gridDim.x) {
    int e = it * 256 + tidx();
    int kv = e & 2047, sd = e >> 11, dir = sd & 1, h = (sd >> 1) & 3, seq = ((sd >> 3) + 32) % 34;
    int nch, cbase;
    float s;
    if (seq < 32) { nch = 4; cbase = seq * 4; s = 0.f; }
    else { int b = seq - 32; nch = 32; cbase = 128 + b * 32; s = p.state_gla[((size_t)(((b * 2 + l) * 2 + dir) * 4 + h)) * 2048 + kv]; }
    for (int n0 = 0; n0 < nch; n0 += 4) {
      float gv[4], uv[4];
#pragma unroll
      for (int k = 0; k < 4; k++) {
        int item = ((cbase + n0 + k) * 4 + h) * 2 + dir;
        gv[k] = W_gn[item * 32 + (kv >> 6)];
        uv[k] = W_un[(size_t)item * 2048 + kv];
      }
#pragma unroll
      for (int k = 0; k < 4; k++) {
        int item = ((cbase + n0 + k) * 4 + h) * 2 + dir;
        W_sin_[(size_t)item * 2048 + kv] = s;
        s = gv[k] * s + uv[k];
      }
    }
    if (seq < 32) p.out[19398656 + ((size_t)(((seq * 2 + l) * 2 + dir) * 4 + h)) * 2048 + kv] = s;
  }
}

__device__ __forceinline__ void phase_gla_out(const P& p, int l, char* smem) {
  bf16_t* sQe = (bf16_t*)smem;
  bf16_t* sKe = sQe + 64 * 40;
  bf16_t* sSt = sKe + 64 * 40;
  bf16_t* sVt = sSt + 64 * 40;
  bf16_t* sAtt = sVt + 64 * 72;
  const int tid = tidx(), lane = tid & 63, w = __builtin_amdgcn_readfirstlane(tid >> 6), l15 = lane & 15, l4 = lane >> 4;
  gla_stage_w2(p, l, smem);
  for (int it = blockIdx.x; it < 768; it += gridDim.x) {
    int h = it & 3, cidx = it >> 2;
    int tb, nch, c, cbase;
    chunk_info(cidx, tb, nch, c, cbase);
    const int tok = tb + c * 64 + lane;
    f32x4 o[4];
#pragma unroll
    for (int j = 0; j < 4; j++) o[j] = f32x4{0.f, 0.f, 0.f, 0.f};
    float4 vr[4], alf[4], alb[4];
    gla_load_v(p, tok, h, w, vr);
    gla_load_alow(p, tok, 0, alf);
    gla_load_alow(p, tok, 1, alb);
    const float* qr = W_hbuf + (size_t)tok * 1984 + 672 + h * 32 + w * 8;
    const float* kr = qr + 128;
    const float4 q0 = *(const float4*)qr, q1 = *(const float4*)(qr + 4), k0 = *(const float4*)kr, k1 = *(const float4*)(kr + 4);
    float sinv[2][8];
#pragma unroll
    for (int dir = 0; dir < 2; dir++) {
      int n = dir ? nch - 1 - c : c;
      int item = ((cbase + n) * 4 + h) * 2 + dir;
      const float* sin = W_sin_ + (size_t)item * 2048 + (w * 8) * 64 + lane;
#pragma unroll
      for (int j = 0; j < 8; j++) sinv[dir][j] = sin[j * 64];
    }
    float gpre[4][4];
#pragma unroll
    for (int r = 0; r < 4; r++)
#pragma unroll
      for (int jn = 0; jn < 4; jn++) gpre[r][jn] = W_hbuf[(size_t)(tb + c * 64 + w * 16 + l4 * 4 + r) * 1984 + 1184 + h * 64 + jn * 16 + l15];
    __syncthreads();
    gla_store_vt(vr, w, lane, sVt);
#pragma unroll
    for (int dir = 0; dir < 2; dir++) {
      float cs[8], tot[8];
      gla_cum_regs(smem, dir ? alb : alf, h, dir, w, lane, cs, tot);
      if (dir) __syncthreads();
      {
        float qq[8] = {q0.x, q0.y, q0.z, q0.w, q1.x, q1.y, q1.z, q1.w};
        float kk[8] = {k0.x, k0.y, k0.z, k0.w, k1.x, k1.y, k1.z, k1.w};
        bf16x8 qv, kv, sv;
#pragma unroll
        for (int j = 0; j < 8; j++) {
          float cm = __shfl(cs[j], 32);
          qv[j] = (short)f2bf(qq[j] * 0.17677669529663687f * __expf(cs[j] - cm));
          kv[j] = (short)f2bf(kk[j] * __expf(cm - cs[j]));
          sv[j] = (short)f2bf(sinv[dir][j] * __expf(cm));
        }
        *(bf16x8*)(sQe + lane * 40 + w * 8) = qv;
        *(bf16x8*)(sKe + lane * 40 + w * 8) = kv;
        *(bf16x8*)(sSt + lane * 40 + w * 8) = sv;
      }
      __syncthreads();
      bf16x8 qa = *(const bf16x8*)(sQe + (w * 16 + l15) * 40 + l4 * 8);
#pragma unroll
      for (int jc = 0; jc < 4; jc++) {
        bf16x8 kb = *(const bf16x8*)(sKe + (jc * 16 + l15) * 40 + l4 * 8);
        f32x4 sacc = __builtin_amdgcn_mfma_f32_16x16x32_bf16(qa, kb, f32x4{0.f, 0.f, 0.f, 0.f}, 0, 0, 0);
#pragma unroll
        for (int r = 0; r < 4; r++) {
          int trow = w * 16 + l4 * 4 + r, scol = jc * 16 + l15;
          bool keep = dir ? (scol >= trow) : (scol <= trow);
          sAtt[trow * 72 + scol] = f2bf(keep ? sacc[r] : 0.f);
        }
      }
      __syncthreads();
#pragma unroll
      for (int ks = 0; ks < 2; ks++) {
        bf16x8 aa = *(const bf16x8*)(sAtt + (w * 16 + l15) * 72 + ks * 32 + l4 * 8);
#pragma unroll
        for (int jn = 0; jn < 4; jn++) {
          bf16x8 vb = *(const bf16x8*)(sVt + (jn * 16 + l15) * 72 + ks * 32 + l4 * 8);
          o[jn] = __builtin_amdgcn_mfma_f32_16x16x32_bf16(aa, vb, o[jn], 0, 0, 0);
        }
      }
#pragma unroll
      for (int jn = 0; jn < 4; jn++) {
        bf16x8 sb = *(const bf16x8*)(sSt + (jn * 16 + l15) * 40 + l4 * 8);
        o[jn] = __builtin_amdgcn_mfma_f32_16x16x32_bf16(qa, sb, o[jn], 0, 0, 0);
      }
    }
#pragma unroll
    for (int r = 0; r < 4; r++) {
      float ss = o[0][r] * o[0][r] + o[1][r] * o[1][r] + o[2][r] * o[2][r] + o[3][r] * o[3][r];
      ss += DPP_F(ss, ss, 0xB1, 0xf);
      ss += DPP_F(ss, ss, 0x4E, 0xf);
      ss += DPP_F(ss, ss, 0x141, 0xf);
      ss += DPP_F(ss, ss, 0x140, 0xf);
      float rs = rsqrtf(ss * (1.f / 64.f) + 1e-6f);
      int tk = tb + c * 64 + w * 16 + l4 * 4 + r;
      const float* grow = W_hbuf + (size_t)tk * 1984 + 1184 + h * 64;
      bf16_t* dst = W_br + (size_t)tk * 1024 + 512 + h * 64;
#pragma unroll
      for (int jn = 0; jn < 4; jn++) {
        int vcol = jn * 16 + l15;
        float val = o[jn][r] * rs * p.gla_norm[l * 64 + vcol];
        dst[vcol] = f2bf(val * siluf(gpre[r][jn]));
      }
    }
  }
}

__device__ __forceinline__ void phase_mixers(const P& p, int l, char* smem) {
  const int N_MLAL = 256, N_DFTL = 64, N_SWAL = 256, N_MLAC = 512, N_SWAC = 512, N_DFTC = 128, N_G1 = 1536;
  const int total = N_MLAL + N_DFTL + N_SWAL + N_MLAC + N_SWAC + N_DFTC + N_G1;
  gla_stage_w2(p, l, smem);
  for (int r_ = 0; r_ * (int)gridDim.x < total; r_++) {
    int it0 = r_ * gridDim.x + ((r_ & 1) ? (gridDim.x - 1 - blockIdx.x) : blockIdx.x);
    if (it0 >= total) continue;
    int it = it0;
    int type;
    bool lat = false;
    if (it < N_MLAL) { type = 0; lat = true; }
    else if ((it -= N_MLAL) < N_DFTL) { type = 2; lat = true; }
    else if ((it -= N_DFTL) < N_SWAL) { type = 1; lat = true; }
    else if ((it -= N_SWAL) < N_MLAC) { type = 0; }
    else if ((it -= N_MLAC) < N_SWAC) { type = 1; }
    else if ((it -= N_SWAC) < N_DFTC) { type = 2; }
    else { it -= N_DFTC; type = 3; }
#ifdef DUPTYPE
    for (int rep_ = 0; rep_ < ((type == (DUPTYPE & 3) && (int)lat == (DUPTYPE >> 2)) ? 2 : 1); rep_++)
#endif
    if (type == 0) {
      int qt, h, b, Sk;
      size_t tok0;
      if (lat) { qt = it & 31; h = (it >> 5) & 3; b = it >> 7; tok0 = T_CTX + b * 2048; Sk = 2560; }
      else { qt = it & 3; h = (it >> 2) & 3; b = it >> 4; tok0 = b * 256; Sk = 256; }
      const bf16_t* Kp = (lat ? W_Ka_lat : W_Ka_ctx) + (size_t)(b * 4 + h) * Sk * 96;
      const bf16_t* Vp = (lat ? W_Va_lat : W_Va_ctx) + (size_t)(b * 4 + h) * Sk * 64;
      attn_item<96>(W_Qa + tok0 * 384 + h * 96, 384, Kp, Vp, W_br + tok0 * 1024 + h * 64, qt * 64, Sk, 0, -1,
                    0.10206207261596575f, false, 0.f, smem);
    } else if (type == 1) {
      int qt, hq, b, Sk, nctx, W;
      size_t tok0;
      if (lat) { qt = it & 31; hq = (it >> 5) & 3; b = it >> 7; tok0 = T_CTX + b * 2048; Sk = 2560; nctx = 512; W = 128; }
      else { qt = it & 3; hq = (it >> 2) & 3; b = it >> 4; tok0 = b * 256; Sk = 256; nctx = 0; W = -1; }
      int kv = hq >> 1;
      const bf16_t* Kp = (lat ? W_Kd_lat : W_Kd_ctx) + (size_t)(b * 2 + kv) * Sk * 64;
      const bf16_t* Vp = (lat ? W_Vd_lat : W_Vd_ctx) + (size_t)(b * 2 + kv) * Sk * 64;
      attn_item<64>(W_Qd + tok0 * 256 + hq * 64, 256, Kp, Vp, W_br + tok0 * 1024 + 768 + hq * 64, qt * 64, Sk, nctx, W,
                    0.125f, true, p.swa_sink[l * 4 + hq], smem);
    } else if (type == 2) {
      int nt = it & 1, mt, b, S;
      size_t tok0;
      if (lat) { mt = (it >> 1) & 15; b = it >> 5; S = 2048; tok0 = T_CTX + b * 2048; }
      else { mt = (it >> 1) & 1; b = it >> 2; S = 256; tok0 = b * 256; }
      const bf16_t* Ap = (lat ? W_A2048 : W_A256) + (size_t)mt * 128 * 2 * S;
      const bf16_t* Bp = (lat ? W_Yt_lat : W_Yt_ctx) + (size_t)(b * 256 + nt * 128) * 2 * S;
      f32x4 acc[4][4];
      ZERO_ACC(acc);
      gemm_core(acc, Ap, 2 * S, Bp, 2 * S, 2 * S, smem);
      EPI_LOOP(acc, mt * 128, nt * 128, { W_br[(tok0 + m) * 1024 + 256 + n] = f2bf(v); });
    } else {
      gla_g1_item(p, l, it, smem);
    }
  }
}

#define EPI4_LOOP_N(acc, c0, t0, NJ, ...)                                                  \
  {                                                                                        \
    const int lane_ = tidx() & 63, w_ = tidx() >> 6, wm_ = w_ >> 1, wn_ = w_ & 1;           \
    _Pragma("unroll") for (int i_ = 0; i_ < 4; i_++)                                       \
    _Pragma("unroll") for (int j_ = 0; j_ < NJ; j_++) {                                    \
      const int col = (c0) + wm_ * 64 + i_ * 16 + (lane_ >> 4) * 4;                        \
      const int tok = (t0) + wn_ * (NJ * 16) + j_ * 16 + (lane_ & 15);                     \
      const f32x4 v4 = acc[i_][j_];                                                        \
      __VA_ARGS__                                                                          \
    }                                                                                      \
  }
__device__ __forceinline__ void phase_merge(const P& p, int l, char* smem) {
  constexpr int NJ = 2;
  bf16_t* sa = (bf16_t*)smem;
  bf16_t* sb = sa + 128 * GB_LD;
  const int tid = tidx(), lane = tid & 63, w = tid >> 6, wm = w >> 1, wn = w & 1;
  const int l15 = lane & 15, l4 = lane >> 4;
  for (int tile = blockIdx.x; tile < 192 * 8; tile += gridDim.x) {
    int tt = tile >> 3, nt = tile & 7, t0 = tt * 64, n0 = nt * 128;
    const bf16_t* A = W_Wt_br + ((size_t)l * 1024 + n0) * 1024;
    const bf16_t* B = W_br + (size_t)t0 * 1024;
    const int lda = 1024, ldb = 1024, K = 1024;
    f32x4 tot[4][2], acc[4][2];
    ZERO_ACC_N(tot, 2);
    ZERO_ACC_N(acc, 2);
    u32x4 ra0[4], rb0[NJ], ra1[4], rb1[NJ];
    G_LOAD(ra0, rb0, 0);
    G_LOAD(ra1, rb1, 64);
    ushort4 gl[4][2];
    for (int k0 = 0; k0 < K; k0 += 128) {
      const bool seg_end = (k0 & 128) != 0;
      const int bidx = k0 >> 8;
      if (seg_end) {
#pragma unroll
        for (int i_ = 0; i_ < 4; i_++)
#pragma unroll
          for (int j_ = 0; j_ < 2; j_++) {
            int col = n0 + wm * 64 + i_ * 16 + l4 * 4, tok = t0 + wn * 32 + j_ * 16 + l15;
            gl[i_][j_] = *(const ushort4*)(W_gates + (size_t)tok * 4096 + bidx * 1024 + col);
          }
      }
      __syncthreads();
      G_STORE(ra0, rb0);
      __syncthreads();
      if (k0 + 128 < K) { G_LOAD(ra0, rb0, k0 + 128); }
      G_COMPUTE();
      __syncthreads();
      G_STORE(ra1, rb1);
      __syncthreads();
      if (k0 + 192 < K) { G_LOAD(ra1, rb1, k0 + 192); }
      G_COMPUTE();
      if (seg_end) {
#pragma unroll
        for (int i_ = 0; i_ < 4; i_++)
#pragma unroll
          for (int j_ = 0; j_ < 2; j_++) {
            tot[i_][j_][0] += bf2f(gl[i_][j_].x) * acc[i_][j_][0];
            tot[i_][j_][1] += bf2f(gl[i_][j_].y) * acc[i_][j_][1];
            tot[i_][j_][2] += bf2f(gl[i_][j_].z) * acc[i_][j_][2];
            tot[i_][j_][3] += bf2f(gl[i_][j_].w) * acc[i_][j_][3];
            acc[i_][j_] = f32x4{0.f, 0.f, 0.f, 0.f};
          }
      }
    }
    EPI4_LOOP_N(tot, n0, t0, 2, {
      ushort4 o_; o_.x = f2bf(v4[0]); o_.y = f2bf(v4[1]); o_.z = f2bf(v4[2]); o_.w = f2bf(v4[3]);
      *(ushort4*)(W_u + (size_t)tok * 1024 + col) = o_;
    });
  }
}

__device__ __forceinline__ void phase_wout(const P& p, int l, char* smem) {
  float* r = W_hbuf;
  const float alpha = 1.4142135623730951f;
  for (int tile = blockIdx.x; tile < 96 * 8; tile += gridDim.x) {
    int mt = tile >> 3, nt = tile & 7, m0 = mt * 128, n0 = nt * 128;
    f32x4 acc[4][4];
    ZERO_ACC(acc);
    gemm_core(acc, W_Wt_out + ((size_t)l * 1024 + n0) * 1024, 1024, W_u + (size_t)m0 * 1024, 1024, 1024, smem);
    const float* g1 = W_mada + (l * 3 + cond_row(m0)) * 6144 + 2048;
    {
      const int lane_ = tidx() & 63, w_ = tidx() >> 6, wm_ = w_ >> 1, wn_ = w_ & 1;
#pragma unroll
      for (int ih = 0; ih < 2; ih++) {
        float4 xv[8];
#pragma unroll
        for (int q = 0; q < 8; q++) {
          int i_ = ih * 2 + (q >> 2), j_ = q & 3;
          int col = n0 + wm_ * 64 + i_ * 16 + (lane_ >> 4) * 4, tok = m0 + wn_ * 64 + j_ * 16 + (lane_ & 15);
          xv[q] = *(const float4*)(x_in_row(p, l, tok) + col);
        }
#pragma unroll
        for (int q = 0; q < 8; q++) {
          int i_ = ih * 2 + (q >> 2), j_ = q & 3;
          int col = n0 + wm_ * 64 + i_ * 16 + (lane_ >> 4) * 4, tok = m0 + wn_ * 64 + j_ * 16 + (lane_ & 15);
          float4 gv = *(const float4*)(g1 + col);
          f32x4 v4 = acc[i_][j_];
          *(float4*)(r + (size_t)tok * 1024 + col) = float4{alpha * xv[q].x + gv.x * v4[0], alpha * xv[q].y + gv.y * v4[1], alpha * xv[q].z + gv.z * v4[2], alpha * xv[q].w + gv.w * v4[3]};
        }
      }
    }
  }
}

__device__ __forceinline__ void phase_ln_mid(const P& p, int l) {
  int lane = tidx() & 63, w = tidx() >> 6;
  const float* r = W_hbuf;
  for (int it = blockIdx.x; it < T_ALL / 4; it += gridDim.x) {
    int g = it * 4 + w;
    float v[16];
    load_row16(r + (size_t)g * 1024, lane, v);
    ln16(v);
    affine16(v, p.ln1_g + l * 1024, p.ln1_b + l * 1024, lane);
    store_row16(x_out_row(p, l, g), lane, v);
    ln16(v);
    const float* m = W_mada + (l * 3 + cond_row(g)) * 6144;
    modulate_store(v, m + 3072, m + 4096, W_u + (size_t)g * 1024, lane);
  }
}

__device__ __forceinline__ void phase_pq(const P& p, int l, char* smem) {
  bf16_t* sc = W_gates;
  bf16_t* sa = (bf16_t*)smem;
  const int tid = tidx(), lane = tid & 63, w = tid >> 6, wm = w >> 1, wn = w & 1, l15 = lane & 15, l4 = lane >> 4;
  for (int tile = blockIdx.x; tile < 96 * 16; tile += gridDim.x) {
    int mt = tile >> 4, hp = tile & 15, m0 = mt * 128, n0 = hp * 128;
    f32x4 acc[4][4];
    ZERO_ACC(acc);
    gemm_core(acc, W_Wt_pq + ((size_t)l * 2048 + n0) * 1024, 1024, W_u + (size_t)m0 * 1024, 1024, 1024, smem);
    __syncthreads();
    {
      bf16_t* sB = sa + 128 * GB_LD * (1 + wm);
#pragma unroll
      for (int i = 0; i < 4; i++)
#pragma unroll
        for (int j = 0; j < 4; j++) {
          ushort4 o_;
          o_.x = f2bf(acc[i][j][0]); o_.y = f2bf(acc[i][j][1]); o_.z = f2bf(acc[i][j][2]); o_.w = f2bf(acc[i][j][3]);
          *(ushort4*)(sB + (wn * 64 + j * 16 + l15) * GB_LD + i * 16 + l4 * 4) = o_;
        }
    }
    f32x4 acc2[4][4];
    ZERO_ACC(acc2);
    const bf16_t* keys = W_keysbf + (size_t)(l * 16 + hp) * 128 * 128;
#pragma unroll
    for (int kh = 0; kh < 2; kh++) {
      u32x4 rk[4];
#pragma unroll
      for (int i = 0; i < 4; i++) { int c = tid + i * 256, r = c >> 3, cc = (c & 7) * 8; rk[i] = *(const u32x4*)(keys + r * 128 + kh * 64 + cc); }
      if (kh) __syncthreads();
#pragma unroll
      for (int i = 0; i < 4; i++) { int c = tid + i * 256, r = c >> 3, cc = (c & 7) * 8; *(u32x4*)(sa + r * GB_LD + cc) = rk[i]; }
      __syncthreads();
      const bf16_t* sBk = sa + 128 * GB_LD * (1 + kh);
#pragma unroll
      for (int ks = 0; ks < 2; ks++) {
        bf16x8 af[4], bfr[4];
#pragma unroll
        for (int i = 0; i < 4; i++) af[i] = *(const bf16x8*)(sa + (wm * 64 + i * 16 + l15) * GB_LD + ks * 32 + l4 * 8);
#pragma unroll
        for (int j = 0; j < 4; j++) bfr[j] = *(const bf16x8*)(sBk + (wn * 64 + j * 16 + l15) * GB_LD + ks * 32 + l4 * 8);
#pragma unroll
        for (int i = 0; i < 4; i++)
#pragma unroll
          for (int j = 0; j < 4; j++) acc2[i][j] = __builtin_amdgcn_mfma_f32_16x16x32_bf16(af[i], bfr[j], acc2[i][j], 0, 0, 0);
      }
    }
    EPI_LOOP(acc2, 0, m0, { sc[((size_t)(hp * 128 + m)) * T_ALL + n] = f2bf(v); });
  }
}

__device__ __forceinline__ void phase_scores(const P& p, int l, char* smem) {}

__device__ __forceinline__ int f2sort(float x) { int b = __float_as_int(x); return b ^ ((b >> 31) & 0x7fffffff); }
__device__ __forceinline__ float sort2f(int s) { return __int_as_float(s ^ ((s >> 31) & 0x7fffffff)); }
__device__ __forceinline__ void bitonic_sort16_desc(int (&a)[16]) {
#pragma unroll
  for (int k = 2; k <= 16; k <<= 1)
#pragma unroll
    for (int j = k >> 1; j > 0; j >>= 1)
#pragma unroll
      for (int i = 0; i < 16; i++) {
        int l_ = i ^ j;
        if (l_ > i) {
          int hi = max(a[i], a[l_]), lo = min(a[i], a[l_]);
          if ((i & k) == 0) { a[i] = hi; a[l_] = lo; } else { a[i] = lo; a[l_] = hi; }
        }
      }
}
__device__ __forceinline__ void merge_top16(int (&T)[16], const int (&S)[16]) {
#pragma unroll
  for (int i = 0; i < 16; i++) T[i] = max(T[i], S[15 - i]);
#pragma unroll
  for (int j = 8; j > 0; j >>= 1)
#pragma unroll
    for (int i = 0; i < 16; i++) {
      int l_ = i ^ j;
      if (l_ > i) { int hi = max(T[i], T[l_]), lo = min(T[i], T[l_]); T[i] = hi; T[l_] = lo; }
    }
}
__device__ __forceinline__ void top16_col(const bf16_t* src, int (&L)[16]) {
#pragma unroll 1
  for (int k0 = 0; k0 < 128; k0 += 16) {
    float xv[16];
#pragma unroll
    for (int k = 0; k < 16; k++) xv[k] = bf2f(src[(size_t)(k0 + k) * T_ALL]);
    int S[16];
#pragma unroll
    for (int k = 0; k < 16; k++) S[k] = (f2sort(xv[k]) & ~127) | (127 - (k0 + k));
    bitonic_sort16_desc(S);
    if (k0 == 0) {
#pragma unroll
      for (int k = 0; k < 16; k++) L[k] = S[k];
    } else {
      merge_top16(L, S);
    }
  }
}
__device__ __forceinline__ void phase_topk(const P& p, int l) {
  const bf16_t* sc = W_gates;
  int lane = tidx() & 63, w = tidx() >> 6;
  for (int it = blockIdx.x * 4 + w; it < 192 * 8; it += gridDim.x * 4) {
    int h = it & 7, t = (it >> 3) * 64 + lane;
    int L1[16], L2[16];
    const bf16_t* s1 = sc + (size_t)(h * 2) * 128 * T_ALL + t;
    top16_col(s1, L1);
    top16_col(s1 + (size_t)128 * T_ALL, L2);
    float v1[16], v2[16];
    unsigned P1[4] = {0u, 0u, 0u, 0u}, P2[4] = {0u, 0u, 0u, 0u};
#pragma unroll
    for (int i = 0; i < 16; i++) {
      v1[i] = sort2f(L1[i] & ~127);
      v2[i] = sort2f(L2[i] & ~127);
      P1[i >> 2] |= (unsigned)(127 - (L1[i] & 127)) << ((i & 3) * 8);
      P2[i >> 2] |= (unsigned)(127 - (L2[i] & 127)) << ((i & 3) * 8);
    }
    int Tk[16];
#pragma unroll
    for (int j = 0; j < 16; j++) Tk[j] = (f2sort(v1[0] + v2[j]) & ~255) | (255 - j);
    {
      int G[3][16];
#pragma unroll
      for (int g_ = 0; g_ < 3; g_++)
#pragma unroll
        for (int k = 0; k < 16; k++) G[g_][k] = (int)0x80000000;
      int cnt = 0;
#pragma unroll
      for (int i = 1; i < 16; i++) {
#pragma unroll
        for (int j = 0; j < 16 / (i + 1); j++) {
          G[cnt >> 4][cnt & 15] = (f2sort(v1[i] + v2[j]) & ~255) | (255 - (i * 16 + j));
          cnt++;
        }
      }
#pragma unroll
      for (int g_ = 0; g_ < 3; g_++) { bitonic_sort16_desc(G[g_]); merge_top16(Tk, G[g_]); }
    }
    float v0 = sort2f(Tk[0] & ~255);
    float e[16], Z = 0.f;
    int oi[16];
#pragma unroll
    for (int s_ = 0; s_ < 16; s_++) {
      e[s_] = __expf(sort2f(Tk[s_] & ~255) - v0);
      Z += e[s_];
      int code = 255 - (Tk[s_] & 255), i = code >> 4, j = code & 15;
      unsigned r1 = (i >> 2) == 0 ? P1[0] : (i >> 2) == 1 ? P1[1] : (i >> 2) == 2 ? P1[2] : P1[3];
      unsigned r2 = (j >> 2) == 0 ? P2[0] : (j >> 2) == 1 ? P2[1] : (j >> 2) == 2 ? P2[2] : P2[3];
      int i1 = (r1 >> ((i & 3) * 8)) & 255, i2 = (r2 >> ((j & 3) * 8)) & 255;
      oi[s_] = i1 * 128 + i2;
    }
    float inv = 1.f / Z;
    int* po = W_pidx + (size_t)t * 128 + h * 16;
    float* pwo = W_pw + (size_t)t * 128 + h * 16;
#pragma unroll
    for (int q = 0; q < 4; q++) {
      *(int4*)(po + q * 4) = int4{oi[q * 4], oi[q * 4 + 1], oi[q * 4 + 2], oi[q * 4 + 3]};
      *(float4*)(pwo + q * 4) = float4{e[q * 4] * inv, e[q * 4 + 1] * inv, e[q * 4 + 2] * inv, e[q * 4 + 3] * inv};
    }
  }
}

__device__ __forceinline__ void unpack16(u32x4 r, float (&f)[16]) {
#pragma unroll
  for (int q = 0; q < 4; q++) {
    auto lo = __builtin_amdgcn_cvt_pk_f32_fp8((int)r[q], false);
    auto hi = __builtin_amdgcn_cvt_pk_f32_fp8((int)r[q], true);
    f[q * 4 + 0] = lo[0]; f[q * 4 + 1] = lo[1]; f[q * 4 + 2] = hi[0]; f[q * 4 + 3] = hi[1];
  }
}
#define PEER_PF 8
#ifndef PEER_REP
#define PEER_REP 1
#endif
__device__ __forceinline__ void phase_peer(const P& p, int l, char* smem) {
  int lane = tidx() & 63, w = tidx() >> 6;
  float* scoef_w = (float*)smem + w * (8 * 128);
  const unsigned char* tu = W_tabU + (size_t)l * 16384 * 1024 + lane * 16;
  const unsigned char* tv = W_tabV + (size_t)l * 16384 * 1024 + lane * 16;
  const int nb = gridDim.x;
  const int ntok = (T_ALL / 4 - (int)blockIdx.x + nb - 1) / nb;
  for (int c0 = 0; c0 < ntok; c0 += 8) {
    const int nc = (ntok - c0) < 8 ? (ntok - c0) : 8;
    __builtin_amdgcn_wave_barrier();
    for (int t = 0; t < nc; t++) {
      const int g = ((int)blockIdx.x + (c0 + t) * nb) * 4 + w;
      float* scoef = scoef_w + t * 128;
      float uu[16];
      {
        u32x4 r0 = *(const u32x4*)(W_u + (size_t)g * 1024 + lane * 16);
        u32x4 r1 = *(const u32x4*)(W_u + (size_t)g * 1024 + lane * 16 + 8);
#pragma unroll
        for (int q = 0; q < 4; q++) {
          uu[q * 2] = __uint_as_float(r0[q] << 16); uu[q * 2 + 1] = __uint_as_float(r0[q] & 0xffff0000u);
          uu[8 + q * 2] = __uint_as_float(r1[q] << 16); uu[8 + q * 2 + 1] = __uint_as_float(r1[q] & 0xffff0000u);
        }
      }
      const float* pwt = W_pw + (size_t)g * 128;
      const int pi0 = W_pidx[(size_t)g * 128 + lane], pi1 = W_pidx[(size_t)g * 128 + 64 + lane];
      auto ldrows = [&](u32x4 (&r)[8], const unsigned char* tab, int e0) {
#pragma unroll
        for (int k = 0; k < 8; k++) {
          int e = e0 + k;
          int idx = __builtin_amdgcn_readlane(e < 64 ? pi0 : pi1, e & 63);
          r[k] = *(const u32x4*)(tab + (size_t)idx * 1024);
        }
      };
      float dv0 = 0.f, dv1 = 0.f;
      auto dots = [&](const u32x4 (&r)[8], int e0) {
#pragma unroll
        for (int k = 0; k < 8; k++) {
          float f[16];
          unpack16(r[k], f);
          float a = 0.f;
#pragma unroll
          for (int j = 0; j < 16; j++) a += uu[j] * f[j];
          float dd = wsum(a);
          if (e0 < 64) dv0 = (lane == e0 + k) ? dd : dv0;
          else dv1 = (lane == e0 + k - 64) ? dd : dv1;
        }
      };
      {
        u32x4 ra[8], rb[8];
        ldrows(ra, tu, 0);
#pragma unroll 1
        for (int e0 = 0; e0 < 128; e0 += 16) {
          ldrows(rb, tu, e0 + 8);
          dots(ra, e0);
          if (e0 + 16 < 128) ldrows(ra, tu, e0 + 16);
          dots(rb, e0 + 8);
        }
      }
      float d0 = dv0 * (1.f / PEER_U_SCALE), d1 = dv1 * (1.f / PEER_U_SCALE);
      float a0 = 0.5f * d0 * (1.f + erff(d0 * 0.7071067811865476f));
      float a1 = 0.5f * d1 * (1.f + erff(d1 * 0.7071067811865476f));
      scoef[lane] = pwt[lane] * a0 * (1.f / PEER_V_SCALE);
      scoef[64 + lane] = pwt[64 + lane] * a1 * (1.f / PEER_V_SCALE);
    }
    __builtin_amdgcn_s_waitcnt(0xc07f);
    __builtin_amdgcn_wave_barrier();
    for (int t = 0; t < nc; t++) {
      const int g = ((int)blockIdx.x + (c0 + t) * nb) * 4 + w;
      const float* scoef = scoef_w + t * 128;
      const int pi0 = W_pidx[(size_t)g * 128 + lane], pi1 = W_pidx[(size_t)g * 128 + 64 + lane];
      auto ldrows = [&](u32x4 (&r)[8], const unsigned char* tab, int e0) {
#pragma unroll
        for (int k = 0; k < 8; k++) {
          int e = e0 + k;
          int idx = __builtin_amdgcn_readlane(e < 64 ? pi0 : pi1, e & 63);
          r[k] = *(const u32x4*)(tab + (size_t)idx * 1024);
        }
      };
      float o[16];
#pragma unroll
      for (int j = 0; j < 16; j++) o[j] = 0.f;
      auto accum = [&](const u32x4 (&r)[8], int e0) {
#pragma unroll
        for (int k = 0; k < 8; k++) {
          float cf = scoef[e0 + k];
          float f[16];
          unpack16(r[k], f);
#pragma unroll
          for (int j = 0; j < 16; j++) o[j] += cf * f[j];
        }
      };
      {
        u32x4 ra[8], rb[8];
        ldrows(ra, tv, 0);
#pragma unroll 1
        for (int e0 = 0; e0 < 128; e0 += 16) {
          ldrows(rb, tv, e0 + 8);
          accum(ra, e0);
          if (e0 + 16 < 128) ldrows(ra, tv, e0 + 16);
          accum(rb, e0 + 8);
        }
      }
      float* xr = x_out_row(p, l, g) + lane * 16;
      const float* m = W_mada + (l * 3 + cond_row(g)) * 6144 + lane * 16;
      float x1[16];
#pragma unroll
      for (int q = 0; q < 4; q++) {
        float4 xv = *(const float4*)(xr + q * 4);
        float4 g2 = *(const float4*)(m + 5120 + q * 4);
        x1[q * 4 + 0] = 1.4142135623730951f * xv.x + g2.x * o[q * 4 + 0];
        x1[q * 4 + 1] = 1.4142135623730951f * xv.y + g2.y * o[q * 4 + 1];
        x1[q * 4 + 2] = 1.4142135623730951f * xv.z + g2.z * o[q * 4 + 2];
        x1[q * 4 + 3] = 1.4142135623730951f * xv.w + g2.w * o[q * 4 + 3];
      }
      ln16(x1);
#pragma unroll
      for (int q = 0; q < 4; q++) {
        float4 a = *(const float4*)(p.ln2_g + l * 1024 + lane * 16 + q * 4);
        float4 c = *(const float4*)(p.ln2_b + l * 1024 + lane * 16 + q * 4);
        x1[q * 4 + 0] = x1[q * 4 + 0] * a.x + c.x; x1[q * 4 + 1] = x1[q * 4 + 1] * a.y + c.y;
        x1[q * 4 + 2] = x1[q * 4 + 2] * a.z + c.z; x1[q * 4 + 3] = x1[q * 4 + 3] * a.w + c.w;
        *(float4*)(xr + q * 4) = float4{x1[q * 4], x1[q * 4 + 1], x1[q * 4 + 2], x1[q * 4 + 3]};
      }
      if (l == 0) {
        ln16(x1);
        const float* m1 = W_mada + (1 * 3 + cond_row(g)) * 6144 + lane * 16;
#pragma unroll
        for (int q = 0; q < 4; q++) {
          float4 a = *(const float4*)(m1 + 1024 + q * 4);
          float4 b = *(const float4*)(m1 + q * 4);
          ushort4 ov;
          ov.x = f2bf(x1[q * 4 + 0] * (1.f + a.x) + b.x);
          ov.y = f2bf(x1[q * 4 + 1] * (1.f + a.y) + b.y);
          ov.z = f2bf(x1[q * 4 + 2] * (1.f + a.z) + b.z);
          ov.w = f2bf(x1[q * 4 + 3] * (1.f + a.w) + b.w);
          *(ushort4*)(W_u + (size_t)g * 1024 + lane * 16 + q * 4) = ov;
          *(int*)(W_u8 + (size_t)g * 1024 + lane * 16 + q * 4) = pack_fp8x4(x1[q * 4 + 0] * (1.f + a.x) + b.x, x1[q * 4 + 1] * (1.f + a.y) + b.y,
                                                                             x1[q * 4 + 2] * (1.f + a.z) + b.z, x1[q * 4 + 3] * (1.f + a.w) + b.w);
        }
      }
    }
  }
}

#define N_PHASES 28
__device__ __forceinline__ void run_phase(const P& p, int ph, char* smem) {
#ifdef ONLYQ
  { int l = ph & 1; if (ONLYQ == -1) { phase_prep(p, smem); return; } if (ONLYQ == -2) { phase_ln0(p); return; }
    switch (ONLYQ) { case 0: phase_win(p, l, smem); break; case 1: phase_post(p, l); break; case 2: phase_small_gemms(p, l, smem); break; case 3: phase_mixers(p, l, smem); break; case 4: phase_gla_scan(p, l); break; case 5: phase_gla_out(p, l, smem); break; case 6: phase_merge(p, l, smem); break; case 7: phase_wout(p, l, smem); break; case 8: phase_ln_mid(p, l); break; case 9: phase_pq(p, l, smem); break; case 10: phase_scores(p, l, smem); break; case 11: phase_topk(p, l); break; case 12: phase_peer(p, l, smem); break; } return; }
#endif
  if (ph == 0) { phase_prep(p, smem); return; }
  if (ph == 1) { phase_ln0(p); return; }
  int l = (ph - 2) / 13, q = (ph - 2) % 13;
#ifdef EXCL
  if (q == EXCL) return;
#endif
  switch (q) {
    case 0: phase_win(p, l, smem); break;
    case 1: phase_post(p, l); break;
    case 2: phase_small_gemms(p, l, smem); break;
    case 3: phase_mixers(p, l, smem); break;
    case 4: phase_gla_scan(p, l); break;
    case 5: phase_gla_out(p, l, smem); break;
    case 6: phase_merge(p, l, smem); break;
    case 7: phase_wout(p, l, smem); break;
    case 8: phase_ln_mid(p, l); break;
    case 9: phase_pq(p, l, smem); break;
    case 10: phase_scores(p, l, smem); break;
    case 11: phase_topk(p, l); break;
    case 12: phase_peer(p, l, smem); break;
  }
}

#define XB_TMO      128
#define XB_XCNT(j)  (256  + 64 * (j))
#define XB_XSUB(j)  (1280 + 64 * (j))
#define XB_XGEN(j)  (2304 + 64 * (j))
#define XB_TOP      3328
#define XB_TOPGEN   3392
#define XCD_BAR_WORDS 3456
#define XB_SPIN_CAP (1u << 18)
#define LAS __attribute__((address_space(3)))

__device__ __forceinline__ unsigned xb_ld(unsigned* p)              { return __hip_atomic_load(p, __ATOMIC_RELAXED, __HIP_MEMORY_SCOPE_AGENT); }
__device__ __forceinline__ unsigned xb_add(unsigned* p, unsigned v) { return __hip_atomic_fetch_add(p, v, __ATOMIC_RELAXED, __HIP_MEMORY_SCOPE_AGENT); }
__device__ __forceinline__ unsigned xb_xcc_id() { return (unsigned)__builtin_amdgcn_s_getreg((3 << 11) | 20) & 0xFu; }
#define XB_SPIN(cond, bar) do { unsigned _sp = 0; while (cond) { __builtin_amdgcn_s_sleep(1); \
    if ((++_sp & 255u) == 0u) { if (xb_ld(&(bar)[XB_TMO])) break; if (_sp > XB_SPIN_CAP) { atomicAdd(&(bar)[XB_TMO], 1u); break; } } } } while (0)

struct XcdBarrier {
    unsigned* bar; unsigned x;
    volatile LAS unsigned* st;
};

__device__ __forceinline__ XcdBarrier xcd_barrier_post(unsigned* bar, volatile LAS unsigned* st) {
    XcdBarrier b; b.bar = bar; b.x = xb_xcc_id(); b.st = st;
    if (threadIdx.x == 0) (void)xb_add(&bar[XB_XCNT(b.x)], 1u);
    return b;
}
__device__ __forceinline__ void xcd_barrier_complete(unsigned* bar, unsigned x, unsigned& nloc, unsigned& nx) {
    const unsigned G = gridDim.x * gridDim.y * gridDim.z;
    unsigned sum, cnt, mine, sp = 0u;
    for (;;) {
        sum = 0u; cnt = 0u; mine = 0u;
#pragma unroll
        for (unsigned j = 0; j < 16; ++j) { const unsigned c = xb_ld(&bar[XB_XCNT(j)]); sum += c; cnt += (c > 0u) ? 1u : 0u; mine = (j == x) ? c : mine; }
        if (sum == G) break;
        __builtin_amdgcn_s_sleep(1);
        if ((++sp & 255u) == 0u) { if (xb_ld(&bar[XB_TMO])) break; if (sp > XB_SPIN_CAP) { atomicAdd(&bar[XB_TMO], 1u); break; } }
    }
    nloc = mine > 0u ? mine : 1u; nx = cnt > 0u ? cnt : 1u;
}

__device__ __forceinline__ void xcd_barrier(const XcdBarrier& b) {
    asm volatile("s_waitcnt vmcnt(0)" ::: "memory");
    __syncthreads();
    if (threadIdx.x == 0) {
        unsigned* bar = b.bar;
        __builtin_amdgcn_s_waitcnt(0);
        unsigned nloc = b.st[0], nx = b.st[1];
        if (nloc == 0u) { xcd_barrier_complete(bar, b.x, nloc, nx); b.st[0] = nloc; b.st[1] = nx; }
        const unsigned old = xb_add(&bar[XB_XSUB(b.x)], 1u);
        const unsigned gen = old / nloc;
        if (old + 1u == (gen + 1u) * nloc) {
            __builtin_amdgcn_fence(__ATOMIC_RELEASE, "agent");
            asm volatile("s_waitcnt vmcnt(0)" ::: "memory");
            const unsigned og = xb_add(&bar[XB_TOP], 1u);
            const unsigned tg = og / nx;
            if (og + 1u == (tg + 1u) * nx) xb_add(&bar[XB_TOPGEN], 1u);
            else XB_SPIN(xb_ld(&bar[XB_TOPGEN]) == tg, bar);
            __builtin_amdgcn_fence(__ATOMIC_ACQUIRE, "agent");
            xb_add(&bar[XB_XGEN(b.x)], 1u);
            asm volatile("s_waitcnt vmcnt(0)" ::: "memory");
        } else {
            XB_SPIN(xb_ld(&bar[XB_XGEN(b.x)]) == gen, bar);
            __builtin_amdgcn_fence(__ATOMIC_ACQUIRE, "agent");
            asm volatile("s_waitcnt vmcnt(0)" ::: "memory");
        }
    }
    __syncthreads();
}


#define SMEM_BYTES 61440

#if MULTI
__global__ void __launch_bounds__(256, 2) k_phase(P p, int ph) {
  __shared__ __attribute__((aligned(16))) char smem[SMEM_BYTES];
  run_phase(p, ph, smem);
}
#else
__global__ void __launch_bounds__(256, 2) k_mega(P p) {
  __shared__ __attribute__((aligned(16))) char smem[SMEM_BYTES];
  __shared__ uint4 xb_words;
  cg::grid_group grid = cg::this_grid();
  if (threadIdx.x == 0) xb_words = make_uint4(0u, 0u, 0u, 0u);
  __syncthreads();
  XcdBarrier xb = xcd_barrier_post((unsigned*)(p.ws + OFF_bar), (volatile LAS unsigned*)&xb_words);
#pragma nounroll
  for (int ph = 0; ph < N_PHASES; ph++) {
    if (ph >= 2 && (ph - 2) % 13 == 10) continue;
    run_phase(p, ph, smem);
#ifdef DUPMASK
    if (ph >= 2 && ((DUPMASK >> ((ph - 2) % 13)) & 1)) run_phase(p, ph, smem);
#endif
    if (ph + 1 < N_PHASES) {
      if (gridDim.y > 1) grid.sync();
      xcd_barrier(xb);
    }
  }
}
#endif

extern "C" void kernel_launch(void* const* d_in, const int* in_sizes, int n_in, void* d_out, int out_size, void* d_ws,
                              size_t ws_size, hipStream_t stream) {
  P p{};
  const float** fp = (const float**)&p;
  for (int i = 0; i < 32; i++) fp[i] = (const float*)d_in[i];
  p.out = (float*)d_out;
  p.ws = (char*)d_ws;
  size_t off = WS_TOTAL;
  if (off > ws_size) { fprintf(stderr, "ws too small: need %zu have %zu\n", off, ws_size); return; }
#if MULTI
  for (int ph = 0; ph < N_PHASES; ph++) hipLaunchKernelGGL(k_phase, dim3(512), dim3(256), 0, stream, p, ph);
#else
  static int grid_blocks = 0;
  if (!grid_blocks) {
    int dev = 0, cus = 0, per_cu = 0;
    hipGetDevice(&dev);
    hipDeviceGetAttribute(&cus, hipDeviceAttributeMultiprocessorCount, dev);
    hipOccupancyMaxActiveBlocksPerMultiprocessor(&per_cu, k_mega, 256, 0);
    if (per_cu > 2) per_cu = 2;
    grid_blocks = cus * per_cu;
  }
  hipMemsetAsync(p.ws + OFF_bar, 0, 16384, stream);
  void* args[] = {&p};
  hipError_t e = hipLaunchCooperativeKernel((void*)k_mega, dim3(grid_blocks), dim3(256), args, 0, stream);
  if (e != hipSuccess) fprintf(stderr, "cooperative launch failed: %s (grid %d)\n", hipGetErrorString(e), grid_blocks);
#endif
}
```
